# Optimizing an MI355X kernel written in HIP

```python
import math
import jax, jax.numpy as jnp
from jax import lax
import numpy as np

D_MODEL = 1024
BATCH = 4
SEQ = 4096
DEPTH = 1

GRID_W = 64
HEAD_DIM = 64
A_HEADS = 8
A_KV = 2
B_HEADS = 8
B_KV = 2
Q_BLOCK = 128
WINDOW = 128
ROPE_THETA = 10000.0
N_BUCKETS = 32
MAX_DISTANCE = 128
PEER_HEADS = 8
PEER_NKEYS = 128
PEER_EXPERTS = PEER_NKEYS * PEER_NKEYS
PEER_TOPK = 16
PEER_DQ = 256
PEER_CHUNK = 128
EPS = 1e-6
NEG = -1e30

A_QW = A_HEADS * HEAD_DIM
A_KVW = A_KV * HEAD_DIM
B_QW = B_HEADS * HEAD_DIM
B_KVW = B_KV * HEAD_DIM
IN_WIDTHS = [A_QW, A_KVW, A_KVW, B_QW, B_KVW, B_KVW, D_MODEL, D_MODEL]
IN_WIDTH = sum(IN_WIDTHS)
IN_OFFSETS = [int(o) for o in np.cumsum(IN_WIDTHS)[:-1]]

kernel_name = "hybrid_gated_axial_window_peer"


def rmsnorm(x, g):
    xf = x.astype(jnp.float32)
    y = xf * lax.rsqrt(jnp.mean(xf * xf, axis=-1, keepdims=True) + EPS)
    return (y * g.astype(jnp.float32)).astype(x.dtype)


def rope1d(u, pos):
    half = u.shape[-1] // 2
    freqs = ROPE_THETA ** (-jnp.arange(half, dtype=jnp.float32) / half)
    ang = pos.astype(jnp.float32)[:, None] * freqs[None, :]
    cos = jnp.cos(ang)[None, :, None, :].astype(u.dtype)
    sin = jnp.sin(ang)[None, :, None, :].astype(u.dtype)
    u1, u2 = u[..., :half], u[..., half:]
    return jnp.concatenate([u1 * cos - u2 * sin, u2 * cos + u1 * sin], axis=-1)


def axial_rope(t, row, col):
    rd = t.shape[-1] // 2
    return jnp.concatenate([rope1d(t[..., :rd], row), rope1d(t[..., rd:], col)], axis=-1)


def dense_gqa_blocks(q, k, v):
    bsz, s = q.shape[0], q.shape[1]
    nb = s // Q_BLOCK
    r = A_HEADS // A_KV
    scale = HEAD_DIM ** -0.5
    qb = q.reshape(bsz, nb, Q_BLOCK, A_KV, r, HEAD_DIM).transpose(1, 0, 2, 3, 4, 5)

    def one_block(qblk):
        sc = jnp.einsum('bqgrd,bkgd->bgrqk', qblk, k).astype(jnp.float32) * scale
        p = jax.nn.softmax(sc, axis=-1)
        return jnp.einsum('bgrqk,bkgd->bqgrd', p.astype(v.dtype), v)

    o = lax.map(one_block, qb)
    return o.transpose(1, 0, 2, 3, 4, 5).reshape(bsz, s, A_HEADS * HEAD_DIM)


def t5_bucket(rel):
    nbk = N_BUCKETS // 2
    max_exact = nbk // 2
    ret = jnp.where(rel > 0, nbk, 0)
    n = jnp.abs(rel)
    large = max_exact + (jnp.log(jnp.maximum(n, 1).astype(jnp.float32) / max_exact)
                         / math.log(MAX_DISTANCE / max_exact) * (nbk - max_exact)).astype(jnp.int32)
    large = jnp.minimum(large, nbk - 1)
    return ret + jnp.where(n < max_exact, n, large)


def windowed_gqa_sink(q, k, v, rel_bias, sink):
    bsz, s = q.shape[0], q.shape[1]
    nb = s // Q_BLOCK
    r = B_HEADS // B_KV
    scale = HEAD_DIM ** -0.5
    pad = ((0, 0), (Q_BLOCK, Q_BLOCK), (0, 0), (0, 0))
    kb = jnp.pad(k, pad).reshape(bsz, nb + 2, Q_BLOCK, B_KV, HEAD_DIM)
    vb = jnp.pad(v, pad).reshape(bsz, nb + 2, Q_BLOCK, B_KV, HEAD_DIM)
    kwin = jnp.concatenate([kb[:, :-2], kb[:, 1:-1], kb[:, 2:]], axis=2)
    vwin = jnp.concatenate([vb[:, :-2], vb[:, 1:-1], vb[:, 2:]], axis=2)
    qb = q.reshape(bsz, nb, Q_BLOCK, B_KV, r, HEAD_DIM)

    qi = jnp.arange(Q_BLOCK)
    kj = jnp.arange(3 * Q_BLOCK)
    rel = kj[None, :] - Q_BLOCK - qi[:, None]
    bias = rel_bias[t5_bucket(rel)].astype(jnp.float32)
    bias = bias.transpose(2, 0, 1).reshape(B_KV, r, Q_BLOCK, 3 * Q_BLOCK)
    kpos = jnp.arange(nb)[:, None] * Q_BLOCK - Q_BLOCK + kj[None, :]
    inb = (kpos >= 0) & (kpos < s)
    mask = inb[:, None, :] & (jnp.abs(rel) <= WINDOW)[None]

    sc = jnp.einsum('bnqgrd,bnkgd->bngrqk', qb, kwin).astype(jnp.float32) * scale + bias[None, None]
    sc = jnp.where(mask[None, :, None, None], sc, NEG)
    sink_l = sink.astype(jnp.float32).reshape(B_KV, r, 1, 1)
    m = jnp.maximum(jnp.max(sc, axis=-1, keepdims=True), sink_l)
    p = jnp.exp(sc - m)
    p = p / (jnp.sum(p, axis=-1, keepdims=True) + jnp.exp(sink_l - m))
    o = jnp.einsum('bngrqk,bnkgd->bnqgrd', p.astype(v.dtype), vwin)
    return o.reshape(bsz, s, B_HEADS * HEAD_DIM)


def peer_ffn(xn, wq, subkeys, u_tab, v_tab):
    bsz, s, d = xn.shape
    q = (xn @ wq).reshape(bsz, s, PEER_HEADS, 2, PEER_DQ // 2)
    sc = jnp.einsum('bshcd,hcnd->bshcn', q, subkeys).astype(jnp.float32)
    s1, i1 = lax.top_k(sc[..., 0, :], PEER_TOPK)
    s2, i2 = lax.top_k(sc[..., 1, :], PEER_TOPK)
    cand = (s1[..., :, None] + s2[..., None, :]).reshape(bsz, s, PEER_HEADS, PEER_TOPK * PEER_TOPK)
    top_s, ci = lax.top_k(cand, PEER_TOPK)
    e_idx = (jnp.take_along_axis(i1, ci // PEER_TOPK, axis=-1) * PEER_NKEYS
             + jnp.take_along_axis(i2, ci % PEER_TOPK, axis=-1))
    gates = jax.nn.softmax(top_s, axis=-1).astype(xn.dtype)

    t = bsz * s
    nc = t // PEER_CHUNK
    xc = xn.reshape(nc, PEER_CHUNK, d)
    ec = e_idx.reshape(nc, PEER_CHUNK, PEER_HEADS, PEER_TOPK)
    gc = gates.reshape(nc, PEER_CHUNK, PEER_HEADS, PEER_TOPK)

    def one_chunk(args):
        xk, ek, gk = args
        u = jnp.take(u_tab, ek, axis=0)
        a = jnp.einsum('cd,chkd->chk', xk, u)
        w = gk * jax.nn.gelu(a, approximate=False)
        vv = jnp.take(v_tab, ek, axis=0)
        return jnp.einsum('chk,chkd->cd', w, vv)

    out = lax.map(one_chunk, (xc, ec, gc))
    return out.reshape(bsz, s, d)


def setup_inputs(seed: int = 0) -> dict:
    key = jax.random.key(seed)
    ks = jax.random.split(key, 20)
    f32 = jnp.float32
    nrm = lambda k, shp, sc: jax.random.normal(k, shp, f32) * sc
    return {
        'x': nrm(ks[0], (BATCH, SEQ, D_MODEL), 1.0),
        'g_mix': 1.0 + nrm(ks[1], (DEPTH, D_MODEL), 0.02),
        'w_in': nrm(ks[2], (DEPTH, D_MODEL, IN_WIDTH), D_MODEL ** -0.5),
        'b_gate': nrm(ks[3], (DEPTH, 2 * D_MODEL), 0.02),
        'q_norm_g': 1.0 + nrm(ks[4], (DEPTH, HEAD_DIM), 0.02),
        'k_norm_g': 1.0 + nrm(ks[5], (DEPTH, HEAD_DIM), 0.02),
        'rel_bias': nrm(ks[6], (N_BUCKETS, B_HEADS), 0.1),
        'sink': nrm(ks[7], (DEPTH, B_HEADS), 0.5),
        'w_branch_a': nrm(ks[8], (DEPTH, A_QW, D_MODEL), A_QW ** -0.5),
        'w_branch_b': nrm(ks[9], (DEPTH, B_QW, D_MODEL), B_QW ** -0.5),
        'w_out': nrm(ks[10], (DEPTH, D_MODEL, D_MODEL), D_MODEL ** -0.5),
        'g_ffn': 1.0 + nrm(ks[11], (DEPTH, D_MODEL), 0.02),
        'peer_wq': nrm(ks[12], (DEPTH, D_MODEL, PEER_HEADS * PEER_DQ), D_MODEL ** -0.5),
        'peer_subkeys': nrm(ks[13], (DEPTH, PEER_HEADS, 2, PEER_NKEYS, PEER_DQ // 2), (PEER_DQ // 2) ** -0.5),
        'peer_u': nrm(ks[14], (DEPTH, PEER_EXPERTS, D_MODEL), D_MODEL ** -0.5),
        'peer_v': nrm(ks[15], (DEPTH, PEER_EXPERTS, D_MODEL), 0.5),
        'g_final': 1.0 + nrm(ks[16], (D_MODEL,), 0.02),
    }


def reference(x, g_mix, w_in, b_gate, q_norm_g, k_norm_g, rel_bias, sink, w_branch_a, w_branch_b,
              w_out, g_ffn, peer_wq, peer_subkeys, peer_u, peer_v, g_final):
    bsz, s, d = x.shape
    rows = s // GRID_W
    row = jnp.broadcast_to(jnp.arange(rows)[:, None], (rows, GRID_W)).reshape(-1)
    col = jnp.broadcast_to(jnp.arange(GRID_W)[None, :], (rows, GRID_W)).reshape(-1)
    h = x
    for l in range(DEPTH):
        n = rmsnorm(h, g_mix[l])
        z = n @ w_in[l]
        qa, ka, va, qb, kb, vb, ga, gb = jnp.split(z, IN_OFFSETS, axis=-1)
        qa = axial_rope(rmsnorm(qa.reshape(bsz, s, A_HEADS, HEAD_DIM), q_norm_g[l]), row, col)
        ka = axial_rope(rmsnorm(ka.reshape(bsz, s, A_KV, HEAD_DIM), k_norm_g[l]), row, col)
        va = va.reshape(bsz, s, A_KV, HEAD_DIM)
        oa = dense_gqa_blocks(qa, ka, va)
        ob = windowed_gqa_sink(qb.reshape(bsz, s, B_HEADS, HEAD_DIM),
                               kb.reshape(bsz, s, B_KV, HEAD_DIM),
                               vb.reshape(bsz, s, B_KV, HEAD_DIM), rel_bias, sink[l])
        gate_a = jax.nn.sigmoid(ga + b_gate[l, :D_MODEL])
        gate_b = jax.nn.sigmoid(gb + b_gate[l, D_MODEL:])
        mix = gate_a * (oa @ w_branch_a[l]) + gate_b * (ob @ w_branch_b[l])
        h = h + mix @ w_out[l]
        h = h + peer_ffn(rmsnorm(h, g_ffn[l]), peer_wq[l], peer_subkeys[l], peer_u[l], peer_v[l])
    return rmsnorm(h, g_final)
```

```cpp
#include <hip/hip_runtime.h>
#include <cstdio>
#include <cstdint>
#include <cmath>
namespace pg8 {
#define PG8_LAS __attribute__((address_space(3)))
typedef unsigned short bf16_t;
typedef short bf16x8 __attribute__((ext_vector_type(8)));
typedef float f32x4 __attribute__((ext_vector_type(4)));
typedef unsigned u32x4 __attribute__((ext_vector_type(4)));
constexpr int BM = 256, BK = 64, HALF = 128, HTB = HALF * BK * 2  , STAGE_BYTES = 8 * HTB, NXCD = 8, WGM = 8;

__host__ __device__ __forceinline__ int lds_byte(int r, int c) { const int st = (r >> 4) * 2 + (c >> 5), rr = r & 15, cc = c & 31, ob = rr * 64 + cc * 2; return st * 1024 + (ob ^ (((ob >> 9) & 1) << 5)); }
__host__ __device__ __forceinline__ void stage_rc(int b, int& R, int& C) { const int st = b / 1024, sb = b % 1024, swz = sb ^ (((sb >> 9) & 1) << 5); R = (st >> 1) * 16 + swz / 64; C = (st & 1) * 32 + (swz % 64) / 2; }
__host__ __device__ __forceinline__ int perm32(int rho) { const int n = rho >> 4, i = rho & 15; return 8 * (i >> 2) + 4 * n + (i & 3); }

struct Unit { int pm, pn; };
struct Gemm { const bf16_t* A; const bf16_t* Bt; int M, N, K; };

struct StaticOrder {
    int nM, nN, nwg, G, c;
    __host__ __device__ void init(int M, int N, int G_, int c_) { nM = M / BM; nN = N / BM; nwg = nM * nN; G = G_; c = c_; }
    __host__ __device__ bool next(int i, Unit& u) const {
        const long L = (long)i * G + c; if (L >= nwg) return false;
        int wgid = (int)L; { const int q = nwg / NXCD, r = nwg % NXCD, xcd = wgid % NXCD, off = wgid / NXCD; wgid = (xcd < r ? xcd * (q + 1) : r * (q + 1) + (xcd - r) * q) + off; }
        const int nig = WGM * nN, gid = wgid / nig, fm = gid * WGM, gsz = (nM - fm) < WGM ? (nM - fm) : WGM;
        u.pm = fm + ((wgid % nig) % gsz); u.pn = (wgid % nig) / gsz; return true;
    }
    __device__ __forceinline__ void a_ready(const Unit&) const {}
    __device__ __forceinline__ void done(const Unit&) const {}
};

__device__ __forceinline__ unsigned cvt_pk_bf16(float lo, float hi) { unsigned r; asm volatile("v_cvt_pk_bf16_f32 %0, %1, %2" : "=v"(r) : "v"(lo), "v"(hi)); return r; }
typedef float f32x2 __attribute__((ext_vector_type(2)));
template <class Epi, class Sched, bool ALIGN_EPI = false, bool SP2 = false>
__device__ __forceinline__ void gemm_phase(PG8_LAS unsigned char* lds, const Gemm g, const Sched& S, const Epi& E) {
    const int tid = threadIdx.x, wid = __builtin_amdgcn_readfirstlane(tid >> 6), lane = tid & 63, wr = wid >> 2, wc = wid & 3, fr = lane & 15, fq = lane >> 4;
    const int K = g.K, nt = K / BK;
    unsigned voffA[2], voffB[2];
#pragma unroll
    for (int i = 0; i < 2; ++i) { int R, C; stage_rc(tid * 16 + i * 8192, R, C); const int Rb = Epi::PERM ? ((R & ~31) + perm32(R & 31)) : R;
        voffA[i] = (unsigned)(R * K + C) * 2u; voffB[i] = (unsigned)(Rb * K + C) * 2u; }
    const size_t kstep = (size_t)(BK * 2);
    const size_t hstep = (size_t)HALF * K * 2;
    const size_t tstep = 2 * hstep;
    const unsigned ldsw = (unsigned)wid * 1024u;
    const int aoff = lds_byte(wr * 64 + fr, fq * 8), boff = lds_byte(wc * 32 + fr, fq * 8);
#define PG8_SA(b, h) (((b) * 2 + (h)) * HTB)
#define PG8_SB(b, h) ((4 + (b) * 2 + (h)) * HTB)
#define PG8_STAGE(bufoff, gbase, voff) do { _Pragma("unroll") for (int _i = 0; _i < 2; ++_i) \
        __builtin_amdgcn_global_load_lds((const unsigned*)((const char*)(gbase) + (voff)[_i]), (PG8_LAS unsigned*)(lds + (bufoff) + ldsw + _i * 8192), 16, 0, 0); } while (0)
#define PG8_LDA(dst, b, h) do { _Pragma("unroll") for (int m = 0; m < 4; ++m) _Pragma("unroll") for (int k = 0; k < 2; ++k) dst[m][k] = *(const PG8_LAS bf16x8*)(lds + PG8_SA(b, h) + aoff + m * 2048 + k * 1024); } while (0)
#define PG8_LDB(dst, b, h) do { _Pragma("unroll") for (int n = 0; n < 2; ++n) _Pragma("unroll") for (int k = 0; k < 2; ++k) dst[n][k] = *(const PG8_LAS bf16x8*)(lds + PG8_SB(b, h) + boff + n * 2048 + k * 1024); } while (0)
#define PG8_MMA(ai, bj, At, Bt) do { __builtin_amdgcn_s_setprio(1); _Pragma("unroll") for (int m = 0; m < 4; ++m) _Pragma("unroll") for (int n = 0; n < 2; ++n) _Pragma("unroll") for (int k = 0; k < 2; ++k) \
        acc[ai][bj][m][n] = __builtin_amdgcn_mfma_f32_16x16x32_bf16(Bt[n][k], At[m][k], acc[ai][bj][m][n], 0, 0, 0); __builtin_amdgcn_s_setprio(0); } while (0)
#define PG8_WAIT_V(n) asm volatile("s_waitcnt vmcnt(" #n ")" ::: "memory")
#define PG8_WAIT_L(n) asm volatile("s_waitcnt lgkmcnt(" #n ")" ::: "memory")
#define PG8_BAR __builtin_amdgcn_s_barrier()
#define PG8_SCHED __builtin_amdgcn_sched_barrier(0)
    Unit cur, nxt; int ui = 0;
    if (!S.next(0, cur)) return;
    f32x4 acc[2][2][4][2];
#pragma unroll
    for (int a = 0; a < 2; ++a)
#pragma unroll
        for (int b = 0; b < 2; ++b)
#pragma unroll
            for (int m = 0; m < 4; ++m)
#pragma unroll
                for (int n = 0; n < 2; ++n) acc[a][b][m][n] = (f32x4){0.f, 0.f, 0.f, 0.f};
    bf16x8 At[4][2], B0[2][2], B1[2][2];
    const char* cA = (const char*)g.A + (size_t)cur.pm * tstep; const char* cB = (const char*)g.Bt + (size_t)cur.pn * tstep;
    S.a_ready(cur);
    if constexpr (SP2) {
        PG8_STAGE(PG8_SB(0, 0), cB, voffB); PG8_STAGE(PG8_SB(0, 1), cB + hstep, voffB); PG8_STAGE(PG8_SA(0, 0), cA, voffA); PG8_STAGE(PG8_SA(0, 1), cA + hstep, voffA);
        if (wr == 1) PG8_BAR;
        PG8_WAIT_V(2); PG8_BAR;
        PG8_STAGE(PG8_SB(1, 0), cB + kstep, voffB); PG8_STAGE(PG8_SA(1, 0), cA + kstep, voffA); PG8_STAGE(PG8_SB(1, 1), cB + hstep + kstep, voffB);
        PG8_WAIT_V(6); PG8_BAR;
    } else {
        PG8_STAGE(PG8_SB(0, 0), cB, voffB); PG8_STAGE(PG8_SA(0, 0), cA, voffA); PG8_STAGE(PG8_SB(0, 1), cB + hstep, voffB); PG8_STAGE(PG8_SA(0, 1), cA + hstep, voffA);
        if (wr == 1) PG8_BAR;
        PG8_WAIT_V(4); PG8_BAR;
        PG8_STAGE(PG8_SB(1, 0), cB + kstep, voffB); PG8_STAGE(PG8_SA(1, 0), cA + kstep, voffA); PG8_STAGE(PG8_SB(1, 1), cB + hstep + kstep, voffB);
        PG8_WAIT_V(6); PG8_BAR;
    }
    for (;;) {
        const bool has_next = S.next(ui + 1, nxt);
        const char* nA = has_next ? (const char*)g.A + (size_t)nxt.pm * tstep : cA; const char* nB = has_next ? (const char*)g.Bt + (size_t)nxt.pn * tstep : cB;
        for (int t = 0; t < nt; t += 2) {
            const bool last = (t == nt - 2);
            const char* a1 = cA + (size_t)(t + 1) * kstep;
            const char* a2 = last ? nA : cA + (size_t)(t + 2) * kstep; const char* b2 = last ? nB : cB + (size_t)(t + 2) * kstep;
            const char* a3 = a2 + kstep; const char* b3 = b2 + kstep;
            if (last && has_next) S.a_ready(nxt);
            if constexpr (SP2) {
            PG8_LDB(B0, 0, 0); PG8_LDB(B1, 0, 1); PG8_SCHED; PG8_LDA(At, 0, 0); PG8_STAGE(PG8_SA(1, 1), a1 + hstep, voffA);
            PG8_WAIT_V(8); PG8_WAIT_L(0); PG8_BAR; PG8_MMA(0, 0, At, B0); PG8_MMA(0, 1, At, B1); PG8_BAR; PG8_SCHED;
            PG8_LDA(At, 0, 1); PG8_STAGE(PG8_SB(0, 0), b2, voffB); PG8_STAGE(PG8_SB(0, 1), b2 + hstep, voffB); PG8_STAGE(PG8_SA(0, 0), a2, voffA);
            PG8_WAIT_V(8); PG8_WAIT_L(0); PG8_BAR; PG8_MMA(1, 0, At, B0); PG8_MMA(1, 1, At, B1); PG8_BAR; PG8_SCHED;
            PG8_LDB(B0, 1, 0); PG8_LDB(B1, 1, 1); PG8_SCHED; PG8_LDA(At, 1, 0); PG8_STAGE(PG8_SA(0, 1), a2 + hstep, voffA);
            PG8_WAIT_V(8); PG8_WAIT_L(0); PG8_BAR; PG8_MMA(0, 0, At, B0); PG8_MMA(0, 1, At, B1); PG8_BAR; PG8_SCHED;
            PG8_LDA(At, 1, 1); PG8_STAGE(PG8_SB(1, 0), b3, voffB); PG8_STAGE(PG8_SB(1, 1), b3 + hstep, voffB); PG8_STAGE(PG8_SA(1, 0), a3, voffA);
            PG8_WAIT_V(8); PG8_WAIT_L(0); PG8_BAR; PG8_MMA(1, 0, At, B0); PG8_MMA(1, 1, At, B1); PG8_BAR; PG8_SCHED;
            } else {
            PG8_LDB(B0, 0, 0); PG8_SCHED; PG8_LDA(At, 0, 0); PG8_STAGE(PG8_SA(1, 1), a1 + hstep, voffA);
            PG8_WAIT_L(8); PG8_BAR; PG8_WAIT_L(0); PG8_MMA(0, 0, At, B0); PG8_BAR; PG8_SCHED;
            PG8_LDB(B1, 0, 1); PG8_STAGE(PG8_SB(0, 0), b2, voffB);
            PG8_BAR; PG8_WAIT_L(0); PG8_MMA(0, 1, At, B1); PG8_BAR;
            PG8_LDA(At, 0, 1); PG8_STAGE(PG8_SA(0, 0), a2, voffA);
            PG8_BAR; PG8_WAIT_L(0); PG8_MMA(1, 0, At, B0); PG8_BAR; PG8_SCHED;
            PG8_STAGE(PG8_SB(0, 1), b2 + hstep, voffB);
            PG8_WAIT_V(6); PG8_BAR; PG8_MMA(1, 1, At, B1); PG8_BAR;
            PG8_LDB(B0, 1, 0); PG8_SCHED; PG8_LDA(At, 1, 0); PG8_STAGE(PG8_SA(0, 1), a2 + hstep, voffA);
            PG8_WAIT_L(8); PG8_BAR; PG8_WAIT_L(0); PG8_MMA(0, 0, At, B0); PG8_BAR; PG8_SCHED;
            PG8_LDB(B1, 1, 1); PG8_STAGE(PG8_SB(1, 0), b3, voffB);
            PG8_BAR; PG8_WAIT_L(0); PG8_MMA(0, 1, At, B1); PG8_BAR;
            PG8_LDA(At, 1, 1); PG8_STAGE(PG8_SA(1, 0), a3, voffA);
            PG8_BAR; PG8_WAIT_L(0); PG8_MMA(1, 0, At, B0); PG8_BAR; PG8_SCHED;
            PG8_STAGE(PG8_SB(1, 1), b3 + hstep, voffB);
            PG8_WAIT_V(6); PG8_BAR; PG8_MMA(1, 1, At, B1); PG8_BAR;
            }
        }
        if constexpr (ALIGN_EPI) { if (wr == 0) PG8_BAR; }
        if constexpr (!Epi::AFTER_DRAIN) { E(acc, cur, wr, wc, fr, fq); S.done(cur); }
        if (!has_next) break;
#pragma unroll
        for (int a = 0; a < 2; ++a)
#pragma unroll
            for (int b = 0; b < 2; ++b)
#pragma unroll
                for (int m = 0; m < 4; ++m)
#pragma unroll
                    for (int n = 0; n < 2; ++n) acc[a][b][m][n] = (f32x4){0.f, 0.f, 0.f, 0.f};
        cur = nxt; cA = nA; cB = nB; ++ui;
        if constexpr (ALIGN_EPI) { if (wr == 1) PG8_BAR; }
    }
    PG8_WAIT_V(0);
    if constexpr (!ALIGN_EPI) { if (wr == 0) PG8_BAR; }
    PG8_BAR;
    if constexpr (Epi::AFTER_DRAIN) { E.fused(acc, cur, wr, wc, fr, fq, lds, wid, lane); S.done(cur); }
#undef PG8_SA
#undef PG8_SB
#undef PG8_STAGE
#undef PG8_LDA
#undef PG8_LDB
#undef PG8_MMA
#undef PG8_WAIT_V
#undef PG8_WAIT_L
#undef PG8_BAR
#undef PG8_SCHED
}
}

constexpr int DM = 1024, NB = 4, SEQ = 4096, NTOK = NB * SEQ;
constexpr int HD = 64, NH = 8, NKV = 2, QW = NH * HD  , GRIDW = 64;
constexpr int INW = 3584;
constexpr int PH = 8, NKEYS = 128, TOPK = 16, NEXP = NKEYS * NKEYS, SCW = PH * 2 * NKEYS  ;
constexpr float EPS = 1e-6f;
constexpr float LOG2E = 1.4426950408889634f;
constexpr float QSCALE = 0.125f * LOG2E;

typedef unsigned u32x2_t __attribute__((ext_vector_type(2)));
typedef float f32x2_t __attribute__((ext_vector_type(2)));
typedef __bf16 bf16x2_t __attribute__((ext_vector_type(2)));
__device__ __forceinline__ unsigned pkbf(float lo, float hi) { f32x2_t v = {lo, hi}; bf16x2_t b = __builtin_convertvector(v, bf16x2_t); return __builtin_bit_cast(unsigned, b); }
__device__ __forceinline__ float bflo(unsigned w) { return __builtin_bit_cast(float, w << 16); }
__device__ __forceinline__ float bfhi(unsigned w) { return __builtin_bit_cast(float, w & 0xffff0000u); }

__device__ __forceinline__ size_t kimg_off(int b, int kvh, int s, int dim) { return ((size_t)((b * NKV + kvh) * (SEQ / 64) + (s >> 6)) << 12) + (dim >> 3) * 512 + (s & 63) * 8 + (dim & 7); }
__device__ __forceinline__ size_t vimg_off(int b, int kvh, int s, int dim) { return ((size_t)((b * NKV + kvh) * (SEQ / 64) + (s >> 6)) << 12) + (dim >> 5) * 2048 + (s & 63) * 32 + (dim & 31); }

namespace pg8 {
struct EpiIn {
    static constexpr bool PERM = false, AFTER_DRAIN = false;
    bf16_t *Qa, *Ka, *Va, *Qb, *Kb, *Vb, *Ga, *Gb;
    const float *qg, *kg, *bgate, *rope;
    __device__ __forceinline__ void operator()(const f32x4 (&acc)[2][2][4][2], const Unit& u, int wr, int wc, int fr, int fq) const {
        const int pn = u.pn;
        if (pn >= 6) {
            const bool isA = pn < 10; bf16_t* G = isA ? Ga : Gb; const int ct = (isA ? pn - 6 : pn - 10) * BM; const float* bb = bgate + (isA ? 0 : DM);
            f32x4 bv[2][2];
#pragma unroll
            for (int bj = 0; bj < 2; ++bj)
#pragma unroll
                for (int n = 0; n < 2; ++n) bv[bj][n] = *(const f32x4*)(bb + ct + bj * HALF + wc * 32 + n * 16 + 4 * fq);
#pragma unroll
            for (int ai = 0; ai < 2; ++ai)
#pragma unroll
                for (int m = 0; m < 4; ++m) { const int row = u.pm * BM + ai * HALF + wr * 64 + m * 16 + fr; bf16_t* rp = G + (size_t)row * DM + ct + wc * 32 + 4 * fq;
#pragma unroll
                    for (int bj = 0; bj < 2; ++bj)
#pragma unroll
                        for (int n = 0; n < 2; ++n) { const f32x4 z = acc[ai][bj][m][n] + bv[bj][n]; f32x4 g;
#pragma unroll
                            for (int j = 0; j < 4; ++j) g[j] = __builtin_amdgcn_rcpf(1.0f + __builtin_amdgcn_exp2f(-LOG2E * z[j]));
                            u32x2_t w; w.x = pkbf(g[0], g[1]); w.y = pkbf(g[2], g[3]); *(u32x2_t*)(rp + bj * HALF + n * 16) = w; } }
            return;
        }
        const bool brA = pn < 3; const int pl = brA ? pn : pn - 3;
        const bool isq = pl < 2, isk = (!isq) && wc < 2;
        const bool normrope = brA && (isq || isk);
        f32x4 gv[2][2];
        if (normrope) { const float* g = isq ? qg : kg;
#pragma unroll
            for (int bj = 0; bj < 2; ++bj)
#pragma unroll
                for (int n = 0; n < 2; ++n) gv[bj][n] = *(const f32x4*)(g + 32 * bj + 16 * n + 4 * fq); }
        const float osc = isq ? QSCALE : 1.0f;
#pragma unroll
        for (int ai = 0; ai < 2; ++ai)
#pragma unroll
            for (int m = 0; m < 4; ++m) {
                const int row = u.pm * BM + ai * HALF + wr * 64 + m * 16 + fr; const int b = row >> 12, s = row & (SEQ - 1);
                f32x4 v[2][2];
#pragma unroll
                for (int bj = 0; bj < 2; ++bj)
#pragma unroll
                    for (int n = 0; n < 2; ++n) v[bj][n] = acc[ai][bj][m][n];
                if (normrope) {
                    float ss = 0.f;
#pragma unroll
                    for (int bj = 0; bj < 2; ++bj)
#pragma unroll
                        for (int n = 0; n < 2; ++n) ss += (v[bj][n][0] * v[bj][n][0] + v[bj][n][1] * v[bj][n][1]) + (v[bj][n][2] * v[bj][n][2] + v[bj][n][3] * v[bj][n][3]);
                    ss += __shfl_xor(ss, 16); ss += __shfl_xor(ss, 32);
                    const float rstd = 1.0f / sqrtf(ss * (1.0f / 64.0f) + EPS);
#pragma unroll
                    for (int bj = 0; bj < 2; ++bj) {
                        const int pos = bj == 0 ? (s >> 6) : (s & (GRIDW - 1));
                        const f32x4 cs0 = *(const f32x4*)(rope + (pos * 16 + 4 * fq) * 2), cs1 = *(const f32x4*)(rope + (pos * 16 + 4 * fq) * 2 + 4);
                        const float cc[4] = {cs0[0], cs0[2], cs1[0], cs1[2]}, sn[4] = {cs0[1], cs0[3], cs1[1], cs1[3]};
#pragma unroll
                        for (int j = 0; j < 4; ++j) { const float u1 = v[bj][0][j] * rstd * gv[bj][0][j], u2 = v[bj][1][j] * rstd * gv[bj][1][j];
                            v[bj][0][j] = u1 * cc[j] - u2 * sn[j]; v[bj][1][j] = u2 * cc[j] + u1 * sn[j]; }
                    }
                }
#pragma unroll
                for (int bj = 0; bj < 2; ++bj)
#pragma unroll
                    for (int n = 0; n < 2; ++n) {
                        const f32x4 o = v[bj][n] * osc; u32x2_t w; w.x = pkbf(o[0], o[1]); w.y = pkbf(o[2], o[3]);
                        const int dim = 32 * bj + 16 * n + 4 * fq;
                        bf16_t* dst;
                        if (isq) dst = (brA ? Qa : Qb) + (size_t)row * QW + (pl * 4 + wc) * HD + dim;
                        else if (wc < 2) dst = (brA ? Ka : Kb) + kimg_off(b, wc, s, dim);
                        else dst = (brA ? Va : Vb) + vimg_off(b, wc - 2, s, dim);
                        *(u32x2_t*)dst = w;
                    }
            }
    }
};

struct EpiMixA {
    static constexpr bool PERM = false, AFTER_DRAIN = false;
    bf16_t* G;
    __device__ __forceinline__ void operator()(const f32x4 (&acc)[2][2][4][2], const Unit& u, int wr, int wc, int fr, int fq) const {
#pragma unroll
        for (int ai = 0; ai < 2; ++ai)
#pragma unroll
            for (int m = 0; m < 4; ++m) { const int row = u.pm * BM + ai * HALF + wr * 64 + m * 16 + fr; bf16_t* rp = G + (size_t)row * DM + u.pn * BM + wc * 32 + 4 * fq;
#pragma unroll
                for (int bj = 0; bj < 2; ++bj)
#pragma unroll
                    for (int n = 0; n < 2; ++n) { u32x2_t* p = (u32x2_t*)(rp + bj * HALF + n * 16); const u32x2_t g = *p; const f32x4 a = acc[ai][bj][m][n];
                        u32x2_t w; w.x = pkbf(a[0] * bflo(g.x), a[1] * bfhi(g.x)); w.y = pkbf(a[2] * bflo(g.y), a[3] * bfhi(g.y)); *p = w; } }
    }
};
struct EpiMixB {
    static constexpr bool PERM = false, AFTER_DRAIN = false;
    const bf16_t* M1; bf16_t* G;
    __device__ __forceinline__ void operator()(const f32x4 (&acc)[2][2][4][2], const Unit& u, int wr, int wc, int fr, int fq) const {
#pragma unroll
        for (int ai = 0; ai < 2; ++ai)
#pragma unroll
            for (int m = 0; m < 4; ++m) { const int row = u.pm * BM + ai * HALF + wr * 64 + m * 16 + fr; const size_t off = (size_t)row * DM + u.pn * BM + wc * 32 + 4 * fq;
#pragma unroll
                for (int bj = 0; bj < 2; ++bj)
#pragma unroll
                    for (int n = 0; n < 2; ++n) { u32x2_t* p = (u32x2_t*)(G + off + bj * HALF + n * 16); const u32x2_t g = *p; const u32x2_t m1 = *(const u32x2_t*)(M1 + off + bj * HALF + n * 16); const f32x4 a = acc[ai][bj][m][n];
                        u32x2_t w; w.x = pkbf(bflo(m1.x) + a[0] * bflo(g.x), bfhi(m1.x) + a[1] * bfhi(g.x)); w.y = pkbf(bflo(m1.y) + a[2] * bflo(g.y), bfhi(m1.y) + a[3] * bfhi(g.y)); *p = w; } }
    }
};
struct EpiOut {
    static constexpr bool PERM = false, AFTER_DRAIN = false;
    const float* X; float* H; bf16_t* HB; float* ssq;
    __device__ __forceinline__ void operator()(const f32x4 (&acc)[2][2][4][2], const Unit& u, int wr, int wc, int fr, int fq) const {
#pragma unroll
        for (int ai = 0; ai < 2; ++ai)
#pragma unroll
            for (int m = 0; m < 4; ++m) { const int row = u.pm * BM + ai * HALF + wr * 64 + m * 16 + fr; const size_t off = (size_t)row * DM + u.pn * BM + wc * 32 + 4 * fq; float ss = 0.f;
#pragma unroll
                for (int bj = 0; bj < 2; ++bj)
#pragma unroll
                    for (int n = 0; n < 2; ++n) { const size_t o2 = off + bj * HALF + n * 16; const f32x4 h = *(const f32x4*)(X + o2) + acc[ai][bj][m][n];
                        *(f32x4*)(H + o2) = h; u32x2_t w; w.x = pkbf(h[0], h[1]); w.y = pkbf(h[2], h[3]); *(u32x2_t*)(HB + o2) = w;
                        ss += (h[0] * h[0] + h[1] * h[1]) + (h[2] * h[2] + h[3] * h[3]); }
                ss += __shfl_xor(ss, 16); ss += __shfl_xor(ss, 32);
                if (fq == 0) ssq[(size_t)row * 16 + u.pn * 4 + wc] = ss; }
    }
};
struct EpiScore {
    static constexpr bool PERM = false, AFTER_DRAIN = false;
    const float* ssq; float* SC;
    __device__ __forceinline__ void operator()(const f32x4 (&acc)[2][2][4][2], const Unit& u, int wr, int wc, int fr, int fq) const {
#pragma unroll
        for (int ai = 0; ai < 2; ++ai)
#pragma unroll
            for (int m = 0; m < 4; ++m) { const int row = u.pm * BM + ai * HALF + wr * 64 + m * 16 + fr;
                const f32x4* sp = (const f32x4*)(ssq + (size_t)row * 16); const f32x4 s0 = sp[0], s1 = sp[1], s2 = sp[2], s3 = sp[3];
                const float tot = (((s0[0] + s0[1]) + (s0[2] + s0[3])) + ((s1[0] + s1[1]) + (s1[2] + s1[3]))) + (((s2[0] + s2[1]) + (s2[2] + s2[3])) + ((s3[0] + s3[1]) + (s3[2] + s3[3])));
                const float rstd = 1.0f / sqrtf(tot * (1.0f / DM) + EPS);
                float* rp = SC + (size_t)row * SCW + u.pn * BM + wc * 32 + 4 * fq;
#pragma unroll
                for (int bj = 0; bj < 2; ++bj)
#pragma unroll
                    for (int n = 0; n < 2; ++n) *(f32x4*)(rp + bj * HALF + n * 16) = acc[ai][bj][m][n] * rstd; }
    }
};
}

#define LAS __attribute__((address_space(3)))
namespace attn {
typedef unsigned short bf16_t;
typedef short bf16x8 __attribute__((ext_vector_type(8)));
typedef short s16x4 __attribute__((ext_vector_type(4)));
typedef float f32x16 __attribute__((ext_vector_type(16)));
typedef unsigned u32x4 __attribute__((ext_vector_type(4)));
constexpr int LDS_KV = 0;
constexpr int LDS_BIAS = 32768;
constexpr int LDS_BYTES = 32768 + 2048;
__device__ __forceinline__ int crow(int r, int hi) { return (r & 3) + 8 * (r >> 2) + 4 * hi; }
__device__ __forceinline__ s16x4 vtr(const LAS char* p) { return __builtin_bit_cast(s16x4, __builtin_amdgcn_ds_read_tr16_b64_v4i16((LAS s16x4*)p)); }
__device__ __forceinline__ float xhalf_max(float v) { auto rr = __builtin_amdgcn_permlane32_swap(__float_as_uint(v), __float_as_uint(v), false, false); return fmaxf(__uint_as_float(rr[0]), __uint_as_float(rr[1])); }
__device__ __forceinline__ float xhalf_sum(float v) { auto rr = __builtin_amdgcn_permlane32_swap(__float_as_uint(v), __float_as_uint(v), false, false); return __uint_as_float(rr[0]) + __uint_as_float(rr[1]); }

template <bool WIN>
__device__ __forceinline__ void attn_unit(LAS char* lds, const bf16_t* Q, const bf16_t* Kimg, const bf16_t* Vimg, bf16_t* O, int b, int h, int qblk, const float* bias_h  , float sink_l2) {
    const int tid = threadIdx.x, lane = tid & 63, r32 = lane & 31, hi = lane >> 5; const int wid = __builtin_amdgcn_readfirstlane(tid >> 6);
    const int q0 = qblk * 256, qw0 = q0 + 32 * wid, qrow = qw0 + r32; const size_t grow = (size_t)b * SEQ + qrow;
    const int kvh = h >> 2;
    const bf16_t* Kb = Kimg + ((size_t)((b * NKV + kvh) * (SEQ / 64)) << 12);
    const bf16_t* Vb = Vimg + ((size_t)((b * NKV + kvh) * (SEQ / 64)) << 12);
    int t_lo = 0, t_hi = SEQ / 64 - 1;
    if (WIN) { t_lo = q0 / 64 - 2; if (t_lo < 0) t_lo = 0; t_hi = q0 / 64 + 5; if (t_hi > SEQ / 64 - 1) t_hi = SEQ / 64 - 1; }
    bf16x8 qr[4];
#pragma unroll
    for (int d0 = 0; d0 < 4; ++d0) qr[d0] = *(const bf16x8*)(Q + grow * QW + h * HD + d0 * 16 + hi * 8);
    LAS float* biasl = (LAS float*)(lds + LDS_BIAS);
    if (WIN) { if (tid < 257) biasl[tid] = bias_h[tid]; }
    u32x4 kreg = *(const u32x4*)(Kb + ((size_t)t_lo << 12) + tid * 8), vreg = *(const u32x4*)(Vb + ((size_t)t_lo << 12) + tid * 8);
    *(LAS u32x4*)(lds + LDS_KV + tid * 16) = kreg; *(LAS u32x4*)(lds + LDS_KV + 8192 + tid * 16) = vreg;
    __syncthreads();
    f32x16 o0 = {}, o1 = {};
    float mrun = WIN ? sink_l2 : -1e30f, lsum = (WIN && hi == 0) ? 1.0f : 0.0f;
    const int vlane = ((lane >> 4) & 1) * 32 + (lane & 3) * 8 + (4 * hi + ((lane & 15) >> 2)) * 64;
    for (int t = t_lo; t <= t_hi; ++t) {
        const int cur = (t - t_lo) & 1;
        const LAS char* Kl = lds + LDS_KV + cur * 16384; const LAS char* Vl = Kl + 8192;
        if (t < t_hi) { kreg = *(const u32x4*)(Kb + ((size_t)(t + 1) << 12) + tid * 8); vreg = *(const u32x4*)(Vb + ((size_t)(t + 1) << 12) + tid * 8); }
        bool active = true;
        if (WIN) active = (64 * t + 63 >= qw0 - 128) && (64 * t <= qw0 + 31 + 128);
        if (active) {
            f32x16 p0 = {}, p1 = {};
#pragma unroll
            for (int d0 = 0; d0 < 4; ++d0) {
                const bf16x8 a0 = *(const LAS bf16x8*)(Kl + (2 * d0 + hi) * 1024 + r32 * 16);
                const bf16x8 a1 = *(const LAS bf16x8*)(Kl + (2 * d0 + hi) * 1024 + 512 + r32 * 16);
                p0 = __builtin_amdgcn_mfma_f32_32x32x16_bf16(a0, qr[d0], p0, 0, 0, 0);
                p1 = __builtin_amdgcn_mfma_f32_32x32x16_bf16(a1, qr[d0], p1, 0, 0, 0);
            }
            if (WIN) {
#pragma unroll
                for (int r = 0; r < 16; ++r) {
                    const int rel0 = 64 * t + crow(r, hi) - qrow, rel1 = rel0 + 32;
                    int i0 = rel0 + 128, i1 = rel1 + 128; const bool ok0 = (i0 >= 0) && (i0 <= 256), ok1 = (i1 >= 0) && (i1 <= 256);
                    i0 = i0 < 0 ? 0 : (i0 > 256 ? 256 : i0); i1 = i1 < 0 ? 0 : (i1 > 256 ? 256 : i1);
                    const float b0 = biasl[i0], b1 = biasl[i1];
                    p0[r] = ok0 ? p0[r] + b0 : -1e30f; p1[r] = ok1 ? p1[r] + b1 : -1e30f;
                }
            }
            float rm = fmaxf(p0[0], p1[0]);
#pragma unroll
            for (int r = 1; r < 16; ++r) rm = fmaxf(rm, fmaxf(p0[r], p1[r]));
            rm = xhalf_max(rm);
            const float mn = fmaxf(mrun, rm), alpha = __builtin_amdgcn_exp2f(mrun - mn); mrun = mn;
            float ps = 0.f;
#pragma unroll
            for (int r = 0; r < 16; ++r) { p0[r] = __builtin_amdgcn_exp2f(p0[r] - mn); p1[r] = __builtin_amdgcn_exp2f(p1[r] - mn); ps += p0[r] + p1[r]; }
            lsum = lsum * alpha + ps;
#pragma unroll
            for (int r = 0; r < 16; ++r) { o0[r] *= alpha; o1[r] *= alpha; }
            u32x4 pk[4];
#pragma unroll
            for (int i = 0; i < 4; ++i) { pk[0][i] = pkbf(p0[2 * i], p0[2 * i + 1]); pk[1][i] = pkbf(p0[8 + 2 * i], p0[9 + 2 * i]); pk[2][i] = pkbf(p1[2 * i], p1[2 * i + 1]); pk[3][i] = pkbf(p1[8 + 2 * i], p1[9 + 2 * i]); }
#pragma unroll
            for (int ks = 0; ks < 4; ++ks) {
                const bf16x8 pf = __builtin_bit_cast(bf16x8, pk[ks]);
                const s16x4 l0 = vtr(Vl + vlane + ks * 1024), h0 = vtr(Vl + vlane + ks * 1024 + 512);
                const s16x4 l1 = vtr(Vl + vlane + 4096 + ks * 1024), h1 = vtr(Vl + vlane + 4096 + ks * 1024 + 512);
                const bf16x8 v0 = {l0[0], l0[1], l0[2], l0[3], h0[0], h0[1], h0[2], h0[3]}, v1 = {l1[0], l1[1], l1[2], l1[3], h1[0], h1[1], h1[2], h1[3]};
                o0 = __builtin_amdgcn_mfma_f32_32x32x16_bf16(v0, pf, o0, 0, 0, 0);
                o1 = __builtin_amdgcn_mfma_f32_32x32x16_bf16(v1, pf, o1, 0, 0, 0);
            }
        }
        if (t < t_hi) { *(LAS u32x4*)(lds + LDS_KV + (cur ^ 1) * 16384 + tid * 16) = kreg; *(LAS u32x4*)(lds + LDS_KV + (cur ^ 1) * 16384 + 8192 + tid * 16) = vreg; }
        __syncthreads();
    }
    const float inv = 1.0f / xhalf_sum(lsum);
    bf16_t* Orow = O + grow * QW + h * HD + 4 * hi;
#pragma unroll
    for (int g = 0; g < 4; ++g) {
        u32x2_t w0, w1;
        w0.x = pkbf(o0[4 * g] * inv, o0[4 * g + 1] * inv); w0.y = pkbf(o0[4 * g + 2] * inv, o0[4 * g + 3] * inv);
        w1.x = pkbf(o1[4 * g] * inv, o1[4 * g + 1] * inv); w1.y = pkbf(o1[4 * g + 2] * inv, o1[4 * g + 3] * inv);
        *(u32x2_t*)(Orow + 8 * g) = w0; *(u32x2_t*)(Orow + 32 + 8 * g) = w1;
    }
    __syncthreads();
}
}

namespace peer {
typedef unsigned u32x4 __attribute__((ext_vector_type(4)));
typedef float f32x4 __attribute__((ext_vector_type(4)));
constexpr int WAVE_LDS = 2048;

template <int CTRL> __device__ __forceinline__ int dppi(int x) { return __builtin_amdgcn_mov_dpp(x, CTRL, 0xf, 0xf, true); }
template <int CTRL> __device__ __forceinline__ float dppf(float x) { return __builtin_bit_cast(float, __builtin_amdgcn_mov_dpp(__builtin_bit_cast(int, x), CTRL, 0xf, 0xf, true)); }
constexpr int XOR1 = 0xB1, XOR2 = 0x4E, XOR7 = 0x141, XOR8 = 0x128;
__device__ __forceinline__ float wave_sum(float x) {
    x += dppf<XOR1>(x); x += dppf<XOR2>(x); x += dppf<XOR7>(x); x += dppf<XOR8>(x);
    auto s = __builtin_amdgcn_permlane16_swap(__float_as_uint(x), __float_as_uint(x), false, false); x = __uint_as_float(s[0]) + __uint_as_float(s[1]);
    auto t = __builtin_amdgcn_permlane32_swap(__float_as_uint(x), __float_as_uint(x), false, false); return __uint_as_float(t[0]) + __uint_as_float(t[1]);
}
__device__ __forceinline__ float dot2bf(unsigned a, unsigned b, float c) { return __builtin_amdgcn_fdot2_f32_bf16(__builtin_bit_cast(bf16x2_t, a), __builtin_bit_cast(bf16x2_t, b), c, false); }
__device__ __forceinline__ int okey(float f, int lowbits, int payload) { int b = __float_as_int(f); b ^= (b >> 31) & 0x7fffffff; return (b & ~((1 << lowbits) - 1)) | payload; }
__device__ __forceinline__ float kval(int k, int lowbits) { int b = (k & ~((1 << lowbits) - 1)) | (1 << (lowbits - 1)); b ^= (b >> 31) & 0x7fffffff; return __int_as_float(b); }
#define CE_DESC(a, b) do { const int _x = (a), _y = (b); (a) = _x > _y ? _x : _y; (b) = _x > _y ? _y : _x; } while (0)
template <int N> __device__ __forceinline__ void bitonic_sort_desc(int (&a)[N]) {
#pragma unroll
    for (int k = 2; k <= N; k <<= 1)
#pragma unroll
        for (int j = k >> 1; j > 0; j >>= 1)
#pragma unroll
            for (int i = 0; i < N; ++i) { const int l = i ^ j; if (l > i) { if ((i & k) == 0) CE_DESC(a[i], a[l]); else CE_DESC(a[l], a[i]); } }
}
template <int N> __device__ __forceinline__ void bitonic_merge_desc(int (&a)[N]) {
#pragma unroll
    for (int j = N >> 1; j > 0; j >>= 1)
#pragma unroll
        for (int i = 0; i < N; ++i) { const int l = i ^ j; if (l > i) CE_DESC(a[i], a[l]); }
}
__device__ __forceinline__ unsigned long long cand_table(int q8) {
    unsigned long long r = 0xFFFFFFFFFFFFFFFFull; int n = 0;
#pragma unroll
    for (int i = 0; i < 16; ++i)
#pragma unroll
        for (int j = 0; j < 16; ++j) if ((i + 1) * (j + 1) <= 16) { if (n / 7 == q8) { const int s = n % 7; r = (r & ~(0xFFull << (8 * s))) | ((unsigned long long)(i * 16 + j) << (8 * s)); } ++n; }
    return r;
}

__device__ __forceinline__ void token(LAS char* wl, int lane, int t, unsigned long long ct, const float* SC, const unsigned short* UT, const unsigned short* VT, float* H  , const float* gffn, const float* gfin) {
    LAS int* skeys = (LAS int*)wl; LAS int* pe = (LAS int*)(wl + 1024); LAS float* pw = (LAS float*)(wl + 1536);
    {
        const int c = lane >> 2, qq = lane & 3; const f32x4* sp = (const f32x4*)(SC + (size_t)t * SCW + c * NKEYS + qq * 32);
        int a[16], bb[16];
#pragma unroll
        for (int i = 0; i < 4; ++i) { const f32x4 v = sp[i];
#pragma unroll
            for (int j = 0; j < 4; ++j) a[4 * i + j] = okey(v[j], 7, 127 - (qq * 32 + 4 * i + j)); }
#pragma unroll
        for (int i = 0; i < 4; ++i) { const f32x4 v = sp[4 + i];
#pragma unroll
            for (int j = 0; j < 4; ++j) bb[4 * i + j] = okey(v[j], 7, 127 - (qq * 32 + 16 + 4 * i + j)); }
        bitonic_sort_desc<16>(a); bitonic_sort_desc<16>(bb);
#pragma unroll
        for (int i = 0; i < 16; ++i) a[i] = a[i] > bb[15 - i] ? a[i] : bb[15 - i];
        bitonic_merge_desc<16>(a);
#pragma unroll
        for (int i = 0; i < 16; ++i) bb[i] = dppi<XOR1>(a[15 - i]);
#pragma unroll
        for (int i = 0; i < 16; ++i) a[i] = a[i] > bb[i] ? a[i] : bb[i];
        bitonic_merge_desc<16>(a);
#pragma unroll
        for (int i = 0; i < 16; ++i) bb[i] = dppi<XOR2>(a[15 - i]);
#pragma unroll
        for (int i = 0; i < 16; ++i) a[i] = a[i] > bb[i] ? a[i] : bb[i];
        bitonic_merge_desc<16>(a);
        if (qq == 0) {
#pragma unroll
            for (int i = 0; i < 4; ++i) *(LAS u32x4*)(skeys + c * 16 + 4 * i) = (u32x4){(unsigned)a[4 * i], (unsigned)a[4 * i + 1], (unsigned)a[4 * i + 2], (unsigned)a[4 * i + 3]};
        }
    }
    asm volatile("s_waitcnt lgkmcnt(0)" ::: "memory");
    {
        const int hh = lane >> 3, q8 = lane & 7;
        int a[16];
#pragma unroll
        for (int s = 0; s < 8; ++s) {
            const int code = s < 7 ? (int)((ct >> (8 * s)) & 0xFF) : 0xFF;
            const int ci = code == 0xFF ? 0 : code;
            const int ka = skeys[(2 * hh) * 16 + (ci >> 4)], kb = skeys[(2 * hh + 1) * 16 + (ci & 15)];
            const float sum = kval(ka, 7) + kval(kb, 7);
            a[s] = code == 0xFF ? (int)0x80000000 : okey(sum, 8, 255 - code);
        }
        {
            int c8[8];
#pragma unroll
            for (int i = 0; i < 8; ++i) c8[i] = a[i];
            bitonic_sort_desc<8>(c8);
#pragma unroll
            for (int i = 0; i < 8; ++i) a[i] = c8[i];
        }
#pragma unroll
        for (int i = 0; i < 8; ++i) a[8 + i] = dppi<XOR1>(a[i]);
        { int tmp[8];
#pragma unroll
          for (int i = 0; i < 8; ++i) tmp[i] = a[8 + i];
#pragma unroll
          for (int i = 0; i < 8; ++i) a[8 + i] = tmp[7 - i]; }
        bitonic_merge_desc<16>(a);
        int bb[16];
#pragma unroll
        for (int i = 0; i < 16; ++i) bb[i] = dppi<XOR2>(a[15 - i]);
#pragma unroll
        for (int i = 0; i < 16; ++i) a[i] = a[i] > bb[i] ? a[i] : bb[i];
        bitonic_merge_desc<16>(a);
#pragma unroll
        for (int i = 0; i < 16; ++i) bb[i] = dppi<XOR7>(a[15 - i]);
#pragma unroll
        for (int i = 0; i < 16; ++i) a[i] = a[i] > bb[i] ? a[i] : bb[i];
        bitonic_merge_desc<16>(a);
        int k0 = a[0], k1 = a[1];
#pragma unroll
        for (int i = 1; i < 8; ++i) { k0 = q8 == i ? a[2 * i] : k0; k1 = q8 == i ? a[2 * i + 1] : k1; }
        const float mx = kval(a[0], 8);
        const int c0 = 255 - (k0 & 255), c1 = 255 - (k1 & 255);
        const int ka0 = skeys[(2 * hh) * 16 + (c0 >> 4)], kb0 = skeys[(2 * hh + 1) * 16 + (c0 & 15)];
        const int ka1 = skeys[(2 * hh) * 16 + (c1 >> 4)], kb1 = skeys[(2 * hh + 1) * 16 + (c1 & 15)];
        const float s0 = kval(ka0, 7) + kval(kb0, 7), s1 = kval(ka1, 7) + kval(kb1, 7);
        const float e0 = __expf(s0 - mx), e1 = __expf(s1 - mx);
        float z = e0 + e1; z += dppf<XOR1>(z); z += dppf<XOR2>(z); z += dppf<XOR7>(z);
        const float rz = 1.0f / z;
        pe[hh * 16 + 2 * q8] = (127 - (ka0 & 127)) * NKEYS + (127 - (kb0 & 127)); pe[hh * 16 + 2 * q8 + 1] = (127 - (ka1 & 127)) * NKEYS + (127 - (kb1 & 127));
        pw[hh * 16 + 2 * q8] = e0 * rz; pw[hh * 16 + 2 * q8 + 1] = e1 * rz;
    }
    asm volatile("s_waitcnt lgkmcnt(0)" ::: "memory");
    float hv[16];
    {
        const float* hp = H + (size_t)t * DM;
#pragma unroll
        for (int i = 0; i < 4; ++i) { const f32x4 v = *(const f32x4*)(hp + (i >> 1) * 512 + 8 * lane + (i & 1) * 4); hv[4 * i] = v[0]; hv[4 * i + 1] = v[1]; hv[4 * i + 2] = v[2]; hv[4 * i + 3] = v[3]; }
    }
    unsigned xn[8];
    {
        float ss = 0.f;
#pragma unroll
        for (int i = 0; i < 16; ++i) ss += hv[i] * hv[i];
        const float rstd = 1.0f / sqrtf(wave_sum(ss) * (1.0f / DM) + EPS);
#pragma unroll
        for (int i = 0; i < 4; ++i) { const f32x4 g = *(const f32x4*)(gffn + (i >> 1) * 512 + 8 * lane + (i & 1) * 4);
            xn[2 * i] = pkbf(hv[4 * i] * rstd * g[0], hv[4 * i + 1] * rstd * g[1]); xn[2 * i + 1] = pkbf(hv[4 * i + 2] * rstd * g[2], hv[4 * i + 3] * rstd * g[3]); }
    }
    const int e_lo = pe[lane], e_hi = pe[64 + lane];
    for (int kb = 0; kb < 128; kb += 8) {
        u32x4 r0[8], r1[8];
#pragma unroll
        for (int r = 0; r < 8; ++r) { const int k = kb + r; const int e = k < 64 ? __builtin_amdgcn_readlane(e_lo, k) : __builtin_amdgcn_readlane(e_hi, k - 64);
            const u32x4* up = (const u32x4*)(UT + (size_t)e * DM); r0[r] = up[lane]; r1[r] = up[64 + lane]; }
#pragma unroll
        for (int r = 0; r < 8; ++r) {
            float d0 = 0.f, d1 = 0.f;
#pragma unroll
            for (int i = 0; i < 4; ++i) { const unsigned ua = i == 0 ? r0[r].x : i == 1 ? r0[r].y : i == 2 ? r0[r].z : r0[r].w, ub = i == 0 ? r1[r].x : i == 1 ? r1[r].y : i == 2 ? r1[r].z : r1[r].w;
                d0 = dot2bf(ua, xn[i], d0); d1 = dot2bf(ub, xn[4 + i], d1); }
            const float av = wave_sum(d0 + d1);
            const float gl = 0.5f * av * (1.0f + erff(av * 0.70710678118654752f));
            if (lane == 0) pw[kb + r] = pw[kb + r] * gl;
        }
    }
    asm volatile("s_waitcnt lgkmcnt(0)" ::: "memory");
    float out[16];
#pragma unroll
    for (int i = 0; i < 16; ++i) out[i] = 0.f;
    for (int kb = 0; kb < 128; kb += 8) {
        u32x4 r0[8], r1[8];
#pragma unroll
        for (int r = 0; r < 8; ++r) { const int k = kb + r; const int e = k < 64 ? __builtin_amdgcn_readlane(e_lo, k) : __builtin_amdgcn_readlane(e_hi, k - 64);
            const u32x4* vp = (const u32x4*)(VT + (size_t)e * DM); r0[r] = vp[lane]; r1[r] = vp[64 + lane]; }
#pragma unroll
        for (int r = 0; r < 8; ++r) {
            const float w = pw[kb + r];
#pragma unroll
            for (int i = 0; i < 4; ++i) { const unsigned ua = i == 0 ? r0[r].x : i == 1 ? r0[r].y : i == 2 ? r0[r].z : r0[r].w, ub = i == 0 ? r1[r].x : i == 1 ? r1[r].y : i == 2 ? r1[r].z : r1[r].w;
                out[2 * i] += w * bflo(ua); out[2 * i + 1] += w * bfhi(ua); out[8 + 2 * i] += w * bflo(ub); out[8 + 2 * i + 1] += w * bfhi(ub); }
        }
    }
    {
        float ss = 0.f;
#pragma unroll
        for (int i = 0; i < 16; ++i) { hv[i] += out[i]; ss += hv[i] * hv[i]; }
        const float rstd = 1.0f / sqrtf(wave_sum(ss) * (1.0f / DM) + EPS);
        float* yp = H + (size_t)t * DM;
#pragma unroll
        for (int i = 0; i < 4; ++i) { const f32x4 g = *(const f32x4*)(gfin + (i >> 1) * 512 + 8 * lane + (i & 1) * 4);
            *(f32x4*)(yp + (i >> 1) * 512 + 8 * lane + (i & 1) * 4) = (f32x4){hv[4 * i] * rstd * g[0], hv[4 * i + 1] * rstd * g[1], hv[4 * i + 2] * rstd * g[2], hv[4 * i + 3] * rstd * g[3]}; }
    }
    asm volatile("s_waitcnt lgkmcnt(0)" ::: "memory");
}
}

constexpr int NWAVES = 8;
#ifndef MK_N_LAUNCHES
#define MK_N_LAUNCHES 7
#endif
constexpr int N_LAUNCHES = MK_N_LAUNCHES;
constexpr int PER_PHASE = 7;

typedef unsigned short bf16;
typedef unsigned v4u __attribute__((ext_vector_type(4)));
typedef float f32x4 __attribute__((ext_vector_type(4)));
#define LDS_WAIT() asm volatile("s_waitcnt lgkmcnt(0)" ::: "memory")
#define VM_WAIT() asm volatile("s_waitcnt vmcnt(0)" ::: "memory")

constexpr size_t MiB = 1u << 20;
constexpr size_t WS_CTL = 0, CTL_ZERO_BYTES = 64 * 1024;
constexpr size_t WS_TAB = 1 * MiB;
constexpr size_t WS_SSQ = 1 * MiB + 64 * 1024;
constexpr size_t WS_WIN = 3 * MiB;
constexpr size_t WS_WA = 10 * MiB, WS_WB = 11 * MiB;
constexpr size_t WS_WO = 12 * MiB;
constexpr size_t WS_WE = 14 * MiB;
constexpr size_t WS_UT = 18 * MiB, WS_VT = 50 * MiB;
constexpr size_t WS_XN = 82 * MiB;
constexpr size_t WS_ACT = 114 * MiB;
constexpr size_t WS_QA = WS_ACT, WS_QB = WS_ACT + 16 * MiB;
constexpr size_t WS_KA = WS_ACT + 32 * MiB, WS_VA = WS_ACT + 36 * MiB, WS_KB = WS_ACT + 40 * MiB, WS_VB = WS_ACT + 44 * MiB;
constexpr size_t WS_GA = WS_ACT + 48 * MiB, WS_GB = WS_ACT + 80 * MiB;
constexpr size_t WS_SC = WS_ACT;
constexpr size_t WS_END = 242 * MiB;
static_assert(WS_GB + 32 * MiB <= WS_END && WS_SC + (size_t)NTOK * SCW * 4 <= WS_END, "d_ws map");

constexpr int RING_BYTES = 131072;
constexpr int MISC_OFF = RING_BYTES + 320;
constexpr int LDS_BYTES = 147456;

#define XB_TMO      128
#define XB_XCNT(j)  (256  + 64 * (j))
#define XB_XSUB(j)  (1280 + 64 * (j))
#define XB_XGEN(j)  (2304 + 64 * (j))
#define XB_TOP      3328
#define XB_TOPGEN   3392
#define XCD_BAR_WORDS 3456
#define XB_SPIN_CAP (1u << 18)

__device__ __forceinline__ unsigned xb_ld(unsigned* p)              { return __hip_atomic_load(p, __ATOMIC_RELAXED, __HIP_MEMORY_SCOPE_AGENT); }
__device__ __forceinline__ unsigned xb_add(unsigned* p, unsigned v) { return __hip_atomic_fetch_add(p, v, __ATOMIC_RELAXED, __HIP_MEMORY_SCOPE_AGENT); }
__device__ __forceinline__ unsigned xb_xcc_id() { return (unsigned)__builtin_amdgcn_s_getreg((3 << 11) | 20) & 0xFu; }
#define XB_SPIN(cond, bar) do { unsigned _sp = 0; while (cond) { __builtin_amdgcn_s_sleep(1); \
    if ((++_sp & 255u) == 0u) { if (xb_ld(&(bar)[XB_TMO])) break; if (_sp > XB_SPIN_CAP) { atomicAdd(&(bar)[XB_TMO], 1u); break; } } } } while (0)

struct XcdBarrier {
    unsigned* bar; unsigned x;
    volatile LAS unsigned* st;
};

__device__ __forceinline__ XcdBarrier xcd_barrier_post(unsigned* bar, volatile LAS unsigned* st) {
    XcdBarrier b; b.bar = bar; b.x = xb_xcc_id(); b.st = st;
    if (threadIdx.x == 0) (void)xb_add(&bar[XB_XCNT(b.x)], 1u);
    return b;
}
__device__ __forceinline__ void xcd_barrier_complete(unsigned* bar, unsigned x, unsigned& nloc, unsigned& nx) {
    const unsigned G = gridDim.x * gridDim.y * gridDim.z;
    unsigned sum, cnt, mine, sp = 0u;
    for (;;) {
        sum = 0u; cnt = 0u; mine = 0u;
#pragma unroll
        for (unsigned j = 0; j < 16; ++j) { const unsigned c = xb_ld(&bar[XB_XCNT(j)]); sum += c; cnt += (c > 0u) ? 1u : 0u; mine = (j == x) ? c : mine; }
        if (sum == G) break;
        __builtin_amdgcn_s_sleep(1);
        if ((++sp & 255u) == 0u) { if (xb_ld(&bar[XB_TMO])) break; if (sp > XB_SPIN_CAP) { atomicAdd(&bar[XB_TMO], 1u); break; } }
    }
    nloc = mine > 0u ? mine : 1u; nx = cnt > 0u ? cnt : 1u;
}

__device__ __forceinline__ void xcd_barrier(const XcdBarrier& b) {
    asm volatile("s_waitcnt vmcnt(0)" ::: "memory");
    __syncthreads();
    if (threadIdx.x == 0) {
        unsigned* bar = b.bar;
        __builtin_amdgcn_s_waitcnt(0);
        unsigned nloc = b.st[0], nx = b.st[1];
        if (nloc == 0u) { xcd_barrier_complete(bar, b.x, nloc, nx); b.st[0] = nloc; b.st[1] = nx; }
        const unsigned old = xb_add(&bar[XB_XSUB(b.x)], 1u);
        const unsigned gen = old / nloc;
        if (old + 1u == (gen + 1u) * nloc) {
            __builtin_amdgcn_fence(__ATOMIC_RELEASE, "agent");
            asm volatile("s_waitcnt vmcnt(0)" ::: "memory");
            const unsigned og = xb_add(&bar[XB_TOP], 1u);
            const unsigned tg = og / nx;
            if (og + 1u == (tg + 1u) * nx) xb_add(&bar[XB_TOPGEN], 1u);
            else XB_SPIN(xb_ld(&bar[XB_TOPGEN]) == tg, bar);
            __builtin_amdgcn_fence(__ATOMIC_ACQUIRE, "agent");
            xb_add(&bar[XB_XGEN(b.x)], 1u);
            asm volatile("s_waitcnt vmcnt(0)" ::: "memory");
        } else {
            XB_SPIN(xb_ld(&bar[XB_XGEN(b.x)]) == gen, bar);
            __builtin_amdgcn_fence(__ATOMIC_ACQUIRE, "agent");
            asm volatile("s_waitcnt vmcnt(0)" ::: "memory");
        }
    }
    __syncthreads();
}


struct Args { const float* in[17]; float* out; unsigned char* ws; int ph_lo, ph_hi, li, pad; };

__device__ __forceinline__ void p0_transpose_item(const float* W, int K, int N, bf16* WT, int k0, int src_n0, int dst_n0, LAS float* scr, int lane) {
#pragma unroll 8
    for (int i = 0; i < 32; ++i) { const int kk = 2 * i + (lane >> 5); scr[kk * 33 + (lane & 31)] = W[(size_t)(k0 + kk) * N + src_n0 + (lane & 31)]; }
    LDS_WAIT();
    const int c = lane & 7;
#pragma unroll
    for (int j = 0; j < 4; ++j) { const int n = (lane >> 3) + 8 * j; const LAS float* s = scr + (8 * c) * 33 + n;
        v4u o; o.x = pkbf(s[0 * 33], s[1 * 33]); o.y = pkbf(s[2 * 33], s[3 * 33]); o.z = pkbf(s[4 * 33], s[5 * 33]); o.w = pkbf(s[6 * 33], s[7 * 33]);
        *(v4u*)(WT + (size_t)(dst_n0 + n) * K + k0 + 8 * c) = o; }
    LDS_WAIT();
}
__device__ __forceinline__ int win_src_col(int dst_n0) {
    if (dst_n0 >= 1536) return dst_n0;
    const int tile = dst_n0 >> 8, c = dst_n0 & 255;
    return tile * 256 + 64 * ((c >> 5) & 3) + 32 * (c >> 7);
}
__device__ __forceinline__ int t5_bucket(int rel) {
    const int n = rel < 0 ? -rel : rel; int bkt;
    if (n < 8) bkt = n; else { int v = 8 + (31 - __builtin_clz(n * n)) - 6; bkt = v > 15 ? 15 : v; }
    return bkt + (rel > 0 ? 16 : 0);
}

__global__ void __launch_bounds__(NWAVES * 64, 2) mk_fwd(Args args) {
    extern __shared__ __attribute__((aligned(16))) unsigned char lds_raw[];
    LAS unsigned char* lds = (LAS unsigned char*)lds_raw;
    volatile LAS unsigned* MISC = (volatile LAS unsigned*)(lds + MISC_OFF);
    const int tid = threadIdx.x, lane = tid & 63, wave = __builtin_amdgcn_readfirstlane(tid >> 6);
    const int G = gridDim.x, bx = blockIdx.x; const int vcu = (G % 8 == 0) ? (bx % 8) * (G / 8) + bx / 8 : bx;
    const int gw = vcu * NWAVES + wave, NGW = G * NWAVES;
    unsigned char* ws = args.ws;
    const float* x = args.in[0]; const float* g_mix = args.in[1]; const float* w_in = args.in[2]; const float* b_gate = args.in[3];
    const float* q_norm_g = args.in[4]; const float* k_norm_g = args.in[5]; const float* rel_bias = args.in[6]; const float* sink = args.in[7];
    const float* w_a = args.in[8]; const float* w_b = args.in[9]; const float* w_out = args.in[10]; const float* g_ffn = args.in[11];
    const float* peer_wq = args.in[12]; const float* subkeys = args.in[13]; const float* peer_u = args.in[14]; const float* peer_v = args.in[15]; const float* g_final = args.in[16];
    float* out = args.out;
    float* ROPE = (float*)(ws + WS_TAB); float* BIAS = (float*)(ws + WS_TAB + 16384); float* SSQ = (float*)(ws + WS_SSQ);
    bf16 *WIN_T = (bf16*)(ws + WS_WIN), *WA_T = (bf16*)(ws + WS_WA), *WB_T = (bf16*)(ws + WS_WB), *WO_T = (bf16*)(ws + WS_WO), *WE_T = (bf16*)(ws + WS_WE);
    bf16 *UT = (bf16*)(ws + WS_UT), *VT = (bf16*)(ws + WS_VT), *XN = (bf16*)(ws + WS_XN);
    bf16 *QA = (bf16*)(ws + WS_QA), *QB = (bf16*)(ws + WS_QB), *KA = (bf16*)(ws + WS_KA), *VA = (bf16*)(ws + WS_VA), *KB = (bf16*)(ws + WS_KB), *VB = (bf16*)(ws + WS_VB);
    bf16 *GA = (bf16*)(ws + WS_GA), *GB = (bf16*)(ws + WS_GB); float* SC = (float*)(ws + WS_SC);

    for (int u = tid; u < (LDS_BYTES - RING_BYTES) / 4; u += NWAVES * 64) ((LAS unsigned*)(lds + RING_BYTES))[u] = 0u;
    __syncthreads();
    XcdBarrier bar; bar.bar = (unsigned*)(ws + WS_CTL) + 1024; bar.x = 0; bar.st = nullptr;
    if (N_LAUNCHES != PER_PHASE) bar = xcd_barrier_post((unsigned*)(ws + WS_CTL) + 1024, MISC + 8);
    const int lo = args.ph_lo, hi = args.ph_hi;
#define IN(k) (lo <= (k) && (k) < hi)
#define BOTH(k) (IN(k) && IN((k) + 1))
#define GRID_BAR() do { if (N_LAUNCHES != PER_PHASE) xcd_barrier(bar); } while (0)

    if (IN(0)) {
        LAS float* scr = (LAS float*)(lds + wave * 16384);
        {
            constexpr int I_IN = (DM / 64) * (INW / 32), I_AB = (QW / 64) * (DM / 32), I_O = (DM / 64) * (DM / 32);
            constexpr int NITEMS = I_IN + 2 * I_AB + I_O;
            for (int it = gw; it < NITEMS; it += NGW) {
                int r = it;
                if (r < I_IN) { const int nblk = INW / 32, kb = r / nblk, nb = r % nblk; p0_transpose_item(w_in, DM, INW, WIN_T, 64 * kb, win_src_col(32 * nb), 32 * nb, scr, lane); continue; } r -= I_IN;
                if (r < I_AB) { const int nblk = DM / 32, kb = r / nblk, nb = r % nblk; p0_transpose_item(w_a, QW, DM, WA_T, 64 * kb, 32 * nb, 32 * nb, scr, lane); continue; } r -= I_AB;
                if (r < I_AB) { const int nblk = DM / 32, kb = r / nblk, nb = r % nblk; p0_transpose_item(w_b, QW, DM, WB_T, 64 * kb, 32 * nb, 32 * nb, scr, lane); continue; } r -= I_AB;
                { const int nblk = DM / 32, kb = r / nblk, nb = r % nblk; p0_transpose_item(w_out, DM, DM, WO_T, 64 * kb, 32 * nb, 32 * nb, scr, lane); }
            }
        }
        __syncthreads();
        {
            LAS float* sk_s = (LAS float*)lds;
            LAS float* wq_s = (LAS float*)(lds + 128 * 129 * 4);
            for (int it = vcu; it < 16 * 16; it += G) {
                const int c = it >> 4, k0 = (it & 15) * 64;
                for (int i = tid; i < 128 * 32; i += NWAVES * 64) { const int n = i >> 5, d4 = (i & 31) * 4; const f32x4 v = *(const f32x4*)(subkeys + ((size_t)c * NKEYS + n) * 128 + d4);
                    sk_s[n * 129 + d4] = v[0]; sk_s[n * 129 + d4 + 1] = v[1]; sk_s[n * 129 + d4 + 2] = v[2]; sk_s[n * 129 + d4 + 3] = v[3]; }
                for (int i = tid; i < 64 * 32; i += NWAVES * 64) { const int k = i >> 5, d4 = (i & 31) * 4; const f32x4 v = *(const f32x4*)(peer_wq + (size_t)(k0 + k) * SCW + c * 128 + d4);
                    wq_s[k * 129 + d4] = v[0]; wq_s[k * 129 + d4 + 1] = v[1]; wq_s[k * 129 + d4 + 2] = v[2]; wq_s[k * 129 + d4 + 3] = v[3]; }
                __syncthreads();
                const int k = tid & 63, ng = tid >> 6; float acc[16];
#pragma unroll
                for (int i = 0; i < 16; ++i) acc[i] = 0.f;
                for (int d = 0; d < 128; ++d) { const float a = wq_s[k * 129 + d];
#pragma unroll
                    for (int i = 0; i < 16; ++i) acc[i] += a * sk_s[(ng * 16 + i) * 129 + d]; }
                const float gk = g_ffn[k0 + k];
#pragma unroll
                for (int i = 0; i < 16; ++i) WE_T[(size_t)(c * 128 + ng * 16 + i) * DM + k0 + k] = (bf16)(pkbf(acc[i] * gk, 0.f) & 0xffffu);
                __syncthreads();
            }
        }
        {
            const size_t n8 = (size_t)NEXP * DM / 8;
            for (size_t i = (size_t)vcu * (NWAVES * 64) + tid; i < n8; i += (size_t)G * NWAVES * 64) {
                const f32x4 a = *(const f32x4*)(peer_u + i * 8), b = *(const f32x4*)(peer_u + i * 8 + 4); *(v4u*)(UT + i * 8) = (v4u){pkbf(a[0], a[1]), pkbf(a[2], a[3]), pkbf(b[0], b[1]), pkbf(b[2], b[3])};
                const f32x4 c = *(const f32x4*)(peer_v + i * 8), d = *(const f32x4*)(peer_v + i * 8 + 4); *(v4u*)(VT + i * 8) = (v4u){pkbf(c[0], c[1]), pkbf(c[2], c[3]), pkbf(d[0], d[1]), pkbf(d[2], d[3])};
            }
        }
        for (int m = gw; m < NTOK; m += NGW) {
            const f32x4* xr = (const f32x4*)(x + (size_t)m * DM) + lane; f32x4 v[4]; float s = 0.f;
#pragma unroll
            for (int j = 0; j < 4; ++j) { v[j] = xr[64 * j]; s += (v[j][0] * v[j][0] + v[j][1] * v[j][1]) + (v[j][2] * v[j][2] + v[j][3] * v[j][3]); }
            const float rstd = 1.0f / sqrtf(peer::wave_sum(s) * (1.0f / DM) + EPS);
            unsigned long long* o8 = (unsigned long long*)(XN + (size_t)m * DM) + lane;
#pragma unroll
            for (int j = 0; j < 4; ++j) { const f32x4 g = *((const f32x4*)g_mix + lane + 64 * j);
                o8[64 * j] = (unsigned long long)pkbf(v[j][0] * rstd * g[0], v[j][1] * rstd * g[1]) | ((unsigned long long)pkbf(v[j][2] * rstd * g[2], v[j][3] * rstd * g[3]) << 32); }
        }
        if (vcu == 0) {
            for (int i = tid; i < 64 * 16; i += NWAVES * 64) { const int pos = i >> 4, f = i & 15; const float fr = powf(10000.0f, -(float)f / 16.0f); const float ang = (float)pos * fr; ROPE[2 * i] = cosf(ang); ROPE[2 * i + 1] = sinf(ang); }
            for (int i = tid; i < 8 * 257; i += NWAVES * 64) { const int h = i / 257, rel = i % 257 - 128; BIAS[i] = rel_bias[t5_bucket(rel) * NH + h] * LOG2E; }
        }
        if (BOTH(0)) GRID_BAR();
    }

    if (IN(1)) {
        pg8::Gemm g{XN, WIN_T, NTOK, INW, DM}; pg8::StaticOrder S; S.init(NTOK, INW, G, bx);
        pg8::EpiIn E{QA, KA, VA, QB, KB, VB, GA, GB, q_norm_g, k_norm_g, b_gate, ROPE};
        pg8::gemm_phase<pg8::EpiIn, pg8::StaticOrder, true, true>(lds, g, S, E);
        if (BOTH(1)) GRID_BAR();
    }

    if (IN(2)) {
        for (int u = vcu; u < 512; u += G) { const int xg = u >> 6, i = u & 63; const int b = xg >> 1, h = 4 * (xg & 1) + (i >> 4), qblk = i & 15;
            attn::attn_unit<false>((LAS char*)lds, QA, KA, VA, QA, b, h, qblk, nullptr, 0.f); }
        for (int u = vcu; u < 512; u += G) { const int xg = u >> 6, i = u & 63; const int b = xg >> 1, h = 4 * (xg & 1) + (i >> 4), qblk = i & 15;
            attn::attn_unit<true>((LAS char*)lds, QB, KB, VB, QB, b, h, qblk, BIAS + h * 257, sink[h] * LOG2E); }
        if (BOTH(2)) GRID_BAR();
    }

    if (IN(3)) {
        { pg8::Gemm g{QA, WA_T, NTOK, DM, QW}; pg8::StaticOrder S; S.init(NTOK, DM, G, bx); pg8::EpiMixA E{GA};
          pg8::gemm_phase<pg8::EpiMixA, pg8::StaticOrder, true, true>(lds, g, S, E); }
        VM_WAIT(); __syncthreads();
        { pg8::Gemm g{QB, WB_T, NTOK, DM, QW}; pg8::StaticOrder S; S.init(NTOK, DM, G, bx); pg8::EpiMixB E{GA, GB};
          pg8::gemm_phase<pg8::EpiMixB, pg8::StaticOrder, true, true>(lds, g, S, E); }
        if (BOTH(3)) GRID_BAR();
    }

    if (IN(4)) {
        pg8::Gemm g{GB, WO_T, NTOK, DM, DM}; pg8::StaticOrder S; S.init(NTOK, DM, G, bx); pg8::EpiOut E{x, out, XN, SSQ};
        pg8::gemm_phase<pg8::EpiOut, pg8::StaticOrder, true, true>(lds, g, S, E);
        if (BOTH(4)) GRID_BAR();
    }

    if (IN(5)) {
        pg8::Gemm g{XN, WE_T, NTOK, SCW, DM}; pg8::StaticOrder S; S.init(NTOK, SCW, G, bx); pg8::EpiScore E{SSQ, SC};
        pg8::gemm_phase<pg8::EpiScore, pg8::StaticOrder, true, true>(lds, g, S, E);
        if (BOTH(5)) GRID_BAR();
    }

    if (IN(6)) {
        LAS char* wl = (LAS char*)lds + wave * peer::WAVE_LDS;
        const unsigned long long ct = peer::cand_table(lane & 7);
        for (int t = gw; t < NTOK; t += NGW) peer::token(wl, lane, t, ct, SC, UT, VT, out, g_ffn, g_final);
    }
#undef IN
#undef BOTH
#undef GRID_BAR
}

extern "C" void kernel_launch(void* const* d_in, const int* in_sizes, int n_in, void* d_out, int out_size, void* d_ws, size_t ws_size, hipStream_t stream) {
    static int grid = 0;
    if (grid == 0) {
        if (n_in != 17 || in_sizes[0] != NTOK * DM || out_size != NTOK * DM || ws_size < WS_END) { fprintf(stderr, "kernel_launch: unexpected shapes (n_in %d, in0 %d, out %d, ws %zu); nothing launched\n", n_in, n_in > 0 ? in_sizes[0] : -1, out_size, ws_size); grid = -1; return; }
        int dev = 0, cus = 0, per_cu = 0;
        if (hipGetDevice(&dev) != hipSuccess || hipDeviceGetAttribute(&cus, hipDeviceAttributeMultiprocessorCount, dev) != hipSuccess) { grid = -1; return; }
        if (hipFuncSetAttribute((const void*)mk_fwd, hipFuncAttributeMaxDynamicSharedMemorySize, LDS_BYTES) != hipSuccess) { fprintf(stderr, "kernel_launch: hipFuncSetAttribute failed\n"); grid = -1; return; }
        if (hipOccupancyMaxActiveBlocksPerMultiprocessor(&per_cu, (const void*)mk_fwd, NWAVES * 64, LDS_BYTES) != hipSuccess || per_cu < 1) { fprintf(stderr, "kernel_launch: occupancy query says %d blocks per CU; nothing launched\n", per_cu); (void)hipGetLastError(); grid = -1; return; }
        grid = cus;
    }
    if (grid < 0) return;
    if (hipMemsetAsync((char*)d_ws + WS_CTL, 0, CTL_ZERO_BYTES, stream) != hipSuccess) { fprintf(stderr, "kernel_launch: hipMemsetAsync failed\n"); return; }
    Args a{};
    for (int i = 0; i < 17; ++i) a.in[i] = (const float*)d_in[i];
    a.out = (float*)d_out; a.ws = (unsigned char*)d_ws;
    if (N_LAUNCHES == 1) {
        a.ph_lo = 0; a.ph_hi = PER_PHASE; a.li = 0;
        void* kargs[] = {&a};
        hipError_t e = hipLaunchCooperativeKernel((const void*)mk_fwd, dim3(grid), dim3(NWAVES * 64), kargs, LDS_BYTES, stream);
        if (e != hipSuccess) fprintf(stderr, "kernel_launch: cooperative launch failed: %s (grid %d)\n", hipGetErrorString(e), grid);
    } else {
        for (int li = 0; li < PER_PHASE; ++li) { a.ph_lo = li; a.ph_hi = li + 1; a.li = li;
            hipLaunchKernelGGL(mk_fwd, dim3(grid), dim3(NWAVES * 64), LDS_BYTES, stream, a); }
    }
}
```

```cpp
#include <hip/hip_runtime.h>
#include <cstdio>
#include <cstdint>
#include <cmath>
namespace pg8 {
#define PG8_LAS __attribute__((address_space(3)))
typedef unsigned short bf16_t;
typedef short bf16x8 __attribute__((ext_vector_type(8)));
typedef float f32x4 __attribute__((ext_vector_type(4)));
typedef unsigned u32x4 __attribute__((ext_vector_type(4)));
constexpr int BM = 256, BK = 64, HALF = 128, HTB = HALF * BK * 2  , STAGE_BYTES = 8 * HTB, NXCD = 8, WGM = 8;

__host__ __device__ __forceinline__ int lds_byte(int r, int c) { const int st = (r >> 4) * 2 + (c >> 5), rr = r & 15, cc = c & 31, ob = rr * 64 + cc * 2; return st * 1024 + (ob ^ (((ob >> 9) & 1) << 5)); }
__host__ __device__ __forceinline__ void stage_rc(int b, int& R, int& C) { const int st = b / 1024, sb = b % 1024, swz = sb ^ (((sb >> 9) & 1) << 5); R = (st >> 1) * 16 + swz / 64; C = (st & 1) * 32 + (swz % 64) / 2; }
__host__ __device__ __forceinline__ int perm32(int rho) { const int n = rho >> 4, i = rho & 15; return 8 * (i >> 2) + 4 * n + (i & 3); }

struct Unit { int pm, pn; };
struct Gemm { const bf16_t* A; const bf16_t* Bt; int M, N, K; };

struct StaticOrder {
    int nM, nN, nwg, G, c;
    __host__ __device__ void init(int M, int N, int G_, int c_) { nM = M / BM; nN = N / BM; nwg = nM * nN; G = G_; c = c_; }
    __host__ __device__ bool next(int i, Unit& u) const {
        const long L = (long)i * G + c; if (L >= nwg) return false;
        int wgid = (int)L; { const int q = nwg / NXCD, r = nwg % NXCD, xcd = wgid % NXCD, off = wgid / NXCD; wgid = (xcd < r ? xcd * (q + 1) : r * (q + 1) + (xcd - r) * q) + off; }
        const int nig = WGM * nN, gid = wgid / nig, fm = gid * WGM, gsz = (nM - fm) < WGM ? (nM - fm) : WGM;
        u.pm = fm + ((wgid % nig) % gsz); u.pn = (wgid % nig) / gsz; return true;
    }
    __device__ __forceinline__ void a_ready(const Unit&) const {}
    __device__ __forceinline__ void done(const Unit&) const {}
};

__device__ __forceinline__ unsigned cvt_pk_bf16(float lo, float hi) { unsigned r; asm volatile("v_cvt_pk_bf16_f32 %0, %1, %2" : "=v"(r) : "v"(lo), "v"(hi)); return r; }
typedef float f32x2 __attribute__((ext_vector_type(2)));
template <class Epi, class Sched, bool ALIGN_EPI = false, bool SP2 = false>
__device__ __forceinline__ void gemm_phase(PG8_LAS unsigned char* lds, const Gemm g, const Sched& S, const Epi& E) {
    const int tid = threadIdx.x, wid = __builtin_amdgcn_readfirstlane(tid >> 6), lane = tid & 63, wr = wid >> 2, wc = wid & 3, fr = lane & 15, fq = lane >> 4;
    const int K = g.K, nt = K / BK;
    unsigned voffA[2], voffB[2];
#pragma unroll
    for (int i = 0; i < 2; ++i) { int R, C; stage_rc(tid * 16 + i * 8192, R, C); const int Rb = Epi::PERM ? ((R & ~31) + perm32(R & 31)) : R;
        voffA[i] = (unsigned)(R * K + C) * 2u; voffB[i] = (unsigned)(Rb * K + C) * 2u; }
    const size_t kstep = (size_t)(BK * 2);
    const size_t hstep = (size_t)HALF * K * 2;
    const size_t tstep = 2 * hstep;
    const unsigned ldsw = (unsigned)wid * 1024u;
    const int aoff = lds_byte(wr * 64 + fr, fq * 8), boff = lds_byte(wc * 32 + fr, fq * 8);
#define PG8_SA(b, h) (((b) * 2 + (h)) * HTB)
#define PG8_SB(b, h) ((4 + (b) * 2 + (h)) * HTB)
#define PG8_STAGE(bufoff, gbase, voff) do { _Pragma("unroll") for (int _i = 0; _i < 2; ++_i) \
        __builtin_amdgcn_global_load_lds((const unsigned*)((const char*)(gbase) + (voff)[_i]), (PG8_LAS unsigned*)(lds + (bufoff) + ldsw + _i * 8192), 16, 0, 0); } while (0)
#define PG8_LDA(dst, b, h) do { _Pragma("unroll") for (int m = 0; m < 4; ++m) _Pragma("unroll") for (int k = 0; k < 2; ++k) dst[m][k] = *(const PG8_LAS bf16x8*)(lds + PG8_SA(b, h) + aoff + m * 2048 + k * 1024); } while (0)
#define PG8_LDB(dst, b, h) do { _Pragma("unroll") for (int n = 0; n < 2; ++n) _Pragma("unroll") for (int k = 0; k < 2; ++k) dst[n][k] = *(const PG8_LAS bf16x8*)(lds + PG8_SB(b, h) + boff + n * 2048 + k * 1024); } while (0)
#define PG8_MMA(ai, bj, At, Bt) do { __builtin_amdgcn_s_setprio(1); _Pragma("unroll") for (int m = 0; m < 4; ++m) _Pragma("unroll") for (int n = 0; n < 2; ++n) _Pragma("unroll") for (int k = 0; k < 2; ++k) \
        acc[ai][bj][m][n] = __builtin_amdgcn_mfma_f32_16x16x32_bf16(Bt[n][k], At[m][k], acc[ai][bj][m][n], 0, 0, 0); __builtin_amdgcn_s_setprio(0); } while (0)
#define PG8_WAIT_V(n) asm volatile("s_waitcnt vmcnt(" #n ")" ::: "memory")
#define PG8_WAIT_L(n) asm volatile("s_waitcnt lgkmcnt(" #n ")" ::: "memory")
#define PG8_BAR __builtin_amdgcn_s_barrier()
#define PG8_SCHED __builtin_amdgcn_sched_barrier(0)
    Unit cur, nxt; int ui = 0;
    if (!S.next(0, cur)) return;
    f32x4 acc[2][2][4][2];
#pragma unroll
    for (int a = 0; a < 2; ++a)
#pragma unroll
        for (int b = 0; b < 2; ++b)
#pragma unroll
            for (int m = 0; m < 4; ++m)
#pragma unroll
                for (int n = 0; n < 2; ++n) acc[a][b][m][n] = (f32x4){0.f, 0.f, 0.f, 0.f};
    bf16x8 At[4][2], B0[2][2], B1[2][2];
    const char* cA = (const char*)g.A + (size_t)cur.pm * tstep; const char* cB = (const char*)g.Bt + (size_t)cur.pn * tstep;
    S.a_ready(cur);
    if constexpr (SP2) {
        PG8_STAGE(PG8_SB(0, 0), cB, voffB); PG8_STAGE(PG8_SB(0, 1), cB + hstep, voffB); PG8_STAGE(PG8_SA(0, 0), cA, voffA); PG8_STAGE(PG8_SA(0, 1), cA + hstep, voffA);
        if (wr == 1) PG8_BAR;
        PG8_WAIT_V(2); PG8_BAR;
        PG8_STAGE(PG8_SB(1, 0), cB + kstep, voffB); PG8_STAGE(PG8_SA(1, 0), cA + kstep, voffA); PG8_STAGE(PG8_SB(1, 1), cB + hstep + kstep, voffB);
        PG8_WAIT_V(6); PG8_BAR;
    } else {
        PG8_STAGE(PG8_SB(0, 0), cB, voffB); PG8_STAGE(PG8_SA(0, 0), cA, voffA); PG8_STAGE(PG8_SB(0, 1), cB + hstep, voffB); PG8_STAGE(PG8_SA(0, 1), cA + hstep, voffA);
        if (wr == 1) PG8_BAR;
        PG8_WAIT_V(4); PG8_BAR;
        PG8_STAGE(PG8_SB(1, 0), cB + kstep, voffB); PG8_STAGE(PG8_SA(1, 0), cA + kstep, voffA); PG8_STAGE(PG8_SB(1, 1), cB + hstep + kstep, voffB);
        PG8_WAIT_V(6); PG8_BAR;
    }
    for (;;) {
        const bool has_next = S.next(ui + 1, nxt);
        const char* nA = has_next ? (const char*)g.A + (size_t)nxt.pm * tstep : cA; const char* nB = has_next ? (const char*)g.Bt + (size_t)nxt.pn * tstep : cB;
        for (int t = 0; t < nt; t += 2) {
            const bool last = (t == nt - 2);
            const char* a1 = cA + (size_t)(t + 1) * kstep;
            const char* a2 = last ? nA : cA + (size_t)(t + 2) * kstep; const char* b2 = last ? nB : cB + (size_t)(t + 2) * kstep;
            const char* a3 = a2 + kstep; const char* b3 = b2 + kstep;
            if (last && has_next) S.a_ready(nxt);
            if constexpr (SP2) {
            PG8_LDB(B0, 0, 0); PG8_LDB(B1, 0, 1); PG8_SCHED; PG8_LDA(At, 0, 0); PG8_STAGE(PG8_SA(1, 1), a1 + hstep, voffA);
            PG8_WAIT_V(8); PG8_WAIT_L(0); PG8_BAR; PG8_MMA(0, 0, At, B0); PG8_MMA(0, 1, At, B1); PG8_BAR; PG8_SCHED;
            PG8_LDA(At, 0, 1); PG8_STAGE(PG8_SB(0, 0), b2, voffB); PG8_STAGE(PG8_SB(0, 1), b2 + hstep, voffB); PG8_STAGE(PG8_SA(0, 0), a2, voffA);
            PG8_WAIT_V(8); PG8_WAIT_L(0); PG8_BAR; PG8_MMA(1, 0, At, B0); PG8_MMA(1, 1, At, B1); PG8_BAR; PG8_SCHED;
            PG8_LDB(B0, 1, 0); PG8_LDB(B1, 1, 1); PG8_SCHED; PG8_LDA(At, 1, 0); PG8_STAGE(PG8_SA(0, 1), a2 + hstep, voffA);
            PG8_WAIT_V(8); PG8_WAIT_L(0); PG8_BAR; PG8_MMA(0, 0, At, B0); PG8_MMA(0, 1, At, B1); PG8_BAR; PG8_SCHED;
            PG8_LDA(At, 1, 1); PG8_STAGE(PG8_SB(1, 0), b3, voffB); PG8_STAGE(PG8_SB(1, 1), b3 + hstep, voffB); PG8_STAGE(PG8_SA(1, 0), a3, voffA);
            PG8_WAIT_V(8); PG8_WAIT_L(0); PG8_BAR; PG8_MMA(1, 0, At, B0); PG8_MMA(1, 1, At, B1); PG8_BAR; PG8_SCHED;
            } else {
            PG8_LDB(B0, 0, 0); PG8_SCHED; PG8_LDA(At, 0, 0); PG8_STAGE(PG8_SA(1, 1), a1 + hstep, voffA);
            PG8_WAIT_L(8); PG8_BAR; PG8_WAIT_L(0); PG8_MMA(0, 0, At, B0); PG8_BAR; PG8_SCHED;
            PG8_LDB(B1, 0, 1); PG8_STAGE(PG8_SB(0, 0), b2, voffB);
            PG8_BAR; PG8_WAIT_L(0); PG8_MMA(0, 1, At, B1); PG8_BAR;
            PG8_LDA(At, 0, 1); PG8_STAGE(PG8_SA(0, 0), a2, voffA);
            PG8_BAR; PG8_WAIT_L(0); PG8_MMA(1, 0, At, B0); PG8_BAR; PG8_SCHED;
            PG8_STAGE(PG8_SB(0, 1), b2 + hstep, voffB);
            PG8_WAIT_V(6); PG8_BAR; PG8_MMA(1, 1, At, B1); PG8_BAR;
            PG8_LDB(B0, 1, 0); PG8_SCHED; PG8_LDA(At, 1, 0); PG8_STAGE(PG8_SA(0, 1), a2 + hstep, voffA);
            PG8_WAIT_L(8); PG8_BAR; PG8_WAIT_L(0); PG8_MMA(0, 0, At, B0); PG8_BAR; PG8_SCHED;
            PG8_LDB(B1, 1, 1); PG8_STAGE(PG8_SB(1, 0), b3, voffB);
            PG8_BAR; PG8_WAIT_L(0); PG8_MMA(0, 1, At, B1); PG8_BAR;
            PG8_LDA(At, 1, 1); PG8_STAGE(PG8_SA(1, 0), a3, voffA);
            PG8_BAR; PG8_WAIT_L(0); PG8_MMA(1, 0, At, B0); PG8_BAR; PG8_SCHED;
            PG8_STAGE(PG8_SB(1, 1), b3 + hstep, voffB);
            PG8_WAIT_V(6); PG8_BAR; PG8_MMA(1, 1, At, B1); PG8_BAR;
            }
        }
        if constexpr (ALIGN_EPI) { if (wr == 0) PG8_BAR; }
        if constexpr (!Epi::AFTER_DRAIN) { E(acc, cur, wr, wc, fr, fq); S.done(cur); }
        if (!has_next) break;
#pragma unroll
        for (int a = 0; a < 2; ++a)
#pragma unroll
            for (int b = 0; b < 2; ++b)
#pragma unroll
                for (int m = 0; m < 4; ++m)
#pragma unroll
                    for (int n = 0; n < 2; ++n) acc[a][b][m][n] = (f32x4){0.f, 0.f, 0.f, 0.f};
        cur = nxt; cA = nA; cB = nB; ++ui;
        if constexpr (ALIGN_EPI) { if (wr == 1) PG8_BAR; }
    }
    PG8_WAIT_V(0);
    if constexpr (!ALIGN_EPI) { if (wr == 0) PG8_BAR; }
    PG8_BAR;
    if constexpr (Epi::AFTER_DRAIN) { E.fused(acc, cur, wr, wc, fr, fq, lds, wid, lane); S.done(cur); }
#undef PG8_SA
#undef PG8_SB
#undef PG8_STAGE
#undef PG8_LDA
#undef PG8_LDB
#undef PG8_MMA
#undef PG8_WAIT_V
#undef PG8_WAIT_L
#undef PG8_BAR
#undef PG8_SCHED
}
}

constexpr int DM = 1024, NB = 4, SEQ = 4096, NTOK = NB * SEQ;
constexpr int HD = 64, NH = 8, NKV = 2, QW = NH * HD  , GRIDW = 64;
constexpr int INW = 3584;
constexpr int PH = 8, NKEYS = 128, TOPK = 16, NEXP = NKEYS * NKEYS, SCW = PH * 2 * NKEYS  ;
constexpr float EPS = 1e-6f;
constexpr float LOG2E = 1.4426950408889634f;
constexpr float QSCALE = 0.125f * LOG2E;

typedef unsigned u32x2_t __attribute__((ext_vector_type(2)));
typedef float f32x2_t __attribute__((ext_vector_type(2)));
typedef __bf16 bf16x2_t __attribute__((ext_vector_type(2)));
__device__ __forceinline__ unsigned pkbf(float lo, float hi) { f32x2_t v = {lo, hi}; bf16x2_t b = __builtin_convertvector(v, bf16x2_t); return __builtin_bit_cast(unsigned, b); }
__device__ __forceinline__ float bflo(unsigned w) { return __builtin_bit_cast(float, w << 16); }
__device__ __forceinline__ float bfhi(unsigned w) { return __builtin_bit_cast(float, w & 0xffff0000u); }

__device__ __forceinline__ size_t kimg_off(int b, int kvh, int s, int dim) { return ((size_t)((b * NKV + kvh) * (SEQ / 64) + (s >> 6)) << 12) + (dim >> 3) * 512 + (s & 63) * 8 + (dim & 7); }
__device__ __forceinline__ size_t vimg_off(int b, int kvh, int s, int dim) { return ((size_t)((b * NKV + kvh) * (SEQ / 64) + (s >> 6)) << 12) + (dim >> 5) * 2048 + (s & 63) * 32 + (dim & 31); }

namespace pg8 {
struct EpiIn {
    static constexpr bool PERM = false, AFTER_DRAIN = false;
    bf16_t *Qa, *Ka, *Va, *Qb, *Kb, *Vb, *Ga, *Gb;
    const float *qg, *kg, *bgate, *rope;
    __device__ __forceinline__ void operator()(const f32x4 (&acc)[2][2][4][2], const Unit& u, int wr, int wc, int fr, int fq) const {
        const int pn = u.pn;
        if (pn >= 6) {
            const bool isA = pn < 10; bf16_t* G = isA ? Ga : Gb; const int ct = (isA ? pn - 6 : pn - 10) * BM; const float* bb = bgate + (isA ? 0 : DM);
            f32x4 bv[2][2];
#pragma unroll
            for (int bj = 0; bj < 2; ++bj)
#pragma unroll
                for (int n = 0; n < 2; ++n) bv[bj][n] = *(const f32x4*)(bb + ct + bj * HALF + wc * 32 + n * 16 + 4 * fq);
#pragma unroll
            for (int ai = 0; ai < 2; ++ai)
#pragma unroll
                for (int m = 0; m < 4; ++m) { const int row = u.pm * BM + ai * HALF + wr * 64 + m * 16 + fr; bf16_t* rp = G + (size_t)row * DM + ct + wc * 32 + 4 * fq;
#pragma unroll
                    for (int bj = 0; bj < 2; ++bj)
#pragma unroll
                        for (int n = 0; n < 2; ++n) { const f32x4 z = acc[ai][bj][m][n] + bv[bj][n]; f32x4 g;
#pragma unroll
                            for (int j = 0; j < 4; ++j) g[j] = __builtin_amdgcn_rcpf(1.0f + __builtin_amdgcn_exp2f(-LOG2E * z[j]));
                            u32x2_t w; w.x = pkbf(g[0], g[1]); w.y = pkbf(g[2], g[3]); *(u32x2_t*)(rp + bj * HALF + n * 16) = w; } }
            return;
        }
        const bool brA = pn < 3; const int pl = brA ? pn : pn - 3;
        const bool isq = pl < 2, isk = (!isq) && wc < 2;
        const bool normrope = brA && (isq || isk);
        f32x4 gv[2][2];
        if (normrope) { const float* g = isq ? qg : kg;
#pragma unroll
            for (int bj = 0; bj < 2; ++bj)
#pragma unroll
                for (int n = 0; n < 2; ++n) gv[bj][n] = *(const f32x4*)(g + 32 * bj + 16 * n + 4 * fq); }
        const float osc = isq ? QSCALE : 1.0f;
#pragma unroll
        for (int ai = 0; ai < 2; ++ai)
#pragma unroll
            for (int m = 0; m < 4; ++m) {
                const int row = u.pm * BM + ai * HALF + wr * 64 + m * 16 + fr; const int b = row >> 12, s = row & (SEQ - 1);
                f32x4 v[2][2];
#pragma unroll
                for (int bj = 0; bj < 2; ++bj)
#pragma unroll
                    for (int n = 0; n < 2; ++n) v[bj][n] = acc[ai][bj][m][n];
                if (normrope) {
                    float ss = 0.f;
#pragma unroll
                    for (int bj = 0; bj < 2; ++bj)
#pragma unroll
                        for (int n = 0; n < 2; ++n) ss += (v[bj][n][0] * v[bj][n][0] + v[bj][n][1] * v[bj][n][1]) + (v[bj][n][2] * v[bj][n][2] + v[bj][n][3] * v[bj][n][3]);
                    ss += __shfl_xor(ss, 16); ss += __shfl_xor(ss, 32);
                    const float rstd = 1.0f / sqrtf(ss * (1.0f / 64.0f) + EPS);
#pragma unroll
                    for (int bj = 0; bj < 2; ++bj) {
                        const int pos = bj == 0 ? (s >> 6) : (s & (GRIDW - 1));
                        const f32x4 cs0 = *(const f32x4*)(rope + (pos * 16 + 4 * fq) * 2), cs1 = *(const f32x4*)(rope + (pos * 16 + 4 * fq) * 2 + 4);
                        const float cc[4] = {cs0[0], cs0[2], cs1[0], cs1[2]}, sn[4] = {cs0[1], cs0[3], cs1[1], cs1[3]};
#pragma unroll
                        for (int j = 0; j < 4; ++j) { const float u1 = v[bj][0][j] * rstd * gv[bj][0][j], u2 = v[bj][1][j] * rstd * gv[bj][1][j];
                            v[bj][0][j] = u1 * cc[j] - u2 * sn[j]; v[bj][1][j] = u2 * cc[j] + u1 * sn[j]; }
                    }
                }
#pragma unroll
                for (int bj = 0; bj < 2; ++bj)
#pragma unroll
                    for (int n = 0; n < 2; ++n) {
                        const f32x4 o = v[bj][n] * osc; u32x2_t w; w.x = pkbf(o[0], o[1]); w.y = pkbf(o[2], o[3]);
                        const int dim = 32 * bj + 16 * n + 4 * fq;
                        bf16_t* dst;
                        if (isq) dst = (brA ? Qa : Qb) + (size_t)row * QW + (pl * 4 + wc) * HD + dim;
                        else if (wc < 2) dst = (brA ? Ka : Kb) + kimg_off(b, wc, s, dim);
                        else dst = (brA ? Va : Vb) + vimg_off(b, wc - 2, s, dim);
                        *(u32x2_t*)dst = w;
                    }
            }
    }
};

struct EpiMixA {
    static constexpr bool PERM = false, AFTER_DRAIN = false;
    bf16_t* G;
    __device__ __forceinline__ void operator()(const f32x4 (&acc)[2][2][4][2], const Unit& u, int wr, int wc, int fr, int fq) const {
#pragma unroll
        for (int ai = 0; ai < 2; ++ai)
#pragma unroll
            for (int m = 0; m < 4; ++m) { const int row = u.pm * BM + ai * HALF + wr * 64 + m * 16 + fr; bf16_t* rp = G + (size_t)row * DM + u.pn * BM + wc * 32 + 4 * fq;
#pragma unroll
                for (int bj = 0; bj < 2; ++bj)
#pragma unroll
                    for (int n = 0; n < 2; ++n) { u32x2_t* p = (u32x2_t*)(rp + bj * HALF + n * 16); const u32x2_t g = *p; const f32x4 a = acc[ai][bj][m][n];
                        u32x2_t w; w.x = pkbf(a[0] * bflo(g.x), a[1] * bfhi(g.x)); w.y = pkbf(a[2] * bflo(g.y), a[3] * bfhi(g.y)); *p = w; } }
    }
};
struct EpiMixB {
    static constexpr bool PERM = false, AFTER_DRAIN = false;
    const bf16_t* M1; bf16_t* G;
    __device__ __forceinline__ void operator()(const f32x4 (&acc)[2][2][4][2], const Unit& u, int wr, int wc, int fr, int fq) const {
#pragma unroll
        for (int ai = 0; ai < 2; ++ai)
#pragma unroll
            for (int m = 0; m < 4; ++m) { const int row = u.pm * BM + ai * HALF + wr * 64 + m * 16 + fr; const size_t off = (size_t)row * DM + u.pn * BM + wc * 32 + 4 * fq;
#pragma unroll
                for (int bj = 0; bj < 2; ++bj)
#pragma unroll
                    for (int n = 0; n < 2; ++n) { u32x2_t* p = (u32x2_t*)(G + off + bj * HALF + n * 16); const u32x2_t g = *p; const u32x2_t m1 = *(const u32x2_t*)(M1 + off + bj * HALF + n * 16); const f32x4 a = acc[ai][bj][m][n];
                        u32x2_t w; w.x = pkbf(bflo(m1.x) + a[0] * bflo(g.x), bfhi(m1.x) + a[1] * bfhi(g.x)); w.y = pkbf(bflo(m1.y) + a[2] * bflo(g.y), bfhi(m1.y) + a[3] * bfhi(g.y)); *p = w; } }
    }
};
struct EpiOut {
    static constexpr bool PERM = false, AFTER_DRAIN = false;
    const float* X; float* H; bf16_t* HB; float* ssq;
    __device__ __forceinline__ void operator()(const f32x4 (&acc)[2][2][4][2], const Unit& u, int wr, int wc, int fr, int fq) const {
#pragma unroll
        for (int ai = 0; ai < 2; ++ai)
#pragma unroll
            for (int m = 0; m < 4; ++m) { const int row = u.pm * BM + ai * HALF + wr * 64 + m * 16 + fr; const size_t off = (size_t)row * DM + u.pn * BM + wc * 32 + 4 * fq; float ss = 0.f;
#pragma unroll
                for (int bj = 0; bj < 2; ++bj)
#pragma unroll
                    for (int n = 0; n < 2; ++n) { const size_t o2 = off + bj * HALF + n * 16; const f32x4 h = *(const f32x4*)(X + o2) + acc[ai][bj][m][n];
                        *(f32x4*)(H + o2) = h; u32x2_t w; w.x = pkbf(h[0], h[1]); w.y = pkbf(h[2], h[3]); *(u32x2_t*)(HB + o2) = w;
                        ss += (h[0] * h[0] + h[1] * h[1]) + (h[2] * h[2] + h[3] * h[3]); }
                ss += __shfl_xor(ss, 16); ss += __shfl_xor(ss, 32);
                if (fq == 0) ssq[(size_t)row * 16 + u.pn * 4 + wc] = ss; }
    }
};
struct EpiScore {
    static constexpr bool PERM = false, AFTER_DRAIN = false;
    const float* ssq; float* SC;
    __device__ __forceinline__ void operator()(const f32x4 (&acc)[2][2][4][2], const Unit& u, int wr, int wc, int fr, int fq) const {
#pragma unroll
        for (int ai = 0; ai < 2; ++ai)
#pragma unroll
            for (int m = 0; m < 4; ++m) { const int row = u.pm * BM + ai * HALF + wr * 64 + m * 16 + fr;
                const f32x4* sp = (const f32x4*)(ssq + (size_t)row * 16); const f32x4 s0 = sp[0], s1 = sp[1], s2 = sp[2], s3 = sp[3];
                const float tot = (((s0[0] + s0[1]) + (s0[2] + s0[3])) + ((s1[0] + s1[1]) + (s1[2] + s1[3]))) + (((s2[0] + s2[1]) + (s2[2] + s2[3])) + ((s3[0] + s3[1]) + (s3[2] + s3[3])));
                const float rstd = 1.0f / sqrtf(tot * (1.0f / DM) + EPS);
                float* rp = SC + (size_t)row * SCW + u.pn * BM + wc * 32 + 4 * fq;
#pragma unroll
                for (int bj = 0; bj < 2; ++bj)
#pragma unroll
                    for (int n = 0; n < 2; ++n) *(f32x4*)(rp + bj * HALF + n * 16) = acc[ai][bj][m][n] * rstd; }
    }
};
}

#define LAS __attribute__((address_space(3)))
namespace attn {
typedef unsigned short bf16_t;
typedef short bf16x8 __attribute__((ext_vector_type(8)));
typedef short s16x4 __attribute__((ext_vector_type(4)));
typedef float f32x16 __attribute__((ext_vector_type(16)));
typedef unsigned u32x4 __attribute__((ext_vector_type(4)));
constexpr int LDS_KV = 0;
constexpr int LDS_BIAS = 32768;
constexpr int LDS_BYTES = 32768 + 2048;
__device__ __forceinline__ int crow(int r, int hi) { return (r & 3) + 8 * (r >> 2) + 4 * hi; }
__device__ __forceinline__ s16x4 vtr(const LAS char* p) { return __builtin_bit_cast(s16x4, __builtin_amdgcn_ds_read_tr16_b64_v4i16((LAS s16x4*)p)); }
__device__ __forceinline__ float xhalf_max(float v) { auto rr = __builtin_amdgcn_permlane32_swap(__float_as_uint(v), __float_as_uint(v), false, false); return fmaxf(__uint_as_float(rr[0]), __uint_as_float(rr[1])); }
__device__ __forceinline__ float xhalf_sum(float v) { auto rr = __builtin_amdgcn_permlane32_swap(__float_as_uint(v), __float_as_uint(v), false, false); return __uint_as_float(rr[0]) + __uint_as_float(rr[1]); }

template <bool WIN>
__device__ __forceinline__ void attn_unit(LAS char* lds, const bf16_t* Q, const bf16_t* Kimg, const bf16_t* Vimg, bf16_t* O, int b, int h, int qblk, const float* bias_h  , float sink_l2) {
    const int tid = threadIdx.x, lane = tid & 63, r32 = lane & 31, hi = lane >> 5; const int wid = __builtin_amdgcn_readfirstlane(tid >> 6);
    const int q0 = qblk * 256, qw0 = q0 + 32 * wid, qrow = qw0 + r32; const size_t grow = (size_t)b * SEQ + qrow;
    const int kvh = h >> 2;
    const bf16_t* Kb = Kimg + ((size_t)((b * NKV + kvh) * (SEQ / 64)) << 12);
    const bf16_t* Vb = Vimg + ((size_t)((b * NKV + kvh) * (SEQ / 64)) << 12);
    int t_lo = 0, t_hi = SEQ / 64 - 1;
    if (WIN) { t_lo = q0 / 64 - 2; if (t_lo < 0) t_lo = 0; t_hi = q0 / 64 + 5; if (t_hi > SEQ / 64 - 1) t_hi = SEQ / 64 - 1; }
    bf16x8 qr[4];
#pragma unroll
    for (int d0 = 0; d0 < 4; ++d0) qr[d0] = *(const bf16x8*)(Q + grow * QW + h * HD + d0 * 16 + hi * 8);
    LAS float* biasl = (LAS float*)(lds + LDS_BIAS);
    if (WIN) { if (tid < 257) biasl[tid] = bias_h[tid]; }
    u32x4 kreg = *(const u32x4*)(Kb + ((size_t)t_lo << 12) + tid * 8), vreg = *(const u32x4*)(Vb + ((size_t)t_lo << 12) + tid * 8);
    *(LAS u32x4*)(lds + LDS_KV + tid * 16) = kreg; *(LAS u32x4*)(lds + LDS_KV + 8192 + tid * 16) = vreg;
    __syncthreads();
    f32x16 o0 = {}, o1 = {};
    float mrun = WIN ? sink_l2 : -1e30f, lsum = (WIN && hi == 0) ? 1.0f : 0.0f;
    const int vlane = ((lane >> 4) & 1) * 32 + (lane & 3) * 8 + (4 * hi + ((lane & 15) >> 2)) * 64;
    for (int t = t_lo; t <= t_hi; ++t) {
        const int cur = (t - t_lo) & 1;
        const LAS char* Kl = lds + LDS_KV + cur * 16384; const LAS char* Vl = Kl + 8192;
        if (t < t_hi) { kreg = *(const u32x4*)(Kb + ((size_t)(t + 1) << 12) + tid * 8); vreg = *(const u32x4*)(Vb + ((size_t)(t + 1) << 12) + tid * 8); }
        bool active = true;
        if (WIN) active = (64 * t + 63 >= qw0 - 128) && (64 * t <= qw0 + 31 + 128);
        if (active) {
            f32x16 p0 = {}, p1 = {};
#pragma unroll
            for (int d0 = 0; d0 < 4; ++d0) {
                const bf16x8 a0 = *(const LAS bf16x8*)(Kl + (2 * d0 + hi) * 1024 + r32 * 16);
                const bf16x8 a1 = *(const LAS bf16x8*)(Kl + (2 * d0 + hi) * 1024 + 512 + r32 * 16);
                p0 = __builtin_amdgcn_mfma_f32_32x32x16_bf16(a0, qr[d0], p0, 0, 0, 0);
                p1 = __builtin_amdgcn_mfma_f32_32x32x16_bf16(a1, qr[d0], p1, 0, 0, 0);
            }
            if (WIN) {
#pragma unroll
                for (int r = 0; r < 16; ++r) {
                    const int rel0 = 64 * t + crow(r, hi) - qrow, rel1 = rel0 + 32;
                    int i0 = rel0 + 128, i1 = rel1 + 128; const bool ok0 = (i0 >= 0) && (i0 <= 256), ok1 = (i1 >= 0) && (i1 <= 256);
                    i0 = i0 < 0 ? 0 : (i0 > 256 ? 256 : i0); i1 = i1 < 0 ? 0 : (i1 > 256 ? 256 : i1);
                    const float b0 = biasl[i0], b1 = biasl[i1];
                    p0[r] = ok0 ? p0[r] + b0 : -1e30f; p1[r] = ok1 ? p1[r] + b1 : -1e30f;
                }
            }
            float rm = fmaxf(p0[0], p1[0]);
#pragma unroll
            for (int r = 1; r < 16; ++r) rm = fmaxf(rm, fmaxf(p0[r], p1[r]));
            rm = xhalf_max(rm);
            const float mn = fmaxf(mrun, rm), alpha = __builtin_amdgcn_exp2f(mrun - mn); mrun = mn;
            float ps = 0.f;
#pragma unroll
            for (int r = 0; r < 16; ++r) { p0[r] = __builtin_amdgcn_exp2f(p0[r] - mn); p1[r] = __builtin_amdgcn_exp2f(p1[r] - mn); ps += p0[r] + p1[r]; }
            lsum = lsum * alpha + ps;
#pragma unroll
            for (int r = 0; r < 16; ++r) { o0[r] *= alpha; o1[r] *= alpha; }
            u32x4 pk[4];
#pragma unroll
            for (int i = 0; i < 4; ++i) { pk[0][i] = pkbf(p0[2 * i], p0[2 * i + 1]); pk[1][i] = pkbf(p0[8 + 2 * i], p0[9 + 2 * i]); pk[2][i] = pkbf(p1[2 * i], p1[2 * i + 1]); pk[3][i] = pkbf(p1[8 + 2 * i], p1[9 + 2 * i]); }
#pragma unroll
            for (int ks = 0; ks < 4; ++ks) {
                const bf16x8 pf = __builtin_bit_cast(bf16x8, pk[ks]);
                const s16x4 l0 = vtr(Vl + vlane + ks * 1024), h0 = vtr(Vl + vlane + ks * 1024 + 512);
                const s16x4 l1 = vtr(Vl + vlane + 4096 + ks * 1024), h1 = vtr(Vl + vlane + 4096 + ks * 1024 + 512);
                const bf16x8 v0 = {l0[0], l0[1], l0[2], l0[3], h0[0], h0[1], h0[2], h0[3]}, v1 = {l1[0], l1[1], l1[2], l1[3], h1[0], h1[1], h1[2], h1[3]};
                o0 = __builtin_amdgcn_mfma_f32_32x32x16_bf16(v0, pf, o0, 0, 0, 0);
                o1 = __builtin_amdgcn_mfma_f32_32x32x16_bf16(v1, pf, o1, 0, 0, 0);
            }
        }
        if (t < t_hi) { *(LAS u32x4*)(lds + LDS_KV + (cur ^ 1) * 16384 + tid * 16) = kreg; *(LAS u32x4*)(lds + LDS_KV + (cur ^ 1) * 16384 + 8192 + tid * 16) = vreg; }
        __syncthreads();
    }
    const float inv = 1.0f / xhalf_sum(lsum);
    bf16_t* Orow = O + grow * QW + h * HD + 4 * hi;
#pragma unroll
    for (int g = 0; g < 4; ++g) {
        u32x2_t w0, w1;
        w0.x = pkbf(o0[4 * g] * inv, o0[4 * g + 1] * inv); w0.y = pkbf(o0[4 * g + 2] * inv, o0[4 * g + 3] * inv);
        w1.x = pkbf(o1[4 * g] * inv, o1[4 * g + 1] * inv); w1.y = pkbf(o1[4 * g + 2] * inv, o1[4 * g + 3] * inv);
        *(u32x2_t*)(Orow + 8 * g) = w0; *(u32x2_t*)(Orow + 32 + 8 * g) = w1;
    }
    __syncthreads();
}
}

namespace peer {
typedef unsigned u32x4 __attribute__((ext_vector_type(4)));
typedef float f32x4 __attribute__((ext_vector_type(4)));
constexpr int WAVE_LDS = 2048;

template <int CTRL> __device__ __forceinline__ int dppi(int x) { return __builtin_amdgcn_mov_dpp(x, CTRL, 0xf, 0xf, true); }
template <int CTRL> __device__ __forceinline__ float dppf(float x) { return __builtin_bit_cast(float, __builtin_amdgcn_mov_dpp(__builtin_bit_cast(int, x), CTRL, 0xf, 0xf, true)); }
constexpr int XOR1 = 0xB1, XOR2 = 0x4E, XOR7 = 0x141, XOR8 = 0x128;
__device__ __forceinline__ float wave_sum(float x) {
    x += dppf<XOR1>(x); x += dppf<XOR2>(x); x += dppf<XOR7>(x); x += dppf<XOR8>(x);
    auto s = __builtin_amdgcn_permlane16_swap(__float_as_uint(x), __float_as_uint(x), false, false); x = __uint_as_float(s[0]) + __uint_as_float(s[1]);
    auto t = __builtin_amdgcn_permlane32_swap(__float_as_uint(x), __float_as_uint(x), false, false); return __uint_as_float(t[0]) + __uint_as_float(t[1]);
}
__device__ __forceinline__ float dot2bf(unsigned a, unsigned b, float c) { return __builtin_amdgcn_fdot2_f32_bf16(__builtin_bit_cast(bf16x2_t, a), __builtin_bit_cast(bf16x2_t, b), c, false); }
__device__ __forceinline__ int okey(float f, int lowbits, int payload) { int b = __float_as_int(f); b ^= (b >> 31) & 0x7fffffff; return (b & ~((1 << lowbits) - 1)) | payload; }
__device__ __forceinline__ float kval(int k, int lowbits) { int b = (k & ~((1 << lowbits) - 1)) | (1 << (lowbits - 1)); b ^= (b >> 31) & 0x7fffffff; return __int_as_float(b); }
#define CE_DESC(a, b) do { const int _x = (a), _y = (b); (a) = _x > _y ? _x : _y; (b) = _x > _y ? _y : _x; } while (0)
template <int N> __device__ __forceinline__ void bitonic_sort_desc(int (&a)[N]) {
#pragma unroll
    for (int k = 2; k <= N; k <<= 1)
#pragma unroll
        for (int j = k >> 1; j > 0; j >>= 1)
#pragma unroll
            for (int i = 0; i < N; ++i) { const int l = i ^ j; if (l > i) { if ((i & k) == 0) CE_DESC(a[i], a[l]); else CE_DESC(a[l], a[i]); } }
}
template <int N> __device__ __forceinline__ void bitonic_merge_desc(int (&a)[N]) {
#pragma unroll
    for (int j = N >> 1; j > 0; j >>= 1)
#pragma unroll
        for (int i = 0; i < N; ++i) { const int l = i ^ j; if (l > i) CE_DESC(a[i], a[l]); }
}
__device__ __forceinline__ unsigned long long cand_table(int q8) {
    unsigned long long r = 0xFFFFFFFFFFFFFFFFull; int n = 0;
#pragma unroll
    for (int i = 0; i < 16; ++i)
#pragma unroll
        for (int j = 0; j < 16; ++j) if ((i + 1) * (j + 1) <= 16) { if (n / 7 == q8) { const int s = n % 7; r = (r & ~(0xFFull << (8 * s))) | ((unsigned long long)(i * 16 + j) << (8 * s)); } ++n; }
    return r;
}

__device__ __forceinline__ void token(LAS char* wl, int lane, int t, unsigned long long ct, const float* SC, const unsigned short* UT, const unsigned short* VT, float* H  , const float* gffn, const float* gfin) {
    LAS int* skeys = (LAS int*)wl; LAS int* pe = (LAS int*)(wl + 1024); LAS float* pw = (LAS float*)(wl + 1536);
    {
        const int c = lane >> 2, qq = lane & 3; const f32x4* sp = (const f32x4*)(SC + (size_t)t * SCW + c * NKEYS + qq * 32);
        int a[16], bb[16];
#pragma unroll
        for (int i = 0; i < 4; ++i) { const f32x4 v = sp[i];
#pragma unroll
            for (int j = 0; j < 4; ++j) a[4 * i + j] = okey(v[j], 7, 127 - (qq * 32 + 4 * i + j)); }
#pragma unroll
        for (int i = 0; i < 4; ++i) { const f32x4 v = sp[4 + i];
#pragma unroll
            for (int j = 0; j < 4; ++j) bb[4 * i + j] = okey(v[j], 7, 127 - (qq * 32 + 16 + 4 * i + j)); }
        bitonic_sort_desc<16>(a); bitonic_sort_desc<16>(bb);
#pragma unroll
        for (int i = 0; i < 16; ++i) a[i] = a[i] > bb[15 - i] ? a[i] : bb[15 - i];
        bitonic_merge_desc<16>(a);
#pragma unroll
        for (int i = 0; i < 16; ++i) bb[i] = dppi<XOR1>(a[15 - i]);
#pragma unroll
        for (int i = 0; i < 16; ++i) a[i] = a[i] > bb[i] ? a[i] : bb[i];
        bitonic_merge_desc<16>(a);
#pragma unroll
        for (int i = 0; i < 16; ++i) bb[i] = dppi<XOR2>(a[15 - i]);
#pragma unroll
        for (int i = 0; i < 16; ++i) a[i] = a[i] > bb[i] ? a[i] : bb[i];
        bitonic_merge_desc<16>(a);
        if (qq == 0) {
#pragma unroll
            for (int i = 0; i < 4; ++i) *(LAS u32x4*)(skeys + c * 16 + 4 * i) = (u32x4){(unsigned)a[4 * i], (unsigned)a[4 * i + 1], (unsigned)a[4 * i + 2], (unsigned)a[4 * i + 3]};
        }
    }
    asm volatile("s_waitcnt lgkmcnt(0)" ::: "memory");
    {
        const int hh = lane >> 3, q8 = lane & 7;
        int a[16];
#pragma unroll
        for (int s = 0; s < 8; ++s) {
            const int code = s < 7 ? (int)((ct >> (8 * s)) & 0xFF) : 0xFF;
            const int ci = code == 0xFF ? 0 : code;
            const int ka = skeys[(2 * hh) * 16 + (ci >> 4)], kb = skeys[(2 * hh + 1) * 16 + (ci & 15)];
            const float sum = kval(ka, 7) + kval(kb, 7);
            a[s] = code == 0xFF ? (int)0x80000000 : okey(sum, 8, 255 - code);
        }
        {
            int c8[8];
#pragma unroll
            for (int i = 0; i < 8; ++i) c8[i] = a[i];
            bitonic_sort_desc<8>(c8);
#pragma unroll
            for (int i = 0; i < 8; ++i) a[i] = c8[i];
        }
#pragma unroll
        for (int i = 0; i < 8; ++i) a[8 + i] = dppi<XOR1>(a[i]);
        { int tmp[8];
#pragma unroll
          for (int i = 0; i < 8; ++i) tmp[i] = a[8 + i];
#pragma unroll
          for (int i = 0; i < 8; ++i) a[8 + i] = tmp[7 - i]; }
        bitonic_merge_desc<16>(a);
        int bb[16];
#pragma unroll
        for (int i = 0; i < 16; ++i) bb[i] = dppi<XOR2>(a[15 - i]);
#pragma unroll
        for (int i = 0; i < 16; ++i) a[i] = a[i] > bb[i] ? a[i] : bb[i];
        bitonic_merge_desc<16>(a);
#pragma unroll
        for (int i = 0; i < 16; ++i) bb[i] = dppi<XOR7>(a[15 - i]);
#pragma unroll
        for (int i = 0; i < 16; ++i) a[i] = a[i] > bb[i] ? a[i] : bb[i];
        bitonic_merge_desc<16>(a);
        int k0 = a[0], k1 = a[1];
#pragma unroll
        for (int i = 1; i < 8; ++i) { k0 = q8 == i ? a[2 * i] : k0; k1 = q8 == i ? a[2 * i + 1] : k1; }
        const float mx = kval(a[0], 8);
        const int c0 = 255 - (k0 & 255), c1 = 255 - (k1 & 255);
        const int ka0 = skeys[(2 * hh) * 16 + (c0 >> 4)], kb0 = skeys[(2 * hh + 1) * 16 + (c0 & 15)];
        const int ka1 = skeys[(2 * hh) * 16 + (c1 >> 4)], kb1 = skeys[(2 * hh + 1) * 16 + (c1 & 15)];
        const float s0 = kval(ka0, 7) + kval(kb0, 7), s1 = kval(ka1, 7) + kval(kb1, 7);
        const float e0 = __expf(s0 - mx), e1 = __expf(s1 - mx);
        float z = e0 + e1; z += dppf<XOR1>(z); z += dppf<XOR2>(z); z += dppf<XOR7>(z);
        const float rz = 1.0f / z;
        pe[hh * 16 + 2 * q8] = (127 - (ka0 & 127)) * NKEYS + (127 - (kb0 & 127)); pe[hh * 16 + 2 * q8 + 1] = (127 - (ka1 & 127)) * NKEYS + (127 - (kb1 & 127));
        pw[hh * 16 + 2 * q8] = e0 * rz; pw[hh * 16 + 2 * q8 + 1] = e1 * rz;
    }
    asm volatile("s_waitcnt lgkmcnt(0)" ::: "memory");
    float hv[16];
    {
        const float* hp = H + (size_t)t * DM;
#pragma unroll
        for (int i = 0; i < 4; ++i) { const f32x4 v = *(const f32x4*)(hp + (i >> 1) * 512 + 8 * lane + (i & 1) * 4); hv[4 * i] = v[0]; hv[4 * i + 1] = v[1]; hv[4 * i + 2] = v[2]; hv[4 * i + 3] = v[3]; }
    }
    unsigned xn[8];
    {
        float ss = 0.f;
#pragma unroll
        for (int i = 0; i < 16; ++i) ss += hv[i] * hv[i];
        const float rstd = 1.0f / sqrtf(wave_sum(ss) * (1.0f / DM) + EPS);
#pragma unroll
        for (int i = 0; i < 4; ++i) { const f32x4 g = *(const f32x4*)(gffn + (i >> 1) * 512 + 8 * lane + (i & 1) * 4);
            xn[2 * i] = pkbf(hv[4 * i] * rstd * g[0], hv[4 * i + 1] * rstd * g[1]); xn[2 * i + 1] = pkbf(hv[4 * i + 2] * rstd * g[2], hv[4 * i + 3] * rstd * g[3]); }
    }
    const int e_lo = pe[lane], e_hi = pe[64 + lane];
    for (int kb = 0; kb < 128; kb += 8) {
        u32x4 r0[8], r1[8];
#pragma unroll
        for (int r = 0; r < 8; ++r) { const int k = kb + r; const int e = k < 64 ? __builtin_amdgcn_readlane(e_lo, k) : __builtin_amdgcn_readlane(e_hi, k - 64);
            const u32x4* up = (const u32x4*)(UT + (size_t)e * DM); r0[r] = up[lane]; r1[r] = up[64 + lane]; }
#pragma unroll
        for (int r = 0; r < 8; ++r) {
            float d0 = 0.f, d1 = 0.f;
#pragma unroll
            for (int i = 0; i < 4; ++i) { const unsigned ua = i == 0 ? r0[r].x : i == 1 ? r0[r].y : i == 2 ? r0[r].z : r0[r].w, ub = i == 0 ? r1[r].x : i == 1 ? r1[r].y : i == 2 ? r1[r].z : r1[r].w;
                d0 = dot2bf(ua, xn[i], d0); d1 = dot2bf(ub, xn[4 + i], d1); }
            const float av = wave_sum(d0 + d1);
            const float gl = 0.5f * av * (1.0f + erff(av * 0.70710678118654752f));
            if (lane == 0) pw[kb + r] = pw[kb + r] * gl;
        }
    }
    asm volatile("s_waitcnt lgkmcnt(0)" ::: "memory");
    float out[16];
#pragma unroll
    for (int i = 0; i < 16; ++i) out[i] = 0.f;
    for (int kb = 0; kb < 128; kb += 8) {
        u32x4 r0[8], r1[8];
#pragma unroll
        for (int r = 0; r < 8; ++r) { const int k = kb + r; const int e = k < 64 ? __builtin_amdgcn_readlane(e_lo, k) : __builtin_amdgcn_readlane(e_hi, k - 64);
            const u32x4* vp = (const u32x4*)(VT + (size_t)e * DM); r0[r] = vp[lane]; r1[r] = vp[64 + lane]; }
#pragma unroll
        for (int r = 0; r < 8; ++r) {
            const float w = pw[kb + r];
#pragma unroll
            for (int i = 0; i < 4; ++i) { const unsigned ua = i == 0 ? r0[r].x : i == 1 ? r0[r].y : i == 2 ? r0[r].z : r0[r].w, ub = i == 0 ? r1[r].x : i == 1 ? r1[r].y : i == 2 ? r1[r].z : r1[r].w;
                out[2 * i] += w * bflo(ua); out[2 * i + 1] += w * bfhi(ua); out[8 + 2 * i] += w * bflo(ub); out[8 + 2 * i + 1] += w * bfhi(ub); }
        }
    }
    {
        float ss = 0.f;
#pragma unroll
        for (int i = 0; i < 16; ++i) { hv[i] += out[i]; ss += hv[i] * hv[i]; }
        const float rstd = 1.0f / sqrtf(wave_sum(ss) * (1.0f / DM) + EPS);
        float* yp = H + (size_t)t * DM;
#pragma unroll
        for (int i = 0; i < 4; ++i) { const f32x4 g = *(const f32x4*)(gfin + (i >> 1) * 512 + 8 * lane + (i & 1) * 4);
            *(f32x4*)(yp + (i >> 1) * 512 + 8 * lane + (i & 1) * 4) = (f32x4){hv[4 * i] * rstd * g[0], hv[4 * i + 1] * rstd * g[1], hv[4 * i + 2] * rstd * g[2], hv[4 * i + 3] * rstd * g[3]}; }
    }
    asm volatile("s_waitcnt lgkmcnt(0)" ::: "memory");
}
}

constexpr int NWAVES = 8;
#ifndef MK_N_LAUNCHES
#define MK_N_LAUNCHES 1
#endif
constexpr int N_LAUNCHES = MK_N_LAUNCHES;
constexpr int PER_PHASE = 7;

typedef unsigned short bf16;
typedef unsigned v4u __attribute__((ext_vector_type(4)));
typedef float f32x4 __attribute__((ext_vector_type(4)));
#define LDS_WAIT() asm volatile("s_waitcnt lgkmcnt(0)" ::: "memory")
#define VM_WAIT() asm volatile("s_waitcnt vmcnt(0)" ::: "memory")

constexpr size_t MiB = 1u << 20;
constexpr size_t WS_CTL = 0, CTL_ZERO_BYTES = 64 * 1024;
constexpr size_t WS_TAB = 1 * MiB;
constexpr size_t WS_SSQ = 1 * MiB + 64 * 1024;
constexpr size_t WS_WIN = 3 * MiB;
constexpr size_t WS_WA = 10 * MiB, WS_WB = 11 * MiB;
constexpr size_t WS_WO = 12 * MiB;
constexpr size_t WS_WE = 14 * MiB;
constexpr size_t WS_UT = 18 * MiB, WS_VT = 50 * MiB;
constexpr size_t WS_XN = 82 * MiB;
constexpr size_t WS_ACT = 114 * MiB;
constexpr size_t WS_QA = WS_ACT, WS_QB = WS_ACT + 16 * MiB;
constexpr size_t WS_KA = WS_ACT + 32 * MiB, WS_VA = WS_ACT + 36 * MiB, WS_KB = WS_ACT + 40 * MiB, WS_VB = WS_ACT + 44 * MiB;
constexpr size_t WS_GA = WS_ACT + 48 * MiB, WS_GB = WS_ACT + 80 * MiB;
constexpr size_t WS_SC = WS_ACT;
constexpr size_t WS_END = 242 * MiB;
static_assert(WS_GB + 32 * MiB <= WS_END && WS_SC + (size_t)NTOK * SCW * 4 <= WS_END, "d_ws map");

constexpr int RING_BYTES = 131072;
constexpr int MISC_OFF = RING_BYTES + 320;
constexpr int LDS_BYTES = 147456;

#define XB_TMO      128
#define XB_XCNT(j)  (256  + 64 * (j))
#define XB_XSUB(j)  (1280 + 64 * (j))
#define XB_XGEN(j)  (2304 + 64 * (j))
#define XB_TOP      3328
#define XB_TOPGEN   3392
#define XCD_BAR_WORDS 3456
#define XB_SPIN_CAP (1u << 18)

__device__ __forceinline__ unsigned xb_ld(unsigned* p)              { return __hip_atomic_load(p, __ATOMIC_RELAXED, __HIP_MEMORY_SCOPE_AGENT); }
__device__ __forceinline__ unsigned xb_add(unsigned* p, unsigned v) { return __hip_atomic_fetch_add(p, v, __ATOMIC_RELAXED, __HIP_MEMORY_SCOPE_AGENT); }
__device__ __forceinline__ unsigned xb_xcc_id() { return (unsigned)__builtin_amdgcn_s_getreg((3 << 11) | 20) & 0xFu; }
#define XB_SPIN(cond, bar) do { unsigned _sp = 0; while (cond) { __builtin_amdgcn_s_sleep(1); \
    if ((++_sp & 255u) == 0u) { if (xb_ld(&(bar)[XB_TMO])) break; if (_sp > XB_SPIN_CAP) { atomicAdd(&(bar)[XB_TMO], 1u); break; } } } } while (0)

struct XcdBarrier {
    unsigned* bar; unsigned x;
    volatile LAS unsigned* st;
};

__device__ __forceinline__ XcdBarrier xcd_barrier_post(unsigned* bar, volatile LAS unsigned* st) {
    XcdBarrier b; b.bar = bar; b.x = xb_xcc_id(); b.st = st;
    if (threadIdx.x == 0) (void)xb_add(&bar[XB_XCNT(b.x)], 1u);
    return b;
}
__device__ __forceinline__ void xcd_barrier_complete(unsigned* bar, unsigned x, unsigned& nloc, unsigned& nx) {
    const unsigned G = gridDim.x * gridDim.y * gridDim.z;
    unsigned sum, cnt, mine, sp = 0u;
    for (;;) {
        sum = 0u; cnt = 0u; mine = 0u;
#pragma unroll
        for (unsigned j = 0; j < 16; ++j) { const unsigned c = xb_ld(&bar[XB_XCNT(j)]); sum += c; cnt += (c > 0u) ? 1u : 0u; mine = (j == x) ? c : mine; }
        if (sum == G) break;
        __builtin_amdgcn_s_sleep(1);
        if ((++sp & 255u) == 0u) { if (xb_ld(&bar[XB_TMO])) break; if (sp > XB_SPIN_CAP) { atomicAdd(&bar[XB_TMO], 1u); break; } }
    }
    nloc = mine > 0u ? mine : 1u; nx = cnt > 0u ? cnt : 1u;
}

__device__ __forceinline__ void xcd_barrier(const XcdBarrier& b) {
    asm volatile("s_waitcnt vmcnt(0)" ::: "memory");
    __syncthreads();
    if (threadIdx.x == 0) {
        unsigned* bar = b.bar;
        __builtin_amdgcn_s_waitcnt(0);
        unsigned nloc = b.st[0], nx = b.st[1];
        if (nloc == 0u) { xcd_barrier_complete(bar, b.x, nloc, nx); b.st[0] = nloc; b.st[1] = nx; }
        const unsigned old = xb_add(&bar[XB_XSUB(b.x)], 1u);
        const unsigned gen = old / nloc;
        if (old + 1u == (gen + 1u) * nloc) {
            __builtin_amdgcn_fence(__ATOMIC_RELEASE, "agent");
            asm volatile("s_waitcnt vmcnt(0)" ::: "memory");
            const unsigned og = xb_add(&bar[XB_TOP], 1u);
            const unsigned tg = og / nx;
            if (og + 1u == (tg + 1u) * nx) xb_add(&bar[XB_TOPGEN], 1u);
            else XB_SPIN(xb_ld(&bar[XB_TOPGEN]) == tg, bar);
            __builtin_amdgcn_fence(__ATOMIC_ACQUIRE, "agent");
            xb_add(&bar[XB_XGEN(b.x)], 1u);
            asm volatile("s_waitcnt vmcnt(0)" ::: "memory");
        } else {
            XB_SPIN(xb_ld(&bar[XB_XGEN(b.x)]) == gen, bar);
            __builtin_amdgcn_fence(__ATOMIC_ACQUIRE, "agent");
            asm volatile("s_waitcnt vmcnt(0)" ::: "memory");
        }
    }
    __syncthreads();
}


struct Args { const float* in[17]; float* out; unsigned char* ws; int ph_lo, ph_hi, li, pad; };

__device__ __forceinline__ void p0_transpose_item(const float* W, int K, int N, bf16* WT, int k0, int src_n0, int dst_n0, LAS float* scr, int lane) {
#pragma unroll 8
    for (int i = 0; i < 32; ++i) { const int kk = 2 * i + (lane >> 5); scr[kk * 33 + (lane & 31)] = W[(size_t)(k0 + kk) * N + src_n0 + (lane & 31)]; }
    LDS_WAIT();
    const int c = lane & 7;
#pragma unroll
    for (int j = 0; j < 4; ++j) { const int n = (lane >> 3) + 8 * j; const LAS float* s = scr + (8 * c) * 33 + n;
        v4u o; o.x = pkbf(s[0 * 33], s[1 * 33]); o.y = pkbf(s[2 * 33], s[3 * 33]); o.z = pkbf(s[4 * 33], s[5 * 33]); o.w = pkbf(s[6 * 33], s[7 * 33]);
        *(v4u*)(WT + (size_t)(dst_n0 + n) * K + k0 + 8 * c) = o; }
    LDS_WAIT();
}
__device__ __forceinline__ int win_src_col(int dst_n0) {
    if (dst_n0 >= 1536) return dst_n0;
    const int tile = dst_n0 >> 8, c = dst_n0 & 255;
    return tile * 256 + 64 * ((c >> 5) & 3) + 32 * (c >> 7);
}
__device__ __forceinline__ int t5_bucket(int rel) {
    const int n = rel < 0 ? -rel : rel; int bkt;
    if (n < 8) bkt = n; else { int v = 8 + (31 - __builtin_clz(n * n)) - 6; bkt = v > 15 ? 15 : v; }
    return bkt + (rel > 0 ? 16 : 0);
}

__global__ void __launch_bounds__(NWAVES * 64, 2) mk_fwd(Args args) {
    extern __shared__ __attribute__((aligned(16))) unsigned char lds_raw[];
    LAS unsigned char* lds = (LAS unsigned char*)lds_raw;
    volatile LAS unsigned* MISC = (volatile LAS unsigned*)(lds + MISC_OFF);
    const int tid = threadIdx.x, lane = tid & 63, wave = __builtin_amdgcn_readfirstlane(tid >> 6);
    const int G = gridDim.x, bx = blockIdx.x; const int vcu = (G % 8 == 0) ? (bx % 8) * (G / 8) + bx / 8 : bx;
    const int gw = vcu * NWAVES + wave, NGW = G * NWAVES;
    unsigned char* ws = args.ws;
    const float* x = args.in[0]; const float* g_mix = args.in[1]; const float* w_in = args.in[2]; const float* b_gate = args.in[3];
    const float* q_norm_g = args.in[4]; const float* k_norm_g = args.in[5]; const float* rel_bias = args.in[6]; const float* sink = args.in[7];
    const float* w_a = args.in[8]; const float* w_b = args.in[9]; const float* w_out = args.in[10]; const float* g_ffn = args.in[11];
    const float* peer_wq = args.in[12]; const float* subkeys = args.in[13]; const float* peer_u = args.in[14]; const float* peer_v = args.in[15]; const float* g_final = args.in[16];
    float* out = args.out;
    float* ROPE = (float*)(ws + WS_TAB); float* BIAS = (float*)(ws + WS_TAB + 16384); float* SSQ = (float*)(ws + WS_SSQ);
    bf16 *WIN_T = (bf16*)(ws + WS_WIN), *WA_T = (bf16*)(ws + WS_WA), *WB_T = (bf16*)(ws + WS_WB), *WO_T = (bf16*)(ws + WS_WO), *WE_T = (bf16*)(ws + WS_WE);
    bf16 *UT = (bf16*)(ws + WS_UT), *VT = (bf16*)(ws + WS_VT), *XN = (bf16*)(ws + WS_XN);
    bf16 *QA = (bf16*)(ws + WS_QA), *QB = (bf16*)(ws + WS_QB), *KA = (bf16*)(ws + WS_KA), *VA = (bf16*)(ws + WS_VA), *KB = (bf16*)(ws + WS_KB), *VB = (bf16*)(ws + WS_VB);
    bf16 *GA = (bf16*)(ws + WS_GA), *GB = (bf16*)(ws + WS_GB); float* SC = (float*)(ws + WS_SC);

    for (int u = tid; u < (LDS_BYTES - RING_BYTES) / 4; u += NWAVES * 64) ((LAS unsigned*)(lds + RING_BYTES))[u] = 0u;
    __syncthreads();
    XcdBarrier bar; bar.bar = (unsigned*)(ws + WS_CTL) + 1024; bar.x = 0; bar.st = nullptr;
    if (N_LAUNCHES != PER_PHASE) bar = xcd_barrier_post((unsigned*)(ws + WS_CTL) + 1024, MISC + 8);
    const int lo = args.ph_lo, hi = args.ph_hi;
#define IN(k) (lo <= (k) && (k) < hi)
#define BOTH(k) (IN(k) && IN((k) + 1))
#define GRID_BAR() do { if (N_LAUNCHES != PER_PHASE) xcd_barrier(bar); } while (0)

    if (IN(0)) {
        LAS float* scr = (LAS float*)(lds + wave * 16384);
        {
            constexpr int I_IN = (DM / 64) * (INW / 32), I_AB = (QW / 64) * (DM / 32), I_O = (DM / 64) * (DM / 32);
            constexpr int NITEMS = I_IN + 2 * I_AB + I_O;
            for (int it = gw; it < NITEMS; it += NGW) {
                int r = it;
                if (r < I_IN) { const int nblk = INW / 32, kb = r / nblk, nb = r % nblk; p0_transpose_item(w_in, DM, INW, WIN_T, 64 * kb, win_src_col(32 * nb), 32 * nb, scr, lane); continue; } r -= I_IN;
                if (r < I_AB) { const int nblk = DM / 32, kb = r / nblk, nb = r % nblk; p0_transpose_item(w_a, QW, DM, WA_T, 64 * kb, 32 * nb, 32 * nb, scr, lane); continue; } r -= I_AB;
                if (r < I_AB) { const int nblk = DM / 32, kb = r / nblk, nb = r % nblk; p0_transpose_item(w_b, QW, DM, WB_T, 64 * kb, 32 * nb, 32 * nb, scr, lane); continue; } r -= I_AB;
                { const int nblk = DM / 32, kb = r / nblk, nb = r % nblk; p0_transpose_item(w_out, DM, DM, WO_T, 64 * kb, 32 * nb, 32 * nb, scr, lane); }
            }
        }
        __syncthreads();
        {
            LAS float* sk_s = (LAS float*)lds;
            LAS float* wq_s = (LAS float*)(lds + 128 * 129 * 4);
            for (int it = vcu; it < 16 * 16; it += G) {
                const int c = it >> 4, k0 = (it & 15) * 64;
                for (int i = tid; i < 128 * 32; i += NWAVES * 64) { const int n = i >> 5, d4 = (i & 31) * 4; const f32x4 v = *(const f32x4*)(subkeys + ((size_t)c * NKEYS + n) * 128 + d4);
                    sk_s[n * 129 + d4] = v[0]; sk_s[n * 129 + d4 + 1] = v[1]; sk_s[n * 129 + d4 + 2] = v[2]; sk_s[n * 129 + d4 + 3] = v[3]; }
                for (int i = tid; i < 64 * 32; i += NWAVES * 64) { const int k = i >> 5, d4 = (i & 31) * 4; const f32x4 v = *(const f32x4*)(peer_wq + (size_t)(k0 + k) * SCW + c * 128 + d4);
                    wq_s[k * 129 + d4] = v[0]; wq_s[k * 129 + d4 + 1] = v[1]; wq_s[k * 129 + d4 + 2] = v[2]; wq_s[k * 129 + d4 + 3] = v[3]; }
                __syncthreads();
                const int k = tid & 63, ng = tid >> 6; float acc[16];
#pragma unroll
                for (int i = 0; i < 16; ++i) acc[i] = 0.f;
                for (int d = 0; d < 128; ++d) { const float a = wq_s[k * 129 + d];
#pragma unroll
                    for (int i = 0; i < 16; ++i) acc[i] += a * sk_s[(ng * 16 + i) * 129 + d]; }
                const float gk = g_ffn[k0 + k];
#pragma unroll
                for (int i = 0; i < 16; ++i) WE_T[(size_t)(c * 128 + ng * 16 + i) * DM + k0 + k] = (bf16)(pkbf(acc[i] * gk, 0.f) & 0xffffu);
                __syncthreads();
            }
        }
        {
            const size_t n8 = (size_t)NEXP * DM / 8;
            for (size_t i = (size_t)vcu * (NWAVES * 64) + tid; i < n8; i += (size_t)G * NWAVES * 64) {
                const f32x4 a = *(const f32x4*)(peer_u + i * 8), b = *(const f32x4*)(peer_u + i * 8 + 4); *(v4u*)(UT + i * 8) = (v4u){pkbf(a[0], a[1]), pkbf(a[2], a[3]), pkbf(b[0], b[1]), pkbf(b[2], b[3])};
                const f32x4 c = *(const f32x4*)(peer_v + i * 8), d = *(const f32x4*)(peer_v + i * 8 + 4); *(v4u*)(VT + i * 8) = (v4u){pkbf(c[0], c[1]), pkbf(c[2], c[3]), pkbf(d[0], d[1]), pkbf(d[2], d[3])};
            }
        }
        for (int m = gw; m < NTOK; m += NGW) {
            const f32x4* xr = (const f32x4*)(x + (size_t)m * DM) + lane; f32x4 v[4]; float s = 0.f;
#pragma unroll
            for (int j = 0; j < 4; ++j) { v[j] = xr[64 * j]; s += (v[j][0] * v[j][0] + v[j][1] * v[j][1]) + (v[j][2] * v[j][2] + v[j][3] * v[j][3]); }
            const float rstd = 1.0f / sqrtf(peer::wave_sum(s) * (1.0f / DM) + EPS);
            unsigned long long* o8 = (unsigned long long*)(XN + (size_t)m * DM) + lane;
#pragma unroll
            for (int j = 0; j < 4; ++j) { const f32x4 g = *((const f32x4*)g_mix + lane + 64 * j);
                o8[64 * j] = (unsigned long long)pkbf(v[j][0] * rstd * g[0], v[j][1] * rstd * g[1]) | ((unsigned long long)pkbf(v[j][2] * rstd * g[2], v[j][3] * rstd * g[3]) << 32); }
        }
        if (vcu == 0) {
            for (int i = tid; i < 64 * 16; i += NWAVES * 64) { const int pos = i >> 4, f = i & 15; const float fr = powf(10000.0f, -(float)f / 16.0f); const float ang = (float)pos * fr; ROPE[2 * i] = cosf(ang); ROPE[2 * i + 1] = sinf(ang); }
            for (int i = tid; i < 8 * 257; i += NWAVES * 64) { const int h = i / 257, rel = i % 257 - 128; BIAS[i] = rel_bias[t5_bucket(rel) * NH + h] * LOG2E; }
        }
        if (BOTH(0)) GRID_BAR();
    }

    if (IN(1)) {
        pg8::Gemm g{XN, WIN_T, NTOK, INW, DM}; pg8::StaticOrder S; S.init(NTOK, INW, G, bx);
        pg8::EpiIn E{QA, KA, VA, QB, KB, VB, GA, GB, q_norm_g, k_norm_g, b_gate, ROPE};
        pg8::gemm_phase<pg8::EpiIn, pg8::StaticOrder, true, true>(lds, g, S, E);
        if (BOTH(1)) GRID_BAR();
    }

    if (IN(2)) {
        for (int u = vcu; u < 512; u += G) { const int xg = u >> 6, i = u & 63; const int b = xg >> 1, h = 4 * (xg & 1) + (i >> 4), qblk = i & 15;
            attn::attn_unit<false>((LAS char*)lds, QA, KA, VA, QA, b, h, qblk, nullptr, 0.f); }
        for (int u = vcu; u < 512; u += G) { const int xg = u >> 6, i = u & 63; const int b = xg >> 1, h = 4 * (xg & 1) + (i >> 4), qblk = i & 15;
            attn::attn_unit<true>((LAS char*)lds, QB, KB, VB, QB, b, h, qblk, BIAS + h * 257, sink[h] * LOG2E); }
        if (BOTH(2)) GRID_BAR();
    }

    if (IN(3)) {
        { pg8::Gemm g{QA, WA_T, NTOK, DM, QW}; pg8::StaticOrder S; S.init(NTOK, DM, G, bx); pg8::EpiMixA E{GA};
          pg8::gemm_phase<pg8::EpiMixA, pg8::StaticOrder, true, true>(lds, g, S, E); }
        VM_WAIT(); __syncthreads();
        { pg8::Gemm g{QB, WB_T, NTOK, DM, QW}; pg8::StaticOrder S; S.init(NTOK, DM, G, bx); pg8::EpiMixB E{GA, GB};
          pg8::gemm_phase<pg8::EpiMixB, pg8::StaticOrder, true, true>(lds, g, S, E); }
        if (BOTH(3)) GRID_BAR();
    }

    if (IN(4)) {
        pg8::Gemm g{GB, WO_T, NTOK, DM, DM}; pg8::StaticOrder S; S.init(NTOK, DM, G, bx); pg8::EpiOut E{x, out, XN, SSQ};
        pg8::gemm_phase<pg8::EpiOut, pg8::StaticOrder, true, true>(lds, g, S, E);
        if (BOTH(4)) GRID_BAR();
    }

    if (IN(5)) {
        pg8::Gemm g{XN, WE_T, NTOK, SCW, DM}; pg8::StaticOrder S; S.init(NTOK, SCW, G, bx); pg8::EpiScore E{SSQ, SC};
        pg8::gemm_phase<pg8::EpiScore, pg8::StaticOrder, true, true>(lds, g, S, E);
        if (BOTH(5)) GRID_BAR();
    }

    if (IN(6)) {
        LAS char* wl = (LAS char*)lds + wave * peer::WAVE_LDS;
        const unsigned long long ct = peer::cand_table(lane & 7);
        for (int t = gw; t < NTOK; t += NGW) peer::token(wl, lane, t, ct, SC, UT, VT, out, g_ffn, g_final);
    }
#undef IN
#undef BOTH
#undef GRID_BAR
}

extern "C" void kernel_launch(void* const* d_in, const int* in_sizes, int n_in, void* d_out, int out_size, void* d_ws, size_t ws_size, hipStream_t stream) {
    static int grid = 0;
    if (grid == 0) {
        if (n_in != 17 || in_sizes[0] != NTOK * DM || out_size != NTOK * DM || ws_size < WS_END) { fprintf(stderr, "kernel_launch: unexpected shapes (n_in %d, in0 %d, out %d, ws %zu); nothing launched\n", n_in, n_in > 0 ? in_sizes[0] : -1, out_size, ws_size); grid = -1; return; }
        int dev = 0, cus = 0, per_cu = 0;
        if (hipGetDevice(&dev) != hipSuccess || hipDeviceGetAttribute(&cus, hipDeviceAttributeMultiprocessorCount, dev) != hipSuccess) { grid = -1; return; }
        if (hipFuncSetAttribute((const void*)mk_fwd, hipFuncAttributeMaxDynamicSharedMemorySize, LDS_BYTES) != hipSuccess) { fprintf(stderr, "kernel_launch: hipFuncSetAttribute failed\n"); grid = -1; return; }
        if (hipOccupancyMaxActiveBlocksPerMultiprocessor(&per_cu, (const void*)mk_fwd, NWAVES * 64, LDS_BYTES) != hipSuccess || per_cu < 1) { fprintf(stderr, "kernel_launch: occupancy query says %d blocks per CU; nothing launched\n", per_cu); (void)hipGetLastError(); grid = -1; return; }
        grid = cus;
    }
    if (grid < 0) return;
    if (hipMemsetAsync((char*)d_ws + WS_CTL, 0, CTL_ZERO_BYTES, stream) != hipSuccess) { fprintf(stderr, "kernel_launch: hipMemsetAsync failed\n"); return; }
    Args a{};
    for (int i = 0; i < 17; ++i) a.in[i] = (const float*)d_in[i];
    a.out = (float*)d_out; a.ws = (unsigned char*)d_ws;
    if (N_LAUNCHES == 1) {
        a.ph_lo = 0; a.ph_hi = PER_PHASE; a.li = 0;
        void* kargs[] = {&a};
        hipError_t e = hipLaunchCooperativeKernel((const void*)mk_fwd, dim3(grid), dim3(NWAVES * 64), kargs, LDS_BYTES, stream);
        if (e != hipSuccess) fprintf(stderr, "kernel_launch: cooperative launch failed: %s (grid %d)\n", hipGetErrorString(e), grid);
    } else {
        for (int li = 0; li < PER_PHASE; ++li) { a.ph_lo = li; a.ph_hi = li + 1; a.li = li;
            hipLaunchKernelGGL(mk_fwd, dim3(grid), dim3(NWAVES * 64), LDS_BYTES, stream, a); }
    }
}
```

```cpp
#include <hip/hip_runtime.h>
#include <cstdio>
#include <cstdint>
#include <cmath>
namespace pg8 {
#define PG8_LAS __attribute__((address_space(3)))
typedef unsigned short bf16_t;
typedef short bf16x8 __attribute__((ext_vector_type(8)));
typedef float f32x4 __attribute__((ext_vector_type(4)));
typedef unsigned u32x4 __attribute__((ext_vector_type(4)));
constexpr int BM = 256, BK = 64, HALF = 128, HTB = HALF * BK * 2  , STAGE_BYTES = 8 * HTB, NXCD = 8, WGM = 8;

__host__ __device__ __forceinline__ int lds_byte(int r, int c) { const int st = (r >> 4) * 2 + (c >> 5), rr = r & 15, cc = c & 31, ob = rr * 64 + cc * 2; return st * 1024 + (ob ^ (((ob >> 9) & 1) << 5)); }
__host__ __device__ __forceinline__ void stage_rc(int b, int& R, int& C) { const int st = b / 1024, sb = b % 1024, swz = sb ^ (((sb >> 9) & 1) << 5); R = (st >> 1) * 16 + swz / 64; C = (st & 1) * 32 + (swz % 64) / 2; }
__host__ __device__ __forceinline__ int perm32(int rho) { const int n = rho >> 4, i = rho & 15; return 8 * (i >> 2) + 4 * n + (i & 3); }

struct Unit { int pm, pn; };
struct Gemm { const bf16_t* A; const bf16_t* Bt; int M, N, K; };

struct StaticOrder {
    int nM, nN, nwg, G, c;
    __host__ __device__ void init(int M, int N, int G_, int c_) { nM = M / BM; nN = N / BM; nwg = nM * nN; G = G_; c = c_; }
    __host__ __device__ bool next(int i, Unit& u) const {
        const long L = (long)i * G + c; if (L >= nwg) return false;
        int wgid = (int)L; { const int q = nwg / NXCD, r = nwg % NXCD, xcd = wgid % NXCD, off = wgid / NXCD; wgid = (xcd < r ? xcd * (q + 1) : r * (q + 1) + (xcd - r) * q) + off; }
        const int nig = WGM * nN, gid = wgid / nig, fm = gid * WGM, gsz = (nM - fm) < WGM ? (nM - fm) : WGM;
        u.pm = fm + ((wgid % nig) % gsz); u.pn = (wgid % nig) / gsz; return true;
    }
    __device__ __forceinline__ void a_ready(const Unit&) const {}
    __device__ __forceinline__ void done(const Unit&) const {}
};

__device__ __forceinline__ unsigned cvt_pk_bf16(float lo, float hi) { unsigned r; asm volatile("v_cvt_pk_bf16_f32 %0, %1, %2" : "=v"(r) : "v"(lo), "v"(hi)); return r; }
typedef float f32x2 __attribute__((ext_vector_type(2)));
template <class Epi, class Sched, bool ALIGN_EPI = false, bool SP2 = false>
__device__ __forceinline__ void gemm_phase(PG8_LAS unsigned char* lds, const Gemm g, const Sched& S, const Epi& E) {
    const int tid = threadIdx.x, wid = __builtin_amdgcn_readfirstlane(tid >> 6), lane = tid & 63, wr = wid >> 2, wc = wid & 3, fr = lane & 15, fq = lane >> 4;
    const int K = g.K, nt = K / BK;
    unsigned voffA[2], voffB[2];
#pragma unroll
    for (int i = 0; i < 2; ++i) { int R, C; stage_rc(tid * 16 + i * 8192, R, C); const int Rb = Epi::PERM ? ((R & ~31) + perm32(R & 31)) : R;
        voffA[i] = (unsigned)(R * K + C) * 2u; voffB[i] = (unsigned)(Rb * K + C) * 2u; }
    const size_t kstep = (size_t)(BK * 2);
    const size_t hstep = (size_t)HALF * K * 2;
    const size_t tstep = 2 * hstep;
    const unsigned ldsw = (unsigned)wid * 1024u;
    const int aoff = lds_byte(wr * 64 + fr, fq * 8), boff = lds_byte(wc * 32 + fr, fq * 8);
#define PG8_SA(b, h) (((b) * 2 + (h)) * HTB)
#define PG8_SB(b, h) ((4 + (b) * 2 + (h)) * HTB)
#define PG8_STAGE(bufoff, gbase, voff) do { _Pragma("unroll") for (int _i = 0; _i < 2; ++_i) \
        __builtin_amdgcn_global_load_lds((const unsigned*)((const char*)(gbase) + (voff)[_i]), (PG8_LAS unsigned*)(lds + (bufoff) + ldsw + _i * 8192), 16, 0, 0); } while (0)
#define PG8_LDA(dst, b, h) do { _Pragma("unroll") for (int m = 0; m < 4; ++m) _Pragma("unroll") for (int k = 0; k < 2; ++k) dst[m][k] = *(const PG8_LAS bf16x8*)(lds + PG8_SA(b, h) + aoff + m * 2048 + k * 1024); } while (0)
#define PG8_LDB(dst, b, h) do { _Pragma("unroll") for (int n = 0; n < 2; ++n) _Pragma("unroll") for (int k = 0; k < 2; ++k) dst[n][k] = *(const PG8_LAS bf16x8*)(lds + PG8_SB(b, h) + boff + n * 2048 + k * 1024); } while (0)
#define PG8_MMA(ai, bj, At, Bt) do { __builtin_amdgcn_s_setprio(1); _Pragma("unroll") for (int m = 0; m < 4; ++m) _Pragma("unroll") for (int n = 0; n < 2; ++n) _Pragma("unroll") for (int k = 0; k < 2; ++k) \
        acc[ai][bj][m][n] = __builtin_amdgcn_mfma_f32_16x16x32_bf16(Bt[n][k], At[m][k], acc[ai][bj][m][n], 0, 0, 0); __builtin_amdgcn_s_setprio(0); } while (0)
#define PG8_WAIT_V(n) asm volatile("s_waitcnt vmcnt(" #n ")" ::: "memory")
#define PG8_WAIT_L(n) asm volatile("s_waitcnt lgkmcnt(" #n ")" ::: "memory")
#define PG8_BAR __builtin_amdgcn_s_barrier()
#define PG8_SCHED __builtin_amdgcn_sched_barrier(0)
    Unit cur, nxt; int ui = 0;
    if (!S.next(0, cur)) return;
    f32x4 acc[2][2][4][2];
#pragma unroll
    for (int a = 0; a < 2; ++a)
#pragma unroll
        for (int b = 0; b < 2; ++b)
#pragma unroll
            for (int m = 0; m < 4; ++m)
#pragma unroll
                for (int n = 0; n < 2; ++n) acc[a][b][m][n] = (f32x4){0.f, 0.f, 0.f, 0.f};
    bf16x8 At[4][2], B0[2][2], B1[2][2];
    const char* cA = (const char*)g.A + (size_t)cur.pm * tstep; const char* cB = (const char*)g.Bt + (size_t)cur.pn * tstep;
    S.a_ready(cur);
    if constexpr (SP2) {
        PG8_STAGE(PG8_SB(0, 0), cB, voffB); PG8_STAGE(PG8_SB(0, 1), cB + hstep, voffB); PG8_STAGE(PG8_SA(0, 0), cA, voffA); PG8_STAGE(PG8_SA(0, 1), cA + hstep, voffA);
        if (wr == 1) PG8_BAR;
        PG8_WAIT_V(2); PG8_BAR;
        PG8_STAGE(PG8_SB(1, 0), cB + kstep, voffB); PG8_STAGE(PG8_SA(1, 0), cA + kstep, voffA); PG8_STAGE(PG8_SB(1, 1), cB + hstep + kstep, voffB);
        PG8_WAIT_V(6); PG8_BAR;
    } else {
        PG8_STAGE(PG8_SB(0, 0), cB, voffB); PG8_STAGE(PG8_SA(0, 0), cA, voffA); PG8_STAGE(PG8_SB(0, 1), cB + hstep, voffB); PG8_STAGE(PG8_SA(0, 1), cA + hstep, voffA);
        if (wr == 1) PG8_BAR;
        PG8_WAIT_V(4); PG8_BAR;
        PG8_STAGE(PG8_SB(1, 0), cB + kstep, voffB); PG8_STAGE(PG8_SA(1, 0), cA + kstep, voffA); PG8_STAGE(PG8_SB(1, 1), cB + hstep + kstep, voffB);
        PG8_WAIT_V(6); PG8_BAR;
    }
    for (;;) {
        const bool has_next = S.next(ui + 1, nxt);
        const char* nA = has_next ? (const char*)g.A + (size_t)nxt.pm * tstep : cA; const char* nB = has_next ? (const char*)g.Bt + (size_t)nxt.pn * tstep : cB;
        for (int t = 0; t < nt; t += 2) {
            const bool last = (t == nt - 2);
            const char* a1 = cA + (size_t)(t + 1) * kstep;
            const char* a2 = last ? nA : cA + (size_t)(t + 2) * kstep; const char* b2 = last ? nB : cB + (size_t)(t + 2) * kstep;
            const char* a3 = a2 + kstep; const char* b3 = b2 + kstep;
            if (last && has_next) S.a_ready(nxt);
            if constexpr (SP2) {
            PG8_LDB(B0, 0, 0); PG8_LDB(B1, 0, 1); PG8_SCHED; PG8_LDA(At, 0, 0); PG8_STAGE(PG8_SA(1, 1), a1 + hstep, voffA);
            PG8_WAIT_V(8); PG8_WAIT_L(0); PG8_BAR; PG8_MMA(0, 0, At, B0); PG8_MMA(0, 1, At, B1); PG8_BAR; PG8_SCHED;
            PG8_LDA(At, 0, 1); PG8_STAGE(PG8_SB(0, 0), b2, voffB); PG8_STAGE(PG8_SB(0, 1), b2 + hstep, voffB); PG8_STAGE(PG8_SA(0, 0), a2, voffA);
            PG8_WAIT_V(8); PG8_WAIT_L(0); PG8_BAR; PG8_MMA(1, 0, At, B0); PG8_MMA(1, 1, At, B1); PG8_BAR; PG8_SCHED;
            PG8_LDB(B0, 1, 0); PG8_LDB(B1, 1, 1); PG8_SCHED; PG8_LDA(At, 1, 0); PG8_STAGE(PG8_SA(0, 1), a2 + hstep, voffA);
            PG8_WAIT_V(8); PG8_WAIT_L(0); PG8_BAR; PG8_MMA(0, 0, At, B0); PG8_MMA(0, 1, At, B1); PG8_BAR; PG8_SCHED;
            PG8_LDA(At, 1, 1); PG8_STAGE(PG8_SB(1, 0), b3, voffB); PG8_STAGE(PG8_SB(1, 1), b3 + hstep, voffB); PG8_STAGE(PG8_SA(1, 0), a3, voffA);
            PG8_WAIT_V(8); PG8_WAIT_L(0); PG8_BAR; PG8_MMA(1, 0, At, B0); PG8_MMA(1, 1, At, B1); PG8_BAR; PG8_SCHED;
            } else {
            PG8_LDB(B0, 0, 0); PG8_SCHED; PG8_LDA(At, 0, 0); PG8_STAGE(PG8_SA(1, 1), a1 + hstep, voffA);
            PG8_WAIT_L(8); PG8_BAR; PG8_WAIT_L(0); PG8_MMA(0, 0, At, B0); PG8_BAR; PG8_SCHED;
            PG8_LDB(B1, 0, 1); PG8_STAGE(PG8_SB(0, 0), b2, voffB);
            PG8_BAR; PG8_WAIT_L(0); PG8_MMA(0, 1, At, B1); PG8_BAR;
            PG8_LDA(At, 0, 1); PG8_STAGE(PG8_SA(0, 0), a2, voffA);
            PG8_BAR; PG8_WAIT_L(0); PG8_MMA(1, 0, At, B0); PG8_BAR; PG8_SCHED;
            PG8_STAGE(PG8_SB(0, 1), b2 + hstep, voffB);
            PG8_WAIT_V(6); PG8_BAR; PG8_MMA(1, 1, At, B1); PG8_BAR;
            PG8_LDB(B0, 1, 0); PG8_SCHED; PG8_LDA(At, 1, 0); PG8_STAGE(PG8_SA(0, 1), a2 + hstep, voffA);
            PG8_WAIT_L(8); PG8_BAR; PG8_WAIT_L(0); PG8_MMA(0, 0, At, B0); PG8_BAR; PG8_SCHED;
            PG8_LDB(B1, 1, 1); PG8_STAGE(PG8_SB(1, 0), b3, voffB);
            PG8_BAR; PG8_WAIT_L(0); PG8_MMA(0, 1, At, B1); PG8_BAR;
            PG8_LDA(At, 1, 1); PG8_STAGE(PG8_SA(1, 0), a3, voffA);
            PG8_BAR; PG8_WAIT_L(0); PG8_MMA(1, 0, At, B0); PG8_BAR; PG8_SCHED;
            PG8_STAGE(PG8_SB(1, 1), b3 + hstep, voffB);
            PG8_WAIT_V(6); PG8_BAR; PG8_MMA(1, 1, At, B1); PG8_BAR;
            }
        }
        if constexpr (ALIGN_EPI) { if (wr == 0) PG8_BAR; }
        if constexpr (!Epi::AFTER_DRAIN) { E(acc, cur, wr, wc, fr, fq); S.done(cur); }
        if (!has_next) break;
#pragma unroll
        for (int a = 0; a < 2; ++a)
#pragma unroll
            for (int b = 0; b < 2; ++b)
#pragma unroll
                for (int m = 0; m < 4; ++m)
#pragma unroll
                    for (int n = 0; n < 2; ++n) acc[a][b][m][n] = (f32x4){0.f, 0.f, 0.f, 0.f};
        cur = nxt; cA = nA; cB = nB; ++ui;
        if constexpr (ALIGN_EPI) { if (wr == 1) PG8_BAR; }
    }
    PG8_WAIT_V(0);
    if constexpr (!ALIGN_EPI) { if (wr == 0) PG8_BAR; }
    PG8_BAR;
    if constexpr (Epi::AFTER_DRAIN) { E.fused(acc, cur, wr, wc, fr, fq, lds, wid, lane); S.done(cur); }
#undef PG8_SA
#undef PG8_SB
#undef PG8_STAGE
#undef PG8_LDA
#undef PG8_LDB
#undef PG8_MMA
#undef PG8_WAIT_V
#undef PG8_WAIT_L
#undef PG8_BAR
#undef PG8_SCHED
}
}

constexpr int DM = 1024, NB = 4, SEQ = 4096, NTOK = NB * SEQ;
constexpr int HD = 64, NH = 8, NKV = 2, QW = NH * HD  , GRIDW = 64;
constexpr int INW = 3584;
constexpr int PH = 8, NKEYS = 128, TOPK = 16, NEXP = NKEYS * NKEYS, SCW = PH * 2 * NKEYS  ;
constexpr float EPS = 1e-6f;
constexpr float LOG2E = 1.4426950408889634f;
constexpr float QSCALE = 0.125f * LOG2E;

typedef unsigned u32x2_t __attribute__((ext_vector_type(2)));
typedef float f32x2_t __attribute__((ext_vector_type(2)));
typedef __bf16 bf16x2_t __attribute__((ext_vector_type(2)));
__device__ __forceinline__ unsigned pkbf(float lo, float hi) { f32x2_t v = {lo, hi}; bf16x2_t b = __builtin_convertvector(v, bf16x2_t); return __builtin_bit_cast(unsigned, b); }
__device__ __forceinline__ float bflo(unsigned w) { return __builtin_bit_cast(float, w << 16); }
__device__ __forceinline__ float bfhi(unsigned w) { return __builtin_bit_cast(float, w & 0xffff0000u); }

__device__ __forceinline__ size_t kimg_off(int b, int kvh, int s, int dim) { return ((size_t)((b * NKV + kvh) * (SEQ / 64) + (s >> 6)) << 12) + (dim >> 3) * 512 + (s & 63) * 8 + (dim & 7); }
__device__ __forceinline__ size_t vimg_off(int b, int kvh, int s, int dim) { return ((size_t)((b * NKV + kvh) * (SEQ / 64) + (s >> 6)) << 12) + (dim >> 5) * 2048 + (s & 63) * 32 + (dim & 31); }

namespace pg8 {
struct EpiIn {
    static constexpr bool PERM = false, AFTER_DRAIN = false;
    bf16_t *Qa, *Ka, *Va, *Qb, *Kb, *Vb, *Ga, *Gb;
    const float *qg, *kg, *bgate, *rope;
    __device__ __forceinline__ void operator()(const f32x4 (&acc)[2][2][4][2], const Unit& u, int wr, int wc, int fr, int fq) const {
        const int pn = u.pn;
        if (pn >= 6) {
            const bool isA = pn < 10; bf16_t* G = isA ? Ga : Gb; const int ct = (isA ? pn - 6 : pn - 10) * BM; const float* bb = bgate + (isA ? 0 : DM);
            f32x4 bv[2][2];
#pragma unroll
            for (int bj = 0; bj < 2; ++bj)
#pragma unroll
                for (int n = 0; n < 2; ++n) bv[bj][n] = *(const f32x4*)(bb + ct + bj * HALF + wc * 32 + n * 16 + 4 * fq);
#pragma unroll
            for (int ai = 0; ai < 2; ++ai)
#pragma unroll
                for (int m = 0; m < 4; ++m) { const int row = u.pm * BM + ai * HALF + wr * 64 + m * 16 + fr; bf16_t* rp = G + (size_t)row * DM + ct + wc * 32 + 4 * fq;
#pragma unroll
                    for (int bj = 0; bj < 2; ++bj)
#pragma unroll
                        for (int n = 0; n < 2; ++n) { const f32x4 z = acc[ai][bj][m][n] + bv[bj][n]; f32x4 g;
#pragma unroll
                            for (int j = 0; j < 4; ++j) g[j] = __builtin_amdgcn_rcpf(1.0f + __builtin_amdgcn_exp2f(-LOG2E * z[j]));
                            u32x2_t w; w.x = pkbf(g[0], g[1]); w.y = pkbf(g[2], g[3]); *(u32x2_t*)(rp + bj * HALF + n * 16) = w; } }
            return;
        }
        const bool brA = pn < 3; const int pl = brA ? pn : pn - 3;
        const bool isq = pl < 2, isk = (!isq) && wc < 2;
        const bool normrope = brA && (isq || isk);
        f32x4 gv[2][2];
        if (normrope) { const float* g = isq ? qg : kg;
#pragma unroll
            for (int bj = 0; bj < 2; ++bj)
#pragma unroll
                for (int n = 0; n < 2; ++n) gv[bj][n] = *(const f32x4*)(g + 32 * bj + 16 * n + 4 * fq); }
        const float osc = isq ? QSCALE : 1.0f;
#pragma unroll
        for (int ai = 0; ai < 2; ++ai)
#pragma unroll
            for (int m = 0; m < 4; ++m) {
                const int row = u.pm * BM + ai * HALF + wr * 64 + m * 16 + fr; const int b = row >> 12, s = row & (SEQ - 1);
                f32x4 v[2][2];
#pragma unroll
                for (int bj = 0; bj < 2; ++bj)
#pragma unroll
                    for (int n = 0; n < 2; ++n) v[bj][n] = acc[ai][bj][m][n];
                if (normrope) {
                    float ss = 0.f;
#pragma unroll
                    for (int bj = 0; bj < 2; ++bj)
#pragma unroll
                        for (int n = 0; n < 2; ++n) ss += (v[bj][n][0] * v[bj][n][0] + v[bj][n][1] * v[bj][n][1]) + (v[bj][n][2] * v[bj][n][2] + v[bj][n][3] * v[bj][n][3]);
                    ss += __shfl_xor(ss, 16); ss += __shfl_xor(ss, 32);
                    const float rstd = 1.0f / sqrtf(ss * (1.0f / 64.0f) + EPS);
#pragma unroll
                    for (int bj = 0; bj < 2; ++bj) {
                        const int pos = bj == 0 ? (s >> 6) : (s & (GRIDW - 1));
                        const f32x4 cs0 = *(const f32x4*)(rope + (pos * 16 + 4 * fq) * 2), cs1 = *(const f32x4*)(rope + (pos * 16 + 4 * fq) * 2 + 4);
                        const float cc[4] = {cs0[0], cs0[2], cs1[0], cs1[2]}, sn[4] = {cs0[1], cs0[3], cs1[1], cs1[3]};
#pragma unroll
                        for (int j = 0; j < 4; ++j) { const float u1 = v[bj][0][j] * rstd * gv[bj][0][j], u2 = v[bj][1][j] * rstd * gv[bj][1][j];
                            v[bj][0][j] = u1 * cc[j] - u2 * sn[j]; v[bj][1][j] = u2 * cc[j] + u1 * sn[j]; }
                    }
                }
#pragma unroll
                for (int bj = 0; bj < 2; ++bj)
#pragma unroll
                    for (int n = 0; n < 2; ++n) {
                        const f32x4 o = v[bj][n] * osc; u32x2_t w; w.x = pkbf(o[0], o[1]); w.y = pkbf(o[2], o[3]);
                        const int dim = 32 * bj + 16 * n + 4 * fq;
                        bf16_t* dst;
                        if (isq) dst = (brA ? Qa : Qb) + (size_t)row * QW + (pl * 4 + wc) * HD + dim;
                        else if (wc < 2) dst = (brA ? Ka : Kb) + kimg_off(b, wc, s, dim);
                        else dst = (brA ? Va : Vb) + vimg_off(b, wc - 2, s, dim);
                        *(u32x2_t*)dst = w;
                    }
            }
    }
};

struct EpiMixA {
    static constexpr bool PERM = false, AFTER_DRAIN = false;
    const bf16_t* G; bf16_t* OUT;
    __device__ __forceinline__ void operator()(const f32x4 (&acc)[2][2][4][2], const Unit& u, int wr, int wc, int fr, int fq) const {
#pragma unroll
        for (int ai = 0; ai < 2; ++ai)
#pragma unroll
            for (int m = 0; m < 4; ++m) { const int row = u.pm * BM + ai * HALF + wr * 64 + m * 16 + fr; const size_t off = (size_t)row * DM + u.pn * BM + wc * 32 + 4 * fq;
#pragma unroll
                for (int bj = 0; bj < 2; ++bj)
#pragma unroll
                    for (int n = 0; n < 2; ++n) { const u32x2_t g = *(const u32x2_t*)(G + off + bj * HALF + n * 16); const f32x4 a = acc[ai][bj][m][n];
                        u32x2_t w; w.x = pkbf(a[0] * bflo(g.x), a[1] * bfhi(g.x)); w.y = pkbf(a[2] * bflo(g.y), a[3] * bfhi(g.y)); *(u32x2_t*)(OUT + off + bj * HALF + n * 16) = w; } }
    }
};
struct EpiMixB {
    static constexpr bool PERM = false, AFTER_DRAIN = false;
    const bf16_t* M1; const bf16_t* G; bf16_t* OUT;
    __device__ __forceinline__ void operator()(const f32x4 (&acc)[2][2][4][2], const Unit& u, int wr, int wc, int fr, int fq) const {
#pragma unroll
        for (int ai = 0; ai < 2; ++ai)
#pragma unroll
            for (int m = 0; m < 4; ++m) { const int row = u.pm * BM + ai * HALF + wr * 64 + m * 16 + fr; const size_t off = (size_t)row * DM + u.pn * BM + wc * 32 + 4 * fq;
#pragma unroll
                for (int bj = 0; bj < 2; ++bj)
#pragma unroll
                    for (int n = 0; n < 2; ++n) { u32x2_t* p = (u32x2_t*)(OUT + off + bj * HALF + n * 16); const u32x2_t g = *(const u32x2_t*)(G + off + bj * HALF + n * 16); const u32x2_t m1 = *(const u32x2_t*)(M1 + off + bj * HALF + n * 16); const f32x4 a = acc[ai][bj][m][n];
                        u32x2_t w; w.x = pkbf(bflo(m1.x) + a[0] * bflo(g.x), bfhi(m1.x) + a[1] * bfhi(g.x)); w.y = pkbf(bflo(m1.y) + a[2] * bflo(g.y), bfhi(m1.y) + a[3] * bfhi(g.y)); *p = w; } }
    }
};
struct EpiOut {
    static constexpr bool PERM = false, AFTER_DRAIN = false;
    const float* X; float* H; bf16_t* HB; float* ssq;
    __device__ __forceinline__ void operator()(const f32x4 (&acc)[2][2][4][2], const Unit& u, int wr, int wc, int fr, int fq) const {
#pragma unroll
        for (int ai = 0; ai < 2; ++ai)
#pragma unroll
            for (int m = 0; m < 4; ++m) { const int row = u.pm * BM + ai * HALF + wr * 64 + m * 16 + fr; const size_t off = (size_t)row * DM + u.pn * BM + wc * 32 + 4 * fq; float ss = 0.f;
#pragma unroll
                for (int bj = 0; bj < 2; ++bj)
#pragma unroll
                    for (int n = 0; n < 2; ++n) { const size_t o2 = off + bj * HALF + n * 16; const f32x4 h = *(const f32x4*)(X + o2) + acc[ai][bj][m][n];
                        *(f32x4*)(H + o2) = h; u32x2_t w; w.x = pkbf(h[0], h[1]); w.y = pkbf(h[2], h[3]); *(u32x2_t*)(HB + o2) = w;
                        ss += (h[0] * h[0] + h[1] * h[1]) + (h[2] * h[2] + h[3] * h[3]); }
                ss += __shfl_xor(ss, 16); ss += __shfl_xor(ss, 32);
                if (fq == 0) ssq[(size_t)row * 16 + u.pn * 4 + wc] = ss; }
    }
};
struct EpiScore {
    static constexpr bool PERM = false, AFTER_DRAIN = false;
    const float* ssq; float* SC;
    __device__ __forceinline__ void operator()(const f32x4 (&acc)[2][2][4][2], const Unit& u, int wr, int wc, int fr, int fq) const {
#pragma unroll
        for (int ai = 0; ai < 2; ++ai)
#pragma unroll
            for (int m = 0; m < 4; ++m) { const int row = u.pm * BM + ai * HALF + wr * 64 + m * 16 + fr;
                const f32x4* sp = (const f32x4*)(ssq + (size_t)row * 16); const f32x4 s0 = sp[0], s1 = sp[1], s2 = sp[2], s3 = sp[3];
                const float tot = (((s0[0] + s0[1]) + (s0[2] + s0[3])) + ((s1[0] + s1[1]) + (s1[2] + s1[3]))) + (((s2[0] + s2[1]) + (s2[2] + s2[3])) + ((s3[0] + s3[1]) + (s3[2] + s3[3])));
                const float rstd = 1.0f / sqrtf(tot * (1.0f / DM) + EPS);
                float* rp = SC + (size_t)row * SCW + u.pn * BM + wc * 32 + 4 * fq;
#pragma unroll
                for (int bj = 0; bj < 2; ++bj)
#pragma unroll
                    for (int n = 0; n < 2; ++n) *(f32x4*)(rp + bj * HALF + n * 16) = acc[ai][bj][m][n] * rstd; }
    }
};
}

#define LAS __attribute__((address_space(3)))
namespace attn {
typedef unsigned short bf16_t;
typedef short bf16x8 __attribute__((ext_vector_type(8)));
typedef short s16x4 __attribute__((ext_vector_type(4)));
typedef float f32x16 __attribute__((ext_vector_type(16)));
typedef unsigned u32x4 __attribute__((ext_vector_type(4)));
constexpr int LDS_KV = 0;
constexpr int LDS_BIAS = 32768;
constexpr int LDS_BYTES = 32768 + 2048;
__device__ __forceinline__ int crow(int r, int hi) { return (r & 3) + 8 * (r >> 2) + 4 * hi; }
__device__ __forceinline__ s16x4 vtr(const LAS char* p) { return __builtin_bit_cast(s16x4, __builtin_amdgcn_ds_read_tr16_b64_v4i16((LAS s16x4*)p)); }
__device__ __forceinline__ float xhalf_max(float v) { auto rr = __builtin_amdgcn_permlane32_swap(__float_as_uint(v), __float_as_uint(v), false, false); return fmaxf(__uint_as_float(rr[0]), __uint_as_float(rr[1])); }
__device__ __forceinline__ float xhalf_sum(float v) { auto rr = __builtin_amdgcn_permlane32_swap(__float_as_uint(v), __float_as_uint(v), false, false); return __uint_as_float(rr[0]) + __uint_as_float(rr[1]); }

template <bool WIN>
__device__ __forceinline__ void attn_unit(LAS char* lds, const bf16_t* Q, const bf16_t* Kimg, const bf16_t* Vimg, bf16_t* O, int b, int h, int qblk, const float* bias_h  , float sink_l2) {
    const int tid = threadIdx.x, lane = tid & 63, r32 = lane & 31, hi = lane >> 5; const int wid = __builtin_amdgcn_readfirstlane(tid >> 6);
    const int q0 = qblk * 256, qw0 = q0 + 32 * wid, qrow = qw0 + r32; const size_t grow = (size_t)b * SEQ + qrow;
    const int kvh = h >> 2;
    const bf16_t* Kb = Kimg + ((size_t)((b * NKV + kvh) * (SEQ / 64)) << 12);
    const bf16_t* Vb = Vimg + ((size_t)((b * NKV + kvh) * (SEQ / 64)) << 12);
    int t_lo = 0, t_hi = SEQ / 64 - 1;
    if (WIN) { t_lo = q0 / 64 - 2; if (t_lo < 0) t_lo = 0; t_hi = q0 / 64 + 5; if (t_hi > SEQ / 64 - 1) t_hi = SEQ / 64 - 1; }
    bf16x8 qr[4];
#pragma unroll
    for (int d0 = 0; d0 < 4; ++d0) qr[d0] = *(const bf16x8*)(Q + grow * QW + h * HD + d0 * 16 + hi * 8);
    LAS float* biasl = (LAS float*)(lds + LDS_BIAS);
    if (WIN) { if (tid < 257) biasl[tid] = bias_h[tid]; }
    u32x4 kreg = *(const u32x4*)(Kb + ((size_t)t_lo << 12) + tid * 8), vreg = *(const u32x4*)(Vb + ((size_t)t_lo << 12) + tid * 8);
    *(LAS u32x4*)(lds + LDS_KV + tid * 16) = kreg; *(LAS u32x4*)(lds + LDS_KV + 8192 + tid * 16) = vreg;
    __syncthreads();
    f32x16 o0 = {}, o1 = {};
    float mrun = WIN ? sink_l2 : -1e30f, lsum = (WIN && hi == 0) ? 1.0f : 0.0f;
    const int vlane = ((lane >> 4) & 1) * 32 + (lane & 3) * 8 + (4 * hi + ((lane & 15) >> 2)) * 64;
    for (int t = t_lo; t <= t_hi; ++t) {
        const int cur = (t - t_lo) & 1;
        const LAS char* Kl = lds + LDS_KV + cur * 16384; const LAS char* Vl = Kl + 8192;
        if (t < t_hi) { kreg = *(const u32x4*)(Kb + ((size_t)(t + 1) << 12) + tid * 8); vreg = *(const u32x4*)(Vb + ((size_t)(t + 1) << 12) + tid * 8); }
        bool active = true;
        if (WIN) active = (64 * t + 63 >= qw0 - 128) && (64 * t <= qw0 + 31 + 128);
        if (active) {
            f32x16 p0 = {}, p1 = {};
#pragma unroll
            for (int d0 = 0; d0 < 4; ++d0) {
                const bf16x8 a0 = *(const LAS bf16x8*)(Kl + (2 * d0 + hi) * 1024 + r32 * 16);
                const bf16x8 a1 = *(const LAS bf16x8*)(Kl + (2 * d0 + hi) * 1024 + 512 + r32 * 16);
                p0 = __builtin_amdgcn_mfma_f32_32x32x16_bf16(a0, qr[d0], p0, 0, 0, 0);
                p1 = __builtin_amdgcn_mfma_f32_32x32x16_bf16(a1, qr[d0], p1, 0, 0, 0);
            }
            if (WIN) {
#pragma unroll
                for (int r = 0; r < 16; ++r) {
                    const int rel0 = 64 * t + crow(r, hi) - qrow, rel1 = rel0 + 32;
                    int i0 = rel0 + 128, i1 = rel1 + 128; const bool ok0 = (i0 >= 0) && (i0 <= 256), ok1 = (i1 >= 0) && (i1 <= 256);
                    i0 = i0 < 0 ? 0 : (i0 > 256 ? 256 : i0); i1 = i1 < 0 ? 0 : (i1 > 256 ? 256 : i1);
                    const float b0 = biasl[i0], b1 = biasl[i1];
                    p0[r] = ok0 ? p0[r] + b0 : -1e30f; p1[r] = ok1 ? p1[r] + b1 : -1e30f;
                }
            }
            float rm = fmaxf(p0[0], p1[0]);
#pragma unroll
            for (int r = 1; r < 16; ++r) rm = fmaxf(rm, fmaxf(p0[r], p1[r]));
            rm = xhalf_max(rm);
            const float mn = fmaxf(mrun, rm), alpha = __builtin_amdgcn_exp2f(mrun - mn); mrun = mn;
            float ps = 0.f;
#pragma unroll
            for (int r = 0; r < 16; ++r) { p0[r] = __builtin_amdgcn_exp2f(p0[r] - mn); p1[r] = __builtin_amdgcn_exp2f(p1[r] - mn); ps += p0[r] + p1[r]; }
            lsum = lsum * alpha + ps;
#pragma unroll
            for (int r = 0; r < 16; ++r) { o0[r] *= alpha; o1[r] *= alpha; }
            u32x4 pk[4];
#pragma unroll
            for (int i = 0; i < 4; ++i) { pk[0][i] = pkbf(p0[2 * i], p0[2 * i + 1]); pk[1][i] = pkbf(p0[8 + 2 * i], p0[9 + 2 * i]); pk[2][i] = pkbf(p1[2 * i], p1[2 * i + 1]); pk[3][i] = pkbf(p1[8 + 2 * i], p1[9 + 2 * i]); }
#pragma unroll
            for (int ks = 0; ks < 4; ++ks) {
                const bf16x8 pf = __builtin_bit_cast(bf16x8, pk[ks]);
                const s16x4 l0 = vtr(Vl + vlane + ks * 1024), h0 = vtr(Vl + vlane + ks * 1024 + 512);
                const s16x4 l1 = vtr(Vl + vlane + 4096 + ks * 1024), h1 = vtr(Vl + vlane + 4096 + ks * 1024 + 512);
                const bf16x8 v0 = {l0[0], l0[1], l0[2], l0[3], h0[0], h0[1], h0[2], h0[3]}, v1 = {l1[0], l1[1], l1[2], l1[3], h1[0], h1[1], h1[2], h1[3]};
                o0 = __builtin_amdgcn_mfma_f32_32x32x16_bf16(v0, pf, o0, 0, 0, 0);
                o1 = __builtin_amdgcn_mfma_f32_32x32x16_bf16(v1, pf, o1, 0, 0, 0);
            }
        }
        if (t < t_hi) { *(LAS u32x4*)(lds + LDS_KV + (cur ^ 1) * 16384 + tid * 16) = kreg; *(LAS u32x4*)(lds + LDS_KV + (cur ^ 1) * 16384 + 8192 + tid * 16) = vreg; }
        __syncthreads();
    }
    const float inv = 1.0f / xhalf_sum(lsum);
    bf16_t* Orow = O + grow * QW + h * HD + 4 * hi;
#pragma unroll
    for (int g = 0; g < 4; ++g) {
        u32x2_t w0, w1;
        w0.x = pkbf(o0[4 * g] * inv, o0[4 * g + 1] * inv); w0.y = pkbf(o0[4 * g + 2] * inv, o0[4 * g + 3] * inv);
        w1.x = pkbf(o1[4 * g] * inv, o1[4 * g + 1] * inv); w1.y = pkbf(o1[4 * g + 2] * inv, o1[4 * g + 3] * inv);
        *(u32x2_t*)(Orow + 8 * g) = w0; *(u32x2_t*)(Orow + 32 + 8 * g) = w1;
    }
    __syncthreads();
}
}

namespace peer {
typedef unsigned u32x4 __attribute__((ext_vector_type(4)));
typedef float f32x4 __attribute__((ext_vector_type(4)));
constexpr int WAVE_LDS = 2048;

template <int CTRL> __device__ __forceinline__ int dppi(int x) { return __builtin_amdgcn_mov_dpp(x, CTRL, 0xf, 0xf, true); }
template <int CTRL> __device__ __forceinline__ float dppf(float x) { return __builtin_bit_cast(float, __builtin_amdgcn_mov_dpp(__builtin_bit_cast(int, x), CTRL, 0xf, 0xf, true)); }
constexpr int XOR1 = 0xB1, XOR2 = 0x4E, XOR7 = 0x141, XOR8 = 0x128;
__device__ __forceinline__ float wave_sum(float x) {
    x += dppf<XOR1>(x); x += dppf<XOR2>(x); x += dppf<XOR7>(x); x += dppf<XOR8>(x);
    auto s = __builtin_amdgcn_permlane16_swap(__float_as_uint(x), __float_as_uint(x), false, false); x = __uint_as_float(s[0]) + __uint_as_float(s[1]);
    auto t = __builtin_amdgcn_permlane32_swap(__float_as_uint(x), __float_as_uint(x), false, false); return __uint_as_float(t[0]) + __uint_as_float(t[1]);
}
__device__ __forceinline__ float dot2bf(unsigned a, unsigned b, float c) { return __builtin_amdgcn_fdot2_f32_bf16(__builtin_bit_cast(bf16x2_t, a), __builtin_bit_cast(bf16x2_t, b), c, false); }
__device__ __forceinline__ int okey(float f, int lowbits, int payload) { int b = __float_as_int(f); b ^= (b >> 31) & 0x7fffffff; return (b & ~((1 << lowbits) - 1)) | payload; }
__device__ __forceinline__ float kval(int k, int lowbits) { int b = (k & ~((1 << lowbits) - 1)) | (1 << (lowbits - 1)); b ^= (b >> 31) & 0x7fffffff; return __int_as_float(b); }
#define CE_DESC(a, b) do { const int _x = (a), _y = (b); (a) = _x > _y ? _x : _y; (b) = _x > _y ? _y : _x; } while (0)
template <int N> __device__ __forceinline__ void bitonic_sort_desc(int (&a)[N]) {
#pragma unroll
    for (int k = 2; k <= N; k <<= 1)
#pragma unroll
        for (int j = k >> 1; j > 0; j >>= 1)
#pragma unroll
            for (int i = 0; i < N; ++i) { const int l = i ^ j; if (l > i) { if ((i & k) == 0) CE_DESC(a[i], a[l]); else CE_DESC(a[l], a[i]); } }
}
template <int N> __device__ __forceinline__ void bitonic_merge_desc(int (&a)[N]) {
#pragma unroll
    for (int j = N >> 1; j > 0; j >>= 1)
#pragma unroll
        for (int i = 0; i < N; ++i) { const int l = i ^ j; if (l > i) CE_DESC(a[i], a[l]); }
}
__device__ __forceinline__ unsigned long long cand_table(int q8) {
    unsigned long long r = 0xFFFFFFFFFFFFFFFFull; int n = 0;
#pragma unroll
    for (int i = 0; i < 16; ++i)
#pragma unroll
        for (int j = 0; j < 16; ++j) if ((i + 1) * (j + 1) <= 16) { if (n / 7 == q8) { const int s = n % 7; r = (r & ~(0xFFull << (8 * s))) | ((unsigned long long)(i * 16 + j) << (8 * s)); } ++n; }
    return r;
}

__device__ __forceinline__ void route_token(LAS char* wl, int lane, int t, unsigned long long ct, const float* SC, const float* H, const float* gffn, unsigned short* E, float* G, unsigned short* XN2) {
    LAS int* skeys = (LAS int*)wl;
    {
        const int c = lane >> 2, qq = lane & 3; const f32x4* sp = (const f32x4*)(SC + (size_t)t * SCW + c * NKEYS + qq * 32);
        int a[16], bb[16];
#pragma unroll
        for (int i = 0; i < 4; ++i) { const f32x4 v = sp[i];
#pragma unroll
            for (int j = 0; j < 4; ++j) a[4 * i + j] = okey(v[j], 7, 127 - (qq * 32 + 4 * i + j)); }
#pragma unroll
        for (int i = 0; i < 4; ++i) { const f32x4 v = sp[4 + i];
#pragma unroll
            for (int j = 0; j < 4; ++j) bb[4 * i + j] = okey(v[j], 7, 127 - (qq * 32 + 16 + 4 * i + j)); }
        bitonic_sort_desc<16>(a); bitonic_sort_desc<16>(bb);
#pragma unroll
        for (int i = 0; i < 16; ++i) a[i] = a[i] > bb[15 - i] ? a[i] : bb[15 - i];
        bitonic_merge_desc<16>(a);
#pragma unroll
        for (int i = 0; i < 16; ++i) bb[i] = dppi<XOR1>(a[15 - i]);
#pragma unroll
        for (int i = 0; i < 16; ++i) a[i] = a[i] > bb[i] ? a[i] : bb[i];
        bitonic_merge_desc<16>(a);
#pragma unroll
        for (int i = 0; i < 16; ++i) bb[i] = dppi<XOR2>(a[15 - i]);
#pragma unroll
        for (int i = 0; i < 16; ++i) a[i] = a[i] > bb[i] ? a[i] : bb[i];
        bitonic_merge_desc<16>(a);
        if (qq == 0) {
#pragma unroll
            for (int i = 0; i < 4; ++i) *(LAS u32x4*)(skeys + c * 16 + 4 * i) = (u32x4){(unsigned)a[4 * i], (unsigned)a[4 * i + 1], (unsigned)a[4 * i + 2], (unsigned)a[4 * i + 3]};
        }
    }
    asm volatile("s_waitcnt lgkmcnt(0)" ::: "memory");
    {
        const int hh = lane >> 3, q8 = lane & 7;
        int a[16];
#pragma unroll
        for (int s = 0; s < 8; ++s) {
            const int code = s < 7 ? (int)((ct >> (8 * s)) & 0xFF) : 0xFF;
            const int ci = code == 0xFF ? 0 : code;
            const int ka = skeys[(2 * hh) * 16 + (ci >> 4)], kb = skeys[(2 * hh + 1) * 16 + (ci & 15)];
            const float sum = kval(ka, 7) + kval(kb, 7);
            a[s] = code == 0xFF ? (int)0x80000000 : okey(sum, 8, 255 - code);
        }
        {
            int c8[8];
#pragma unroll
            for (int i = 0; i < 8; ++i) c8[i] = a[i];
            bitonic_sort_desc<8>(c8);
#pragma unroll
            for (int i = 0; i < 8; ++i) a[i] = c8[i];
        }
#pragma unroll
        for (int i = 0; i < 8; ++i) a[8 + i] = dppi<XOR1>(a[i]);
        { int tmp[8];
#pragma unroll
          for (int i = 0; i < 8; ++i) tmp[i] = a[8 + i];
#pragma unroll
          for (int i = 0; i < 8; ++i) a[8 + i] = tmp[7 - i]; }
        bitonic_merge_desc<16>(a);
        int bb[16];
#pragma unroll
        for (int i = 0; i < 16; ++i) bb[i] = dppi<XOR2>(a[15 - i]);
#pragma unroll
        for (int i = 0; i < 16; ++i) a[i] = a[i] > bb[i] ? a[i] : bb[i];
        bitonic_merge_desc<16>(a);
#pragma unroll
        for (int i = 0; i < 16; ++i) bb[i] = dppi<XOR7>(a[15 - i]);
#pragma unroll
        for (int i = 0; i < 16; ++i) a[i] = a[i] > bb[i] ? a[i] : bb[i];
        bitonic_merge_desc<16>(a);
        int k0 = a[0], k1 = a[1];
#pragma unroll
        for (int i = 1; i < 8; ++i) { k0 = q8 == i ? a[2 * i] : k0; k1 = q8 == i ? a[2 * i + 1] : k1; }
        const float mx = kval(a[0], 8);
        const int c0 = 255 - (k0 & 255), c1 = 255 - (k1 & 255);
        const int ka0 = skeys[(2 * hh) * 16 + (c0 >> 4)], kb0 = skeys[(2 * hh + 1) * 16 + (c0 & 15)];
        const int ka1 = skeys[(2 * hh) * 16 + (c1 >> 4)], kb1 = skeys[(2 * hh + 1) * 16 + (c1 & 15)];
        const float s0 = kval(ka0, 7) + kval(kb0, 7), s1 = kval(ka1, 7) + kval(kb1, 7);
        const float e0 = __expf(s0 - mx), e1 = __expf(s1 - mx);
        float z = e0 + e1; z += dppf<XOR1>(z); z += dppf<XOR2>(z); z += dppf<XOR7>(z);
        const float rz = 1.0f / z;
        const unsigned e0i = (unsigned)((127 - (ka0 & 127)) * NKEYS + (127 - (kb0 & 127))), e1i = (unsigned)((127 - (ka1 & 127)) * NKEYS + (127 - (kb1 & 127)));
        *(unsigned*)(E + (size_t)t * 128 + hh * 16 + 2 * q8) = e0i | (e1i << 16);
        *(f32x2_t*)(G + (size_t)t * 128 + hh * 16 + 2 * q8) = (f32x2_t){e0 * rz, e1 * rz};
    }
    {
        const f32x4* hr = (const f32x4*)(H + (size_t)t * DM) + lane; f32x4 v[4]; float ss = 0.f;
#pragma unroll
        for (int j = 0; j < 4; ++j) { v[j] = hr[64 * j]; ss += (v[j][0] * v[j][0] + v[j][1] * v[j][1]) + (v[j][2] * v[j][2] + v[j][3] * v[j][3]); }
        const float rstd = 1.0f / sqrtf(wave_sum(ss) * (1.0f / DM) + EPS);
        unsigned long long* o8 = (unsigned long long*)(XN2 + (size_t)t * DM) + lane;
#pragma unroll
        for (int j = 0; j < 4; ++j) { const f32x4 g = *((const f32x4*)gffn + lane + 64 * j);
            o8[64 * j] = (unsigned long long)pkbf(v[j][0] * rstd * g[0], v[j][1] * rstd * g[1]) | ((unsigned long long)pkbf(v[j][2] * rstd * g[2], v[j][3] * rstd * g[3]) << 32); }
    }
    asm volatile("s_waitcnt lgkmcnt(0)" ::: "memory");
}

constexpr size_t SLICE_BYTES = (size_t)NEXP * 128;
__device__ __forceinline__ unsigned getw(const u32x4& v, int i) { return i == 0 ? v.x : i == 1 ? v.y : i == 2 ? v.z : v.w; }
__device__ __forceinline__ float wave_max(float x) {
    x = fmaxf(x, dppf<XOR1>(x)); x = fmaxf(x, dppf<XOR2>(x)); x = fmaxf(x, dppf<XOR7>(x)); x = fmaxf(x, dppf<XOR8>(x));
    auto s = __builtin_amdgcn_permlane16_swap(__float_as_uint(x), __float_as_uint(x), false, false); x = fmaxf(__uint_as_float(s[0]), __uint_as_float(s[1]));
    auto t = __builtin_amdgcn_permlane32_swap(__float_as_uint(x), __float_as_uint(x), false, false); return fmaxf(__uint_as_float(t[0]), __uint_as_float(t[1]));
}
__device__ __forceinline__ void table_row_fp8(const float* src, unsigned char* T8, float* INV, int e, int lane) {
    const f32x4* p = (const f32x4*)(src + (size_t)e * DM + 16 * lane); const f32x4 a = p[0], b = p[1], c = p[2], d = p[3];
    float mx = fmaxf(fmaxf(fmaxf(fabsf(a[0]), fabsf(a[1])), fmaxf(fabsf(a[2]), fabsf(a[3]))), fmaxf(fmaxf(fabsf(b[0]), fabsf(b[1])), fmaxf(fabsf(b[2]), fabsf(b[3]))));
    mx = fmaxf(mx, fmaxf(fmaxf(fmaxf(fabsf(c[0]), fabsf(c[1])), fmaxf(fabsf(c[2]), fabsf(c[3]))), fmaxf(fmaxf(fabsf(d[0]), fabsf(d[1])), fmaxf(fabsf(d[2]), fabsf(d[3])))));
    mx = wave_max(mx);
    const float sc = mx > 0.f ? 448.0f / mx : 1.0f;
    u32x4 o; unsigned w;
    w = 0; w = __builtin_amdgcn_cvt_pk_fp8_f32(a[0] * sc, a[1] * sc, w, false); w = __builtin_amdgcn_cvt_pk_fp8_f32(a[2] * sc, a[3] * sc, w, true); o.x = w;
    w = 0; w = __builtin_amdgcn_cvt_pk_fp8_f32(b[0] * sc, b[1] * sc, w, false); w = __builtin_amdgcn_cvt_pk_fp8_f32(b[2] * sc, b[3] * sc, w, true); o.y = w;
    w = 0; w = __builtin_amdgcn_cvt_pk_fp8_f32(c[0] * sc, c[1] * sc, w, false); w = __builtin_amdgcn_cvt_pk_fp8_f32(c[2] * sc, c[3] * sc, w, true); o.z = w;
    w = 0; w = __builtin_amdgcn_cvt_pk_fp8_f32(d[0] * sc, d[1] * sc, w, false); w = __builtin_amdgcn_cvt_pk_fp8_f32(d[2] * sc, d[3] * sc, w, true); o.w = w;
    *(u32x4*)(T8 + (size_t)(lane >> 3) * SLICE_BYTES + (size_t)e * 128 + (lane & 7) * 16) = o;
    if (lane == 0) INV[e] = mx > 0.f ? mx * (1.0f / 448.0f) : 1.0f;
}
__device__ __forceinline__ void upass_token(int lane, int t, int s, const unsigned char* U8s, const unsigned short* E, const unsigned short* XN2, unsigned short* PA) {
    const int rs = lane >> 3, c8 = lane & 7;
    const u32x4 ea = *(const u32x4*)(E + (size_t)t * 128 + rs * 16), eb = *(const u32x4*)(E + (size_t)t * 128 + rs * 16 + 8);
    const u32x4 xa = *(const u32x4*)(XN2 + (size_t)t * DM + s * 128 + c8 * 16), xb = *(const u32x4*)(XN2 + (size_t)t * DM + s * 128 + c8 * 16 + 8);
    u32x4 row[16];
#pragma unroll
    for (int j = 0; j < 16; ++j) { const unsigned ew = getw(j < 8 ? ea : eb, (j & 7) >> 1); const unsigned e = (j & 1) ? (ew >> 16) : (ew & 0xffffu);
        row[j] = *(const u32x4*)(U8s + (size_t)e * 128 + c8 * 16); }
    f32x2_t xf[8];
#pragma unroll
    for (int i = 0; i < 4; ++i) { const unsigned wa = getw(xa, i), wb = getw(xb, i); xf[i] = (f32x2_t){bflo(wa), bfhi(wa)}; xf[4 + i] = (f32x2_t){bflo(wb), bfhi(wb)}; }
    float part[16];
#pragma unroll
    for (int j = 0; j < 16; ++j) {
        f32x2_t acc = {0.f, 0.f};
#pragma unroll
        for (int w = 0; w < 4; ++w) { const unsigned q = getw(row[j], w);
            acc = __builtin_elementwise_fma(__builtin_amdgcn_cvt_pk_f32_fp8(q, false), xf[2 * w], acc); acc = __builtin_elementwise_fma(__builtin_amdgcn_cvt_pk_f32_fp8(q, true), xf[2 * w + 1], acc); }
        float p = acc.x + acc.y; p += dppf<XOR1>(p); p += dppf<XOR2>(p); p += dppf<XOR7>(p); part[j] = p;
    }
    float p0 = part[0], p1 = part[1];
#pragma unroll
    for (int i = 1; i < 8; ++i) { p0 = c8 == i ? part[2 * i] : p0; p1 = c8 == i ? part[2 * i + 1] : p1; }
    *(unsigned*)(PA + ((size_t)t * 8 + s) * 128 + rs * 16 + 2 * c8) = pkbf(p0, p1);
}
__device__ __forceinline__ void wpass_token(int lane, int t, const unsigned short* E, const float* G, const unsigned short* PA, const float* INVU, const float* INVV, float* W) {
    float a0 = 0.f, a1 = 0.f;
#pragma unroll
    for (int s = 0; s < 8; ++s) { const unsigned w = *(const unsigned*)(PA + ((size_t)t * 8 + s) * 128 + 2 * lane); a0 += bflo(w); a1 += bfhi(w); }
    const unsigned ew = *(const unsigned*)(E + (size_t)t * 128 + 2 * lane); const unsigned e0 = ew & 0xffffu, e1 = ew >> 16;
    const f32x2_t g = *(const f32x2_t*)(G + (size_t)t * 128 + 2 * lane);
    a0 *= INVU[e0]; a1 *= INVU[e1];
    const float w0 = g.x * 0.5f * a0 * (1.0f + erff(a0 * 0.70710678118654752f)) * INVV[e0], w1 = g.y * 0.5f * a1 * (1.0f + erff(a1 * 0.70710678118654752f)) * INVV[e1];
    *(f32x2_t*)(W + (size_t)t * 128 + 2 * lane) = (f32x2_t){w0, w1};
}
__device__ __forceinline__ void vpass_token(int lane, int t, int s, const unsigned char* V8s, const unsigned short* E, const float* W, float* HP  , float* PSS) {
    const int rs = lane >> 3, c8 = lane & 7;
    const u32x4 ea = *(const u32x4*)(E + (size_t)t * 128 + rs * 16), eb = *(const u32x4*)(E + (size_t)t * 128 + rs * 16 + 8);
    const f32x4* wp = (const f32x4*)(W + (size_t)t * 128 + rs * 16); const f32x4 w0 = wp[0], w1 = wp[1], w2 = wp[2], w3 = wp[3];
    u32x4 row[16];
#pragma unroll
    for (int j = 0; j < 16; ++j) { const unsigned ew = getw(j < 8 ? ea : eb, (j & 7) >> 1); const unsigned e = (j & 1) ? (ew >> 16) : (ew & 0xffffu);
        row[j] = *(const u32x4*)(V8s + (size_t)e * 128 + c8 * 16); }
    f32x2_t o[8];
#pragma unroll
    for (int i = 0; i < 8; ++i) o[i] = (f32x2_t){0.f, 0.f};
#pragma unroll
    for (int j = 0; j < 16; ++j) {
        const f32x4 wq = j < 4 ? w0 : j < 8 ? w1 : j < 12 ? w2 : w3; const int jj = j & 3; const float wj = jj == 0 ? wq.x : jj == 1 ? wq.y : jj == 2 ? wq.z : wq.w; const f32x2_t w2v = {wj, wj};
#pragma unroll
        for (int w = 0; w < 4; ++w) { const unsigned q = getw(row[j], w);
            o[2 * w] = __builtin_elementwise_fma(__builtin_amdgcn_cvt_pk_f32_fp8(q, false), w2v, o[2 * w]); o[2 * w + 1] = __builtin_elementwise_fma(__builtin_amdgcn_cvt_pk_f32_fp8(q, true), w2v, o[2 * w + 1]); }
    }
    float of[16];
#pragma unroll
    for (int i = 0; i < 8; ++i) { of[2 * i] = o[i].x; of[2 * i + 1] = o[i].y; }
#pragma unroll
    for (int i = 0; i < 16; ++i) { float x = of[i]; x += dppf<XOR8>(x);
        auto s1 = __builtin_amdgcn_permlane16_swap(__float_as_uint(x), __float_as_uint(x), false, false); x = __uint_as_float(s1[0]) + __uint_as_float(s1[1]);
        auto s2 = __builtin_amdgcn_permlane32_swap(__float_as_uint(x), __float_as_uint(x), false, false); of[i] = __uint_as_float(s2[0]) + __uint_as_float(s2[1]); }
    float* hp = HP + (size_t)t * DM + s * 128 + c8 * 16; float ss = 0.f;
    f32x4 hv[4];
#pragma unroll
    for (int i = 0; i < 4; ++i) { hv[i] = *(const f32x4*)(hp + 4 * i); hv[i][0] += of[4 * i]; hv[i][1] += of[4 * i + 1]; hv[i][2] += of[4 * i + 2]; hv[i][3] += of[4 * i + 3];
        ss += (hv[i][0] * hv[i][0] + hv[i][1] * hv[i][1]) + (hv[i][2] * hv[i][2] + hv[i][3] * hv[i][3]); }
    ss += dppf<XOR1>(ss); ss += dppf<XOR2>(ss); ss += dppf<XOR7>(ss);
    if (rs == 0) {
#pragma unroll
        for (int i = 0; i < 4; ++i) *(f32x4*)(hp + 4 * i) = hv[i];
        if (c8 == 0) PSS[(size_t)t * 8 + s] = ss;
    }
}
__device__ __forceinline__ void final_token(int lane, int t, float* Y, const float* PSS, const float* gfin) {
    const f32x4 s0 = *(const f32x4*)(PSS + (size_t)t * 8), s1 = *(const f32x4*)(PSS + (size_t)t * 8 + 4);
    const float tot = ((s0[0] + s0[1]) + (s0[2] + s0[3])) + ((s1[0] + s1[1]) + (s1[2] + s1[3]));
    const float rstd = 1.0f / sqrtf(tot * (1.0f / DM) + EPS);
    f32x4* yr = (f32x4*)(Y + (size_t)t * DM) + lane;
#pragma unroll
    for (int j = 0; j < 4; ++j) { const f32x4 g = *((const f32x4*)gfin + lane + 64 * j); f32x4 v = yr[64 * j]; v[0] *= rstd * g[0]; v[1] *= rstd * g[1]; v[2] *= rstd * g[2]; v[3] *= rstd * g[3]; yr[64 * j] = v; }
}
}

constexpr int NWAVES = 8;
#ifndef MK_N_LAUNCHES
#define MK_N_LAUNCHES 1
#endif
constexpr int N_LAUNCHES = MK_N_LAUNCHES;
constexpr int PER_PHASE = 7;
#ifndef PROBE
#define PROBE -1
#endif
#define NREP(k) ((PROBE == (k)) ? 2 : 1)

typedef unsigned short bf16;
typedef unsigned v4u __attribute__((ext_vector_type(4)));
typedef float f32x4 __attribute__((ext_vector_type(4)));
#define LDS_WAIT() asm volatile("s_waitcnt lgkmcnt(0)" ::: "memory")
#define VM_WAIT() asm volatile("s_waitcnt vmcnt(0)" ::: "memory")

constexpr size_t MiB = 1u << 20;
constexpr size_t WS_CTL = 0, CTL_ZERO_BYTES = 64 * 1024;
constexpr size_t WS_TAB = 1 * MiB;
constexpr size_t WS_SSQ = 1 * MiB + 64 * 1024;
constexpr size_t WS_WIN = 3 * MiB;
constexpr size_t WS_WA = 10 * MiB, WS_WB = 11 * MiB;
constexpr size_t WS_WO = 12 * MiB;
constexpr size_t WS_WE = 14 * MiB;
constexpr size_t WS_U8 = 18 * MiB, WS_V8 = 34 * MiB;
constexpr size_t WS_PA = 50 * MiB;
constexpr size_t WS_INVU = 2 * MiB + 128 * 1024, WS_INVV = WS_INVU + 64 * 1024;
constexpr size_t WS_G = 3 * MiB, WS_E = 11 * MiB;
constexpr size_t WS_W = 114 * MiB, WS_PSS = 122 * MiB;
constexpr int CW_RANK = 8192;
constexpr size_t WS_XN = 82 * MiB;
constexpr size_t WS_ACT = 114 * MiB;
constexpr size_t WS_QA = WS_ACT, WS_QB = WS_ACT + 16 * MiB;
constexpr size_t WS_KA = WS_ACT + 32 * MiB, WS_VA = WS_ACT + 36 * MiB, WS_KB = WS_ACT + 40 * MiB, WS_VB = WS_ACT + 44 * MiB;
constexpr size_t WS_GA = WS_ACT + 48 * MiB, WS_GB = WS_ACT + 80 * MiB;
constexpr size_t WS_SC = WS_ACT;
constexpr size_t WS_END = 242 * MiB;
static_assert(WS_GB + 32 * MiB <= WS_END && WS_SC + (size_t)NTOK * SCW * 4 <= WS_END, "d_ws map");

constexpr int RING_BYTES = 131072;
constexpr int MISC_OFF = RING_BYTES + 320;
constexpr int LDS_BYTES = 147456;

#define XB_TMO      128
#define XB_XCNT(j)  (256  + 64 * (j))
#define XB_XSUB(j)  (1280 + 64 * (j))
#define XB_XGEN(j)  (2304 + 64 * (j))
#define XB_TOP      3328
#define XB_TOPGEN   3392
#define XCD_BAR_WORDS 3456
#define XB_SPIN_CAP (1u << 18)

__device__ __forceinline__ unsigned xb_ld(unsigned* p)              { return __hip_atomic_load(p, __ATOMIC_RELAXED, __HIP_MEMORY_SCOPE_AGENT); }
__device__ __forceinline__ unsigned xb_add(unsigned* p, unsigned v) { return __hip_atomic_fetch_add(p, v, __ATOMIC_RELAXED, __HIP_MEMORY_SCOPE_AGENT); }
__device__ __forceinline__ unsigned xb_xcc_id() { return (unsigned)__builtin_amdgcn_s_getreg((3 << 11) | 20) & 0xFu; }
#define XB_SPIN(cond, bar) do { unsigned _sp = 0; while (cond) { __builtin_amdgcn_s_sleep(1); \
    if ((++_sp & 255u) == 0u) { if (xb_ld(&(bar)[XB_TMO])) break; if (_sp > XB_SPIN_CAP) { atomicAdd(&(bar)[XB_TMO], 1u); break; } } } } while (0)

struct XcdBarrier {
    unsigned* bar; unsigned x;
    volatile LAS unsigned* st;
};

__device__ __forceinline__ XcdBarrier xcd_barrier_post(unsigned* bar, volatile LAS unsigned* st) {
    XcdBarrier b; b.bar = bar; b.x = xb_xcc_id(); b.st = st;
    if (threadIdx.x == 0) (void)xb_add(&bar[XB_XCNT(b.x)], 1u);
    return b;
}
__device__ __forceinline__ void xcd_barrier_complete(unsigned* bar, unsigned x, unsigned& nloc, unsigned& nx) {
    const unsigned G = gridDim.x * gridDim.y * gridDim.z;
    unsigned sum, cnt, mine, sp = 0u;
    for (;;) {
        sum = 0u; cnt = 0u; mine = 0u;
#pragma unroll
        for (unsigned j = 0; j < 16; ++j) { const unsigned c = xb_ld(&bar[XB_XCNT(j)]); sum += c; cnt += (c > 0u) ? 1u : 0u; mine = (j == x) ? c : mine; }
        if (sum == G) break;
        __builtin_amdgcn_s_sleep(1);
        if ((++sp & 255u) == 0u) { if (xb_ld(&bar[XB_TMO])) break; if (sp > XB_SPIN_CAP) { atomicAdd(&bar[XB_TMO], 1u); break; } }
    }
    nloc = mine > 0u ? mine : 1u; nx = cnt > 0u ? cnt : 1u;
}

__device__ __forceinline__ void xcd_barrier(const XcdBarrier& b) {
    asm volatile("s_waitcnt vmcnt(0)" ::: "memory");
    __syncthreads();
    if (threadIdx.x == 0) {
        unsigned* bar = b.bar;
        __builtin_amdgcn_s_waitcnt(0);
        unsigned nloc = b.st[0], nx = b.st[1];
        if (nloc == 0u) { xcd_barrier_complete(bar, b.x, nloc, nx); b.st[0] = nloc; b.st[1] = nx; }
        const unsigned old = xb_add(&bar[XB_XSUB(b.x)], 1u);
        const unsigned gen = old / nloc;
        if (old + 1u == (gen + 1u) * nloc) {
            __builtin_amdgcn_fence(__ATOMIC_RELEASE, "agent");
            asm volatile("s_waitcnt vmcnt(0)" ::: "memory");
            const unsigned og = xb_add(&bar[XB_TOP], 1u);
            const unsigned tg = og / nx;
            if (og + 1u == (tg + 1u) * nx) xb_add(&bar[XB_TOPGEN], 1u);
            else XB_SPIN(xb_ld(&bar[XB_TOPGEN]) == tg, bar);
            __builtin_amdgcn_fence(__ATOMIC_ACQUIRE, "agent");
            xb_add(&bar[XB_XGEN(b.x)], 1u);
            asm volatile("s_waitcnt vmcnt(0)" ::: "memory");
        } else {
            XB_SPIN(xb_ld(&bar[XB_XGEN(b.x)]) == gen, bar);
            __builtin_amdgcn_fence(__ATOMIC_ACQUIRE, "agent");
            asm volatile("s_waitcnt vmcnt(0)" ::: "memory");
        }
    }
    __syncthreads();
}


struct Args { const float* in[17]; float* out; unsigned char* ws; int ph_lo, ph_hi, li, pad; };

__device__ __forceinline__ void p0_transpose_item(const float* W, int K, int N, bf16* WT, int k0, int src_n0, int dst_n0, LAS float* scr, int lane) {
#pragma unroll 8
    for (int i = 0; i < 32; ++i) { const int kk = 2 * i + (lane >> 5); scr[kk * 33 + (lane & 31)] = W[(size_t)(k0 + kk) * N + src_n0 + (lane & 31)]; }
    LDS_WAIT();
    const int c = lane & 7;
#pragma unroll
    for (int j = 0; j < 4; ++j) { const int n = (lane >> 3) + 8 * j; const LAS float* s = scr + (8 * c) * 33 + n;
        v4u o; o.x = pkbf(s[0 * 33], s[1 * 33]); o.y = pkbf(s[2 * 33], s[3 * 33]); o.z = pkbf(s[4 * 33], s[5 * 33]); o.w = pkbf(s[6 * 33], s[7 * 33]);
        *(v4u*)(WT + (size_t)(dst_n0 + n) * K + k0 + 8 * c) = o; }
    LDS_WAIT();
}
__device__ __forceinline__ int win_src_col(int dst_n0) {
    if (dst_n0 >= 1536) return dst_n0;
    const int tile = dst_n0 >> 8, c = dst_n0 & 255;
    return tile * 256 + 64 * ((c >> 5) & 3) + 32 * (c >> 7);
}
__device__ __forceinline__ int t5_bucket(int rel) {
    const int n = rel < 0 ? -rel : rel; int bkt;
    if (n < 8) bkt = n; else { int v = 8 + (31 - __builtin_clz(n * n)) - 6; bkt = v > 15 ? 15 : v; }
    return bkt + (rel > 0 ? 16 : 0);
}

__global__ void __launch_bounds__(NWAVES * 64, 2) mk_fwd(Args args) {
    extern __shared__ __attribute__((aligned(16))) unsigned char lds_raw[];
    LAS unsigned char* lds = (LAS unsigned char*)lds_raw;
    volatile LAS unsigned* MISC = (volatile LAS unsigned*)(lds + MISC_OFF);
    const int tid = threadIdx.x, lane = tid & 63, wave = __builtin_amdgcn_readfirstlane(tid >> 6);
    const int G = gridDim.x, bx = blockIdx.x; const int vcu = (G % 8 == 0) ? (bx % 8) * (G / 8) + bx / 8 : bx;
    const int gw = vcu * NWAVES + wave, NGW = G * NWAVES;
    unsigned char* ws = args.ws;
    const float* x = args.in[0]; const float* g_mix = args.in[1]; const float* w_in = args.in[2]; const float* b_gate = args.in[3];
    const float* q_norm_g = args.in[4]; const float* k_norm_g = args.in[5]; const float* rel_bias = args.in[6]; const float* sink = args.in[7];
    const float* w_a = args.in[8]; const float* w_b = args.in[9]; const float* w_out = args.in[10]; const float* g_ffn = args.in[11];
    const float* peer_wq = args.in[12]; const float* subkeys = args.in[13]; const float* peer_u = args.in[14]; const float* peer_v = args.in[15]; const float* g_final = args.in[16];
    float* out = args.out;
    float* ROPE = (float*)(ws + WS_TAB); float* BIAS = (float*)(ws + WS_TAB + 16384); float* SSQ = (float*)(ws + WS_SSQ);
    bf16 *WIN_T = (bf16*)(ws + WS_WIN), *WA_T = (bf16*)(ws + WS_WA), *WB_T = (bf16*)(ws + WS_WB), *WO_T = (bf16*)(ws + WS_WO), *WE_T = (bf16*)(ws + WS_WE);
    unsigned char *U8 = ws + WS_U8, *V8 = ws + WS_V8; bf16 *PA = (bf16*)(ws + WS_PA), *XN = (bf16*)(ws + WS_XN);
    float *INVU = (float*)(ws + WS_INVU), *INVV = (float*)(ws + WS_INVV), *RG = (float*)(ws + WS_G), *RW = (float*)(ws + WS_W), *PSS = (float*)(ws + WS_PSS); bf16* RE = (bf16*)(ws + WS_E);
    bf16 *QA = (bf16*)(ws + WS_QA), *QB = (bf16*)(ws + WS_QB), *KA = (bf16*)(ws + WS_KA), *VA = (bf16*)(ws + WS_VA), *KB = (bf16*)(ws + WS_KB), *VB = (bf16*)(ws + WS_VB);
    bf16 *GA = (bf16*)(ws + WS_GA), *GB = (bf16*)(ws + WS_GB); float* SC = (float*)(ws + WS_SC);

    for (int u = tid; u < (LDS_BYTES - RING_BYTES) / 4; u += NWAVES * 64) ((LAS unsigned*)(lds + RING_BYTES))[u] = 0u;
    __syncthreads();
    XcdBarrier bar; bar.bar = (unsigned*)(ws + WS_CTL) + 1024; bar.x = 0; bar.st = nullptr;
    if (N_LAUNCHES != PER_PHASE) bar = xcd_barrier_post((unsigned*)(ws + WS_CTL) + 1024, MISC + 8);
    if (tid == 0) { const unsigned xc = xb_xcc_id(); MISC[13] = xc; MISC[12] = xb_add((unsigned*)(ws + WS_CTL) + CW_RANK + 64 * xc, 1u); }
    const int lo = args.ph_lo, hi = args.ph_hi;
#define IN(k) (lo <= (k) && (k) < hi)
#define BOTH(k) (IN(k) && IN((k) + 1))
#define GRID_BAR() do { if (N_LAUNCHES != PER_PHASE) xcd_barrier(bar); } while (0)

    if (IN(0)) for (int rep_ = 0; rep_ < NREP(0); ++rep_) {
        if (rep_) { VM_WAIT(); __syncthreads(); }
        LAS float* scr = (LAS float*)(lds + wave * 16384);
        {
            constexpr int I_IN = (DM / 64) * (INW / 32), I_AB = (QW / 64) * (DM / 32), I_O = (DM / 64) * (DM / 32);
            constexpr int NITEMS = I_IN + 2 * I_AB + I_O;
            for (int it = gw; it < NITEMS; it += NGW) {
                int r = it;
                if (r < I_IN) { const int nblk = INW / 32, kb = r / nblk, nb = r % nblk; p0_transpose_item(w_in, DM, INW, WIN_T, 64 * kb, win_src_col(32 * nb), 32 * nb, scr, lane); continue; } r -= I_IN;
                if (r < I_AB) { const int nblk = DM / 32, kb = r / nblk, nb = r % nblk; p0_transpose_item(w_a, QW, DM, WA_T, 64 * kb, 32 * nb, 32 * nb, scr, lane); continue; } r -= I_AB;
                if (r < I_AB) { const int nblk = DM / 32, kb = r / nblk, nb = r % nblk; p0_transpose_item(w_b, QW, DM, WB_T, 64 * kb, 32 * nb, 32 * nb, scr, lane); continue; } r -= I_AB;
                { const int nblk = DM / 32, kb = r / nblk, nb = r % nblk; p0_transpose_item(w_out, DM, DM, WO_T, 64 * kb, 32 * nb, 32 * nb, scr, lane); }
            }
        }
        __syncthreads();
        {
            LAS float* sk_s = (LAS float*)lds;
            LAS float* wq_s = (LAS float*)(lds + 128 * 129 * 4);
            for (int it = vcu; it < 16 * 16; it += G) {
                const int c = it >> 4, k0 = (it & 15) * 64;
                for (int i = tid; i < 128 * 32; i += NWAVES * 64) { const int n = i >> 5, d4 = (i & 31) * 4; const f32x4 v = *(const f32x4*)(subkeys + ((size_t)c * NKEYS + n) * 128 + d4);
                    sk_s[n * 129 + d4] = v[0]; sk_s[n * 129 + d4 + 1] = v[1]; sk_s[n * 129 + d4 + 2] = v[2]; sk_s[n * 129 + d4 + 3] = v[3]; }
                for (int i = tid; i < 64 * 32; i += NWAVES * 64) { const int k = i >> 5, d4 = (i & 31) * 4; const f32x4 v = *(const f32x4*)(peer_wq + (size_t)(k0 + k) * SCW + c * 128 + d4);
                    wq_s[k * 129 + d4] = v[0]; wq_s[k * 129 + d4 + 1] = v[1]; wq_s[k * 129 + d4 + 2] = v[2]; wq_s[k * 129 + d4 + 3] = v[3]; }
                __syncthreads();
                const int k = tid & 63, ng = tid >> 6; float acc[16];
#pragma unroll
                for (int i = 0; i < 16; ++i) acc[i] = 0.f;
                for (int d = 0; d < 128; ++d) { const float a = wq_s[k * 129 + d];
#pragma unroll
                    for (int i = 0; i < 16; ++i) acc[i] += a * sk_s[(ng * 16 + i) * 129 + d]; }
                const float gk = g_ffn[k0 + k];
#pragma unroll
                for (int i = 0; i < 16; ++i) WE_T[(size_t)(c * 128 + ng * 16 + i) * DM + k0 + k] = (bf16)(pkbf(acc[i] * gk, 0.f) & 0xffffu);
                __syncthreads();
            }
        }
        for (int e = gw; e < 2 * NEXP; e += NGW) { if (e < NEXP) peer::table_row_fp8(peer_u, U8, INVU, e, lane); else peer::table_row_fp8(peer_v, V8, INVV, e - NEXP, lane); }
        for (int m = gw; m < NTOK; m += NGW) {
            const f32x4* xr = (const f32x4*)(x + (size_t)m * DM) + lane; f32x4 v[4]; float s = 0.f;
#pragma unroll
            for (int j = 0; j < 4; ++j) { v[j] = xr[64 * j]; s += (v[j][0] * v[j][0] + v[j][1] * v[j][1]) + (v[j][2] * v[j][2] + v[j][3] * v[j][3]); }
            const float rstd = 1.0f / sqrtf(peer::wave_sum(s) * (1.0f / DM) + EPS);
            unsigned long long* o8 = (unsigned long long*)(XN + (size_t)m * DM) + lane;
#pragma unroll
            for (int j = 0; j < 4; ++j) { const f32x4 g = *((const f32x4*)g_mix + lane + 64 * j);
                o8[64 * j] = (unsigned long long)pkbf(v[j][0] * rstd * g[0], v[j][1] * rstd * g[1]) | ((unsigned long long)pkbf(v[j][2] * rstd * g[2], v[j][3] * rstd * g[3]) << 32); }
        }
        if (vcu == 0) {
            for (int i = tid; i < 64 * 16; i += NWAVES * 64) { const int pos = i >> 4, f = i & 15; const float fr = powf(10000.0f, -(float)f / 16.0f); const float ang = (float)pos * fr; ROPE[2 * i] = cosf(ang); ROPE[2 * i + 1] = sinf(ang); }
            for (int i = tid; i < 8 * 257; i += NWAVES * 64) { const int h = i / 257, rel = i % 257 - 128; BIAS[i] = rel_bias[t5_bucket(rel) * NH + h] * LOG2E; }
        }
        if (BOTH(0) && rep_ == NREP(0) - 1) GRID_BAR();
    }

    if (IN(1)) {
        pg8::Gemm g{XN, WIN_T, NTOK, INW, DM}; pg8::StaticOrder S; S.init(NTOK, INW, G, bx);
        pg8::EpiIn E{QA, KA, VA, QB, KB, VB, GA, GB, q_norm_g, k_norm_g, b_gate, ROPE};
        for (int rep_ = 0; rep_ < NREP(1); ++rep_) pg8::gemm_phase<pg8::EpiIn, pg8::StaticOrder, true, true>(lds, g, S, E);
        if (BOTH(1)) GRID_BAR();
    }

    if (IN(2)) {
        if (PROBE == 2) {
            bf16* DUM = (bf16*)(ws + WS_ACT + 112 * MiB);
            for (int u = vcu; u < 512; u += G) { const int xg = u >> 6, i = u & 63; const int b = xg >> 1, h = 4 * (xg & 1) + (i >> 4), qblk = i & 15;
                attn::attn_unit<false>((LAS char*)lds, QA, KA, VA, DUM, b, h, qblk, nullptr, 0.f); }
            for (int u = vcu; u < 512; u += G) { const int xg = u >> 6, i = u & 63; const int b = xg >> 1, h = 4 * (xg & 1) + (i >> 4), qblk = i & 15;
                attn::attn_unit<true>((LAS char*)lds, QB, KB, VB, DUM, b, h, qblk, BIAS + h * 257, sink[h] * LOG2E); }
        }
        for (int u = vcu; u < 512; u += G) { const int xg = u >> 6, i = u & 63; const int b = xg >> 1, h = 4 * (xg & 1) + (i >> 4), qblk = i & 15;
            attn::attn_unit<false>((LAS char*)lds, QA, KA, VA, QA, b, h, qblk, nullptr, 0.f); }
        for (int u = vcu; u < 512; u += G) { const int xg = u >> 6, i = u & 63; const int b = xg >> 1, h = 4 * (xg & 1) + (i >> 4), qblk = i & 15;
            attn::attn_unit<true>((LAS char*)lds, QB, KB, VB, QB, b, h, qblk, BIAS + h * 257, sink[h] * LOG2E); }
        if (BOTH(2)) GRID_BAR();
    }

    if (IN(3)) {
        if (PROBE == 3) {
            { pg8::Gemm g{QA, WA_T, NTOK, DM, QW}; pg8::StaticOrder S; S.init(NTOK, DM, G, bx); pg8::EpiMixA E{GA, XN};
              pg8::gemm_phase<pg8::EpiMixA, pg8::StaticOrder, true, true>(lds, g, S, E); }
            VM_WAIT(); __syncthreads();
            { pg8::Gemm g{QB, WB_T, NTOK, DM, QW}; pg8::StaticOrder S; S.init(NTOK, DM, G, bx); pg8::EpiMixB E{XN, GB, XN};
              pg8::gemm_phase<pg8::EpiMixB, pg8::StaticOrder, true, true>(lds, g, S, E); }
            VM_WAIT(); __syncthreads();
        }
        { pg8::Gemm g{QA, WA_T, NTOK, DM, QW}; pg8::StaticOrder S; S.init(NTOK, DM, G, bx); pg8::EpiMixA E{GA, GA};
          pg8::gemm_phase<pg8::EpiMixA, pg8::StaticOrder, true, true>(lds, g, S, E); }
        VM_WAIT(); __syncthreads();
        { pg8::Gemm g{QB, WB_T, NTOK, DM, QW}; pg8::StaticOrder S; S.init(NTOK, DM, G, bx); pg8::EpiMixB E{GA, GB, GB};
          pg8::gemm_phase<pg8::EpiMixB, pg8::StaticOrder, true, true>(lds, g, S, E); }
        if (BOTH(3)) GRID_BAR();
    }

    if (IN(4)) {
        pg8::Gemm g{GB, WO_T, NTOK, DM, DM}; pg8::StaticOrder S; S.init(NTOK, DM, G, bx); pg8::EpiOut E{x, out, XN, SSQ};
        for (int rep_ = 0; rep_ < NREP(4); ++rep_) pg8::gemm_phase<pg8::EpiOut, pg8::StaticOrder, true, true>(lds, g, S, E);
        if (BOTH(4)) GRID_BAR();
    }

    if (IN(5)) {
        pg8::Gemm g{XN, WE_T, NTOK, SCW, DM}; pg8::StaticOrder S; S.init(NTOK, SCW, G, bx); pg8::EpiScore E{SSQ, SC};
        for (int rep_ = 0; rep_ < NREP(5); ++rep_) pg8::gemm_phase<pg8::EpiScore, pg8::StaticOrder, true, true>(lds, g, S, E);
        if (BOTH(5)) GRID_BAR();
    }

    if (IN(6)) {
        LAS char* wl = (LAS char*)lds + wave * peer::WAVE_LDS;
        const unsigned long long ct = peer::cand_table(lane & 7);
        for (int t = gw; t < NTOK; t += NGW) peer::route_token(wl, lane, t, ct, SC, out, g_ffn, RE, RG, XN);
        GRID_BAR();
        int nloc = 0, nx = 0, ox = 0; const int myx = (int)MISC[13], rank = (int)MISC[12];
#pragma unroll
        for (int j = 0; j < 16; ++j) { const int c = (int)xb_ld((unsigned*)(ws + WS_CTL) + CW_RANK + 64 * j); nx += c > 0; ox += (c > 0 && j < myx); nloc = j == myx ? c : nloc; }
        const int wv = rank * NWAVES + wave, nwv = nloc * NWAVES;
        for (int s = ox; s < 8; s += nx) { const unsigned char* U8s = U8 + (size_t)s * peer::SLICE_BYTES;
            for (int t = wv; t < NTOK; t += nwv) peer::upass_token(lane, t, s, U8s, RE, XN, PA); }
        GRID_BAR();
        for (int t = gw; t < NTOK; t += NGW) peer::wpass_token(lane, t, RE, RG, PA, INVU, INVV, RW);
        GRID_BAR();
        for (int s = ox; s < 8; s += nx) { const unsigned char* V8s = V8 + (size_t)s * peer::SLICE_BYTES;
            for (int t = wv; t < NTOK; t += nwv) peer::vpass_token(lane, t, s, V8s, RE, RW, out, PSS); }
        GRID_BAR();
        for (int t = gw; t < NTOK; t += NGW) peer::final_token(lane, t, out, PSS, g_final);
    }
#undef IN
#undef BOTH
#undef GRID_BAR
}

extern "C" void kernel_launch(void* const* d_in, const int* in_sizes, int n_in, void* d_out, int out_size, void* d_ws, size_t ws_size, hipStream_t stream) {
    static int grid = 0;
    if (grid == 0) {
        if (n_in != 17 || in_sizes[0] != NTOK * DM || out_size != NTOK * DM || ws_size < WS_END) { fprintf(stderr, "kernel_launch: unexpected shapes (n_in %d, in0 %d, out %d, ws %zu); nothing launched\n", n_in, n_in > 0 ? in_sizes[0] : -1, out_size, ws_size); grid = -1; return; }
        int dev = 0, cus = 0, per_cu = 0;
        if (hipGetDevice(&dev) != hipSuccess || hipDeviceGetAttribute(&cus, hipDeviceAttributeMultiprocessorCount, dev) != hipSuccess) { grid = -1; return; }
        if (hipFuncSetAttribute((const void*)mk_fwd, hipFuncAttributeMaxDynamicSharedMemorySize, LDS_BYTES) != hipSuccess) { fprintf(stderr, "kernel_launch: hipFuncSetAttribute failed\n"); grid = -1; return; }
        if (hipOccupancyMaxActiveBlocksPerMultiprocessor(&per_cu, (const void*)mk_fwd, NWAVES * 64, LDS_BYTES) != hipSuccess || per_cu < 1) { fprintf(stderr, "kernel_launch: occupancy query says %d blocks per CU; nothing launched\n", per_cu); (void)hipGetLastError(); grid = -1; return; }
        grid = cus;
    }
    if (grid < 0) return;
    if (hipMemsetAsync((char*)d_ws + WS_CTL, 0, CTL_ZERO_BYTES, stream) != hipSuccess) { fprintf(stderr, "kernel_launch: hipMemsetAsync failed\n"); return; }
    Args a{};
    for (int i = 0; i < 17; ++i) a.in[i] = (const float*)d_in[i];
    a.out = (float*)d_out; a.ws = (unsigned char*)d_ws;
    if (N_LAUNCHES == 1) {
        a.ph_lo = 0; a.ph_hi = PER_PHASE; a.li = 0;
        void* kargs[] = {&a};
        hipError_t e = hipLaunchCooperativeKernel((const void*)mk_fwd, dim3(grid), dim3(NWAVES * 64), kargs, LDS_BYTES, stream);
        if (e != hipSuccess) fprintf(stderr, "kernel_launch: cooperative launch failed: %s (grid %d)\n", hipGetErrorString(e), grid);
    } else {
        for (int li = 0; li < PER_PHASE; ++li) { a.ph_lo = li; a.ph_hi = li + 1; a.li = li;
            hipLaunchKernelGGL(mk_fwd, dim3(grid), dim3(NWAVES * 64), LDS_BYTES, stream, a); }
    }
}
```

```cpp
#include <hip/hip_runtime.h>
#include <cstdio>
#include <cstdint>
#include <cmath>
namespace pg8 {
#define PG8_LAS __attribute__((address_space(3)))
typedef unsigned short bf16_t;
typedef short bf16x8 __attribute__((ext_vector_type(8)));
typedef float f32x4 __attribute__((ext_vector_type(4)));
typedef unsigned u32x4 __attribute__((ext_vector_type(4)));
constexpr int BM = 256, BK = 64, HALF = 128, HTB = HALF * BK * 2  , STAGE_BYTES = 8 * HTB, NXCD = 8, WGM = 8;

__host__ __device__ __forceinline__ int lds_byte(int r, int c) { const int st = (r >> 4) * 2 + (c >> 5), rr = r & 15, cc = c & 31, ob = rr * 64 + cc * 2; return st * 1024 + (ob ^ (((ob >> 9) & 1) << 5)); }
__host__ __device__ __forceinline__ void stage_rc(int b, int& R, int& C) { const int st = b / 1024, sb = b % 1024, swz = sb ^ (((sb >> 9) & 1) << 5); R = (st >> 1) * 16 + swz / 64; C = (st & 1) * 32 + (swz % 64) / 2; }
__host__ __device__ __forceinline__ int perm32(int rho) { const int n = rho >> 4, i = rho & 15; return 8 * (i >> 2) + 4 * n + (i & 3); }

struct Unit { int pm, pn; };
struct Gemm { const bf16_t* A; const bf16_t* Bt; int M, N, K; };

struct StaticOrder {
    int nM, nN, nwg, G, c;
    __host__ __device__ void init(int M, int N, int G_, int c_) { nM = M / BM; nN = N / BM; nwg = nM * nN; G = G_; c = c_; }
    __host__ __device__ bool next(int i, Unit& u) const {
        const long L = (long)i * G + c; if (L >= nwg) return false;
        int wgid = (int)L; { const int q = nwg / NXCD, r = nwg % NXCD, xcd = wgid % NXCD, off = wgid / NXCD; wgid = (xcd < r ? xcd * (q + 1) : r * (q + 1) + (xcd - r) * q) + off; }
        const int nig = WGM * nN, gid = wgid / nig, fm = gid * WGM, gsz = (nM - fm) < WGM ? (nM - fm) : WGM;
        u.pm = fm + ((wgid % nig) % gsz); u.pn = (wgid % nig) / gsz; return true;
    }
    __device__ __forceinline__ void a_ready(const Unit&) const {}
    __device__ __forceinline__ void done(const Unit&) const {}
};

__device__ __forceinline__ unsigned cvt_pk_bf16(float lo, float hi) { unsigned r; asm volatile("v_cvt_pk_bf16_f32 %0, %1, %2" : "=v"(r) : "v"(lo), "v"(hi)); return r; }
typedef float f32x2 __attribute__((ext_vector_type(2)));
template <class Epi, class Sched, bool ALIGN_EPI = false, bool SP2 = false>
__device__ __forceinline__ void gemm_phase(PG8_LAS unsigned char* lds, const Gemm g, const Sched& S, const Epi& E) {
    const int tid = threadIdx.x, wid = __builtin_amdgcn_readfirstlane(tid >> 6), lane = tid & 63, wr = wid >> 2, wc = wid & 3, fr = lane & 15, fq = lane >> 4;
    const int K = g.K, nt = K / BK;
    unsigned voffA[2], voffB[2];
#pragma unroll
    for (int i = 0; i < 2; ++i) { int R, C; stage_rc(tid * 16 + i * 8192, R, C); const int Rb = Epi::PERM ? ((R & ~31) + perm32(R & 31)) : R;
        voffA[i] = (unsigned)(R * K + C) * 2u; voffB[i] = (unsigned)(Rb * K + C) * 2u; }
    const size_t kstep = (size_t)(BK * 2);
    const size_t hstep = (size_t)HALF * K * 2;
    const size_t tstep = 2 * hstep;
    const unsigned ldsw = (unsigned)wid * 1024u;
    const int aoff = lds_byte(wr * 64 + fr, fq * 8), boff = lds_byte(wc * 32 + fr, fq * 8);
#define PG8_SA(b, h) (((b) * 2 + (h)) * HTB)
#define PG8_SB(b, h) ((4 + (b) * 2 + (h)) * HTB)
#define PG8_STAGE(bufoff, gbase, voff) do { _Pragma("unroll") for (int _i = 0; _i < 2; ++_i) \
        __builtin_amdgcn_global_load_lds((const unsigned*)((const char*)(gbase) + (voff)[_i]), (PG8_LAS unsigned*)(lds + (bufoff) + ldsw + _i * 8192), 16, 0, 0); } while (0)
#define PG8_LDA(dst, b, h) do { _Pragma("unroll") for (int m = 0; m < 4; ++m) _Pragma("unroll") for (int k = 0; k < 2; ++k) dst[m][k] = *(const PG8_LAS bf16x8*)(lds + PG8_SA(b, h) + aoff + m * 2048 + k * 1024); } while (0)
#define PG8_LDB(dst, b, h) do { _Pragma("unroll") for (int n = 0; n < 2; ++n) _Pragma("unroll") for (int k = 0; k < 2; ++k) dst[n][k] = *(const PG8_LAS bf16x8*)(lds + PG8_SB(b, h) + boff + n * 2048 + k * 1024); } while (0)
#define PG8_MMA(ai, bj, At, Bt) do { __builtin_amdgcn_s_setprio(1); _Pragma("unroll") for (int m = 0; m < 4; ++m) _Pragma("unroll") for (int n = 0; n < 2; ++n) _Pragma("unroll") for (int k = 0; k < 2; ++k) \
        acc[ai][bj][m][n] = __builtin_amdgcn_mfma_f32_16x16x32_bf16(Bt[n][k], At[m][k], acc[ai][bj][m][n], 0, 0, 0); __builtin_amdgcn_s_setprio(0); } while (0)
#define PG8_WAIT_V(n) asm volatile("s_waitcnt vmcnt(" #n ")" ::: "memory")
#define PG8_WAIT_L(n) asm volatile("s_waitcnt lgkmcnt(" #n ")" ::: "memory")
#define PG8_BAR __builtin_amdgcn_s_barrier()
#define PG8_SCHED __builtin_amdgcn_sched_barrier(0)
    Unit cur, nxt; int ui = 0;
    if (!S.next(0, cur)) return;
    f32x4 acc[2][2][4][2];
#pragma unroll
    for (int a = 0; a < 2; ++a)
#pragma unroll
        for (int b = 0; b < 2; ++b)
#pragma unroll
            for (int m = 0; m < 4; ++m)
#pragma unroll
                for (int n = 0; n < 2; ++n) acc[a][b][m][n] = (f32x4){0.f, 0.f, 0.f, 0.f};
    bf16x8 At[4][2], B0[2][2], B1[2][2];
    const char* cA = (const char*)g.A + (size_t)cur.pm * tstep; const char* cB = (const char*)g.Bt + (size_t)cur.pn * tstep;
    S.a_ready(cur);
    if constexpr (SP2) {
        PG8_STAGE(PG8_SB(0, 0), cB, voffB); PG8_STAGE(PG8_SB(0, 1), cB + hstep, voffB); PG8_STAGE(PG8_SA(0, 0), cA, voffA); PG8_STAGE(PG8_SA(0, 1), cA + hstep, voffA);
        if (wr == 1) PG8_BAR;
        PG8_WAIT_V(2); PG8_BAR;
        PG8_STAGE(PG8_SB(1, 0), cB + kstep, voffB); PG8_STAGE(PG8_SA(1, 0), cA + kstep, voffA); PG8_STAGE(PG8_SB(1, 1), cB + hstep + kstep, voffB);
        PG8_WAIT_V(6); PG8_BAR;
    } else {
        PG8_STAGE(PG8_SB(0, 0), cB, voffB); PG8_STAGE(PG8_SA(0, 0), cA, voffA); PG8_STAGE(PG8_SB(0, 1), cB + hstep, voffB); PG8_STAGE(PG8_SA(0, 1), cA + hstep, voffA);
        if (wr == 1) PG8_BAR;
        PG8_WAIT_V(4); PG8_BAR;
        PG8_STAGE(PG8_SB(1, 0), cB + kstep, voffB); PG8_STAGE(PG8_SA(1, 0), cA + kstep, voffA); PG8_STAGE(PG8_SB(1, 1), cB + hstep + kstep, voffB);
        PG8_WAIT_V(6); PG8_BAR;
    }
    for (;;) {
        const bool has_next = S.next(ui + 1, nxt);
        const char* nA = has_next ? (const char*)g.A + (size_t)nxt.pm * tstep : cA; const char* nB = has_next ? (const char*)g.Bt + (size_t)nxt.pn * tstep : cB;
        for (int t = 0; t < nt; t += 2) {
            const bool last = (t == nt - 2);
            const char* a1 = cA + (size_t)(t + 1) * kstep;
            const char* a2 = last ? nA : cA + (size_t)(t + 2) * kstep; const char* b2 = last ? nB : cB + (size_t)(t + 2) * kstep;
            const char* a3 = a2 + kstep; const char* b3 = b2 + kstep;
            if (last && has_next) S.a_ready(nxt);
            if constexpr (SP2) {
            PG8_LDB(B0, 0, 0); PG8_LDB(B1, 0, 1); PG8_SCHED; PG8_LDA(At, 0, 0); PG8_STAGE(PG8_SA(1, 1), a1 + hstep, voffA);
            PG8_WAIT_V(8); PG8_WAIT_L(0); PG8_BAR; PG8_MMA(0, 0, At, B0); PG8_MMA(0, 1, At, B1); PG8_BAR; PG8_SCHED;
            PG8_LDA(At, 0, 1); PG8_STAGE(PG8_SB(0, 0), b2, voffB); PG8_STAGE(PG8_SB(0, 1), b2 + hstep, voffB); PG8_STAGE(PG8_SA(0, 0), a2, voffA);
            PG8_WAIT_V(8); PG8_WAIT_L(0); PG8_BAR; PG8_MMA(1, 0, At, B0); PG8_MMA(1, 1, At, B1); PG8_BAR; PG8_SCHED;
            PG8_LDB(B0, 1, 0); PG8_LDB(B1, 1, 1); PG8_SCHED; PG8_LDA(At, 1, 0); PG8_STAGE(PG8_SA(0, 1), a2 + hstep, voffA);
            PG8_WAIT_V(8); PG8_WAIT_L(0); PG8_BAR; PG8_MMA(0, 0, At, B0); PG8_MMA(0, 1, At, B1); PG8_BAR; PG8_SCHED;
            PG8_LDA(At, 1, 1); PG8_STAGE(PG8_SB(1, 0), b3, voffB); PG8_STAGE(PG8_SB(1, 1), b3 + hstep, voffB); PG8_STAGE(PG8_SA(1, 0), a3, voffA);
            PG8_WAIT_V(8); PG8_WAIT_L(0); PG8_BAR; PG8_MMA(1, 0, At, B0); PG8_MMA(1, 1, At, B1); PG8_BAR; PG8_SCHED;
            } else {
            PG8_LDB(B0, 0, 0); PG8_SCHED; PG8_LDA(At, 0, 0); PG8_STAGE(PG8_SA(1, 1), a1 + hstep, voffA);
            PG8_WAIT_L(8); PG8_BAR; PG8_WAIT_L(0); PG8_MMA(0, 0, At, B0); PG8_BAR; PG8_SCHED;
            PG8_LDB(B1, 0, 1); PG8_STAGE(PG8_SB(0, 0), b2, voffB);
            PG8_BAR; PG8_WAIT_L(0); PG8_MMA(0, 1, At, B1); PG8_BAR;
            PG8_LDA(At, 0, 1); PG8_STAGE(PG8_SA(0, 0), a2, voffA);
            PG8_BAR; PG8_WAIT_L(0); PG8_MMA(1, 0, At, B0); PG8_BAR; PG8_SCHED;
            PG8_STAGE(PG8_SB(0, 1), b2 + hstep, voffB);
            PG8_WAIT_V(6); PG8_BAR; PG8_MMA(1, 1, At, B1); PG8_BAR;
            PG8_LDB(B0, 1, 0); PG8_SCHED; PG8_LDA(At, 1, 0); PG8_STAGE(PG8_SA(0, 1), a2 + hstep, voffA);
            PG8_WAIT_L(8); PG8_BAR; PG8_WAIT_L(0); PG8_MMA(0, 0, At, B0); PG8_BAR; PG8_SCHED;
            PG8_LDB(B1, 1, 1); PG8_STAGE(PG8_SB(1, 0), b3, voffB);
            PG8_BAR; PG8_WAIT_L(0); PG8_MMA(0, 1, At, B1); PG8_BAR;
            PG8_LDA(At, 1, 1); PG8_STAGE(PG8_SA(1, 0), a3, voffA);
            PG8_BAR; PG8_WAIT_L(0); PG8_MMA(1, 0, At, B0); PG8_BAR; PG8_SCHED;
            PG8_STAGE(PG8_SB(1, 1), b3 + hstep, voffB);
            PG8_WAIT_V(6); PG8_BAR; PG8_MMA(1, 1, At, B1); PG8_BAR;
            }
        }
        if constexpr (ALIGN_EPI) { if (wr == 0) PG8_BAR; }
        if constexpr (!Epi::AFTER_DRAIN) { E(acc, cur, wr, wc, fr, fq); S.done(cur); }
        if (!has_next) break;
#pragma unroll
        for (int a = 0; a < 2; ++a)
#pragma unroll
            for (int b = 0; b < 2; ++b)
#pragma unroll
                for (int m = 0; m < 4; ++m)
#pragma unroll
                    for (int n = 0; n < 2; ++n) acc[a][b][m][n] = (f32x4){0.f, 0.f, 0.f, 0.f};
        cur = nxt; cA = nA; cB = nB; ++ui;
        if constexpr (ALIGN_EPI) { if (wr == 1) PG8_BAR; }
    }
    PG8_WAIT_V(0);
    if constexpr (!ALIGN_EPI) { if (wr == 0) PG8_BAR; }
    PG8_BAR;
    if constexpr (Epi::AFTER_DRAIN) { E.fused(acc, cur, wr, wc, fr, fq, lds, wid, lane); S.done(cur); }
#undef PG8_SA
#undef PG8_SB
#undef PG8_STAGE
#undef PG8_LDA
#undef PG8_LDB
#undef PG8_MMA
#undef PG8_WAIT_V
#undef PG8_WAIT_L
#undef PG8_BAR
#undef PG8_SCHED
}
}

constexpr int DM = 1024, NB = 4, SEQ = 4096, NTOK = NB * SEQ;
constexpr int HD = 64, NH = 8, NKV = 2, QW = NH * HD  , GRIDW = 64;
constexpr int INW = 3584;
constexpr int PH = 8, NKEYS = 128, TOPK = 16, NEXP = NKEYS * NKEYS, SCW = PH * 2 * NKEYS  ;
constexpr float EPS = 1e-6f;
constexpr float LOG2E = 1.4426950408889634f;
constexpr float QSCALE = 0.125f * LOG2E;

typedef unsigned u32x2_t __attribute__((ext_vector_type(2)));
typedef float f32x2_t __attribute__((ext_vector_type(2)));
typedef __bf16 bf16x2_t __attribute__((ext_vector_type(2)));
__device__ __forceinline__ unsigned pkbf(float lo, float hi) { f32x2_t v = {lo, hi}; bf16x2_t b = __builtin_convertvector(v, bf16x2_t); return __builtin_bit_cast(unsigned, b); }
__device__ __forceinline__ float bflo(unsigned w) { return __builtin_bit_cast(float, w << 16); }
__device__ __forceinline__ float bfhi(unsigned w) { return __builtin_bit_cast(float, w & 0xffff0000u); }

__device__ __forceinline__ size_t kimg_off(int b, int kvh, int s, int dim) { return ((size_t)((b * NKV + kvh) * (SEQ / 64) + (s >> 6)) << 12) + (dim >> 3) * 512 + (s & 63) * 8 + (dim & 7); }
__device__ __forceinline__ size_t vimg_off(int b, int kvh, int s, int dim) { return ((size_t)((b * NKV + kvh) * (SEQ / 64) + (s >> 6)) << 12) + (dim >> 5) * 2048 + (s & 63) * 32 + (dim & 31); }

namespace pg8 {
struct EpiIn {
    static constexpr bool PERM = false, AFTER_DRAIN = false;
    bf16_t *Qa, *Ka, *Va, *Qb, *Kb, *Vb, *Ga, *Gb;
    const float *qg, *kg, *bgate, *rope;
    __device__ __forceinline__ void operator()(const f32x4 (&acc)[2][2][4][2], const Unit& u, int wr, int wc, int fr, int fq) const {
        const int pn = u.pn;
        if (pn >= 6) {
            const bool isA = pn < 10; bf16_t* G = isA ? Ga : Gb; const int ct = (isA ? pn - 6 : pn - 10) * BM; const float* bb = bgate + (isA ? 0 : DM);
            f32x4 bv[2][2];
#pragma unroll
            for (int bj = 0; bj < 2; ++bj)
#pragma unroll
                for (int n = 0; n < 2; ++n) bv[bj][n] = *(const f32x4*)(bb + ct + bj * HALF + wc * 32 + n * 16 + 4 * fq);
#pragma unroll
            for (int ai = 0; ai < 2; ++ai)
#pragma unroll
                for (int m = 0; m < 4; ++m) { const int row = u.pm * BM + ai * HALF + wr * 64 + m * 16 + fr; bf16_t* rp = G + (size_t)row * DM + ct + wc * 32 + 4 * fq;
#pragma unroll
                    for (int bj = 0; bj < 2; ++bj)
#pragma unroll
                        for (int n = 0; n < 2; ++n) { const f32x4 z = acc[ai][bj][m][n] + bv[bj][n]; f32x4 g;
#pragma unroll
                            for (int j = 0; j < 4; ++j) g[j] = __builtin_amdgcn_rcpf(1.0f + __builtin_amdgcn_exp2f(-LOG2E * z[j]));
                            u32x2_t w; w.x = pkbf(g[0], g[1]); w.y = pkbf(g[2], g[3]); *(u32x2_t*)(rp + bj * HALF + n * 16) = w; } }
            return;
        }
        const bool brA = pn < 3; const int pl = brA ? pn : pn - 3;
        const bool isq = pl < 2, isk = (!isq) && wc < 2;
        const bool normrope = brA && (isq || isk);
        f32x4 gv[2][2];
        if (normrope) { const float* g = isq ? qg : kg;
#pragma unroll
            for (int bj = 0; bj < 2; ++bj)
#pragma unroll
                for (int n = 0; n < 2; ++n) gv[bj][n] = *(const f32x4*)(g + 32 * bj + 16 * n + 4 * fq); }
        const float osc = isq ? QSCALE : 1.0f;
#pragma unroll
        for (int ai = 0; ai < 2; ++ai)
#pragma unroll
            for (int m = 0; m < 4; ++m) {
                const int row = u.pm * BM + ai * HALF + wr * 64 + m * 16 + fr; const int b = row >> 12, s = row & (SEQ - 1);
                f32x4 v[2][2];
#pragma unroll
                for (int bj = 0; bj < 2; ++bj)
#pragma unroll
                    for (int n = 0; n < 2; ++n) v[bj][n] = acc[ai][bj][m][n];
                if (normrope) {
                    float ss = 0.f;
#pragma unroll
                    for (int bj = 0; bj < 2; ++bj)
#pragma unroll
                        for (int n = 0; n < 2; ++n) ss += (v[bj][n][0] * v[bj][n][0] + v[bj][n][1] * v[bj][n][1]) + (v[bj][n][2] * v[bj][n][2] + v[bj][n][3] * v[bj][n][3]);
                    ss += __shfl_xor(ss, 16); ss += __shfl_xor(ss, 32);
                    const float rstd = 1.0f / sqrtf(ss * (1.0f / 64.0f) + EPS);
#pragma unroll
                    for (int bj = 0; bj < 2; ++bj) {
                        const int pos = bj == 0 ? (s >> 6) : (s & (GRIDW - 1));
                        const f32x4 cs0 = *(const f32x4*)(rope + (pos * 16 + 4 * fq) * 2), cs1 = *(const f32x4*)(rope + (pos * 16 + 4 * fq) * 2 + 4);
                        const float cc[4] = {cs0[0], cs0[2], cs1[0], cs1[2]}, sn[4] = {cs0[1], cs0[3], cs1[1], cs1[3]};
#pragma unroll
                        for (int j = 0; j < 4; ++j) { const float u1 = v[bj][0][j] * rstd * gv[bj][0][j], u2 = v[bj][1][j] * rstd * gv[bj][1][j];
                            v[bj][0][j] = u1 * cc[j] - u2 * sn[j]; v[bj][1][j] = u2 * cc[j] + u1 * sn[j]; }
                    }
                }
#pragma unroll
                for (int bj = 0; bj < 2; ++bj)
#pragma unroll
                    for (int n = 0; n < 2; ++n) {
                        const f32x4 o = v[bj][n] * osc; u32x2_t w; w.x = pkbf(o[0], o[1]); w.y = pkbf(o[2], o[3]);
                        const int dim = 32 * bj + 16 * n + 4 * fq;
                        bf16_t* dst;
                        if (isq) dst = (brA ? Qa : Qb) + (size_t)row * QW + (pl * 4 + wc) * HD + dim;
                        else if (wc < 2) dst = (brA ? Ka : Kb) + kimg_off(b, wc, s, dim);
                        else dst = (brA ? Va : Vb) + vimg_off(b, wc - 2, s, dim);
                        *(u32x2_t*)dst = w;
                    }
            }
    }
};

struct EpiMixA {
    static constexpr bool PERM = false, AFTER_DRAIN = false;
    const bf16_t* G; bf16_t* OUT;
    __device__ __forceinline__ void operator()(const f32x4 (&acc)[2][2][4][2], const Unit& u, int wr, int wc, int fr, int fq) const {
#pragma unroll
        for (int ai = 0; ai < 2; ++ai)
#pragma unroll
            for (int m = 0; m < 4; ++m) { const int row = u.pm * BM + ai * HALF + wr * 64 + m * 16 + fr; const size_t off = (size_t)row * DM + u.pn * BM + wc * 32 + 4 * fq;
#pragma unroll
                for (int bj = 0; bj < 2; ++bj)
#pragma unroll
                    for (int n = 0; n < 2; ++n) { const u32x2_t g = *(const u32x2_t*)(G + off + bj * HALF + n * 16); const f32x4 a = acc[ai][bj][m][n];
                        u32x2_t w; w.x = pkbf(a[0] * bflo(g.x), a[1] * bfhi(g.x)); w.y = pkbf(a[2] * bflo(g.y), a[3] * bfhi(g.y)); *(u32x2_t*)(OUT + off + bj * HALF + n * 16) = w; } }
    }
};
struct EpiMixB {
    static constexpr bool PERM = false, AFTER_DRAIN = false;
    const bf16_t* M1; const bf16_t* G; bf16_t* OUT;
    __device__ __forceinline__ void operator()(const f32x4 (&acc)[2][2][4][2], const Unit& u, int wr, int wc, int fr, int fq) const {
#pragma unroll
        for (int ai = 0; ai < 2; ++ai)
#pragma unroll
            for (int m = 0; m < 4; ++m) { const int row = u.pm * BM + ai * HALF + wr * 64 + m * 16 + fr; const size_t off = (size_t)row * DM + u.pn * BM + wc * 32 + 4 * fq;
#pragma unroll
                for (int bj = 0; bj < 2; ++bj)
#pragma unroll
                    for (int n = 0; n < 2; ++n) { u32x2_t* p = (u32x2_t*)(OUT + off + bj * HALF + n * 16); const u32x2_t g = *(const u32x2_t*)(G + off + bj * HALF + n * 16); const u32x2_t m1 = *(const u32x2_t*)(M1 + off + bj * HALF + n * 16); const f32x4 a = acc[ai][bj][m][n];
                        u32x2_t w; w.x = pkbf(bflo(m1.x) + a[0] * bflo(g.x), bfhi(m1.x) + a[1] * bfhi(g.x)); w.y = pkbf(bflo(m1.y) + a[2] * bflo(g.y), bfhi(m1.y) + a[3] * bfhi(g.y)); *p = w; } }
    }
};
struct EpiOut {
    static constexpr bool PERM = false, AFTER_DRAIN = false;
    const float* X; float* H; bf16_t* HB; float* ssq;
    __device__ __forceinline__ void operator()(const f32x4 (&acc)[2][2][4][2], const Unit& u, int wr, int wc, int fr, int fq) const {
#pragma unroll
        for (int ai = 0; ai < 2; ++ai)
#pragma unroll
            for (int m = 0; m < 4; ++m) { const int row = u.pm * BM + ai * HALF + wr * 64 + m * 16 + fr; const size_t off = (size_t)row * DM + u.pn * BM + wc * 32 + 4 * fq; float ss = 0.f;
#pragma unroll
                for (int bj = 0; bj < 2; ++bj)
#pragma unroll
                    for (int n = 0; n < 2; ++n) { const size_t o2 = off + bj * HALF + n * 16; const f32x4 h = *(const f32x4*)(X + o2) + acc[ai][bj][m][n];
                        *(f32x4*)(H + o2) = h; u32x2_t w; w.x = pkbf(h[0], h[1]); w.y = pkbf(h[2], h[3]); *(u32x2_t*)(HB + o2) = w;
                        ss += (h[0] * h[0] + h[1] * h[1]) + (h[2] * h[2] + h[3] * h[3]); }
                ss += __shfl_xor(ss, 16); ss += __shfl_xor(ss, 32);
                if (fq == 0) ssq[(size_t)row * 16 + u.pn * 4 + wc] = ss; }
    }
};
struct EpiScore {
    static constexpr bool PERM = false, AFTER_DRAIN = false;
    const float* ssq; float* SC;
    __device__ __forceinline__ void operator()(const f32x4 (&acc)[2][2][4][2], const Unit& u, int wr, int wc, int fr, int fq) const {
#pragma unroll
        for (int ai = 0; ai < 2; ++ai)
#pragma unroll
            for (int m = 0; m < 4; ++m) { const int row = u.pm * BM + ai * HALF + wr * 64 + m * 16 + fr;
                const f32x4* sp = (const f32x4*)(ssq + (size_t)row * 16); const f32x4 s0 = sp[0], s1 = sp[1], s2 = sp[2], s3 = sp[3];
                const float tot = (((s0[0] + s0[1]) + (s0[2] + s0[3])) + ((s1[0] + s1[1]) + (s1[2] + s1[3]))) + (((s2[0] + s2[1]) + (s2[2] + s2[3])) + ((s3[0] + s3[1]) + (s3[2] + s3[3])));
                const float rstd = 1.0f / sqrtf(tot * (1.0f / DM) + EPS);
                float* rp = SC + (size_t)row * SCW + u.pn * BM + wc * 32 + 4 * fq;
#pragma unroll
                for (int bj = 0; bj < 2; ++bj)
#pragma unroll
                    for (int n = 0; n < 2; ++n) *(f32x4*)(rp + bj * HALF + n * 16) = acc[ai][bj][m][n] * rstd; }
    }
};
}

#define LAS __attribute__((address_space(3)))
namespace attn {
typedef unsigned short bf16_t;
typedef short bf16x8 __attribute__((ext_vector_type(8)));
typedef short s16x4 __attribute__((ext_vector_type(4)));
typedef float f32x16 __attribute__((ext_vector_type(16)));
typedef unsigned u32x4 __attribute__((ext_vector_type(4)));
constexpr int LDS_KV = 0;
constexpr int LDS_BIAS = 32768;
constexpr int LDS_BYTES = 32768 + 2048;
__device__ __forceinline__ int crow(int r, int hi) { return (r & 3) + 8 * (r >> 2) + 4 * hi; }
__device__ __forceinline__ s16x4 vtr(const LAS char* p) { return __builtin_bit_cast(s16x4, __builtin_amdgcn_ds_read_tr16_b64_v4i16((LAS s16x4*)p)); }
__device__ __forceinline__ float xhalf_max(float v) { auto rr = __builtin_amdgcn_permlane32_swap(__float_as_uint(v), __float_as_uint(v), false, false); return fmaxf(__uint_as_float(rr[0]), __uint_as_float(rr[1])); }
__device__ __forceinline__ float xhalf_sum(float v) { auto rr = __builtin_amdgcn_permlane32_swap(__float_as_uint(v), __float_as_uint(v), false, false); return __uint_as_float(rr[0]) + __uint_as_float(rr[1]); }

template <bool WIN>
__device__ __forceinline__ void attn_unit(LAS char* lds, const bf16_t* Q, const bf16_t* Kimg, const bf16_t* Vimg, bf16_t* O, int b, int h, int qblk, const float* bias_h  , float sink_l2) {
    const int tid = threadIdx.x, lane = tid & 63, r32 = lane & 31, hi = lane >> 5; const int wid = __builtin_amdgcn_readfirstlane(tid >> 6);
    const int q0 = qblk * 256, qw0 = q0 + 32 * wid, qrow = qw0 + r32; const size_t grow = (size_t)b * SEQ + qrow;
    const int kvh = h >> 2;
    const bf16_t* Kb = Kimg + ((size_t)((b * NKV + kvh) * (SEQ / 64)) << 12);
    const bf16_t* Vb = Vimg + ((size_t)((b * NKV + kvh) * (SEQ / 64)) << 12);
    int t_lo = 0, t_hi = SEQ / 64 - 1;
    if (WIN) { t_lo = q0 / 64 - 2; if (t_lo < 0) t_lo = 0; t_hi = q0 / 64 + 5; if (t_hi > SEQ / 64 - 1) t_hi = SEQ / 64 - 1; }
    bf16x8 qr[4];
#pragma unroll
    for (int d0 = 0; d0 < 4; ++d0) qr[d0] = *(const bf16x8*)(Q + grow * QW + h * HD + d0 * 16 + hi * 8);
    LAS float* biasl = (LAS float*)(lds + LDS_BIAS);
    if (WIN) { if (tid < 257) biasl[tid] = bias_h[tid]; }
    u32x4 kreg = *(const u32x4*)(Kb + ((size_t)t_lo << 12) + tid * 8), vreg = *(const u32x4*)(Vb + ((size_t)t_lo << 12) + tid * 8);
    *(LAS u32x4*)(lds + LDS_KV + tid * 16) = kreg; *(LAS u32x4*)(lds + LDS_KV + 8192 + tid * 16) = vreg;
    __syncthreads();
    f32x16 o0 = {}, o1 = {};
    float mrun = WIN ? sink_l2 : -1e30f, lsum = (WIN && hi == 0) ? 1.0f : 0.0f;
    const int vlane = ((lane >> 4) & 1) * 32 + (lane & 3) * 8 + (4 * hi + ((lane & 15) >> 2)) * 64;
    for (int t = t_lo; t <= t_hi; ++t) {
        const int cur = (t - t_lo) & 1;
        const LAS char* Kl = lds + LDS_KV + cur * 16384; const LAS char* Vl = Kl + 8192;
        if (t < t_hi) { kreg = *(const u32x4*)(Kb + ((size_t)(t + 1) << 12) + tid * 8); vreg = *(const u32x4*)(Vb + ((size_t)(t + 1) << 12) + tid * 8); }
        bool active = true;
        if (WIN) active = (64 * t + 63 >= qw0 - 128) && (64 * t <= qw0 + 31 + 128);
        if (active) {
            f32x16 p0 = {}, p1 = {};
#pragma unroll
            for (int d0 = 0; d0 < 4; ++d0) {
                const bf16x8 a0 = *(const LAS bf16x8*)(Kl + (2 * d0 + hi) * 1024 + r32 * 16);
                const bf16x8 a1 = *(const LAS bf16x8*)(Kl + (2 * d0 + hi) * 1024 + 512 + r32 * 16);
                p0 = __builtin_amdgcn_mfma_f32_32x32x16_bf16(a0, qr[d0], p0, 0, 0, 0);
                p1 = __builtin_amdgcn_mfma_f32_32x32x16_bf16(a1, qr[d0], p1, 0, 0, 0);
            }
            if (WIN) {
#pragma unroll
                for (int r = 0; r < 16; ++r) {
                    const int rel0 = 64 * t + crow(r, hi) - qrow, rel1 = rel0 + 32;
                    int i0 = rel0 + 128, i1 = rel1 + 128; const bool ok0 = (i0 >= 0) && (i0 <= 256), ok1 = (i1 >= 0) && (i1 <= 256);
                    i0 = i0 < 0 ? 0 : (i0 > 256 ? 256 : i0); i1 = i1 < 0 ? 0 : (i1 > 256 ? 256 : i1);
                    const float b0 = biasl[i0], b1 = biasl[i1];
                    p0[r] = ok0 ? p0[r] + b0 : -1e30f; p1[r] = ok1 ? p1[r] + b1 : -1e30f;
                }
            }
            float rm = fmaxf(p0[0], p1[0]);
#pragma unroll
            for (int r = 1; r < 16; ++r) rm = fmaxf(rm, fmaxf(p0[r], p1[r]));
            rm = xhalf_max(rm);
            const float mn = fmaxf(mrun, rm), alpha = __builtin_amdgcn_exp2f(mrun - mn); mrun = mn;
            float ps = 0.f;
#pragma unroll
            for (int r = 0; r < 16; ++r) { p0[r] = __builtin_amdgcn_exp2f(p0[r] - mn); p1[r] = __builtin_amdgcn_exp2f(p1[r] - mn); ps += p0[r] + p1[r]; }
            lsum = lsum * alpha + ps;
#pragma unroll
            for (int r = 0; r < 16; ++r) { o0[r] *= alpha; o1[r] *= alpha; }
            u32x4 pk[4];
#pragma unroll
            for (int i = 0; i < 4; ++i) { pk[0][i] = pkbf(p0[2 * i], p0[2 * i + 1]); pk[1][i] = pkbf(p0[8 + 2 * i], p0[9 + 2 * i]); pk[2][i] = pkbf(p1[2 * i], p1[2 * i + 1]); pk[3][i] = pkbf(p1[8 + 2 * i], p1[9 + 2 * i]); }
#pragma unroll
            for (int ks = 0; ks < 4; ++ks) {
                const bf16x8 pf = __builtin_bit_cast(bf16x8, pk[ks]);
                const s16x4 l0 = vtr(Vl + vlane + ks * 1024), h0 = vtr(Vl + vlane + ks * 1024 + 512);
                const s16x4 l1 = vtr(Vl + vlane + 4096 + ks * 1024), h1 = vtr(Vl + vlane + 4096 + ks * 1024 + 512);
                const bf16x8 v0 = {l0[0], l0[1], l0[2], l0[3], h0[0], h0[1], h0[2], h0[3]}, v1 = {l1[0], l1[1], l1[2], l1[3], h1[0], h1[1], h1[2], h1[3]};
                o0 = __builtin_amdgcn_mfma_f32_32x32x16_bf16(v0, pf, o0, 0, 0, 0);
                o1 = __builtin_amdgcn_mfma_f32_32x32x16_bf16(v1, pf, o1, 0, 0, 0);
            }
        }
        if (t < t_hi) { *(LAS u32x4*)(lds + LDS_KV + (cur ^ 1) * 16384 + tid * 16) = kreg; *(LAS u32x4*)(lds + LDS_KV + (cur ^ 1) * 16384 + 8192 + tid * 16) = vreg; }
        __syncthreads();
    }
    const float inv = 1.0f / xhalf_sum(lsum);
    bf16_t* Orow = O + grow * QW + h * HD + 4 * hi;
#pragma unroll
    for (int g = 0; g < 4; ++g) {
        u32x2_t w0, w1;
        w0.x = pkbf(o0[4 * g] * inv, o0[4 * g + 1] * inv); w0.y = pkbf(o0[4 * g + 2] * inv, o0[4 * g + 3] * inv);
        w1.x = pkbf(o1[4 * g] * inv, o1[4 * g + 1] * inv); w1.y = pkbf(o1[4 * g + 2] * inv, o1[4 * g + 3] * inv);
        *(u32x2_t*)(Orow + 8 * g) = w0; *(u32x2_t*)(Orow + 32 + 8 * g) = w1;
    }
    __syncthreads();
}
}

namespace peer {
typedef unsigned u32x4 __attribute__((ext_vector_type(4)));
typedef float f32x4 __attribute__((ext_vector_type(4)));
constexpr int WAVE_LDS = 2048;

template <int CTRL> __device__ __forceinline__ int dppi(int x) { return __builtin_amdgcn_mov_dpp(x, CTRL, 0xf, 0xf, true); }
template <int CTRL> __device__ __forceinline__ float dppf(float x) { return __builtin_bit_cast(float, __builtin_amdgcn_mov_dpp(__builtin_bit_cast(int, x), CTRL, 0xf, 0xf, true)); }
constexpr int XOR1 = 0xB1, XOR2 = 0x4E, XOR7 = 0x141, XOR8 = 0x128;
__device__ __forceinline__ float wave_sum(float x) {
    x += dppf<XOR1>(x); x += dppf<XOR2>(x); x += dppf<XOR7>(x); x += dppf<XOR8>(x);
    auto s = __builtin_amdgcn_permlane16_swap(__float_as_uint(x), __float_as_uint(x), false, false); x = __uint_as_float(s[0]) + __uint_as_float(s[1]);
    auto t = __builtin_amdgcn_permlane32_swap(__float_as_uint(x), __float_as_uint(x), false, false); return __uint_as_float(t[0]) + __uint_as_float(t[1]);
}
__device__ __forceinline__ float dot2bf(unsigned a, unsigned b, float c) { return __builtin_amdgcn_fdot2_f32_bf16(__builtin_bit_cast(bf16x2_t, a), __builtin_bit_cast(bf16x2_t, b), c, false); }
__device__ __forceinline__ int okey(float f, int lowbits, int payload) { int b = __float_as_int(f); b ^= (b >> 31) & 0x7fffffff; return (b & ~((1 << lowbits) - 1)) | payload; }
__device__ __forceinline__ float kval(int k, int lowbits) { int b = (k & ~((1 << lowbits) - 1)) | (1 << (lowbits - 1)); b ^= (b >> 31) & 0x7fffffff; return __int_as_float(b); }
#define CE_DESC(a, b) do { const int _x = (a), _y = (b); (a) = _x > _y ? _x : _y; (b) = _x > _y ? _y : _x; } while (0)
template <int N> __device__ __forceinline__ void bitonic_sort_desc(int (&a)[N]) {
#pragma unroll
    for (int k = 2; k <= N; k <<= 1)
#pragma unroll
        for (int j = k >> 1; j > 0; j >>= 1)
#pragma unroll
            for (int i = 0; i < N; ++i) { const int l = i ^ j; if (l > i) { if ((i & k) == 0) CE_DESC(a[i], a[l]); else CE_DESC(a[l], a[i]); } }
}
template <int N> __device__ __forceinline__ void bitonic_merge_desc(int (&a)[N]) {
#pragma unroll
    for (int j = N >> 1; j > 0; j >>= 1)
#pragma unroll
        for (int i = 0; i < N; ++i) { const int l = i ^ j; if (l > i) CE_DESC(a[i], a[l]); }
}
__device__ __forceinline__ unsigned long long cand_table(int q8) {
    unsigned long long r = 0xFFFFFFFFFFFFFFFFull; int n = 0;
#pragma unroll
    for (int i = 0; i < 16; ++i)
#pragma unroll
        for (int j = 0; j < 16; ++j) if ((i + 1) * (j + 1) <= 16) { if (n / 7 == q8) { const int s = n % 7; r = (r & ~(0xFFull << (8 * s))) | ((unsigned long long)(i * 16 + j) << (8 * s)); } ++n; }
    return r;
}

__device__ __forceinline__ void route_token(LAS char* wl, int lane, int t, unsigned long long ct, const float* SC, const float* H, const float* gffn, unsigned short* E, float* G, unsigned short* XN2) {
    LAS int* skeys = (LAS int*)wl;
    {
        const int c = lane >> 2, qq = lane & 3; const f32x4* sp = (const f32x4*)(SC + (size_t)t * SCW + c * NKEYS + qq * 32);
        int a[16], bb[16];
#pragma unroll
        for (int i = 0; i < 4; ++i) { const f32x4 v = sp[i];
#pragma unroll
            for (int j = 0; j < 4; ++j) a[4 * i + j] = okey(v[j], 7, 127 - (qq * 32 + 4 * i + j)); }
#pragma unroll
        for (int i = 0; i < 4; ++i) { const f32x4 v = sp[4 + i];
#pragma unroll
            for (int j = 0; j < 4; ++j) bb[4 * i + j] = okey(v[j], 7, 127 - (qq * 32 + 16 + 4 * i + j)); }
        bitonic_sort_desc<16>(a); bitonic_sort_desc<16>(bb);
#pragma unroll
        for (int i = 0; i < 16; ++i) a[i] = a[i] > bb[15 - i] ? a[i] : bb[15 - i];
        bitonic_merge_desc<16>(a);
#pragma unroll
        for (int i = 0; i < 16; ++i) bb[i] = dppi<XOR1>(a[15 - i]);
#pragma unroll
        for (int i = 0; i < 16; ++i) a[i] = a[i] > bb[i] ? a[i] : bb[i];
        bitonic_merge_desc<16>(a);
#pragma unroll
        for (int i = 0; i < 16; ++i) bb[i] = dppi<XOR2>(a[15 - i]);
#pragma unroll
        for (int i = 0; i < 16; ++i) a[i] = a[i] > bb[i] ? a[i] : bb[i];
        bitonic_merge_desc<16>(a);
        if (qq == 0) {
#pragma unroll
            for (int i = 0; i < 4; ++i) *(LAS u32x4*)(skeys + c * 16 + 4 * i) = (u32x4){(unsigned)a[4 * i], (unsigned)a[4 * i + 1], (unsigned)a[4 * i + 2], (unsigned)a[4 * i + 3]};
        }
    }
    asm volatile("s_waitcnt lgkmcnt(0)" ::: "memory");
    {
        const int hh = lane >> 3, q8 = lane & 7;
        int a[16];
#pragma unroll
        for (int s = 0; s < 8; ++s) {
            const int code = s < 7 ? (int)((ct >> (8 * s)) & 0xFF) : 0xFF;
            const int ci = code == 0xFF ? 0 : code;
            const int ka = skeys[(2 * hh) * 16 + (ci >> 4)], kb = skeys[(2 * hh + 1) * 16 + (ci & 15)];
            const float sum = kval(ka, 7) + kval(kb, 7);
            a[s] = code == 0xFF ? (int)0x80000000 : okey(sum, 8, 255 - code);
        }
        {
            int c8[8];
#pragma unroll
            for (int i = 0; i < 8; ++i) c8[i] = a[i];
            bitonic_sort_desc<8>(c8);
#pragma unroll
            for (int i = 0; i < 8; ++i) a[i] = c8[i];
        }
#pragma unroll
        for (int i = 0; i < 8; ++i) a[8 + i] = dppi<XOR1>(a[i]);
        { int tmp[8];
#pragma unroll
          for (int i = 0; i < 8; ++i) tmp[i] = a[8 + i];
#pragma unroll
          for (int i = 0; i < 8; ++i) a[8 + i] = tmp[7 - i]; }
        bitonic_merge_desc<16>(a);
        int bb[16];
#pragma unroll
        for (int i = 0; i < 16; ++i) bb[i] = dppi<XOR2>(a[15 - i]);
#pragma unroll
        for (int i = 0; i < 16; ++i) a[i] = a[i] > bb[i] ? a[i] : bb[i];
        bitonic_merge_desc<16>(a);
#pragma unroll
        for (int i = 0; i < 16; ++i) bb[i] = dppi<XOR7>(a[15 - i]);
#pragma unroll
        for (int i = 0; i < 16; ++i) a[i] = a[i] > bb[i] ? a[i] : bb[i];
        bitonic_merge_desc<16>(a);
        int k0 = a[0], k1 = a[1];
#pragma unroll
        for (int i = 1; i < 8; ++i) { k0 = q8 == i ? a[2 * i] : k0; k1 = q8 == i ? a[2 * i + 1] : k1; }
        const float mx = kval(a[0], 8);
        const int c0 = 255 - (k0 & 255), c1 = 255 - (k1 & 255);
        const int ka0 = skeys[(2 * hh) * 16 + (c0 >> 4)], kb0 = skeys[(2 * hh + 1) * 16 + (c0 & 15)];
        const int ka1 = skeys[(2 * hh) * 16 + (c1 >> 4)], kb1 = skeys[(2 * hh + 1) * 16 + (c1 & 15)];
        const float s0 = kval(ka0, 7) + kval(kb0, 7), s1 = kval(ka1, 7) + kval(kb1, 7);
        const float e0 = __expf(s0 - mx), e1 = __expf(s1 - mx);
        float z = e0 + e1; z += dppf<XOR1>(z); z += dppf<XOR2>(z); z += dppf<XOR7>(z);
        const float rz = 1.0f / z;
        const unsigned e0i = (unsigned)((127 - (ka0 & 127)) * NKEYS + (127 - (kb0 & 127))), e1i = (unsigned)((127 - (ka1 & 127)) * NKEYS + (127 - (kb1 & 127)));
        *(unsigned*)(E + (size_t)t * 128 + hh * 16 + 2 * q8) = e0i | (e1i << 16);
        *(f32x2_t*)(G + (size_t)t * 128 + hh * 16 + 2 * q8) = (f32x2_t){e0 * rz, e1 * rz};
    }
    {
        const f32x4* hr = (const f32x4*)(H + (size_t)t * DM) + lane; f32x4 v[4]; float ss = 0.f;
#pragma unroll
        for (int j = 0; j < 4; ++j) { v[j] = hr[64 * j]; ss += (v[j][0] * v[j][0] + v[j][1] * v[j][1]) + (v[j][2] * v[j][2] + v[j][3] * v[j][3]); }
        const float rstd = 1.0f / sqrtf(wave_sum(ss) * (1.0f / DM) + EPS);
        unsigned long long* o8 = (unsigned long long*)(XN2 + (size_t)t * DM) + lane;
#pragma unroll
        for (int j = 0; j < 4; ++j) { const f32x4 g = *((const f32x4*)gffn + lane + 64 * j);
            o8[64 * j] = (unsigned long long)pkbf(v[j][0] * rstd * g[0], v[j][1] * rstd * g[1]) | ((unsigned long long)pkbf(v[j][2] * rstd * g[2], v[j][3] * rstd * g[3]) << 32); }
    }
    asm volatile("s_waitcnt lgkmcnt(0)" ::: "memory");
}

constexpr size_t SLICE_BYTES = (size_t)NEXP * 128;
__device__ __forceinline__ unsigned getw(const u32x4& v, int i) { return i == 0 ? v.x : i == 1 ? v.y : i == 2 ? v.z : v.w; }
__device__ __forceinline__ float wave_max(float x) {
    x = fmaxf(x, dppf<XOR1>(x)); x = fmaxf(x, dppf<XOR2>(x)); x = fmaxf(x, dppf<XOR7>(x)); x = fmaxf(x, dppf<XOR8>(x));
    auto s = __builtin_amdgcn_permlane16_swap(__float_as_uint(x), __float_as_uint(x), false, false); x = fmaxf(__uint_as_float(s[0]), __uint_as_float(s[1]));
    auto t = __builtin_amdgcn_permlane32_swap(__float_as_uint(x), __float_as_uint(x), false, false); return fmaxf(__uint_as_float(t[0]), __uint_as_float(t[1]));
}
__device__ __forceinline__ void table_row_fp8(const float* src, unsigned char* T8, float* INV, int e, int lane) {
    const f32x4* p = (const f32x4*)(src + (size_t)e * DM + 16 * lane); const f32x4 a = p[0], b = p[1], c = p[2], d = p[3];
    float mx = fmaxf(fmaxf(fmaxf(fabsf(a[0]), fabsf(a[1])), fmaxf(fabsf(a[2]), fabsf(a[3]))), fmaxf(fmaxf(fabsf(b[0]), fabsf(b[1])), fmaxf(fabsf(b[2]), fabsf(b[3]))));
    mx = fmaxf(mx, fmaxf(fmaxf(fmaxf(fabsf(c[0]), fabsf(c[1])), fmaxf(fabsf(c[2]), fabsf(c[3]))), fmaxf(fmaxf(fabsf(d[0]), fabsf(d[1])), fmaxf(fabsf(d[2]), fabsf(d[3])))));
    mx = wave_max(mx);
    const float sc = mx > 0.f ? 448.0f / mx : 1.0f;
    u32x4 o; unsigned w;
    w = 0; w = __builtin_amdgcn_cvt_pk_fp8_f32(a[0] * sc, a[1] * sc, w, false); w = __builtin_amdgcn_cvt_pk_fp8_f32(a[2] * sc, a[3] * sc, w, true); o.x = w;
    w = 0; w = __builtin_amdgcn_cvt_pk_fp8_f32(b[0] * sc, b[1] * sc, w, false); w = __builtin_amdgcn_cvt_pk_fp8_f32(b[2] * sc, b[3] * sc, w, true); o.y = w;
    w = 0; w = __builtin_amdgcn_cvt_pk_fp8_f32(c[0] * sc, c[1] * sc, w, false); w = __builtin_amdgcn_cvt_pk_fp8_f32(c[2] * sc, c[3] * sc, w, true); o.z = w;
    w = 0; w = __builtin_amdgcn_cvt_pk_fp8_f32(d[0] * sc, d[1] * sc, w, false); w = __builtin_amdgcn_cvt_pk_fp8_f32(d[2] * sc, d[3] * sc, w, true); o.w = w;
    *(u32x4*)(T8 + (size_t)(lane >> 3) * SLICE_BYTES + (size_t)e * 128 + (lane & 7) * 16) = o;
    if (lane == 0) INV[e] = mx > 0.f ? mx * (1.0f / 448.0f) : 1.0f;
}
__device__ __forceinline__ void upass_token(int lane, int t, int s, const unsigned char* U8s, const unsigned short* E, const unsigned short* XN2, unsigned short* PA) {
    const int rs = lane >> 3, c8 = lane & 7;
    const u32x4 ea = *(const u32x4*)(E + (size_t)t * 128 + rs * 16), eb = *(const u32x4*)(E + (size_t)t * 128 + rs * 16 + 8);
    const u32x4 xa = *(const u32x4*)(XN2 + (size_t)t * DM + s * 128 + c8 * 16), xb = *(const u32x4*)(XN2 + (size_t)t * DM + s * 128 + c8 * 16 + 8);
    u32x4 row[16];
#pragma unroll
    for (int j = 0; j < 16; ++j) { const unsigned ew = getw(j < 8 ? ea : eb, (j & 7) >> 1); const unsigned e = (j & 1) ? (ew >> 16) : (ew & 0xffffu);
        row[j] = *(const u32x4*)(U8s + (size_t)e * 128 + c8 * 16); }
    f32x2_t xf[8];
#pragma unroll
    for (int i = 0; i < 4; ++i) { const unsigned wa = getw(xa, i), wb = getw(xb, i); xf[i] = (f32x2_t){bflo(wa), bfhi(wa)}; xf[4 + i] = (f32x2_t){bflo(wb), bfhi(wb)}; }
    float part[16];
#pragma unroll
    for (int j = 0; j < 16; ++j) {
        f32x2_t acc = {0.f, 0.f};
#pragma unroll
        for (int w = 0; w < 4; ++w) { const unsigned q = getw(row[j], w);
            acc = __builtin_elementwise_fma(__builtin_amdgcn_cvt_pk_f32_fp8(q, false), xf[2 * w], acc); acc = __builtin_elementwise_fma(__builtin_amdgcn_cvt_pk_f32_fp8(q, true), xf[2 * w + 1], acc); }
        float p = acc.x + acc.y; p += dppf<XOR1>(p); p += dppf<XOR2>(p); p += dppf<XOR7>(p); part[j] = p;
    }
    float p0 = part[0], p1 = part[1];
#pragma unroll
    for (int i = 1; i < 8; ++i) { p0 = c8 == i ? part[2 * i] : p0; p1 = c8 == i ? part[2 * i + 1] : p1; }
    *(unsigned*)(PA + ((size_t)t * 8 + s) * 128 + rs * 16 + 2 * c8) = pkbf(p0, p1);
}
__device__ __forceinline__ void wpass_token(int lane, int t, const unsigned short* E, const float* G, const unsigned short* PA, const float* INVU, const float* INVV, float* W) {
    float a0 = 0.f, a1 = 0.f;
#pragma unroll
    for (int s = 0; s < 8; ++s) { const unsigned w = *(const unsigned*)(PA + ((size_t)t * 8 + s) * 128 + 2 * lane); a0 += bflo(w); a1 += bfhi(w); }
    const unsigned ew = *(const unsigned*)(E + (size_t)t * 128 + 2 * lane); const unsigned e0 = ew & 0xffffu, e1 = ew >> 16;
    const f32x2_t g = *(const f32x2_t*)(G + (size_t)t * 128 + 2 * lane);
    a0 *= INVU[e0]; a1 *= INVU[e1];
    const float w0 = g.x * 0.5f * a0 * (1.0f + erff(a0 * 0.70710678118654752f)) * INVV[e0], w1 = g.y * 0.5f * a1 * (1.0f + erff(a1 * 0.70710678118654752f)) * INVV[e1];
    *(f32x2_t*)(W + (size_t)t * 128 + 2 * lane) = (f32x2_t){w0, w1};
}
__device__ __forceinline__ void vpass_token(int lane, int t, int s, const unsigned char* V8s, const unsigned short* E, const float* W, const float* HIN, float* HP  , float* PSS) {
    const int rs = lane >> 3, c8 = lane & 7;
    const u32x4 ea = *(const u32x4*)(E + (size_t)t * 128 + rs * 16), eb = *(const u32x4*)(E + (size_t)t * 128 + rs * 16 + 8);
    const f32x4* wp = (const f32x4*)(W + (size_t)t * 128 + rs * 16); const f32x4 w0 = wp[0], w1 = wp[1], w2 = wp[2], w3 = wp[3];
    u32x4 row[16];
#pragma unroll
    for (int j = 0; j < 16; ++j) { const unsigned ew = getw(j < 8 ? ea : eb, (j & 7) >> 1); const unsigned e = (j & 1) ? (ew >> 16) : (ew & 0xffffu);
        row[j] = *(const u32x4*)(V8s + (size_t)e * 128 + c8 * 16); }
    f32x2_t o[8];
#pragma unroll
    for (int i = 0; i < 8; ++i) o[i] = (f32x2_t){0.f, 0.f};
#pragma unroll
    for (int j = 0; j < 16; ++j) {
        const f32x4 wq = j < 4 ? w0 : j < 8 ? w1 : j < 12 ? w2 : w3; const int jj = j & 3; const float wj = jj == 0 ? wq.x : jj == 1 ? wq.y : jj == 2 ? wq.z : wq.w; const f32x2_t w2v = {wj, wj};
#pragma unroll
        for (int w = 0; w < 4; ++w) { const unsigned q = getw(row[j], w);
            o[2 * w] = __builtin_elementwise_fma(__builtin_amdgcn_cvt_pk_f32_fp8(q, false), w2v, o[2 * w]); o[2 * w + 1] = __builtin_elementwise_fma(__builtin_amdgcn_cvt_pk_f32_fp8(q, true), w2v, o[2 * w + 1]); }
    }
    float of[16];
#pragma unroll
    for (int i = 0; i < 8; ++i) { of[2 * i] = o[i].x; of[2 * i + 1] = o[i].y; }
#pragma unroll
    for (int i = 0; i < 16; ++i) { float x = of[i]; x += dppf<XOR8>(x);
        auto s1 = __builtin_amdgcn_permlane16_swap(__float_as_uint(x), __float_as_uint(x), false, false); x = __uint_as_float(s1[0]) + __uint_as_float(s1[1]);
        auto s2 = __builtin_amdgcn_permlane32_swap(__float_as_uint(x), __float_as_uint(x), false, false); of[i] = __uint_as_float(s2[0]) + __uint_as_float(s2[1]); }
    const float* hin = HIN + (size_t)t * DM + s * 128 + c8 * 16; float* hp = HP + s * 128 + c8 * 16; float ss = 0.f;
    f32x4 hv[4];
#pragma unroll
    for (int i = 0; i < 4; ++i) { hv[i] = *(const f32x4*)(hin + 4 * i); hv[i][0] += of[4 * i]; hv[i][1] += of[4 * i + 1]; hv[i][2] += of[4 * i + 2]; hv[i][3] += of[4 * i + 3];
        ss += (hv[i][0] * hv[i][0] + hv[i][1] * hv[i][1]) + (hv[i][2] * hv[i][2] + hv[i][3] * hv[i][3]); }
    ss += dppf<XOR1>(ss); ss += dppf<XOR2>(ss); ss += dppf<XOR7>(ss);
    if (rs == 0) {
#pragma unroll
        for (int i = 0; i < 4; ++i) *(f32x4*)(hp + 4 * i) = hv[i];
        if (c8 == 0) PSS[(size_t)t * 8 + s] = ss;
    }
}
__device__ __forceinline__ void final_token(int lane, int t, float* Y, const float* PSS, const float* gfin) {
    const f32x4 s0 = *(const f32x4*)(PSS + (size_t)t * 8), s1 = *(const f32x4*)(PSS + (size_t)t * 8 + 4);
    const float tot = ((s0[0] + s0[1]) + (s0[2] + s0[3])) + ((s1[0] + s1[1]) + (s1[2] + s1[3]));
    const float rstd = 1.0f / sqrtf(tot * (1.0f / DM) + EPS);
    f32x4* yr = (f32x4*)(Y + (size_t)t * DM) + lane;
#pragma unroll
    for (int j = 0; j < 4; ++j) { const f32x4 g = *((const f32x4*)gfin + lane + 64 * j); f32x4 v = yr[64 * j]; v[0] *= rstd * g[0]; v[1] *= rstd * g[1]; v[2] *= rstd * g[2]; v[3] *= rstd * g[3]; yr[64 * j] = v; }
}
}

constexpr int NWAVES = 8;
#ifndef MK_N_LAUNCHES
#define MK_N_LAUNCHES 1
#endif
constexpr int N_LAUNCHES = MK_N_LAUNCHES;
constexpr int PER_PHASE = 7;
#ifndef PROBE
#define PROBE -1
#endif
#define NREP(k) ((PROBE == (k)) ? 2 : 1)

typedef unsigned short bf16;
typedef unsigned v4u __attribute__((ext_vector_type(4)));
typedef float f32x4 __attribute__((ext_vector_type(4)));
#define LDS_WAIT() asm volatile("s_waitcnt lgkmcnt(0)" ::: "memory")
#define VM_WAIT() asm volatile("s_waitcnt vmcnt(0)" ::: "memory")

constexpr size_t MiB = 1u << 20;
constexpr size_t WS_CTL = 0, CTL_ZERO_BYTES = 64 * 1024;
constexpr size_t WS_TAB = 1 * MiB;
constexpr size_t WS_SSQ = 1 * MiB + 64 * 1024;
constexpr size_t WS_WIN = 3 * MiB;
constexpr size_t WS_WA = 10 * MiB, WS_WB = 11 * MiB;
constexpr size_t WS_WO = 12 * MiB;
constexpr size_t WS_WE = 14 * MiB;
constexpr size_t WS_U8 = 18 * MiB, WS_V8 = 34 * MiB;
constexpr size_t WS_PA = 50 * MiB;
constexpr size_t WS_INVU = 2 * MiB + 128 * 1024, WS_INVV = WS_INVU + 64 * 1024;
constexpr size_t WS_G = 3 * MiB, WS_E = 11 * MiB;
constexpr size_t WS_W = 114 * MiB, WS_PSS = 122 * MiB;
constexpr int CW_RANK = 8192;
constexpr size_t WS_XN = 82 * MiB;
constexpr size_t WS_ACT = 114 * MiB;
constexpr size_t WS_QA = WS_ACT, WS_QB = WS_ACT + 16 * MiB;
constexpr size_t WS_KA = WS_ACT + 32 * MiB, WS_VA = WS_ACT + 36 * MiB, WS_KB = WS_ACT + 40 * MiB, WS_VB = WS_ACT + 44 * MiB;
constexpr size_t WS_GA = WS_ACT + 48 * MiB, WS_GB = WS_ACT + 80 * MiB;
constexpr size_t WS_SC = WS_ACT;
constexpr size_t WS_END = 242 * MiB;
static_assert(WS_GB + 32 * MiB <= WS_END && WS_SC + (size_t)NTOK * SCW * 4 <= WS_END, "d_ws map");

constexpr int RING_BYTES = 131072;
constexpr int MISC_OFF = RING_BYTES + 320;
constexpr int LDS_BYTES = 147456;

#define XB_TMO      128
#define XB_XCNT(j)  (256  + 64 * (j))
#define XB_XSUB(j)  (1280 + 64 * (j))
#define XB_XGEN(j)  (2304 + 64 * (j))
#define XB_TOP      3328
#define XB_TOPGEN   3392
#define XCD_BAR_WORDS 3456
#define XB_SPIN_CAP (1u << 18)

__device__ __forceinline__ unsigned xb_ld(unsigned* p)              { return __hip_atomic_load(p, __ATOMIC_RELAXED, __HIP_MEMORY_SCOPE_AGENT); }
__device__ __forceinline__ unsigned xb_add(unsigned* p, unsigned v) { return __hip_atomic_fetch_add(p, v, __ATOMIC_RELAXED, __HIP_MEMORY_SCOPE_AGENT); }
__device__ __forceinline__ unsigned xb_xcc_id() { return (unsigned)__builtin_amdgcn_s_getreg((3 << 11) | 20) & 0xFu; }
#define XB_SPIN(cond, bar) do { unsigned _sp = 0; while (cond) { __builtin_amdgcn_s_sleep(1); \
    if ((++_sp & 255u) == 0u) { if (xb_ld(&(bar)[XB_TMO])) break; if (_sp > XB_SPIN_CAP) { atomicAdd(&(bar)[XB_TMO], 1u); break; } } } } while (0)

struct XcdBarrier {
    unsigned* bar; unsigned x;
    volatile LAS unsigned* st;
};

__device__ __forceinline__ XcdBarrier xcd_barrier_post(unsigned* bar, volatile LAS unsigned* st) {
    XcdBarrier b; b.bar = bar; b.x = xb_xcc_id(); b.st = st;
    if (threadIdx.x == 0) (void)xb_add(&bar[XB_XCNT(b.x)], 1u);
    return b;
}
__device__ __forceinline__ void xcd_barrier_complete(unsigned* bar, unsigned x, unsigned& nloc, unsigned& nx) {
    const unsigned G = gridDim.x * gridDim.y * gridDim.z;
    unsigned sum, cnt, mine, sp = 0u;
    for (;;) {
        sum = 0u; cnt = 0u; mine = 0u;
#pragma unroll
        for (unsigned j = 0; j < 16; ++j) { const unsigned c = xb_ld(&bar[XB_XCNT(j)]); sum += c; cnt += (c > 0u) ? 1u : 0u; mine = (j == x) ? c : mine; }
        if (sum == G) break;
        __builtin_amdgcn_s_sleep(1);
        if ((++sp & 255u) == 0u) { if (xb_ld(&bar[XB_TMO])) break; if (sp > XB_SPIN_CAP) { atomicAdd(&bar[XB_TMO], 1u); break; } }
    }
    nloc = mine > 0u ? mine : 1u; nx = cnt > 0u ? cnt : 1u;
}

__device__ __forceinline__ void xcd_barrier(const XcdBarrier& b) {
    asm volatile("s_waitcnt vmcnt(0)" ::: "memory");
    __syncthreads();
    if (threadIdx.x == 0) {
        unsigned* bar = b.bar;
        __builtin_amdgcn_s_waitcnt(0);
        unsigned nloc = b.st[0], nx = b.st[1];
        if (nloc == 0u) { xcd_barrier_complete(bar, b.x, nloc, nx); b.st[0] = nloc; b.st[1] = nx; }
        const unsigned old = xb_add(&bar[XB_XSUB(b.x)], 1u);
        const unsigned gen = old / nloc;
        if (old + 1u == (gen + 1u) * nloc) {
            __builtin_amdgcn_fence(__ATOMIC_RELEASE, "agent");
            asm volatile("s_waitcnt vmcnt(0)" ::: "memory");
            const unsigned og = xb_add(&bar[XB_TOP], 1u);
            const unsigned tg = og / nx;
            if (og + 1u == (tg + 1u) * nx) xb_add(&bar[XB_TOPGEN], 1u);
            else XB_SPIN(xb_ld(&bar[XB_TOPGEN]) == tg, bar);
            __builtin_amdgcn_fence(__ATOMIC_ACQUIRE, "agent");
            xb_add(&bar[XB_XGEN(b.x)], 1u);
            asm volatile("s_waitcnt vmcnt(0)" ::: "memory");
        } else {
            XB_SPIN(xb_ld(&bar[XB_XGEN(b.x)]) == gen, bar);
            __builtin_amdgcn_fence(__ATOMIC_ACQUIRE, "agent");
            asm volatile("s_waitcnt vmcnt(0)" ::: "memory");
        }
    }
    __syncthreads();
}


struct Args { const float* in[17]; float* out; unsigned char* ws; int ph_lo, ph_hi, li, pad; };

__device__ __forceinline__ void p0_transpose_item(const float* W, int K, int N, bf16* WT, int k0, int src_n0, int dst_n0, LAS float* scr, int lane) {
#pragma unroll 8
    for (int i = 0; i < 32; ++i) { const int kk = 2 * i + (lane >> 5); scr[kk * 33 + (lane & 31)] = W[(size_t)(k0 + kk) * N + src_n0 + (lane & 31)]; }
    LDS_WAIT();
    const int c = lane & 7;
#pragma unroll
    for (int j = 0; j < 4; ++j) { const int n = (lane >> 3) + 8 * j; const LAS float* s = scr + (8 * c) * 33 + n;
        v4u o; o.x = pkbf(s[0 * 33], s[1 * 33]); o.y = pkbf(s[2 * 33], s[3 * 33]); o.z = pkbf(s[4 * 33], s[5 * 33]); o.w = pkbf(s[6 * 33], s[7 * 33]);
        *(v4u*)(WT + (size_t)(dst_n0 + n) * K + k0 + 8 * c) = o; }
    LDS_WAIT();
}
__device__ __forceinline__ int win_src_col(int dst_n0) {
    if (dst_n0 >= 1536) return dst_n0;
    const int tile = dst_n0 >> 8, c = dst_n0 & 255;
    return tile * 256 + 64 * ((c >> 5) & 3) + 32 * (c >> 7);
}
__device__ __forceinline__ int t5_bucket(int rel) {
    const int n = rel < 0 ? -rel : rel; int bkt;
    if (n < 8) bkt = n; else { int v = 8 + (31 - __builtin_clz(n * n)) - 6; bkt = v > 15 ? 15 : v; }
    return bkt + (rel > 0 ? 16 : 0);
}

__global__ void __launch_bounds__(NWAVES * 64, 2) mk_fwd(Args args) {
    extern __shared__ __attribute__((aligned(16))) unsigned char lds_raw[];
    LAS unsigned char* lds = (LAS unsigned char*)lds_raw;
    volatile LAS unsigned* MISC = (volatile LAS unsigned*)(lds + MISC_OFF);
    const int tid = threadIdx.x, lane = tid & 63, wave = __builtin_amdgcn_readfirstlane(tid >> 6);
    const int G = gridDim.x, bx = blockIdx.x; const int vcu = (G % 8 == 0) ? (bx % 8) * (G / 8) + bx / 8 : bx;
    const int gw = vcu * NWAVES + wave, NGW = G * NWAVES;
    unsigned char* ws = args.ws;
    const float* x = args.in[0]; const float* g_mix = args.in[1]; const float* w_in = args.in[2]; const float* b_gate = args.in[3];
    const float* q_norm_g = args.in[4]; const float* k_norm_g = args.in[5]; const float* rel_bias = args.in[6]; const float* sink = args.in[7];
    const float* w_a = args.in[8]; const float* w_b = args.in[9]; const float* w_out = args.in[10]; const float* g_ffn = args.in[11];
    const float* peer_wq = args.in[12]; const float* subkeys = args.in[13]; const float* peer_u = args.in[14]; const float* peer_v = args.in[15]; const float* g_final = args.in[16];
    float* out = args.out;
    float* ROPE = (float*)(ws + WS_TAB); float* BIAS = (float*)(ws + WS_TAB + 16384); float* SSQ = (float*)(ws + WS_SSQ);
    bf16 *WIN_T = (bf16*)(ws + WS_WIN), *WA_T = (bf16*)(ws + WS_WA), *WB_T = (bf16*)(ws + WS_WB), *WO_T = (bf16*)(ws + WS_WO), *WE_T = (bf16*)(ws + WS_WE);
    unsigned char *U8 = ws + WS_U8, *V8 = ws + WS_V8; bf16 *PA = (bf16*)(ws + WS_PA), *XN = (bf16*)(ws + WS_XN);
    float *INVU = (float*)(ws + WS_INVU), *INVV = (float*)(ws + WS_INVV), *RG = (float*)(ws + WS_G), *RW = (float*)(ws + WS_W), *PSS = (float*)(ws + WS_PSS); bf16* RE = (bf16*)(ws + WS_E);
    bf16 *QA = (bf16*)(ws + WS_QA), *QB = (bf16*)(ws + WS_QB), *KA = (bf16*)(ws + WS_KA), *VA = (bf16*)(ws + WS_VA), *KB = (bf16*)(ws + WS_KB), *VB = (bf16*)(ws + WS_VB);
    bf16 *GA = (bf16*)(ws + WS_GA), *GB = (bf16*)(ws + WS_GB); float* SC = (float*)(ws + WS_SC);

    for (int u = tid; u < (LDS_BYTES - RING_BYTES) / 4; u += NWAVES * 64) ((LAS unsigned*)(lds + RING_BYTES))[u] = 0u;
    __syncthreads();
    XcdBarrier bar; bar.bar = (unsigned*)(ws + WS_CTL) + 1024; bar.x = 0; bar.st = nullptr;
    if (N_LAUNCHES != PER_PHASE) bar = xcd_barrier_post((unsigned*)(ws + WS_CTL) + 1024, MISC + 8);
    if (tid == 0) { const unsigned xc = xb_xcc_id(); MISC[13] = xc; MISC[12] = xb_add((unsigned*)(ws + WS_CTL) + CW_RANK + 64 * xc, 1u); }
    const int lo = args.ph_lo, hi = args.ph_hi;
#define IN(k) (lo <= (k) && (k) < hi)
#define BOTH(k) (IN(k) && IN((k) + 1))
#define GRID_BAR() do { if (N_LAUNCHES != PER_PHASE) xcd_barrier(bar); } while (0)

    if (IN(0)) for (int rep_ = 0; rep_ < NREP(0); ++rep_) {
        if (rep_) { VM_WAIT(); __syncthreads(); }
        LAS float* scr = (LAS float*)(lds + wave * 16384);
        {
            constexpr int I_IN = (DM / 64) * (INW / 32), I_AB = (QW / 64) * (DM / 32), I_O = (DM / 64) * (DM / 32);
            constexpr int NITEMS = I_IN + 2 * I_AB + I_O;
            for (int it = gw; it < NITEMS; it += NGW) {
                int r = it;
                if (r < I_IN) { const int nblk = INW / 32, kb = r / nblk, nb = r % nblk; p0_transpose_item(w_in, DM, INW, WIN_T, 64 * kb, win_src_col(32 * nb), 32 * nb, scr, lane); continue; } r -= I_IN;
                if (r < I_AB) { const int nblk = DM / 32, kb = r / nblk, nb = r % nblk; p0_transpose_item(w_a, QW, DM, WA_T, 64 * kb, 32 * nb, 32 * nb, scr, lane); continue; } r -= I_AB;
                if (r < I_AB) { const int nblk = DM / 32, kb = r / nblk, nb = r % nblk; p0_transpose_item(w_b, QW, DM, WB_T, 64 * kb, 32 * nb, 32 * nb, scr, lane); continue; } r -= I_AB;
                { const int nblk = DM / 32, kb = r / nblk, nb = r % nblk; p0_transpose_item(w_out, DM, DM, WO_T, 64 * kb, 32 * nb, 32 * nb, scr, lane); }
            }
        }
        __syncthreads();
        {
            LAS float* sk_s = (LAS float*)lds;
            LAS float* wq_s = (LAS float*)(lds + 128 * 129 * 4);
            for (int it = vcu; it < 16 * 16; it += G) {
                const int c = it >> 4, k0 = (it & 15) * 64;
                for (int i = tid; i < 128 * 32; i += NWAVES * 64) { const int n = i >> 5, d4 = (i & 31) * 4; const f32x4 v = *(const f32x4*)(subkeys + ((size_t)c * NKEYS + n) * 128 + d4);
                    sk_s[n * 129 + d4] = v[0]; sk_s[n * 129 + d4 + 1] = v[1]; sk_s[n * 129 + d4 + 2] = v[2]; sk_s[n * 129 + d4 + 3] = v[3]; }
                for (int i = tid; i < 64 * 32; i += NWAVES * 64) { const int k = i >> 5, d4 = (i & 31) * 4; const f32x4 v = *(const f32x4*)(peer_wq + (size_t)(k0 + k) * SCW + c * 128 + d4);
                    wq_s[k * 129 + d4] = v[0]; wq_s[k * 129 + d4 + 1] = v[1]; wq_s[k * 129 + d4 + 2] = v[2]; wq_s[k * 129 + d4 + 3] = v[3]; }
                __syncthreads();
                const int k = tid & 63, ng = tid >> 6; float acc[16];
#pragma unroll
                for (int i = 0; i < 16; ++i) acc[i] = 0.f;
                for (int d = 0; d < 128; ++d) { const float a = wq_s[k * 129 + d];
#pragma unroll
                    for (int i = 0; i < 16; ++i) acc[i] += a * sk_s[(ng * 16 + i) * 129 + d]; }
                const float gk = g_ffn[k0 + k];
#pragma unroll
                for (int i = 0; i < 16; ++i) WE_T[(size_t)(c * 128 + ng * 16 + i) * DM + k0 + k] = (bf16)(pkbf(acc[i] * gk, 0.f) & 0xffffu);
                __syncthreads();
            }
        }
        for (int e = gw; e < 2 * NEXP; e += NGW) { if (e < NEXP) peer::table_row_fp8(peer_u, U8, INVU, e, lane); else peer::table_row_fp8(peer_v, V8, INVV, e - NEXP, lane); }
        for (int m = gw; m < NTOK; m += NGW) {
            const f32x4* xr = (const f32x4*)(x + (size_t)m * DM) + lane; f32x4 v[4]; float s = 0.f;
#pragma unroll
            for (int j = 0; j < 4; ++j) { v[j] = xr[64 * j]; s += (v[j][0] * v[j][0] + v[j][1] * v[j][1]) + (v[j][2] * v[j][2] + v[j][3] * v[j][3]); }
            const float rstd = 1.0f / sqrtf(peer::wave_sum(s) * (1.0f / DM) + EPS);
            unsigned long long* o8 = (unsigned long long*)(XN + (size_t)m * DM) + lane;
#pragma unroll
            for (int j = 0; j < 4; ++j) { const f32x4 g = *((const f32x4*)g_mix + lane + 64 * j);
                o8[64 * j] = (unsigned long long)pkbf(v[j][0] * rstd * g[0], v[j][1] * rstd * g[1]) | ((unsigned long long)pkbf(v[j][2] * rstd * g[2], v[j][3] * rstd * g[3]) << 32); }
        }
        if (vcu == 0) {
            for (int i = tid; i < 64 * 16; i += NWAVES * 64) { const int pos = i >> 4, f = i & 15; const float fr = powf(10000.0f, -(float)f / 16.0f); const float ang = (float)pos * fr; ROPE[2 * i] = cosf(ang); ROPE[2 * i + 1] = sinf(ang); }
            for (int i = tid; i < 8 * 257; i += NWAVES * 64) { const int h = i / 257, rel = i % 257 - 128; BIAS[i] = rel_bias[t5_bucket(rel) * NH + h] * LOG2E; }
        }
        if (BOTH(0) && rep_ == NREP(0) - 1) GRID_BAR();
    }

    if (IN(1)) {
        pg8::Gemm g{XN, WIN_T, NTOK, INW, DM}; pg8::StaticOrder S; S.init(NTOK, INW, G, bx);
        pg8::EpiIn E{QA, KA, VA, QB, KB, VB, GA, GB, q_norm_g, k_norm_g, b_gate, ROPE};
        if (PROBE == 1) { pg8::gemm_phase<pg8::EpiIn, pg8::StaticOrder, true, true>(lds, g, S, E); VM_WAIT(); __syncthreads(); }
        pg8::gemm_phase<pg8::EpiIn, pg8::StaticOrder, true, true>(lds, g, S, E);
        if (BOTH(1)) GRID_BAR();
    }

    if (IN(2)) {
        if (PROBE == 2) {
            bf16* DUM = (bf16*)(ws + WS_ACT + 112 * MiB);
            for (int u = vcu; u < 512; u += G) { const int xg = u >> 6, i = u & 63; const int b = xg >> 1, h = 4 * (xg & 1) + (i >> 4), qblk = i & 15;
                attn::attn_unit<false>((LAS char*)lds, QA, KA, VA, DUM, b, h, qblk, nullptr, 0.f); }
            for (int u = vcu; u < 512; u += G) { const int xg = u >> 6, i = u & 63; const int b = xg >> 1, h = 4 * (xg & 1) + (i >> 4), qblk = i & 15;
                attn::attn_unit<true>((LAS char*)lds, QB, KB, VB, DUM, b, h, qblk, BIAS + h * 257, sink[h] * LOG2E); }
        }
        for (int u = vcu; u < 512; u += G) { const int xg = u >> 6, i = u & 63; const int b = xg >> 1, h = 4 * (xg & 1) + (i >> 4), qblk = i & 15;
            attn::attn_unit<false>((LAS char*)lds, QA, KA, VA, QA, b, h, qblk, nullptr, 0.f); }
        for (int u = vcu; u < 512; u += G) { const int xg = u >> 6, i = u & 63; const int b = xg >> 1, h = 4 * (xg & 1) + (i >> 4), qblk = i & 15;
            attn::attn_unit<true>((LAS char*)lds, QB, KB, VB, QB, b, h, qblk, BIAS + h * 257, sink[h] * LOG2E); }
        if (BOTH(2)) GRID_BAR();
    }

    if (IN(3)) {
        if (PROBE == 3) {
            { pg8::Gemm g{QA, WA_T, NTOK, DM, QW}; pg8::StaticOrder S; S.init(NTOK, DM, G, bx); pg8::EpiMixA E{GA, XN};
              pg8::gemm_phase<pg8::EpiMixA, pg8::StaticOrder, true, true>(lds, g, S, E); }
            VM_WAIT(); __syncthreads();
            { pg8::Gemm g{QB, WB_T, NTOK, DM, QW}; pg8::StaticOrder S; S.init(NTOK, DM, G, bx); pg8::EpiMixB E{XN, GB, XN};
              pg8::gemm_phase<pg8::EpiMixB, pg8::StaticOrder, true, true>(lds, g, S, E); }
            VM_WAIT(); __syncthreads();
        }
        { pg8::Gemm g{QA, WA_T, NTOK, DM, QW}; pg8::StaticOrder S; S.init(NTOK, DM, G, bx); pg8::EpiMixA E{GA, GA};
          pg8::gemm_phase<pg8::EpiMixA, pg8::StaticOrder, true, true>(lds, g, S, E); }
        VM_WAIT(); __syncthreads();
        { pg8::Gemm g{QB, WB_T, NTOK, DM, QW}; pg8::StaticOrder S; S.init(NTOK, DM, G, bx); pg8::EpiMixB E{GA, GB, GB};
          pg8::gemm_phase<pg8::EpiMixB, pg8::StaticOrder, true, true>(lds, g, S, E); }
        if (BOTH(3)) GRID_BAR();
    }

    if (IN(4)) {
        pg8::Gemm g{GB, WO_T, NTOK, DM, DM}; pg8::StaticOrder S; S.init(NTOK, DM, G, bx); pg8::EpiOut E{x, out, XN, SSQ};
        for (int rep_ = 0; rep_ < NREP(4); ++rep_) pg8::gemm_phase<pg8::EpiOut, pg8::StaticOrder, true, true>(lds, g, S, E);
        if (BOTH(4)) GRID_BAR();
    }

    if (IN(5)) {
        pg8::Gemm g{XN, WE_T, NTOK, SCW, DM}; pg8::StaticOrder S; S.init(NTOK, SCW, G, bx); pg8::EpiScore E{SSQ, SC};
        for (int rep_ = 0; rep_ < NREP(5); ++rep_) pg8::gemm_phase<pg8::EpiScore, pg8::StaticOrder, true, true>(lds, g, S, E);
        if (BOTH(5)) GRID_BAR();
    }

    if (IN(6)) {
        LAS char* wl = (LAS char*)lds + wave * peer::WAVE_LDS;
        const unsigned long long ct = peer::cand_table(lane & 7);
        for (int rep_ = 0; rep_ < NREP(60); ++rep_) for (int t = gw; t < NTOK; t += NGW) peer::route_token(wl, lane, t, ct, SC, out, g_ffn, RE, RG, XN);
        GRID_BAR();
        int nloc = 0, nx = 0, ox = 0; const int myx = (int)MISC[13], rank = (int)MISC[12];
#pragma unroll
        for (int j = 0; j < 16; ++j) { const int c = (int)xb_ld((unsigned*)(ws + WS_CTL) + CW_RANK + 64 * j); nx += c > 0; ox += (c > 0 && j < myx); nloc = j == myx ? c : nloc; }
        const int wv = rank * NWAVES + wave, nwv = nloc * NWAVES;
        for (int rep_ = 0; rep_ < NREP(61); ++rep_) for (int s = ox; s < 8; s += nx) { const unsigned char* U8s = U8 + (size_t)s * peer::SLICE_BYTES;
            for (int t = wv; t < NTOK; t += nwv) peer::upass_token(lane, t, s, U8s, RE, XN, PA); }
        GRID_BAR();
        for (int rep_ = 0; rep_ < NREP(62); ++rep_) for (int t = gw; t < NTOK; t += NGW) peer::wpass_token(lane, t, RE, RG, PA, INVU, INVV, RW);
        GRID_BAR();
        for (int s = ox; s < 8; s += nx) { const unsigned char* V8s = V8 + (size_t)s * peer::SLICE_BYTES;
            if (PROBE == 63) for (int t = wv; t < NTOK; t += nwv) peer::vpass_token(lane, t, s, V8s, RE, RW, out, (float*)(ws + WS_XN) + (size_t)(t & 8191) * DM, PSS);
            for (int t = wv; t < NTOK; t += nwv) peer::vpass_token(lane, t, s, V8s, RE, RW, out, out + (size_t)t * DM, PSS); }
        GRID_BAR();
        for (int t = gw; t < NTOK; t += NGW) peer::final_token(lane, t, out, PSS, g_final);
    }
#undef IN
#undef BOTH
#undef GRID_BAR
}

extern "C" void kernel_launch(void* const* d_in, const int* in_sizes, int n_in, void* d_out, int out_size, void* d_ws, size_t ws_size, hipStream_t stream) {
    static int grid = 0;
    if (grid == 0) {
        if (n_in != 17 || in_sizes[0] != NTOK * DM || out_size != NTOK * DM || ws_size < WS_END) { fprintf(stderr, "kernel_launch: unexpected shapes (n_in %d, in0 %d, out %d, ws %zu); nothing launched\n", n_in, n_in > 0 ? in_sizes[0] : -1, out_size, ws_size); grid = -1; return; }
        int dev = 0, cus = 0, per_cu = 0;
        if (hipGetDevice(&dev) != hipSuccess || hipDeviceGetAttribute(&cus, hipDeviceAttributeMultiprocessorCount, dev) != hipSuccess) { grid = -1; return; }
        if (hipFuncSetAttribute((const void*)mk_fwd, hipFuncAttributeMaxDynamicSharedMemorySize, LDS_BYTES) != hipSuccess) { fprintf(stderr, "kernel_launch: hipFuncSetAttribute failed\n"); grid = -1; return; }
        if (hipOccupancyMaxActiveBlocksPerMultiprocessor(&per_cu, (const void*)mk_fwd, NWAVES * 64, LDS_BYTES) != hipSuccess || per_cu < 1) { fprintf(stderr, "kernel_launch: occupancy query says %d blocks per CU; nothing launched\n", per_cu); (void)hipGetLastError(); grid = -1; return; }
        grid = cus;
    }
    if (grid < 0) return;
    if (hipMemsetAsync((char*)d_ws + WS_CTL, 0, CTL_ZERO_BYTES, stream) != hipSuccess) { fprintf(stderr, "kernel_launch: hipMemsetAsync failed\n"); return; }
    Args a{};
    for (int i = 0; i < 17; ++i) a.in[i] = (const float*)d_in[i];
    a.out = (float*)d_out; a.ws = (unsigned char*)d_ws;
    if (N_LAUNCHES == 1) {
        a.ph_lo = 0; a.ph_hi = PER_PHASE; a.li = 0;
#if defined(COOP_LAUNCH)
        void* kargs[] = {&a};
        hipError_t e = hipLaunchCooperativeKernel((const void*)mk_fwd, dim3(grid), dim3(NWAVES * 64), kargs, LDS_BYTES, stream);
        if (e != hipSuccess) fprintf(stderr, "kernel_launch: cooperative launch failed: %s (grid %d)\n", hipGetErrorString(e), grid);
#else
        hipLaunchKernelGGL(mk_fwd, dim3(grid), dim3(NWAVES * 64), LDS_BYTES, stream, a);
#endif
    } else {
        for (int li = 0; li < PER_PHASE; ++li) { a.ph_lo = li; a.ph_hi = li + 1; a.li = li;
            hipLaunchKernelGGL(mk_fwd, dim3(grid), dim3(NWAVES * 64), LDS_BYTES, stream, a); }
    }
}
```

```cpp
#include <hip/hip_runtime.h>
#include <cstdio>
#include <cstdint>
#include <cmath>
namespace pg8 {
#define PG8_LAS __attribute__((address_space(3)))
typedef unsigned short bf16_t;
typedef short bf16x8 __attribute__((ext_vector_type(8)));
typedef float f32x4 __attribute__((ext_vector_type(4)));
typedef unsigned u32x4 __attribute__((ext_vector_type(4)));
constexpr int BM = 256, BK = 64, HALF = 128, HTB = HALF * BK * 2  , STAGE_BYTES = 8 * HTB, NXCD = 8, WGM = 8;

__host__ __device__ __forceinline__ int lds_byte(int r, int c) { const int st = (r >> 4) * 2 + (c >> 5), rr = r & 15, cc = c & 31, ob = rr * 64 + cc * 2; return st * 1024 + (ob ^ (((ob >> 9) & 1) << 5)); }
__host__ __device__ __forceinline__ void stage_rc(int b, int& R, int& C) { const int st = b / 1024, sb = b % 1024, swz = sb ^ (((sb >> 9) & 1) << 5); R = (st >> 1) * 16 + swz / 64; C = (st & 1) * 32 + (swz % 64) / 2; }
__host__ __device__ __forceinline__ int perm32(int rho) { const int n = rho >> 4, i = rho & 15; return 8 * (i >> 2) + 4 * n + (i & 3); }

struct Unit { int pm, pn; };
struct Gemm { const bf16_t* A; const bf16_t* Bt; int M, N, K; };

struct StaticOrder {
    int nM, nN, nwg, G, c;
    __host__ __device__ void init(int M, int N, int G_, int c_) { nM = M / BM; nN = N / BM; nwg = nM * nN; G = G_; c = c_; }
    __host__ __device__ bool next(int i, Unit& u) const {
        const long L = (long)i * G + c; if (L >= nwg) return false;
        int wgid = (int)L; { const int q = nwg / NXCD, r = nwg % NXCD, xcd = wgid % NXCD, off = wgid / NXCD; wgid = (xcd < r ? xcd * (q + 1) : r * (q + 1) + (xcd - r) * q) + off; }
        const int nig = WGM * nN, gid = wgid / nig, fm = gid * WGM, gsz = (nM - fm) < WGM ? (nM - fm) : WGM;
        u.pm = fm + ((wgid % nig) % gsz); u.pn = (wgid % nig) / gsz; return true;
    }
    __device__ __forceinline__ void a_ready(const Unit&) const {}
    __device__ __forceinline__ void done(const Unit&) const {}
};

__device__ __forceinline__ unsigned cvt_pk_bf16(float lo, float hi) { unsigned r; asm volatile("v_cvt_pk_bf16_f32 %0, %1, %2" : "=v"(r) : "v"(lo), "v"(hi)); return r; }
typedef float f32x2 __attribute__((ext_vector_type(2)));
template <class Epi, class Sched, bool ALIGN_EPI = false, bool SP2 = false>
__device__ __forceinline__ void gemm_phase(PG8_LAS unsigned char* lds, const Gemm g, const Sched& S, const Epi& E) {
    const int tid = threadIdx.x, wid = __builtin_amdgcn_readfirstlane(tid >> 6), lane = tid & 63, wr = wid >> 2, wc = wid & 3, fr = lane & 15, fq = lane >> 4;
    const int K = g.K, nt = K / BK;
    unsigned voffA[2], voffB[2];
#pragma unroll
    for (int i = 0; i < 2; ++i) { int R, C; stage_rc(tid * 16 + i * 8192, R, C); const int Rb = Epi::PERM ? ((R & ~31) + perm32(R & 31)) : R;
        voffA[i] = (unsigned)(R * K + C) * 2u; voffB[i] = (unsigned)(Rb * K + C) * 2u; }
    const size_t kstep = (size_t)(BK * 2);
    const size_t hstep = (size_t)HALF * K * 2;
    const size_t tstep = 2 * hstep;
    const unsigned ldsw = (unsigned)wid * 1024u;
    const int aoff = lds_byte(wr * 64 + fr, fq * 8), boff = lds_byte(wc * 32 + fr, fq * 8);
#define PG8_SA(b, h) (((b) * 2 + (h)) * HTB)
#define PG8_SB(b, h) ((4 + (b) * 2 + (h)) * HTB)
#define PG8_STAGE(bufoff, gbase, voff) do { _Pragma("unroll") for (int _i = 0; _i < 2; ++_i) \
        __builtin_amdgcn_global_load_lds((const unsigned*)((const char*)(gbase) + (voff)[_i]), (PG8_LAS unsigned*)(lds + (bufoff) + ldsw + _i * 8192), 16, 0, 0); } while (0)
#define PG8_LDA(dst, b, h) do { _Pragma("unroll") for (int m = 0; m < 4; ++m) _Pragma("unroll") for (int k = 0; k < 2; ++k) dst[m][k] = *(const PG8_LAS bf16x8*)(lds + PG8_SA(b, h) + aoff + m * 2048 + k * 1024); } while (0)
#define PG8_LDB(dst, b, h) do { _Pragma("unroll") for (int n = 0; n < 2; ++n) _Pragma("unroll") for (int k = 0; k < 2; ++k) dst[n][k] = *(const PG8_LAS bf16x8*)(lds + PG8_SB(b, h) + boff + n * 2048 + k * 1024); } while (0)
#define PG8_MMA(ai, bj, At, Bt) do { __builtin_amdgcn_s_setprio(1); _Pragma("unroll") for (int m = 0; m < 4; ++m) _Pragma("unroll") for (int n = 0; n < 2; ++n) _Pragma("unroll") for (int k = 0; k < 2; ++k) \
        acc[ai][bj][m][n] = __builtin_amdgcn_mfma_f32_16x16x32_bf16(Bt[n][k], At[m][k], acc[ai][bj][m][n], 0, 0, 0); __builtin_amdgcn_s_setprio(0); } while (0)
#define PG8_WAIT_V(n) asm volatile("s_waitcnt vmcnt(" #n ")" ::: "memory")
#define PG8_WAIT_L(n) asm volatile("s_waitcnt lgkmcnt(" #n ")" ::: "memory")
#define PG8_BAR __builtin_amdgcn_s_barrier()
#define PG8_SCHED __builtin_amdgcn_sched_barrier(0)
    Unit cur, nxt; int ui = 0;
    if (!S.next(0, cur)) return;
    f32x4 acc[2][2][4][2];
#pragma unroll
    for (int a = 0; a < 2; ++a)
#pragma unroll
        for (int b = 0; b < 2; ++b)
#pragma unroll
            for (int m = 0; m < 4; ++m)
#pragma unroll
                for (int n = 0; n < 2; ++n) acc[a][b][m][n] = (f32x4){0.f, 0.f, 0.f, 0.f};
    bf16x8 At[4][2], B0[2][2], B1[2][2];
    const char* cA = (const char*)g.A + (size_t)cur.pm * tstep; const char* cB = (const char*)g.Bt + (size_t)cur.pn * tstep;
    S.a_ready(cur);
    if constexpr (SP2) {
        PG8_STAGE(PG8_SB(0, 0), cB, voffB); PG8_STAGE(PG8_SB(0, 1), cB + hstep, voffB); PG8_STAGE(PG8_SA(0, 0), cA, voffA); PG8_STAGE(PG8_SA(0, 1), cA + hstep, voffA);
        if (wr == 1) PG8_BAR;
        PG8_WAIT_V(2); PG8_BAR;
        PG8_STAGE(PG8_SB(1, 0), cB + kstep, voffB); PG8_STAGE(PG8_SA(1, 0), cA + kstep, voffA); PG8_STAGE(PG8_SB(1, 1), cB + hstep + kstep, voffB);
        PG8_WAIT_V(6); PG8_BAR;
    } else {
        PG8_STAGE(PG8_SB(0, 0), cB, voffB); PG8_STAGE(PG8_SA(0, 0), cA, voffA); PG8_STAGE(PG8_SB(0, 1), cB + hstep, voffB); PG8_STAGE(PG8_SA(0, 1), cA + hstep, voffA);
        if (wr == 1) PG8_BAR;
        PG8_WAIT_V(4); PG8_BAR;
        PG8_STAGE(PG8_SB(1, 0), cB + kstep, voffB); PG8_STAGE(PG8_SA(1, 0), cA + kstep, voffA); PG8_STAGE(PG8_SB(1, 1), cB + hstep + kstep, voffB);
        PG8_WAIT_V(6); PG8_BAR;
    }
    for (;;) {
        const bool has_next = S.next(ui + 1, nxt);
        const char* nA = has_next ? (const char*)g.A + (size_t)nxt.pm * tstep : cA; const char* nB = has_next ? (const char*)g.Bt + (size_t)nxt.pn * tstep : cB;
        for (int t = 0; t < nt; t += 2) {
            const bool last = (t == nt - 2);
            const char* a1 = cA + (size_t)(t + 1) * kstep;
            const char* a2 = last ? nA : cA + (size_t)(t + 2) * kstep; const char* b2 = last ? nB : cB + (size_t)(t + 2) * kstep;
            const char* a3 = a2 + kstep; const char* b3 = b2 + kstep;
            if (last && has_next) S.a_ready(nxt);
            if constexpr (SP2) {
            PG8_LDB(B0, 0, 0); PG8_LDB(B1, 0, 1); PG8_SCHED; PG8_LDA(At, 0, 0); PG8_STAGE(PG8_SA(1, 1), a1 + hstep, voffA);
            PG8_WAIT_V(8); PG8_WAIT_L(0); PG8_BAR; PG8_MMA(0, 0, At, B0); PG8_MMA(0, 1, At, B1); PG8_BAR; PG8_SCHED;
            PG8_LDA(At, 0, 1); PG8_STAGE(PG8_SB(0, 0), b2, voffB); PG8_STAGE(PG8_SB(0, 1), b2 + hstep, voffB); PG8_STAGE(PG8_SA(0, 0), a2, voffA);
            PG8_WAIT_V(8); PG8_WAIT_L(0); PG8_BAR; PG8_MMA(1, 0, At, B0); PG8_MMA(1, 1, At, B1); PG8_BAR; PG8_SCHED;
            PG8_LDB(B0, 1, 0); PG8_LDB(B1, 1, 1); PG8_SCHED; PG8_LDA(At, 1, 0); PG8_STAGE(PG8_SA(0, 1), a2 + hstep, voffA);
            PG8_WAIT_V(8); PG8_WAIT_L(0); PG8_BAR; PG8_MMA(0, 0, At, B0); PG8_MMA(0, 1, At, B1); PG8_BAR; PG8_SCHED;
            PG8_LDA(At, 1, 1); PG8_STAGE(PG8_SB(1, 0), b3, voffB); PG8_STAGE(PG8_SB(1, 1), b3 + hstep, voffB); PG8_STAGE(PG8_SA(1, 0), a3, voffA);
            PG8_WAIT_V(8); PG8_WAIT_L(0); PG8_BAR; PG8_MMA(1, 0, At, B0); PG8_MMA(1, 1, At, B1); PG8_BAR; PG8_SCHED;
            } else {
            PG8_LDB(B0, 0, 0); PG8_SCHED; PG8_LDA(At, 0, 0); PG8_STAGE(PG8_SA(1, 1), a1 + hstep, voffA);
            PG8_WAIT_L(8); PG8_BAR; PG8_WAIT_L(0); PG8_MMA(0, 0, At, B0); PG8_BAR; PG8_SCHED;
            PG8_LDB(B1, 0, 1); PG8_STAGE(PG8_SB(0, 0), b2, voffB);
            PG8_BAR; PG8_WAIT_L(0); PG8_MMA(0, 1, At, B1); PG8_BAR;
            PG8_LDA(At, 0, 1); PG8_STAGE(PG8_SA(0, 0), a2, voffA);
            PG8_BAR; PG8_WAIT_L(0); PG8_MMA(1, 0, At, B0); PG8_BAR; PG8_SCHED;
            PG8_STAGE(PG8_SB(0, 1), b2 + hstep, voffB);
            PG8_WAIT_V(6); PG8_BAR; PG8_MMA(1, 1, At, B1); PG8_BAR;
            PG8_LDB(B0, 1, 0); PG8_SCHED; PG8_LDA(At, 1, 0); PG8_STAGE(PG8_SA(0, 1), a2 + hstep, voffA);
            PG8_WAIT_L(8); PG8_BAR; PG8_WAIT_L(0); PG8_MMA(0, 0, At, B0); PG8_BAR; PG8_SCHED;
            PG8_LDB(B1, 1, 1); PG8_STAGE(PG8_SB(1, 0), b3, voffB);
            PG8_BAR; PG8_WAIT_L(0); PG8_MMA(0, 1, At, B1); PG8_BAR;
            PG8_LDA(At, 1, 1); PG8_STAGE(PG8_SA(1, 0), a3, voffA);
            PG8_BAR; PG8_WAIT_L(0); PG8_MMA(1, 0, At, B0); PG8_BAR; PG8_SCHED;
            PG8_STAGE(PG8_SB(1, 1), b3 + hstep, voffB);
            PG8_WAIT_V(6); PG8_BAR; PG8_MMA(1, 1, At, B1); PG8_BAR;
            }
        }
        if constexpr (ALIGN_EPI) { if (wr == 0) PG8_BAR; }
        if constexpr (!Epi::AFTER_DRAIN) { E(acc, cur, wr, wc, fr, fq); S.done(cur); }
        if (!has_next) break;
#pragma unroll
        for (int a = 0; a < 2; ++a)
#pragma unroll
            for (int b = 0; b < 2; ++b)
#pragma unroll
                for (int m = 0; m < 4; ++m)
#pragma unroll
                    for (int n = 0; n < 2; ++n) acc[a][b][m][n] = (f32x4){0.f, 0.f, 0.f, 0.f};
        cur = nxt; cA = nA; cB = nB; ++ui;
        if constexpr (ALIGN_EPI) { if (wr == 1) PG8_BAR; }
    }
    PG8_WAIT_V(0);
    if constexpr (!ALIGN_EPI) { if (wr == 0) PG8_BAR; }
    PG8_BAR;
    if constexpr (Epi::AFTER_DRAIN) { E.fused(acc, cur, wr, wc, fr, fq, lds, wid, lane); S.done(cur); }
#undef PG8_SA
#undef PG8_SB
#undef PG8_STAGE
#undef PG8_LDA
#undef PG8_LDB
#undef PG8_MMA
#undef PG8_WAIT_V
#undef PG8_WAIT_L
#undef PG8_BAR
#undef PG8_SCHED
}
}

constexpr int DM = 1024, NB = 4, SEQ = 4096, NTOK = NB * SEQ;
constexpr int HD = 64, NH = 8, NKV = 2, QW = NH * HD  , GRIDW = 64;
constexpr int INW = 3584;
constexpr int PH = 8, NKEYS = 128, TOPK = 16, NEXP = NKEYS * NKEYS, SCW = PH * 2 * NKEYS  ;
constexpr float EPS = 1e-6f;
constexpr float LOG2E = 1.4426950408889634f;
constexpr float QSCALE = 0.125f * LOG2E;

typedef unsigned u32x2_t __attribute__((ext_vector_type(2)));
typedef float f32x2_t __attribute__((ext_vector_type(2)));
typedef __bf16 bf16x2_t __attribute__((ext_vector_type(2)));
__device__ __forceinline__ unsigned pkbf(float lo, float hi) { f32x2_t v = {lo, hi}; bf16x2_t b = __builtin_convertvector(v, bf16x2_t); return __builtin_bit_cast(unsigned, b); }
__device__ __forceinline__ float bflo(unsigned w) { return __builtin_bit_cast(float, w << 16); }
__device__ __forceinline__ float bfhi(unsigned w) { return __builtin_bit_cast(float, w & 0xffff0000u); }

__device__ __forceinline__ size_t kimg_off(int b, int kvh, int s, int dim) { return ((size_t)((b * NKV + kvh) * (SEQ / 64) + (s >> 6)) << 12) + (dim >> 3) * 512 + (s & 63) * 8 + (dim & 7); }
__device__ __forceinline__ size_t vimg_off(int b, int kvh, int s, int dim) { return ((size_t)((b * NKV + kvh) * (SEQ / 64) + (s >> 6)) << 12) + (dim >> 5) * 2048 + (s & 63) * 32 + (dim & 31); }

namespace pg8 {
struct EpiIn {
    static constexpr bool PERM = false, AFTER_DRAIN = false;
    bf16_t *Qa, *Ka, *Va, *Qb, *Kb, *Vb, *Ga, *Gb;
    const float *qg, *kg, *bgate, *rope;
    __device__ __forceinline__ void operator()(const f32x4 (&acc)[2][2][4][2], const Unit& u, int wr, int wc, int fr, int fq) const {
        const int pn = u.pn;
        if (pn >= 6) {
            const bool isA = pn < 10; bf16_t* G = isA ? Ga : Gb; const int ct = (isA ? pn - 6 : pn - 10) * BM; const float* bb = bgate + (isA ? 0 : DM);
            f32x4 bv[2][2];
#pragma unroll
            for (int bj = 0; bj < 2; ++bj)
#pragma unroll
                for (int n = 0; n < 2; ++n) bv[bj][n] = *(const f32x4*)(bb + ct + bj * HALF + wc * 32 + n * 16 + 4 * fq);
#pragma unroll
            for (int ai = 0; ai < 2; ++ai)
#pragma unroll
                for (int m = 0; m < 4; ++m) { const int row = u.pm * BM + ai * HALF + wr * 64 + m * 16 + fr; bf16_t* rp = G + (size_t)row * DM + ct + wc * 32 + 4 * fq;
#pragma unroll
                    for (int bj = 0; bj < 2; ++bj)
#pragma unroll
                        for (int n = 0; n < 2; ++n) { const f32x4 z = acc[ai][bj][m][n] + bv[bj][n]; f32x4 g;
#pragma unroll
                            for (int j = 0; j < 4; ++j) g[j] = __builtin_amdgcn_rcpf(1.0f + __builtin_amdgcn_exp2f(-LOG2E * z[j]));
                            u32x2_t w; w.x = pkbf(g[0], g[1]); w.y = pkbf(g[2], g[3]); *(u32x2_t*)(rp + bj * HALF + n * 16) = w; } }
            return;
        }
        const bool brA = pn < 3; const int pl = brA ? pn : pn - 3;
        const bool isq = pl < 2, isk = (!isq) && wc < 2;
        const bool normrope = brA && (isq || isk);
        f32x4 gv[2][2];
        if (normrope) { const float* g = isq ? qg : kg;
#pragma unroll
            for (int bj = 0; bj < 2; ++bj)
#pragma unroll
                for (int n = 0; n < 2; ++n) gv[bj][n] = *(const f32x4*)(g + 32 * bj + 16 * n + 4 * fq); }
        const float osc = isq ? QSCALE : 1.0f;
#pragma unroll
        for (int ai = 0; ai < 2; ++ai)
#pragma unroll
            for (int m = 0; m < 4; ++m) {
                const int row = u.pm * BM + ai * HALF + wr * 64 + m * 16 + fr; const int b = row >> 12, s = row & (SEQ - 1);
                f32x4 v[2][2];
#pragma unroll
                for (int bj = 0; bj < 2; ++bj)
#pragma unroll
                    for (int n = 0; n < 2; ++n) v[bj][n] = acc[ai][bj][m][n];
                if (normrope) {
                    float ss = 0.f;
#pragma unroll
                    for (int bj = 0; bj < 2; ++bj)
#pragma unroll
                        for (int n = 0; n < 2; ++n) ss += (v[bj][n][0] * v[bj][n][0] + v[bj][n][1] * v[bj][n][1]) + (v[bj][n][2] * v[bj][n][2] + v[bj][n][3] * v[bj][n][3]);
                    ss += __shfl_xor(ss, 16); ss += __shfl_xor(ss, 32);
                    const float rstd = 1.0f / sqrtf(ss * (1.0f / 64.0f) + EPS);
#pragma unroll
                    for (int bj = 0; bj < 2; ++bj) {
                        const int pos = bj == 0 ? (s >> 6) : (s & (GRIDW - 1));
                        const f32x4 cs0 = *(const f32x4*)(rope + (pos * 16 + 4 * fq) * 2), cs1 = *(const f32x4*)(rope + (pos * 16 + 4 * fq) * 2 + 4);
                        const float cc[4] = {cs0[0], cs0[2], cs1[0], cs1[2]}, sn[4] = {cs0[1], cs0[3], cs1[1], cs1[3]};
#pragma unroll
                        for (int j = 0; j < 4; ++j) { const float u1 = v[bj][0][j] * rstd * gv[bj][0][j], u2 = v[bj][1][j] * rstd * gv[bj][1][j];
                            v[bj][0][j] = u1 * cc[j] - u2 * sn[j]; v[bj][1][j] = u2 * cc[j] + u1 * sn[j]; }
                    }
                }
#pragma unroll
                for (int bj = 0; bj < 2; ++bj)
#pragma unroll
                    for (int n = 0; n < 2; ++n) {
                        const f32x4 o = v[bj][n] * osc; u32x2_t w; w.x = pkbf(o[0], o[1]); w.y = pkbf(o[2], o[3]);
                        const int dim = 32 * bj + 16 * n + 4 * fq;
                        bf16_t* dst;
                        if (isq) dst = (brA ? Qa : Qb) + (size_t)row * QW + (pl * 4 + wc) * HD + dim;
                        else if (wc < 2) dst = (brA ? Ka : Kb) + kimg_off(b, wc, s, dim);
                        else dst = (brA ? Va : Vb) + vimg_off(b, wc - 2, s, dim);
                        *(u32x2_t*)dst = w;
                    }
            }
    }
};

struct EpiMixA {
    static constexpr bool PERM = false, AFTER_DRAIN = false;
    const bf16_t* G; bf16_t* OUT;
    __device__ __forceinline__ void operator()(const f32x4 (&acc)[2][2][4][2], const Unit& u, int wr, int wc, int fr, int fq) const {
#pragma unroll
        for (int ai = 0; ai < 2; ++ai)
#pragma unroll
            for (int m = 0; m < 4; ++m) { const int row = u.pm * BM + ai * HALF + wr * 64 + m * 16 + fr; const size_t off = (size_t)row * DM + u.pn * BM + wc * 32 + 4 * fq;
#pragma unroll
                for (int bj = 0; bj < 2; ++bj)
#pragma unroll
                    for (int n = 0; n < 2; ++n) { const u32x2_t g = *(const u32x2_t*)(G + off + bj * HALF + n * 16); const f32x4 a = acc[ai][bj][m][n];
                        u32x2_t w; w.x = pkbf(a[0] * bflo(g.x), a[1] * bfhi(g.x)); w.y = pkbf(a[2] * bflo(g.y), a[3] * bfhi(g.y)); *(u32x2_t*)(OUT + off + bj * HALF + n * 16) = w; } }
    }
};
struct EpiMixB {
    static constexpr bool PERM = false, AFTER_DRAIN = false;
    const bf16_t* M1; const bf16_t* G; bf16_t* OUT;
    __device__ __forceinline__ void operator()(const f32x4 (&acc)[2][2][4][2], const Unit& u, int wr, int wc, int fr, int fq) const {
#pragma unroll
        for (int ai = 0; ai < 2; ++ai)
#pragma unroll
            for (int m = 0; m < 4; ++m) { const int row = u.pm * BM + ai * HALF + wr * 64 + m * 16 + fr; const size_t off = (size_t)row * DM + u.pn * BM + wc * 32 + 4 * fq;
#pragma unroll
                for (int bj = 0; bj < 2; ++bj)
#pragma unroll
                    for (int n = 0; n < 2; ++n) { u32x2_t* p = (u32x2_t*)(OUT + off + bj * HALF + n * 16); const u32x2_t g = *(const u32x2_t*)(G + off + bj * HALF + n * 16); const u32x2_t m1 = *(const u32x2_t*)(M1 + off + bj * HALF + n * 16); const f32x4 a = acc[ai][bj][m][n];
                        u32x2_t w; w.x = pkbf(bflo(m1.x) + a[0] * bflo(g.x), bfhi(m1.x) + a[1] * bfhi(g.x)); w.y = pkbf(bflo(m1.y) + a[2] * bflo(g.y), bfhi(m1.y) + a[3] * bfhi(g.y)); *p = w; } }
    }
};
struct EpiOut {
    static constexpr bool PERM = false, AFTER_DRAIN = false;
    const float* X; bf16_t* HB; float* ssq;
    __device__ __forceinline__ void operator()(const f32x4 (&acc)[2][2][4][2], const Unit& u, int wr, int wc, int fr, int fq) const {
#pragma unroll
        for (int ai = 0; ai < 2; ++ai)
#pragma unroll
            for (int m = 0; m < 4; ++m) { const int row = u.pm * BM + ai * HALF + wr * 64 + m * 16 + fr; const size_t off = (size_t)row * DM + u.pn * BM + wc * 32 + 4 * fq; float ss = 0.f;
#pragma unroll
                for (int bj = 0; bj < 2; ++bj)
#pragma unroll
                    for (int n = 0; n < 2; ++n) { const size_t o2 = off + bj * HALF + n * 16; const f32x4 h = *(const f32x4*)(X + o2) + acc[ai][bj][m][n];
                        u32x2_t w; w.x = pkbf(h[0], h[1]); w.y = pkbf(h[2], h[3]); *(u32x2_t*)(HB + o2) = w;
                        ss += (h[0] * h[0] + h[1] * h[1]) + (h[2] * h[2] + h[3] * h[3]); }
                ss += __shfl_xor(ss, 16); ss += __shfl_xor(ss, 32);
                if (fq == 0) ssq[(size_t)row * 16 + u.pn * 4 + wc] = ss; }
    }
};
struct EpiScore {
    static constexpr bool PERM = false, AFTER_DRAIN = false;
    const float* ssq; float* SC;
    __device__ __forceinline__ void operator()(const f32x4 (&acc)[2][2][4][2], const Unit& u, int wr, int wc, int fr, int fq) const {
#pragma unroll
        for (int ai = 0; ai < 2; ++ai)
#pragma unroll
            for (int m = 0; m < 4; ++m) { const int row = u.pm * BM + ai * HALF + wr * 64 + m * 16 + fr;
                const f32x4* sp = (const f32x4*)(ssq + (size_t)row * 16); const f32x4 s0 = sp[0], s1 = sp[1], s2 = sp[2], s3 = sp[3];
                const float tot = (((s0[0] + s0[1]) + (s0[2] + s0[3])) + ((s1[0] + s1[1]) + (s1[2] + s1[3]))) + (((s2[0] + s2[1]) + (s2[2] + s2[3])) + ((s3[0] + s3[1]) + (s3[2] + s3[3])));
                const float rstd = 1.0f / sqrtf(tot * (1.0f / DM) + EPS);
                float* rp = SC + (size_t)row * SCW + u.pn * BM + wc * 32 + 4 * fq;
#pragma unroll
                for (int bj = 0; bj < 2; ++bj)
#pragma unroll
                    for (int n = 0; n < 2; ++n) *(f32x4*)(rp + bj * HALF + n * 16) = acc[ai][bj][m][n] * rstd; }
    }
};
}

#define LAS __attribute__((address_space(3)))
namespace attn {
typedef unsigned short bf16_t;
typedef short bf16x8 __attribute__((ext_vector_type(8)));
typedef short s16x4 __attribute__((ext_vector_type(4)));
typedef float f32x16 __attribute__((ext_vector_type(16)));
typedef unsigned u32x4 __attribute__((ext_vector_type(4)));
constexpr int LDS_K = 0, LDS_V = 32768;
constexpr int LDS_BIAS = 65536;
constexpr int LDS_BYTES = 65536 + 3072;
constexpr float THR = 8.0f;
__device__ __forceinline__ int crow(int r, int hi) { return (r & 3) + 8 * (r >> 2) + 4 * hi; }
__device__ __forceinline__ s16x4 vtr(const LAS char* p) { return __builtin_bit_cast(s16x4, __builtin_amdgcn_ds_read_tr16_b64_v4i16((LAS s16x4*)p)); }
__device__ __forceinline__ float xhalf_max(float v) { auto rr = __builtin_amdgcn_permlane32_swap(__float_as_uint(v), __float_as_uint(v), false, false); return fmaxf(__uint_as_float(rr[0]), __uint_as_float(rr[1])); }
__device__ __forceinline__ float xhalf_sum(float v) { auto rr = __builtin_amdgcn_permlane32_swap(__float_as_uint(v), __float_as_uint(v), false, false); return __uint_as_float(rr[0]) + __uint_as_float(rr[1]); }
#ifndef ATTN_PRIO
#define ATTN_PRIO 1
#endif
__device__ __forceinline__ float max3f(float a, float b, float c) { float r; asm("v_max3_f32 %0, %1, %2, %3" : "=v"(r) : "v"(a), "v"(b), "v"(c)); return r; }
__device__ __forceinline__ float max2f(float a, float b) { float r; asm("v_max_f32_e32 %0, %1, %2" : "=v"(r) : "v"(a), "v"(b)); return r; }
#define ATT_BAR() do { asm volatile("s_waitcnt lgkmcnt(0)" ::: "memory"); __builtin_amdgcn_s_barrier(); asm volatile("" ::: "memory"); } while (0)

template <bool WIN>
__device__ __forceinline__ void attn_unit(LAS char* lds, const bf16_t* Q, const bf16_t* Kimg, const bf16_t* Vimg, bf16_t* O, int b, int h, int qblk, const float* bias_h  , float sink_l2) {
    const int tid = threadIdx.x, lane = tid & 63, r32 = lane & 31, hi = lane >> 5; const int wid = __builtin_amdgcn_readfirstlane(tid >> 6); const int grp = wid >> 2;
    const int q0 = qblk * 256, qw0 = q0 + 32 * wid, qrow = qw0 + r32; const size_t grow = (size_t)b * SEQ + qrow;
    const int kvh = h >> 2;
    int t_lo = 0, t_hi = SEQ / 64 - 1;
    if (WIN) { t_lo = q0 / 64 - 2; if (t_lo < 0) t_lo = 0; t_hi = q0 / 64 + 5; if (t_hi > SEQ / 64 - 1) t_hi = SEQ / 64 - 1; }
    const int n = t_hi - t_lo + 1;
    const bf16_t* Kb = Kimg + ((size_t)((b * NKV + kvh) * (SEQ / 64) + t_lo) << 12) + tid * 8;
    const bf16_t* Vb = Vimg + ((size_t)((b * NKV + kvh) * (SEQ / 64) + t_lo) << 12) + tid * 8;
    bf16x8 qr[4];
#pragma unroll
    for (int d0 = 0; d0 < 4; ++d0) qr[d0] = *(const bf16x8*)(Q + grow * QW + h * HD + d0 * 16 + hi * 8);
    LAS float* biasl = (LAS float*)(lds + LDS_BIAS);
    if (WIN) { for (int j = tid; j < 768; j += 512) biasl[j] = (j >= 256 && j <= 512) ? bias_h[j - 256] : -1e30f; }
    u32x4 kreg, vreg;
    { const u32x4 k0 = *(const u32x4*)Kb, v0 = *(const u32x4*)Vb, k1 = *(const u32x4*)(Kb + 4096), v1 = *(const u32x4*)(Vb + 4096);
      kreg = *(const u32x4*)(Kb + 2 * 4096); vreg = *(const u32x4*)(Vb + 2 * 4096);
      *(LAS u32x4*)(lds + LDS_K + tid * 16) = k0; *(LAS u32x4*)(lds + LDS_V + tid * 16) = v0;
      *(LAS u32x4*)(lds + LDS_K + 8192 + tid * 16) = k1; *(LAS u32x4*)(lds + LDS_V + 8192 + tid * 16) = v1; }
    ATT_BAR();
    if (grp) ATT_BAR();
    f32x16 o0 = {}, o1 = {}, p0, p1, negm;
    float mref = WIN ? sink_l2 : 0.0f, lsum = (WIN && hi == 0) ? 1.0f : 0.0f;
#pragma unroll
    for (int r = 0; r < 16; ++r) negm[r] = -mref;
    const int vlane = ((lane >> 4) & 1) * 32 + (lane & 3) * 8 + (4 * hi + ((lane & 15) >> 2)) * 64;
    const LAS char* kfr = lds + LDS_K + hi * 1024 + r32 * 16;
    u32x4 pk[4]; bf16x8 kf[8], vf[8];
#define ATT_LDK(sl) do { const LAS char* kp_ = kfr + (sl) * 8192; \
        _Pragma("unroll") for (int d0 = 0; d0 < 4; ++d0) { kf[2 * d0] = *(const LAS bf16x8*)(kp_ + d0 * 2048); kf[2 * d0 + 1] = *(const LAS bf16x8*)(kp_ + d0 * 2048 + 512); } } while (0)
#define ATT_LDV(sl) do { const LAS char* vp_ = lds + LDS_V + (sl) * 8192 + vlane; \
        _Pragma("unroll") for (int ks = 0; ks < 4; ++ks) { \
            const s16x4 l0 = vtr(vp_ + ks * 1024), h0 = vtr(vp_ + ks * 1024 + 512), l1 = vtr(vp_ + 4096 + ks * 1024), h1 = vtr(vp_ + 4096 + ks * 1024 + 512); \
            vf[2 * ks] = (bf16x8){l0[0], l0[1], l0[2], l0[3], h0[0], h0[1], h0[2], h0[3]}; vf[2 * ks + 1] = (bf16x8){l1[0], l1[1], l1[2], l1[3], h1[0], h1[1], h1[2], h1[3]}; } } while (0)
#define ATT_QK() do { \
        p0 = __builtin_amdgcn_mfma_f32_32x32x16_bf16(kf[0], qr[0], negm, 0, 0, 0); p1 = __builtin_amdgcn_mfma_f32_32x32x16_bf16(kf[1], qr[0], negm, 0, 0, 0); \
        _Pragma("unroll") for (int d0 = 1; d0 < 4; ++d0) { p0 = __builtin_amdgcn_mfma_f32_32x32x16_bf16(kf[2 * d0], qr[d0], p0, 0, 0, 0); p1 = __builtin_amdgcn_mfma_f32_32x32x16_bf16(kf[2 * d0 + 1], qr[d0], p1, 0, 0, 0); } } while (0)
#define ATT_PV() do { \
        _Pragma("unroll") for (int ks = 0; ks < 4; ++ks) { const bf16x8 pf = __builtin_bit_cast(bf16x8, pk[ks]); \
            o0 = __builtin_amdgcn_mfma_f32_32x32x16_bf16(vf[2 * ks], pf, o0, 0, 0, 0); o1 = __builtin_amdgcn_mfma_f32_32x32x16_bf16(vf[2 * ks + 1], pf, o1, 0, 0, 0); } } while (0)
    int ia = 0, ib = n - 1;
    if (WIN) { int lo_t = (qw0 - 128) >> 6; if (lo_t < t_lo) lo_t = t_lo; int hi_t = (qw0 + 31 + 128) >> 6; if (hi_t > t_hi) hi_t = t_hi; ia = lo_t - t_lo; ib = hi_t - t_lo; }
#define ATT_STAGE(i) do { if ((i) + 2 < n) { const int sl_ = ((i) + 2) & 3; *(LAS u32x4*)(lds + LDS_K + sl_ * 8192 + tid * 16) = kreg; *(LAS u32x4*)(lds + LDS_V + sl_ * 8192 + tid * 16) = vreg; \
            if ((i) + 3 < n) { kreg = *(const u32x4*)(Kb + (size_t)((i) + 3) * 4096); vreg = *(const u32x4*)(Vb + (size_t)((i) + 3) * 4096); } } } while (0)
    bool first = !WIN;
    int i = 0;
    if (ia == 0) { ATT_LDK(0); asm volatile("s_waitcnt lgkmcnt(0)" ::: "memory"); ATT_QK(); }
    ATT_BAR();
    for (; i < ia; ++i) {
        ATT_STAGE(i);
        ATT_BAR();
        if (i + 1 == ia) { ATT_LDK((i + 1) & 3); asm volatile("s_waitcnt lgkmcnt(0)" ::: "memory"); ATT_QK(); }
        ATT_BAR();
    }
    for (; i <= ib; ++i) {
        ATT_LDV(i & 3);
        __builtin_amdgcn_sched_barrier(0);
        asm volatile("s_nop 15\n\ts_nop 7" : "+v"(p0), "+v"(p1));
        if (WIN) {
            const LAS float* bp = biasl + (64 * (t_lo + i) - qrow + 4 * hi + 384);
#pragma unroll
            for (int r = 0; r < 16; ++r) { p0[r] += bp[(r & 3) + 8 * (r >> 2)]; p1[r] += bp[32 + (r & 3) + 8 * (r >> 2)]; }
        }
        float ra = max3f(p0[0], p0[1], p1[0]), rb = max3f(p0[2], p0[3], p1[1]); ra = max3f(ra, p1[2], p1[3]);
#pragma unroll
        for (int r = 4; r < 16; r += 4) { ra = max3f(ra, p0[r], p0[r + 1]); rb = max3f(rb, p0[r + 2], p0[r + 3]); ra = max3f(ra, p1[r], p1[r + 1]); rb = max3f(rb, p1[r + 2], p1[r + 3]); }
        float rm = xhalf_max(max2f(ra, rb));
        if (first || __builtin_amdgcn_ballot_w64(rm > THR) != 0ull) {
            const float delta = first ? rm : fmaxf(rm, 0.0f); const float f = first ? 1.0f : __builtin_amdgcn_exp2f(-delta);
            mref += delta; lsum *= f;
#pragma unroll
            for (int r = 0; r < 16; ++r) { p0[r] -= delta; p1[r] -= delta; o0[r] *= f; o1[r] *= f; negm[r] = -mref; }
            first = false;
        }
        float ps = 0.f;
#pragma unroll
        for (int r = 0; r < 16; ++r) { p0[r] = __builtin_amdgcn_exp2f(p0[r]); p1[r] = __builtin_amdgcn_exp2f(p1[r]); ps += p0[r] + p1[r]; }
        lsum += ps;
#pragma unroll
        for (int q = 0; q < 4; ++q) { pk[0][q] = pkbf(p0[2 * q], p0[2 * q + 1]); pk[1][q] = pkbf(p0[8 + 2 * q], p0[9 + 2 * q]); pk[2][q] = pkbf(p1[2 * q], p1[2 * q + 1]); pk[3][q] = pkbf(p1[8 + 2 * q], p1[9 + 2 * q]); }
        ATT_STAGE(i);
        asm volatile("s_waitcnt lgkmcnt(0)" : "+v"(vf[0]), "+v"(vf[1]), "+v"(vf[2]), "+v"(vf[3]), "+v"(vf[4]), "+v"(vf[5]), "+v"(vf[6]), "+v"(vf[7]) : : "memory");
        ATT_BAR();
        __builtin_amdgcn_s_setprio(ATTN_PRIO);
        if (i < ib) ATT_LDK((i + 1) & 3);
        ATT_PV();
        if (i < ib) ATT_QK();
        __builtin_amdgcn_s_setprio(0);
        ATT_BAR();
    }
    for (; i < n; ++i) { ATT_STAGE(i); ATT_BAR(); ATT_BAR(); }
#undef ATT_STAGE
#undef ATT_QK
#undef ATT_PV
#undef ATT_LDK
#undef ATT_LDV
    const float inv = 1.0f / xhalf_sum(lsum);
    bf16_t* Orow = O + grow * QW + h * HD + 4 * hi;
#pragma unroll
    for (int g = 0; g < 4; ++g) {
        u32x2_t w0, w1;
        w0.x = pkbf(o0[4 * g] * inv, o0[4 * g + 1] * inv); w0.y = pkbf(o0[4 * g + 2] * inv, o0[4 * g + 3] * inv);
        w1.x = pkbf(o1[4 * g] * inv, o1[4 * g + 1] * inv); w1.y = pkbf(o1[4 * g + 2] * inv, o1[4 * g + 3] * inv);
        *(u32x2_t*)(Orow + 8 * g) = w0; *(u32x2_t*)(Orow + 32 + 8 * g) = w1;
    }
    if (!grp) ATT_BAR();
}
}

namespace peer {
typedef unsigned u32x4 __attribute__((ext_vector_type(4)));
typedef float f32x4 __attribute__((ext_vector_type(4)));
constexpr int WAVE_LDS = 2048;

template <int CTRL> __device__ __forceinline__ int dppi(int x) { return __builtin_amdgcn_mov_dpp(x, CTRL, 0xf, 0xf, true); }
template <int CTRL> __device__ __forceinline__ float dppf(float x) { return __builtin_bit_cast(float, __builtin_amdgcn_mov_dpp(__builtin_bit_cast(int, x), CTRL, 0xf, 0xf, true)); }
constexpr int XOR1 = 0xB1, XOR2 = 0x4E, XOR7 = 0x141, XOR8 = 0x128;
__device__ __forceinline__ float wave_sum(float x) {
    x += dppf<XOR1>(x); x += dppf<XOR2>(x); x += dppf<XOR7>(x); x += dppf<XOR8>(x);
    auto s = __builtin_amdgcn_permlane16_swap(__float_as_uint(x), __float_as_uint(x), false, false); x = __uint_as_float(s[0]) + __uint_as_float(s[1]);
    auto t = __builtin_amdgcn_permlane32_swap(__float_as_uint(x), __float_as_uint(x), false, false); return __uint_as_float(t[0]) + __uint_as_float(t[1]);
}
__device__ __forceinline__ float dot2bf(unsigned a, unsigned b, float c) { return __builtin_amdgcn_fdot2_f32_bf16(__builtin_bit_cast(bf16x2_t, a), __builtin_bit_cast(bf16x2_t, b), c, false); }
__device__ __forceinline__ int okey(float f, int lowbits, int payload) { int b = __float_as_int(f); b ^= (b >> 31) & 0x7fffffff; return (b & ~((1 << lowbits) - 1)) | payload; }
__device__ __forceinline__ float kval(int k, int lowbits) { int b = (k & ~((1 << lowbits) - 1)) | (1 << (lowbits - 1)); b ^= (b >> 31) & 0x7fffffff; return __int_as_float(b); }
#define CE_DESC(a, b) do { const int _x = (a), _y = (b); (a) = _x > _y ? _x : _y; (b) = _x > _y ? _y : _x; } while (0)
template <int N> __device__ __forceinline__ void bitonic_sort_desc(int (&a)[N]) {
#pragma unroll
    for (int k = 2; k <= N; k <<= 1)
#pragma unroll
        for (int j = k >> 1; j > 0; j >>= 1)
#pragma unroll
            for (int i = 0; i < N; ++i) { const int l = i ^ j; if (l > i) { if ((i & k) == 0) CE_DESC(a[i], a[l]); else CE_DESC(a[l], a[i]); } }
}
template <int N> __device__ __forceinline__ void bitonic_merge_desc(int (&a)[N]) {
#pragma unroll
    for (int j = N >> 1; j > 0; j >>= 1)
#pragma unroll
        for (int i = 0; i < N; ++i) { const int l = i ^ j; if (l > i) CE_DESC(a[i], a[l]); }
}
__device__ __forceinline__ unsigned long long cand_table(int q8) {
    unsigned long long r = 0xFFFFFFFFFFFFFFFFull; int n = 0;
#pragma unroll
    for (int i = 0; i < 16; ++i)
#pragma unroll
        for (int j = 0; j < 16; ++j) if ((i + 1) * (j + 1) <= 16) { if (n / 7 == q8) { const int s = n % 7; r = (r & ~(0xFFull << (8 * s))) | ((unsigned long long)(i * 16 + j) << (8 * s)); } ++n; }
    return r;
}

__device__ __forceinline__ void route_token(LAS char* wl, int lane, int t, unsigned long long ct, const float* SC, const unsigned short* H  , const float* gffn, unsigned short* E, float* G, unsigned short* XN2) {
    LAS int* skeys = (LAS int*)wl;
    {
        const int c = lane >> 2, qq = lane & 3; const f32x4* sp = (const f32x4*)(SC + (size_t)t * SCW + c * NKEYS + qq * 32);
        int a[16], bb[16];
#pragma unroll
        for (int i = 0; i < 4; ++i) { const f32x4 v = sp[i];
#pragma unroll
            for (int j = 0; j < 4; ++j) a[4 * i + j] = okey(v[j], 7, 127 - (qq * 32 + 4 * i + j)); }
#pragma unroll
        for (int i = 0; i < 4; ++i) { const f32x4 v = sp[4 + i];
#pragma unroll
            for (int j = 0; j < 4; ++j) bb[4 * i + j] = okey(v[j], 7, 127 - (qq * 32 + 16 + 4 * i + j)); }
        bitonic_sort_desc<16>(a); bitonic_sort_desc<16>(bb);
#pragma unroll
        for (int i = 0; i < 16; ++i) a[i] = a[i] > bb[15 - i] ? a[i] : bb[15 - i];
        bitonic_merge_desc<16>(a);
#pragma unroll
        for (int i = 0; i < 16; ++i) bb[i] = dppi<XOR1>(a[15 - i]);
#pragma unroll
        for (int i = 0; i < 16; ++i) a[i] = a[i] > bb[i] ? a[i] : bb[i];
        bitonic_merge_desc<16>(a);
#pragma unroll
        for (int i = 0; i < 16; ++i) bb[i] = dppi<XOR2>(a[15 - i]);
#pragma unroll
        for (int i = 0; i < 16; ++i) a[i] = a[i] > bb[i] ? a[i] : bb[i];
        bitonic_merge_desc<16>(a);
        if (qq == 0) {
#pragma unroll
            for (int i = 0; i < 4; ++i) *(LAS u32x4*)(skeys + c * 16 + 4 * i) = (u32x4){(unsigned)a[4 * i], (unsigned)a[4 * i + 1], (unsigned)a[4 * i + 2], (unsigned)a[4 * i + 3]};
        }
    }
    asm volatile("s_waitcnt lgkmcnt(0)" ::: "memory");
    {
        const int hh = lane >> 3, q8 = lane & 7;
        int a[16];
#pragma unroll
        for (int s = 0; s < 8; ++s) {
            const int code = s < 7 ? (int)((ct >> (8 * s)) & 0xFF) : 0xFF;
            const int ci = code == 0xFF ? 0 : code;
            const int ka = skeys[(2 * hh) * 16 + (ci >> 4)], kb = skeys[(2 * hh + 1) * 16 + (ci & 15)];
            const float sum = kval(ka, 7) + kval(kb, 7);
            a[s] = code == 0xFF ? (int)0x80000000 : okey(sum, 8, 255 - code);
        }
        {
            int c8[8];
#pragma unroll
            for (int i = 0; i < 8; ++i) c8[i] = a[i];
            bitonic_sort_desc<8>(c8);
#pragma unroll
            for (int i = 0; i < 8; ++i) a[i] = c8[i];
        }
#pragma unroll
        for (int i = 0; i < 8; ++i) a[8 + i] = dppi<XOR1>(a[i]);
        { int tmp[8];
#pragma unroll
          for (int i = 0; i < 8; ++i) tmp[i] = a[8 + i];
#pragma unroll
          for (int i = 0; i < 8; ++i) a[8 + i] = tmp[7 - i]; }
        bitonic_merge_desc<16>(a);
        int bb[16];
#pragma unroll
        for (int i = 0; i < 16; ++i) bb[i] = dppi<XOR2>(a[15 - i]);
#pragma unroll
        for (int i = 0; i < 16; ++i) a[i] = a[i] > bb[i] ? a[i] : bb[i];
        bitonic_merge_desc<16>(a);
#pragma unroll
        for (int i = 0; i < 16; ++i) bb[i] = dppi<XOR7>(a[15 - i]);
#pragma unroll
        for (int i = 0; i < 16; ++i) a[i] = a[i] > bb[i] ? a[i] : bb[i];
        bitonic_merge_desc<16>(a);
        int k0 = a[0], k1 = a[1];
#pragma unroll
        for (int i = 1; i < 8; ++i) { k0 = q8 == i ? a[2 * i] : k0; k1 = q8 == i ? a[2 * i + 1] : k1; }
        const float mx = kval(a[0], 8);
        const int c0 = 255 - (k0 & 255), c1 = 255 - (k1 & 255);
        const int ka0 = skeys[(2 * hh) * 16 + (c0 >> 4)], kb0 = skeys[(2 * hh + 1) * 16 + (c0 & 15)];
        const int ka1 = skeys[(2 * hh) * 16 + (c1 >> 4)], kb1 = skeys[(2 * hh + 1) * 16 + (c1 & 15)];
        const float s0 = kval(ka0, 7) + kval(kb0, 7), s1 = kval(ka1, 7) + kval(kb1, 7);
        const float e0 = __expf(s0 - mx), e1 = __expf(s1 - mx);
        float z = e0 + e1; z += dppf<XOR1>(z); z += dppf<XOR2>(z); z += dppf<XOR7>(z);
        const float rz = 1.0f / z;
        const unsigned e0i = (unsigned)((127 - (ka0 & 127)) * NKEYS + (127 - (kb0 & 127))), e1i = (unsigned)((127 - (ka1 & 127)) * NKEYS + (127 - (kb1 & 127)));
        *(unsigned*)(E + (size_t)t * 128 + hh * 16 + 2 * q8) = e0i | (e1i << 16);
        *(f32x2_t*)(G + (size_t)t * 128 + hh * 16 + 2 * q8) = (f32x2_t){e0 * rz, e1 * rz};
    }
    {
        const u32x2_t* hr = (const u32x2_t*)(H + (size_t)t * DM) + lane; f32x4 v[4]; float ss = 0.f;
#pragma unroll
        for (int j = 0; j < 4; ++j) { const u32x2_t hw = hr[64 * j]; v[j] = (f32x4){bflo(hw.x), bfhi(hw.x), bflo(hw.y), bfhi(hw.y)}; ss += (v[j][0] * v[j][0] + v[j][1] * v[j][1]) + (v[j][2] * v[j][2] + v[j][3] * v[j][3]); }
        const float rstd = 1.0f / sqrtf(wave_sum(ss) * (1.0f / DM) + EPS);
        unsigned long long* o8 = (unsigned long long*)(XN2 + (size_t)t * DM) + lane;
#pragma unroll
        for (int j = 0; j < 4; ++j) { const f32x4 g = *((const f32x4*)gffn + lane + 64 * j);
            o8[64 * j] = (unsigned long long)pkbf(v[j][0] * rstd * g[0], v[j][1] * rstd * g[1]) | ((unsigned long long)pkbf(v[j][2] * rstd * g[2], v[j][3] * rstd * g[3]) << 32); }
    }
    asm volatile("s_waitcnt lgkmcnt(0)" ::: "memory");
}

constexpr size_t SLICE_BYTES = (size_t)NEXP * 128;
__device__ __forceinline__ unsigned getw(const u32x4& v, int i) { return i == 0 ? v.x : i == 1 ? v.y : i == 2 ? v.z : v.w; }
__device__ __forceinline__ float wave_max(float x) {
    x = fmaxf(x, dppf<XOR1>(x)); x = fmaxf(x, dppf<XOR2>(x)); x = fmaxf(x, dppf<XOR7>(x)); x = fmaxf(x, dppf<XOR8>(x));
    auto s = __builtin_amdgcn_permlane16_swap(__float_as_uint(x), __float_as_uint(x), false, false); x = fmaxf(__uint_as_float(s[0]), __uint_as_float(s[1]));
    auto t = __builtin_amdgcn_permlane32_swap(__float_as_uint(x), __float_as_uint(x), false, false); return fmaxf(__uint_as_float(t[0]), __uint_as_float(t[1]));
}
__device__ __forceinline__ void table_row_fp8(const float* src, unsigned char* T8, float* INV, int e, int lane) {
    const f32x4* p = (const f32x4*)(src + (size_t)e * DM + 16 * lane); const f32x4 a = p[0], b = p[1], c = p[2], d = p[3];
    float mx = fmaxf(fmaxf(fmaxf(fabsf(a[0]), fabsf(a[1])), fmaxf(fabsf(a[2]), fabsf(a[3]))), fmaxf(fmaxf(fabsf(b[0]), fabsf(b[1])), fmaxf(fabsf(b[2]), fabsf(b[3]))));
    mx = fmaxf(mx, fmaxf(fmaxf(fmaxf(fabsf(c[0]), fabsf(c[1])), fmaxf(fabsf(c[2]), fabsf(c[3]))), fmaxf(fmaxf(fabsf(d[0]), fabsf(d[1])), fmaxf(fabsf(d[2]), fabsf(d[3])))));
    mx = wave_max(mx);
    const float sc = mx > 0.f ? 448.0f / mx : 1.0f;
    u32x4 o; unsigned w;
    w = 0; w = __builtin_amdgcn_cvt_pk_fp8_f32(a[0] * sc, a[1] * sc, w, false); w = __builtin_amdgcn_cvt_pk_fp8_f32(a[2] * sc, a[3] * sc, w, true); o.x = w;
    w = 0; w = __builtin_amdgcn_cvt_pk_fp8_f32(b[0] * sc, b[1] * sc, w, false); w = __builtin_amdgcn_cvt_pk_fp8_f32(b[2] * sc, b[3] * sc, w, true); o.y = w;
    w = 0; w = __builtin_amdgcn_cvt_pk_fp8_f32(c[0] * sc, c[1] * sc, w, false); w = __builtin_amdgcn_cvt_pk_fp8_f32(c[2] * sc, c[3] * sc, w, true); o.z = w;
    w = 0; w = __builtin_amdgcn_cvt_pk_fp8_f32(d[0] * sc, d[1] * sc, w, false); w = __builtin_amdgcn_cvt_pk_fp8_f32(d[2] * sc, d[3] * sc, w, true); o.w = w;
    *(u32x4*)(T8 + (size_t)(lane >> 3) * SLICE_BYTES + (size_t)e * 128 + (lane & 7) * 16) = o;
    if (lane == 0) INV[e] = mx > 0.f ? mx * (1.0f / 448.0f) : 1.0f;
}
struct ECtx { u32x4 ea, eb; };
struct XCtx { u32x4 xa, xb; };
__device__ __forceinline__ ECtx e_ctx(int lane, int t, const unsigned short* E) { ECtx c; c.ea = *(const u32x4*)(E + (size_t)t * 128 + (lane >> 3) * 16); c.eb = *(const u32x4*)(E + (size_t)t * 128 + (lane >> 3) * 16 + 8); return c; }
__device__ __forceinline__ XCtx x_ctx(int lane, int t, int s, const unsigned short* XN2) { XCtx c; c.xa = *(const u32x4*)(XN2 + (size_t)t * DM + s * 128 + (lane & 7) * 16); c.xb = *(const u32x4*)(XN2 + (size_t)t * DM + s * 128 + (lane & 7) * 16 + 8); return c; }
__device__ __forceinline__ void g_rows(u32x4 (&row)[16], const ECtx& c, const unsigned char* T8s, int c8) {
#pragma unroll
    for (int j = 0; j < 16; ++j) { const unsigned ew = getw(j < 8 ? c.ea : c.eb, (j & 7) >> 1); const unsigned e = (j & 1) ? (ew >> 16) : (ew & 0xffffu);
        row[j] = *(const u32x4*)(T8s + (size_t)e * 128 + c8 * 16); }
}
__device__ __forceinline__ void u_compute(int lane, int t, int s, const XCtx& c, const u32x4 (&row)[16], unsigned short* PA) {
    const int rs = lane >> 3, c8 = lane & 7;
    f32x2_t xf[8];
#pragma unroll
    for (int i = 0; i < 4; ++i) { const unsigned wa = getw(c.xa, i), wb = getw(c.xb, i); xf[i] = (f32x2_t){bflo(wa), bfhi(wa)}; xf[4 + i] = (f32x2_t){bflo(wb), bfhi(wb)}; }
    float part[16];
#pragma unroll
    for (int j = 0; j < 16; ++j) {
        f32x2_t acc = {0.f, 0.f};
#pragma unroll
        for (int w = 0; w < 4; ++w) { const unsigned q = getw(row[j], w);
            acc = __builtin_elementwise_fma(__builtin_amdgcn_cvt_pk_f32_fp8(q, false), xf[2 * w], acc); acc = __builtin_elementwise_fma(__builtin_amdgcn_cvt_pk_f32_fp8(q, true), xf[2 * w + 1], acc); }
        float p = acc.x + acc.y; p += dppf<XOR1>(p); p += dppf<XOR2>(p); p += dppf<XOR7>(p); part[j] = p;
    }
    float p0 = part[0], p1 = part[1];
#pragma unroll
    for (int i = 1; i < 8; ++i) { p0 = c8 == i ? part[2 * i] : p0; p1 = c8 == i ? part[2 * i + 1] : p1; }
    *(unsigned*)(PA + ((size_t)t * 8 + s) * 128 + rs * 16 + 2 * c8) = pkbf(p0, p1);
}
#define TCL(t_) ((t_) < NTOK ? (t_) : NTOK - 1)
__device__ __forceinline__ void upass_slice(int lane, int s, int wv, int nwv, const unsigned char* U8s, const unsigned short* E, const unsigned short* XN2, unsigned short* PA) {
    const int c8 = lane & 7;
    int t = wv; if (t >= NTOK) return;
    ECtx eA = e_ctx(lane, t, E), eB = e_ctx(lane, TCL(t + nwv), E); XCtx xA = x_ctx(lane, t, s, XN2), xB;
    u32x4 rA[16], rB[16];
    g_rows(rA, eA, U8s, c8);
    for (; t < NTOK; t += 2 * nwv) {
        eA = e_ctx(lane, TCL(t + 2 * nwv), E); xB = x_ctx(lane, TCL(t + nwv), s, XN2); g_rows(rB, eB, U8s, c8);
        u_compute(lane, t, s, xA, rA, PA);
        eB = e_ctx(lane, TCL(t + 3 * nwv), E); xA = x_ctx(lane, TCL(t + 2 * nwv), s, XN2); g_rows(rA, eA, U8s, c8);
        if (t + nwv < NTOK) u_compute(lane, t + nwv, s, xB, rB, PA);
    }
}
__device__ __forceinline__ void wpass_token(int lane, int t, const unsigned short* E, const float* G, const unsigned short* PA, const float* INVU, const float* INVV, float* W) {
    float a0 = 0.f, a1 = 0.f;
#pragma unroll
    for (int s = 0; s < 8; ++s) { const unsigned w = *(const unsigned*)(PA + ((size_t)t * 8 + s) * 128 + 2 * lane); a0 += bflo(w); a1 += bfhi(w); }
    const unsigned ew = *(const unsigned*)(E + (size_t)t * 128 + 2 * lane); const unsigned e0 = ew & 0xffffu, e1 = ew >> 16;
    const f32x2_t g = *(const f32x2_t*)(G + (size_t)t * 128 + 2 * lane);
    a0 *= INVU[e0]; a1 *= INVU[e1];
    const float w0 = g.x * 0.5f * a0 * (1.0f + erff(a0 * 0.70710678118654752f)) * INVV[e0], w1 = g.y * 0.5f * a1 * (1.0f + erff(a1 * 0.70710678118654752f)) * INVV[e1];
    *(f32x2_t*)(W + (size_t)t * 128 + 2 * lane) = (f32x2_t){w0, w1};
}
struct WCtx { f32x4 w0, w1, w2, w3; };
__device__ __forceinline__ WCtx w_ctx(int lane, int t, const float* W) { const f32x4* wp = (const f32x4*)(W + (size_t)t * 128 + (lane >> 3) * 16); WCtx c; c.w0 = wp[0]; c.w1 = wp[1]; c.w2 = wp[2]; c.w3 = wp[3]; return c; }
__device__ __forceinline__ void v_compute(int lane, int t, int s, const WCtx& wc, const u32x4 (&row)[16], unsigned short* PO) {
    const int rs = lane >> 3, c8 = lane & 7;
    f32x2_t o[8];
#pragma unroll
    for (int i = 0; i < 8; ++i) o[i] = (f32x2_t){0.f, 0.f};
#pragma unroll
    for (int j = 0; j < 16; ++j) {
        const f32x4 wq = j < 4 ? wc.w0 : j < 8 ? wc.w1 : j < 12 ? wc.w2 : wc.w3; const int jj = j & 3; const float wj = jj == 0 ? wq.x : jj == 1 ? wq.y : jj == 2 ? wq.z : wq.w; const f32x2_t w2v = {wj, wj};
#pragma unroll
        for (int w = 0; w < 4; ++w) { const unsigned q = getw(row[j], w);
            o[2 * w] = __builtin_elementwise_fma(__builtin_amdgcn_cvt_pk_f32_fp8(q, false), w2v, o[2 * w]); o[2 * w + 1] = __builtin_elementwise_fma(__builtin_amdgcn_cvt_pk_f32_fp8(q, true), w2v, o[2 * w + 1]); }
    }
    float of[16];
#pragma unroll
    for (int i = 0; i < 8; ++i) { of[2 * i] = o[i].x; of[2 * i + 1] = o[i].y; }
#pragma unroll
    for (int i = 0; i < 16; ++i) { float x = of[i]; x += dppf<XOR8>(x);
        auto s1 = __builtin_amdgcn_permlane16_swap(__float_as_uint(x), __float_as_uint(x), false, false); x = __uint_as_float(s1[0]) + __uint_as_float(s1[1]);
        auto s2 = __builtin_amdgcn_permlane32_swap(__float_as_uint(x), __float_as_uint(x), false, false); of[i] = __uint_as_float(s2[0]) + __uint_as_float(s2[1]); }
    if (rs == 0) {
        unsigned short* po = PO + (size_t)t * DM + s * 128 + c8 * 16;
        *(u32x4*)po = (u32x4){pkbf(of[0], of[1]), pkbf(of[2], of[3]), pkbf(of[4], of[5]), pkbf(of[6], of[7])};
        *(u32x4*)(po + 8) = (u32x4){pkbf(of[8], of[9]), pkbf(of[10], of[11]), pkbf(of[12], of[13]), pkbf(of[14], of[15])};
    }
}
__device__ __forceinline__ void vpass_slice(int lane, int s, int wv, int nwv, const unsigned char* V8s, const unsigned short* E, const float* W, unsigned short* PO) {
    const int c8 = lane & 7;
    int t = wv; if (t >= NTOK) return;
    ECtx eA = e_ctx(lane, t, E), eB = e_ctx(lane, TCL(t + nwv), E); WCtx wA = w_ctx(lane, t, W), wB;
    u32x4 rA[16], rB[16];
    g_rows(rA, eA, V8s, c8);
    for (; t < NTOK; t += 2 * nwv) {
        eA = e_ctx(lane, TCL(t + 2 * nwv), E); wB = w_ctx(lane, TCL(t + nwv), W); g_rows(rB, eB, V8s, c8);
        v_compute(lane, t, s, wA, rA, PO);
        eB = e_ctx(lane, TCL(t + 3 * nwv), E); wA = w_ctx(lane, TCL(t + 2 * nwv), W); g_rows(rA, eA, V8s, c8);
        if (t + nwv < NTOK) v_compute(lane, t + nwv, s, wB, rB, PO);
    }
}
#undef TCL
__device__ __forceinline__ void final_token(int lane, int t, float* Y, const unsigned short* HB, const unsigned short* PO, const float* gfin) {
    f32x4* yr = (f32x4*)(Y + (size_t)t * DM) + lane; const u32x2_t* pr = (const u32x2_t*)(PO + (size_t)t * DM) + lane; const u32x2_t* hr = (const u32x2_t*)(HB + (size_t)t * DM) + lane;
    f32x4 v[4]; float ss = 0.f;
#pragma unroll
    for (int j = 0; j < 4; ++j) { const u32x2_t hw = hr[64 * j]; v[j] = (f32x4){bflo(hw.x), bfhi(hw.x), bflo(hw.y), bfhi(hw.y)}; const u32x2_t p = pr[64 * j]; v[j][0] += bflo(p.x); v[j][1] += bfhi(p.x); v[j][2] += bflo(p.y); v[j][3] += bfhi(p.y);
        ss += (v[j][0] * v[j][0] + v[j][1] * v[j][1]) + (v[j][2] * v[j][2] + v[j][3] * v[j][3]); }
    const float rstd = 1.0f / sqrtf(wave_sum(ss) * (1.0f / DM) + EPS);
#pragma unroll
    for (int j = 0; j < 4; ++j) { const f32x4 g = *((const f32x4*)gfin + lane + 64 * j); yr[64 * j] = (f32x4){v[j][0] * rstd * g[0], v[j][1] * rstd * g[1], v[j][2] * rstd * g[2], v[j][3] * rstd * g[3]}; }
}
}

constexpr int NWAVES = 8;
#ifndef MK_N_LAUNCHES
#define MK_N_LAUNCHES 1
#endif
constexpr int N_LAUNCHES = MK_N_LAUNCHES;
constexpr int PER_PHASE = 7;
#ifndef PROBE
#define PROBE -1
#endif
#define NREP(k) ((PROBE == (k)) ? 2 : 1)

typedef unsigned short bf16;
typedef unsigned v4u __attribute__((ext_vector_type(4)));
typedef float f32x4 __attribute__((ext_vector_type(4)));
#define LDS_WAIT() asm volatile("s_waitcnt lgkmcnt(0)" ::: "memory")
#define VM_WAIT() asm volatile("s_waitcnt vmcnt(0)" ::: "memory")

constexpr size_t MiB = 1u << 20;
constexpr size_t WS_CTL = 0, CTL_ZERO_BYTES = 64 * 1024;
constexpr size_t WS_TAB = 1 * MiB;
constexpr size_t WS_SSQ = 1 * MiB + 64 * 1024;
constexpr size_t WS_WIN = 3 * MiB;
constexpr size_t WS_WA = 10 * MiB, WS_WB = 11 * MiB;
constexpr size_t WS_WO = 12 * MiB;
constexpr size_t WS_WE = 14 * MiB;
constexpr size_t WS_U8 = 18 * MiB, WS_V8 = 34 * MiB;
constexpr size_t WS_PA = 50 * MiB;
constexpr size_t WS_INVU = 2 * MiB + 128 * 1024, WS_INVV = WS_INVU + 64 * 1024;
constexpr size_t WS_G = 3 * MiB, WS_E = 11 * MiB;
constexpr size_t WS_W = 114 * MiB, WS_PSS = 122 * MiB;
constexpr int CW_RANK = 8192;
constexpr size_t WS_XN = 82 * MiB;
constexpr size_t WS_ACT = 114 * MiB;
constexpr size_t WS_QA = WS_ACT, WS_QB = WS_ACT + 16 * MiB;
constexpr size_t WS_KA = WS_ACT + 32 * MiB, WS_VA = WS_ACT + 36 * MiB, WS_KB = WS_ACT + 40 * MiB, WS_VB = WS_ACT + 44 * MiB;
constexpr size_t WS_GA = WS_ACT + 48 * MiB, WS_GB = WS_ACT + 80 * MiB;
constexpr size_t WS_SC = WS_ACT;
constexpr size_t WS_END = 242 * MiB;
static_assert(WS_GB + 32 * MiB <= WS_END && WS_SC + (size_t)NTOK * SCW * 4 <= WS_END, "d_ws map");

constexpr int RING_BYTES = 131072;
constexpr int MISC_OFF = RING_BYTES + 320;
constexpr int LDS_BYTES = 147456;

#define XB_TMO      128
#define XB_XCNT(j)  (256  + 64 * (j))
#define XB_XSUB(j)  (1280 + 64 * (j))
#define XB_XGEN(j)  (2304 + 64 * (j))
#define XB_TOP      3328
#define XB_TOPGEN   3392
#define XCD_BAR_WORDS 3456
#define XB_SPIN_CAP (1u << 18)

__device__ __forceinline__ unsigned xb_ld(unsigned* p)              { return __hip_atomic_load(p, __ATOMIC_RELAXED, __HIP_MEMORY_SCOPE_AGENT); }
__device__ __forceinline__ unsigned xb_add(unsigned* p, unsigned v) { return __hip_atomic_fetch_add(p, v, __ATOMIC_RELAXED, __HIP_MEMORY_SCOPE_AGENT); }
__device__ __forceinline__ unsigned xb_xcc_id() { return (unsigned)__builtin_amdgcn_s_getreg((3 << 11) | 20) & 0xFu; }
#define XB_SPIN(cond, bar) do { unsigned _sp = 0; while (cond) { __builtin_amdgcn_s_sleep(1); \
    if ((++_sp & 255u) == 0u) { if (xb_ld(&(bar)[XB_TMO])) break; if (_sp > XB_SPIN_CAP) { atomicAdd(&(bar)[XB_TMO], 1u); break; } } } } while (0)

struct XcdBarrier {
    unsigned* bar; unsigned x;
    volatile LAS unsigned* st;
};

__device__ __forceinline__ XcdBarrier xcd_barrier_post(unsigned* bar, volatile LAS unsigned* st) {
    XcdBarrier b; b.bar = bar; b.x = xb_xcc_id(); b.st = st;
    if (threadIdx.x == 0) (void)xb_add(&bar[XB_XCNT(b.x)], 1u);
    return b;
}
__device__ __forceinline__ void xcd_barrier_complete(unsigned* bar, unsigned x, unsigned& nloc, unsigned& nx) {
    const unsigned G = gridDim.x * gridDim.y * gridDim.z;
    unsigned sum, cnt, mine, sp = 0u;
    for (;;) {
        sum = 0u; cnt = 0u; mine = 0u;
#pragma unroll
        for (unsigned j = 0; j < 16; ++j) { const unsigned c = xb_ld(&bar[XB_XCNT(j)]); sum += c; cnt += (c > 0u) ? 1u : 0u; mine = (j == x) ? c : mine; }
        if (sum == G) break;
        __builtin_amdgcn_s_sleep(1);
        if ((++sp & 255u) == 0u) { if (xb_ld(&bar[XB_TMO])) break; if (sp > XB_SPIN_CAP) { atomicAdd(&bar[XB_TMO], 1u); break; } }
    }
    nloc = mine > 0u ? mine : 1u; nx = cnt > 0u ? cnt : 1u;
}

__device__ __forceinline__ void xcd_barrier(const XcdBarrier& b) {
    asm volatile("s_waitcnt vmcnt(0)" ::: "memory");
    __syncthreads();
    if (threadIdx.x == 0) {
        unsigned* bar = b.bar;
        __builtin_amdgcn_s_waitcnt(0);
        unsigned nloc = b.st[0], nx = b.st[1];
        if (nloc == 0u) { xcd_barrier_complete(bar, b.x, nloc, nx); b.st[0] = nloc; b.st[1] = nx; }
        const unsigned old = xb_add(&bar[XB_XSUB(b.x)], 1u);
        const unsigned gen = old / nloc;
        if (old + 1u == (gen + 1u) * nloc) {
            __builtin_amdgcn_fence(__ATOMIC_RELEASE, "agent");
            asm volatile("s_waitcnt vmcnt(0)" ::: "memory");
            const unsigned og = xb_add(&bar[XB_TOP], 1u);
            const unsigned tg = og / nx;
            if (og + 1u == (tg + 1u) * nx) xb_add(&bar[XB_TOPGEN], 1u);
            else XB_SPIN(xb_ld(&bar[XB_TOPGEN]) == tg, bar);
            __builtin_amdgcn_fence(__ATOMIC_ACQUIRE, "agent");
            xb_add(&bar[XB_XGEN(b.x)], 1u);
            asm volatile("s_waitcnt vmcnt(0)" ::: "memory");
        } else {
            XB_SPIN(xb_ld(&bar[XB_XGEN(b.x)]) == gen, bar);
            __builtin_amdgcn_fence(__ATOMIC_ACQUIRE, "agent");
            asm volatile("s_waitcnt vmcnt(0)" ::: "memory");
        }
    }
    __syncthreads();
}


struct Args { const float* in[17]; float* out; unsigned char* ws; int ph_lo, ph_hi, li, pad; };

__device__ __forceinline__ void p0_transpose_item(const float* W, int K, int N, bf16* WT, int k0, int src_n0, int dst_n0, LAS float* scr, int lane) {
#pragma unroll 8
    for (int i = 0; i < 32; ++i) { const int kk = 2 * i + (lane >> 5); scr[kk * 33 + (lane & 31)] = W[(size_t)(k0 + kk) * N + src_n0 + (lane & 31)]; }
    LDS_WAIT();
    const int c = lane & 7;
#pragma unroll
    for (int j = 0; j < 4; ++j) { const int n = (lane >> 3) + 8 * j; const LAS float* s = scr + (8 * c) * 33 + n;
        v4u o; o.x = pkbf(s[0 * 33], s[1 * 33]); o.y = pkbf(s[2 * 33], s[3 * 33]); o.z = pkbf(s[4 * 33], s[5 * 33]); o.w = pkbf(s[6 * 33], s[7 * 33]);
        *(v4u*)(WT + (size_t)(dst_n0 + n) * K + k0 + 8 * c) = o; }
    LDS_WAIT();
}
__device__ __forceinline__ int win_src_col(int dst_n0) {
    if (dst_n0 >= 1536) return dst_n0;
    const int tile = dst_n0 >> 8, c = dst_n0 & 255;
    return tile * 256 + 64 * ((c >> 5) & 3) + 32 * (c >> 7);
}
__device__ __forceinline__ int t5_bucket(int rel) {
    const int n = rel < 0 ? -rel : rel; int bkt;
    if (n < 8) bkt = n; else { int v = 8 + (31 - __builtin_clz(n * n)) - 6; bkt = v > 15 ? 15 : v; }
    return bkt + (rel > 0 ? 16 : 0);
}

__global__ void __launch_bounds__(NWAVES * 64, 2) mk_fwd(Args args) {
    extern __shared__ __attribute__((aligned(16))) unsigned char lds_raw[];
    LAS unsigned char* lds = (LAS unsigned char*)lds_raw;
    volatile LAS unsigned* MISC = (volatile LAS unsigned*)(lds + MISC_OFF);
    const int tid = threadIdx.x, lane = tid & 63, wave = __builtin_amdgcn_readfirstlane(tid >> 6);
    const int G = gridDim.x, bx = blockIdx.x; const int vcu = (G % 8 == 0) ? (bx % 8) * (G / 8) + bx / 8 : bx;
    const int gw = vcu * NWAVES + wave, NGW = G * NWAVES;
    unsigned char* ws = args.ws;
    const float* x = args.in[0]; const float* g_mix = args.in[1]; const float* w_in = args.in[2]; const float* b_gate = args.in[3];
    const float* q_norm_g = args.in[4]; const float* k_norm_g = args.in[5]; const float* rel_bias = args.in[6]; const float* sink = args.in[7];
    const float* w_a = args.in[8]; const float* w_b = args.in[9]; const float* w_out = args.in[10]; const float* g_ffn = args.in[11];
    const float* peer_wq = args.in[12]; const float* subkeys = args.in[13]; const float* peer_u = args.in[14]; const float* peer_v = args.in[15]; const float* g_final = args.in[16];
    float* out = args.out;
    float* ROPE = (float*)(ws + WS_TAB); float* BIAS = (float*)(ws + WS_TAB + 16384); float* SSQ = (float*)(ws + WS_SSQ);
    bf16 *WIN_T = (bf16*)(ws + WS_WIN), *WA_T = (bf16*)(ws + WS_WA), *WB_T = (bf16*)(ws + WS_WB), *WO_T = (bf16*)(ws + WS_WO), *WE_T = (bf16*)(ws + WS_WE);
    unsigned char *U8 = ws + WS_U8, *V8 = ws + WS_V8; bf16 *PA = (bf16*)(ws + WS_PA), *XN = (bf16*)(ws + WS_XN);
    float *INVU = (float*)(ws + WS_INVU), *INVV = (float*)(ws + WS_INVV), *RG = (float*)(ws + WS_G), *RW = (float*)(ws + WS_W), *PSS = (float*)(ws + WS_PSS); bf16* RE = (bf16*)(ws + WS_E);
    bf16 *QA = (bf16*)(ws + WS_QA), *QB = (bf16*)(ws + WS_QB), *KA = (bf16*)(ws + WS_KA), *VA = (bf16*)(ws + WS_VA), *KB = (bf16*)(ws + WS_KB), *VB = (bf16*)(ws + WS_VB);
    bf16 *GA = (bf16*)(ws + WS_GA), *GB = (bf16*)(ws + WS_GB); float* SC = (float*)(ws + WS_SC);

    for (int u = tid; u < (LDS_BYTES - RING_BYTES) / 4; u += NWAVES * 64) ((LAS unsigned*)(lds + RING_BYTES))[u] = 0u;
    __syncthreads();
    XcdBarrier bar; bar.bar = (unsigned*)(ws + WS_CTL) + 1024; bar.x = 0; bar.st = nullptr;
    if (N_LAUNCHES != PER_PHASE) bar = xcd_barrier_post((unsigned*)(ws + WS_CTL) + 1024, MISC + 8);
    if (tid == 0) { const unsigned xc = xb_xcc_id(); MISC[13] = xc; MISC[12] = xb_add((unsigned*)(ws + WS_CTL) + CW_RANK + 64 * xc, 1u); }
    const int lo = args.ph_lo, hi = args.ph_hi;
#define IN(k) (lo <= (k) && (k) < hi)
#define BOTH(k) (IN(k) && IN((k) + 1))
#define GRID_BAR() do { if (N_LAUNCHES != PER_PHASE) xcd_barrier(bar); STAMP(); } while (0)
#ifdef TSEL
    int n_stamp_ = 0;
#define STAMP() do { if (tid == 0) MISC[16 + n_stamp_] = (unsigned)__builtin_amdgcn_s_memrealtime(); ++n_stamp_; } while (0)
#else
#define STAMP() do { } while (0)
#endif
    STAMP();

    if (IN(0)) for (int rep_ = 0; rep_ < NREP(0); ++rep_) {
        if (rep_) { VM_WAIT(); __syncthreads(); }
        LAS float* scr = (LAS float*)(lds + wave * 16384);
        {
            constexpr int I_IN = (DM / 64) * (INW / 32), I_AB = (QW / 64) * (DM / 32), I_O = (DM / 64) * (DM / 32);
            constexpr int NITEMS = I_IN + 2 * I_AB + I_O;
            for (int it = gw; it < NITEMS; it += NGW) {
                int r = it;
                if (r < I_IN) { const int nblk = INW / 32, kb = r / nblk, nb = r % nblk; p0_transpose_item(w_in, DM, INW, WIN_T, 64 * kb, win_src_col(32 * nb), 32 * nb, scr, lane); continue; } r -= I_IN;
                if (r < I_AB) { const int nblk = DM / 32, kb = r / nblk, nb = r % nblk; p0_transpose_item(w_a, QW, DM, WA_T, 64 * kb, 32 * nb, 32 * nb, scr, lane); continue; } r -= I_AB;
                if (r < I_AB) { const int nblk = DM / 32, kb = r / nblk, nb = r % nblk; p0_transpose_item(w_b, QW, DM, WB_T, 64 * kb, 32 * nb, 32 * nb, scr, lane); continue; } r -= I_AB;
                { const int nblk = DM / 32, kb = r / nblk, nb = r % nblk; p0_transpose_item(w_out, DM, DM, WO_T, 64 * kb, 32 * nb, 32 * nb, scr, lane); }
            }
        }
        __syncthreads();
        {
            LAS float* sk_s = (LAS float*)lds;
            LAS float* wq_s = (LAS float*)(lds + 128 * 129 * 4);
            for (int it = vcu; it < 16 * 16; it += G) {
                const int c = it >> 4, k0 = (it & 15) * 64;
                for (int i = tid; i < 128 * 32; i += NWAVES * 64) { const int n = i >> 5, d4 = (i & 31) * 4; const f32x4 v = *(const f32x4*)(subkeys + ((size_t)c * NKEYS + n) * 128 + d4);
                    sk_s[n * 129 + d4] = v[0]; sk_s[n * 129 + d4 + 1] = v[1]; sk_s[n * 129 + d4 + 2] = v[2]; sk_s[n * 129 + d4 + 3] = v[3]; }
                for (int i = tid; i < 64 * 32; i += NWAVES * 64) { const int k = i >> 5, d4 = (i & 31) * 4; const f32x4 v = *(const f32x4*)(peer_wq + (size_t)(k0 + k) * SCW + c * 128 + d4);
                    wq_s[k * 129 + d4] = v[0]; wq_s[k * 129 + d4 + 1] = v[1]; wq_s[k * 129 + d4 + 2] = v[2]; wq_s[k * 129 + d4 + 3] = v[3]; }
                __syncthreads();
                const int k = tid & 63, ng = tid >> 6; float acc[16];
#pragma unroll
                for (int i = 0; i < 16; ++i) acc[i] = 0.f;
                for (int d = 0; d < 128; ++d) { const float a = wq_s[k * 129 + d];
#pragma unroll
                    for (int i = 0; i < 16; ++i) acc[i] += a * sk_s[(ng * 16 + i) * 129 + d]; }
                const float gk = g_ffn[k0 + k];
#pragma unroll
                for (int i = 0; i < 16; ++i) WE_T[(size_t)(c * 128 + ng * 16 + i) * DM + k0 + k] = (bf16)(pkbf(acc[i] * gk, 0.f) & 0xffffu);
                __syncthreads();
            }
        }
        for (int e = gw; e < 2 * NEXP; e += NGW) { if (e < NEXP) peer::table_row_fp8(peer_u, U8, INVU, e, lane); else peer::table_row_fp8(peer_v, V8, INVV, e - NEXP, lane); }
        for (int m = gw; m < NTOK; m += NGW) {
            const f32x4* xr = (const f32x4*)(x + (size_t)m * DM) + lane; f32x4 v[4]; float s = 0.f;
#pragma unroll
            for (int j = 0; j < 4; ++j) { v[j] = xr[64 * j]; s += (v[j][0] * v[j][0] + v[j][1] * v[j][1]) + (v[j][2] * v[j][2] + v[j][3] * v[j][3]); }
            const float rstd = 1.0f / sqrtf(peer::wave_sum(s) * (1.0f / DM) + EPS);
            unsigned long long* o8 = (unsigned long long*)(XN + (size_t)m * DM) + lane;
#pragma unroll
            for (int j = 0; j < 4; ++j) { const f32x4 g = *((const f32x4*)g_mix + lane + 64 * j);
                o8[64 * j] = (unsigned long long)pkbf(v[j][0] * rstd * g[0], v[j][1] * rstd * g[1]) | ((unsigned long long)pkbf(v[j][2] * rstd * g[2], v[j][3] * rstd * g[3]) << 32); }
        }
        if (vcu == 0) {
            for (int i = tid; i < 64 * 16; i += NWAVES * 64) { const int pos = i >> 4, f = i & 15; const float fr = powf(10000.0f, -(float)f / 16.0f); const float ang = (float)pos * fr; ROPE[2 * i] = cosf(ang); ROPE[2 * i + 1] = sinf(ang); }
            for (int i = tid; i < 8 * 257; i += NWAVES * 64) { const int h = i / 257, rel = i % 257 - 128; BIAS[i] = rel_bias[t5_bucket(rel) * NH + h] * LOG2E; }
        }
        if (BOTH(0) && rep_ == NREP(0) - 1) GRID_BAR();
    }

    if (IN(1)) {
        pg8::Gemm g{XN, WIN_T, NTOK, INW, DM}; pg8::StaticOrder S; S.init(NTOK, INW, G, bx);
        pg8::EpiIn E{QA, KA, VA, QB, KB, VB, GA, GB, q_norm_g, k_norm_g, b_gate, ROPE};
        if (PROBE == 1) { pg8::gemm_phase<pg8::EpiIn, pg8::StaticOrder, true, true>(lds, g, S, E); VM_WAIT(); __syncthreads(); }
        pg8::gemm_phase<pg8::EpiIn, pg8::StaticOrder, true, true>(lds, g, S, E);
        if (BOTH(1)) GRID_BAR();
    }

    if (IN(2)) {
        if (PROBE == 2) {
            bf16* DUM = (bf16*)(ws + WS_ACT + 112 * MiB);
            for (int u = vcu; u < 512; u += G) { const int xg = u >> 6, i = u & 63; const int b = xg >> 1, h = 4 * (xg & 1) + (i >> 4), qblk = i & 15;
                attn::attn_unit<false>((LAS char*)lds, QA, KA, VA, DUM, b, h, qblk, nullptr, 0.f); }
            for (int u = vcu; u < 512; u += G) { const int xg = u >> 6, i = u & 63; const int b = xg >> 1, h = 4 * (xg & 1) + (i >> 4), qblk = i & 15;
                attn::attn_unit<true>((LAS char*)lds, QB, KB, VB, DUM, b, h, qblk, BIAS + h * 257, sink[h] * LOG2E); }
        }
        for (int u = vcu; u < 512; u += G) { const int xg = u >> 6, i = u & 63; const int b = xg >> 1, h = 4 * (xg & 1) + (i >> 4), qblk = i & 15;
            attn::attn_unit<false>((LAS char*)lds, QA, KA, VA, QA, b, h, qblk, nullptr, 0.f); }
        for (int u = vcu; u < 512; u += G) { const int xg = u >> 6, i = u & 63; const int b = xg >> 1, h = 4 * (xg & 1) + (i >> 4), qblk = i & 15;
            attn::attn_unit<true>((LAS char*)lds, QB, KB, VB, QB, b, h, qblk, BIAS + h * 257, sink[h] * LOG2E); }
        if (BOTH(2)) GRID_BAR();
    }

    if (IN(3)) {
        if (PROBE == 3) {
            { pg8::Gemm g{QA, WA_T, NTOK, DM, QW}; pg8::StaticOrder S; S.init(NTOK, DM, G, bx); pg8::EpiMixA E{GA, XN};
              pg8::gemm_phase<pg8::EpiMixA, pg8::StaticOrder, true, true>(lds, g, S, E); }
            VM_WAIT(); __syncthreads();
            { pg8::Gemm g{QB, WB_T, NTOK, DM, QW}; pg8::StaticOrder S; S.init(NTOK, DM, G, bx); pg8::EpiMixB E{XN, GB, XN};
              pg8::gemm_phase<pg8::EpiMixB, pg8::StaticOrder, true, true>(lds, g, S, E); }
            VM_WAIT(); __syncthreads();
        }
        { pg8::Gemm g{QA, WA_T, NTOK, DM, QW}; pg8::StaticOrder S; S.init(NTOK, DM, G, bx); pg8::EpiMixA E{GA, GA};
          pg8::gemm_phase<pg8::EpiMixA, pg8::StaticOrder, true, true>(lds, g, S, E); }
        VM_WAIT(); __syncthreads();
        { pg8::Gemm g{QB, WB_T, NTOK, DM, QW}; pg8::StaticOrder S; S.init(NTOK, DM, G, bx); pg8::EpiMixB E{GA, GB, GB};
          pg8::gemm_phase<pg8::EpiMixB, pg8::StaticOrder, true, true>(lds, g, S, E); }
        if (BOTH(3)) GRID_BAR();
    }

    if (IN(4)) {
        pg8::Gemm g{GB, WO_T, NTOK, DM, DM}; pg8::StaticOrder S; S.init(NTOK, DM, G, bx); pg8::EpiOut E{x, XN, SSQ};
        for (int rep_ = 0; rep_ < NREP(4); ++rep_) pg8::gemm_phase<pg8::EpiOut, pg8::StaticOrder, true, true>(lds, g, S, E);
        if (BOTH(4)) GRID_BAR();
    }

    if (IN(5)) {
        pg8::Gemm g{XN, WE_T, NTOK, SCW, DM}; pg8::StaticOrder S; S.init(NTOK, SCW, G, bx); pg8::EpiScore E{SSQ, SC};
        for (int rep_ = 0; rep_ < NREP(5); ++rep_) pg8::gemm_phase<pg8::EpiScore, pg8::StaticOrder, true, true>(lds, g, S, E);
        if (BOTH(5)) GRID_BAR();
    }

    if (IN(6)) {
        LAS char* wl = (LAS char*)lds + wave * peer::WAVE_LDS;
        const unsigned long long ct = peer::cand_table(lane & 7);
        for (int rep_ = 0; rep_ < NREP(60); ++rep_) for (int t = gw; t < NTOK; t += NGW) peer::route_token(wl, lane, t, ct, SC, XN, g_ffn, RE, RG, (bf16*)out);
        GRID_BAR();
        int nloc = 0, nx = 0, ox = 0; const int myx = (int)MISC[13], rank = (int)MISC[12];
#pragma unroll
        for (int j = 0; j < 16; ++j) { const int c = (int)xb_ld((unsigned*)(ws + WS_CTL) + CW_RANK + 64 * j); nx += c > 0; ox += (c > 0 && j < myx); nloc = j == myx ? c : nloc; }
        const int wv = rank * NWAVES + wave, nwv = nloc * NWAVES;
        for (int rep_ = 0; rep_ < NREP(61); ++rep_) for (int s = ox; s < 8; s += nx) { const unsigned char* U8s = U8 + (size_t)s * peer::SLICE_BYTES;
            peer::upass_slice(lane, s, wv, nwv, U8s, RE, (const bf16*)out, PA); }
        GRID_BAR();
        for (int rep_ = 0; rep_ < NREP(62); ++rep_) for (int t = gw; t < NTOK; t += NGW) peer::wpass_token(lane, t, RE, RG, PA, INVU, INVV, RW);
        GRID_BAR();
        for (int s = ox; s < 8; s += nx) { const unsigned char* V8s = V8 + (size_t)s * peer::SLICE_BYTES;
            for (int rep_ = 0; rep_ < NREP(63); ++rep_) peer::vpass_slice(lane, s, wv, nwv, V8s, RE, RW, PA); }
        GRID_BAR();
        for (int t = gw; t < NTOK; t += NGW) peer::final_token(lane, t, out, XN, PA, g_final);
#ifdef TSEL
        STAMP();
        if (bx == 0 && tid == 0) { VM_WAIT(); const unsigned d = MISC[16 + TSEL + 1] - MISC[16 + TSEL]; out[0] += (float)d * 0.001f; }
#endif
    }
#undef IN
#undef BOTH
#undef GRID_BAR
}

extern "C" void kernel_launch(void* const* d_in, const int* in_sizes, int n_in, void* d_out, int out_size, void* d_ws, size_t ws_size, hipStream_t stream) {
    static int grid = 0;
    if (grid == 0) {
        if (n_in != 17 || in_sizes[0] != NTOK * DM || out_size != NTOK * DM || ws_size < WS_END) { fprintf(stderr, "kernel_launch: unexpected shapes (n_in %d, in0 %d, out %d, ws %zu); nothing launched\n", n_in, n_in > 0 ? in_sizes[0] : -1, out_size, ws_size); grid = -1; return; }
        int dev = 0, cus = 0, per_cu = 0;
        if (hipGetDevice(&dev) != hipSuccess || hipDeviceGetAttribute(&cus, hipDeviceAttributeMultiprocessorCount, dev) != hipSuccess) { grid = -1; return; }
        if (hipFuncSetAttribute((const void*)mk_fwd, hipFuncAttributeMaxDynamicSharedMemorySize, LDS_BYTES) != hipSuccess) { fprintf(stderr, "kernel_launch: hipFuncSetAttribute failed\n"); grid = -1; return; }
        if (hipOccupancyMaxActiveBlocksPerMultiprocessor(&per_cu, (const void*)mk_fwd, NWAVES * 64, LDS_BYTES) != hipSuccess || per_cu < 1) { fprintf(stderr, "kernel_launch: occupancy query says %d blocks per CU; nothing launched\n", per_cu); (void)hipGetLastError(); grid = -1; return; }
        grid = cus;
    }
    if (grid < 0) return;
    if (hipMemsetAsync((char*)d_ws + WS_CTL, 0, CTL_ZERO_BYTES, stream) != hipSuccess) { fprintf(stderr, "kernel_launch: hipMemsetAsync failed\n"); return; }
    Args a{};
    for (int i = 0; i < 17; ++i) a.in[i] = (const float*)d_in[i];
    a.out = (float*)d_out; a.ws = (unsigned char*)d_ws;
    if (N_LAUNCHES == 1) {
        a.ph_lo = 0; a.ph_hi = PER_PHASE; a.li = 0;
#if defined(COOP_LAUNCH)
        void* kargs[] = {&a};
        hipError_t e = hipLaunchCooperativeKernel((const void*)mk_fwd, dim3(grid), dim3(NWAVES * 64), kargs, LDS_BYTES, stream);
        if (e != hipSuccess) fprintf(stderr, "kernel_launch: cooperative launch failed: %s (grid %d)\n", hipGetErrorString(e), grid);
#else
        if (PROBE == 100) { hipLaunchKernelGGL(mk_fwd, dim3(grid), dim3(NWAVES * 64), LDS_BYTES, stream, a); (void)hipMemsetAsync((char*)d_ws + WS_CTL, 0, CTL_ZERO_BYTES, stream); }
        hipLaunchKernelGGL(mk_fwd, dim3(grid), dim3(NWAVES * 64), LDS_BYTES, stream, a);
#endif
    } else {
        for (int li = 0; li < PER_PHASE; ++li) { a.ph_lo = li; a.ph_hi = li + 1; a.li = li;
            hipLaunchKernelGGL(mk_fwd, dim3(grid), dim3(NWAVES * 64), LDS_BYTES, stream, a); }
    }
}
```

```cpp
#include <hip/hip_runtime.h>
#include <cstdio>
#include <cstdint>
#include <cmath>
namespace pg8 {
#define PG8_LAS __attribute__((address_space(3)))
typedef unsigned short bf16_t;
typedef short bf16x8 __attribute__((ext_vector_type(8)));
typedef float f32x4 __attribute__((ext_vector_type(4)));
typedef unsigned u32x4 __attribute__((ext_vector_type(4)));
constexpr int BM = 256, BK = 64, HALF = 128, HTB = HALF * BK * 2  , STAGE_BYTES = 8 * HTB, NXCD = 8, WGM = 8;

__host__ __device__ __forceinline__ int lds_byte(int r, int c) { const int st = (r >> 4) * 2 + (c >> 5), rr = r & 15, cc = c & 31, ob = rr * 64 + cc * 2; return st * 1024 + (ob ^ (((ob >> 9) & 1) << 5)); }
__host__ __device__ __forceinline__ void stage_rc(int b, int& R, int& C) { const int st = b / 1024, sb = b % 1024, swz = sb ^ (((sb >> 9) & 1) << 5); R = (st >> 1) * 16 + swz / 64; C = (st & 1) * 32 + (swz % 64) / 2; }
__host__ __device__ __forceinline__ int perm32(int rho) { const int n = rho >> 4, i = rho & 15; return 8 * (i >> 2) + 4 * n + (i & 3); }

struct Unit { int pm, pn; };
struct Gemm { const bf16_t* A; const bf16_t* Bt; int M, N, K; };

struct StaticOrder {
    int nM, nN, nwg, G, c;
    __host__ __device__ void init(int M, int N, int G_, int c_) { nM = M / BM; nN = N / BM; nwg = nM * nN; G = G_; c = c_; }
    __host__ __device__ bool next(int i, Unit& u) const {
        const long L = (long)i * G + c; if (L >= nwg) return false;
        int wgid = (int)L; { const int q = nwg / NXCD, r = nwg % NXCD, xcd = wgid % NXCD, off = wgid / NXCD; wgid = (xcd < r ? xcd * (q + 1) : r * (q + 1) + (xcd - r) * q) + off; }
        const int nig = WGM * nN, gid = wgid / nig, fm = gid * WGM, gsz = (nM - fm) < WGM ? (nM - fm) : WGM;
        u.pm = fm + ((wgid % nig) % gsz); u.pn = (wgid % nig) / gsz; return true;
    }
    __device__ __forceinline__ void a_ready(const Unit&) const {}
    __device__ __forceinline__ void done(const Unit&) const {}
};

__device__ __forceinline__ unsigned cvt_pk_bf16(float lo, float hi) { unsigned r; asm volatile("v_cvt_pk_bf16_f32 %0, %1, %2" : "=v"(r) : "v"(lo), "v"(hi)); return r; }
typedef float f32x2 __attribute__((ext_vector_type(2)));
template <class Epi, class Sched, bool ALIGN_EPI = false, bool SP2 = false>
__device__ __forceinline__ void gemm_phase(PG8_LAS unsigned char* lds, const Gemm g, const Sched& S, const Epi& E) {
    const int tid = threadIdx.x, wid = __builtin_amdgcn_readfirstlane(tid >> 6), lane = tid & 63, wr = wid >> 2, wc = wid & 3, fr = lane & 15, fq = lane >> 4;
    const int K = g.K, nt = K / BK;
    unsigned voffA[2], voffB[2];
#pragma unroll
    for (int i = 0; i < 2; ++i) { int R, C; stage_rc(tid * 16 + i * 8192, R, C); const int Rb = Epi::PERM ? ((R & ~31) + perm32(R & 31)) : R;
        voffA[i] = (unsigned)(R * K + C) * 2u; voffB[i] = (unsigned)(Rb * K + C) * 2u; }
    const size_t kstep = (size_t)(BK * 2);
    const size_t hstep = (size_t)HALF * K * 2;
    const size_t tstep = 2 * hstep;
    const unsigned ldsw = (unsigned)wid * 1024u;
    const int aoff = lds_byte(wr * 64 + fr, fq * 8), boff = lds_byte(wc * 32 + fr, fq * 8);
#define PG8_SA(b, h) (((b) * 2 + (h)) * HTB)
#define PG8_SB(b, h) ((4 + (b) * 2 + (h)) * HTB)
#define PG8_STAGE(bufoff, gbase, voff) do { _Pragma("unroll") for (int _i = 0; _i < 2; ++_i) \
        __builtin_amdgcn_global_load_lds((const unsigned*)((const char*)(gbase) + (voff)[_i]), (PG8_LAS unsigned*)(lds + (bufoff) + ldsw + _i * 8192), 16, 0, 0); } while (0)
#define PG8_LDA(dst, b, h) do { _Pragma("unroll") for (int m = 0; m < 4; ++m) _Pragma("unroll") for (int k = 0; k < 2; ++k) dst[m][k] = *(const PG8_LAS bf16x8*)(lds + PG8_SA(b, h) + aoff + m * 2048 + k * 1024); } while (0)
#define PG8_LDB(dst, b, h) do { _Pragma("unroll") for (int n = 0; n < 2; ++n) _Pragma("unroll") for (int k = 0; k < 2; ++k) dst[n][k] = *(const PG8_LAS bf16x8*)(lds + PG8_SB(b, h) + boff + n * 2048 + k * 1024); } while (0)
#define PG8_MMA(ai, bj, At, Bt) do { __builtin_amdgcn_s_setprio(1); _Pragma("unroll") for (int m = 0; m < 4; ++m) _Pragma("unroll") for (int n = 0; n < 2; ++n) _Pragma("unroll") for (int k = 0; k < 2; ++k) \
        acc[ai][bj][m][n] = __builtin_amdgcn_mfma_f32_16x16x32_bf16(Bt[n][k], At[m][k], acc[ai][bj][m][n], 0, 0, 0); __builtin_amdgcn_s_setprio(0); } while (0)
#define PG8_WAIT_V(n) asm volatile("s_waitcnt vmcnt(" #n ")" ::: "memory")
#define PG8_WAIT_L(n) asm volatile("s_waitcnt lgkmcnt(" #n ")" ::: "memory")
#define PG8_BAR __builtin_amdgcn_s_barrier()
#define PG8_SCHED __builtin_amdgcn_sched_barrier(0)
    Unit cur, nxt; int ui = 0;
    if (!S.next(0, cur)) return;
    f32x4 acc[2][2][4][2];
#pragma unroll
    for (int a = 0; a < 2; ++a)
#pragma unroll
        for (int b = 0; b < 2; ++b)
#pragma unroll
            for (int m = 0; m < 4; ++m)
#pragma unroll
                for (int n = 0; n < 2; ++n) acc[a][b][m][n] = (f32x4){0.f, 0.f, 0.f, 0.f};
    bf16x8 At[4][2], B0[2][2], B1[2][2];
    const char* cA = (const char*)g.A + (size_t)cur.pm * tstep; const char* cB = (const char*)g.Bt + (size_t)cur.pn * tstep;
    S.a_ready(cur);
    if constexpr (SP2) {
        PG8_STAGE(PG8_SB(0, 0), cB, voffB); PG8_STAGE(PG8_SB(0, 1), cB + hstep, voffB); PG8_STAGE(PG8_SA(0, 0), cA, voffA); PG8_STAGE(PG8_SA(0, 1), cA + hstep, voffA);
        if (wr == 1) PG8_BAR;
        PG8_WAIT_V(2); PG8_BAR;
        PG8_STAGE(PG8_SB(1, 0), cB + kstep, voffB); PG8_STAGE(PG8_SA(1, 0), cA + kstep, voffA); PG8_STAGE(PG8_SB(1, 1), cB + hstep + kstep, voffB);
        PG8_WAIT_V(6); PG8_BAR;
    } else {
        PG8_STAGE(PG8_SB(0, 0), cB, voffB); PG8_STAGE(PG8_SA(0, 0), cA, voffA); PG8_STAGE(PG8_SB(0, 1), cB + hstep, voffB); PG8_STAGE(PG8_SA(0, 1), cA + hstep, voffA);
        if (wr == 1) PG8_BAR;
        PG8_WAIT_V(4); PG8_BAR;
        PG8_STAGE(PG8_SB(1, 0), cB + kstep, voffB); PG8_STAGE(PG8_SA(1, 0), cA + kstep, voffA); PG8_STAGE(PG8_SB(1, 1), cB + hstep + kstep, voffB);
        PG8_WAIT_V(6); PG8_BAR;
    }
    for (;;) {
        const bool has_next = S.next(ui + 1, nxt);
        const char* nA = has_next ? (const char*)g.A + (size_t)nxt.pm * tstep : cA; const char* nB = has_next ? (const char*)g.Bt + (size_t)nxt.pn * tstep : cB;
        for (int t = 0; t < nt; t += 2) {
            if constexpr (Epi::HAS_MID) { if (t == (nt >> 1)) E.mid(acc, cur, wr, wc, fr, fq); }
            const bool last = (t == nt - 2);
            const char* a1 = cA + (size_t)(t + 1) * kstep;
            const char* a2 = last ? nA : cA + (size_t)(t + 2) * kstep; const char* b2 = last ? nB : cB + (size_t)(t + 2) * kstep;
            const char* a3 = a2 + kstep; const char* b3 = b2 + kstep;
            if (last && has_next) S.a_ready(nxt);
            if constexpr (SP2) {
            PG8_LDB(B0, 0, 0); PG8_LDB(B1, 0, 1); PG8_SCHED; PG8_LDA(At, 0, 0); PG8_STAGE(PG8_SA(1, 1), a1 + hstep, voffA);
            PG8_WAIT_V(8); PG8_WAIT_L(0); PG8_BAR; PG8_MMA(0, 0, At, B0); PG8_MMA(0, 1, At, B1); PG8_BAR; PG8_SCHED;
            PG8_LDA(At, 0, 1); PG8_STAGE(PG8_SB(0, 0), b2, voffB); PG8_STAGE(PG8_SB(0, 1), b2 + hstep, voffB); PG8_STAGE(PG8_SA(0, 0), a2, voffA);
            PG8_WAIT_V(8); PG8_WAIT_L(0); PG8_BAR; PG8_MMA(1, 0, At, B0); PG8_MMA(1, 1, At, B1); PG8_BAR; PG8_SCHED;
            PG8_LDB(B0, 1, 0); PG8_LDB(B1, 1, 1); PG8_SCHED; PG8_LDA(At, 1, 0); PG8_STAGE(PG8_SA(0, 1), a2 + hstep, voffA);
            PG8_WAIT_V(8); PG8_WAIT_L(0); PG8_BAR; PG8_MMA(0, 0, At, B0); PG8_MMA(0, 1, At, B1); PG8_BAR; PG8_SCHED;
            PG8_LDA(At, 1, 1); PG8_STAGE(PG8_SB(1, 0), b3, voffB); PG8_STAGE(PG8_SB(1, 1), b3 + hstep, voffB); PG8_STAGE(PG8_SA(1, 0), a3, voffA);
            PG8_WAIT_V(8); PG8_WAIT_L(0); PG8_BAR; PG8_MMA(1, 0, At, B0); PG8_MMA(1, 1, At, B1); PG8_BAR; PG8_SCHED;
            } else {
            PG8_LDB(B0, 0, 0); PG8_SCHED; PG8_LDA(At, 0, 0); PG8_STAGE(PG8_SA(1, 1), a1 + hstep, voffA);
            PG8_WAIT_L(8); PG8_BAR; PG8_WAIT_L(0); PG8_MMA(0, 0, At, B0); PG8_BAR; PG8_SCHED;
            PG8_LDB(B1, 0, 1); PG8_STAGE(PG8_SB(0, 0), b2, voffB);
            PG8_BAR; PG8_WAIT_L(0); PG8_MMA(0, 1, At, B1); PG8_BAR;
            PG8_LDA(At, 0, 1); PG8_STAGE(PG8_SA(0, 0), a2, voffA);
            PG8_BAR; PG8_WAIT_L(0); PG8_MMA(1, 0, At, B0); PG8_BAR; PG8_SCHED;
            PG8_STAGE(PG8_SB(0, 1), b2 + hstep, voffB);
            PG8_WAIT_V(6); PG8_BAR; PG8_MMA(1, 1, At, B1); PG8_BAR;
            PG8_LDB(B0, 1, 0); PG8_SCHED; PG8_LDA(At, 1, 0); PG8_STAGE(PG8_SA(0, 1), a2 + hstep, voffA);
            PG8_WAIT_L(8); PG8_BAR; PG8_WAIT_L(0); PG8_MMA(0, 0, At, B0); PG8_BAR; PG8_SCHED;
            PG8_LDB(B1, 1, 1); PG8_STAGE(PG8_SB(1, 0), b3, voffB);
            PG8_BAR; PG8_WAIT_L(0); PG8_MMA(0, 1, At, B1); PG8_BAR;
            PG8_LDA(At, 1, 1); PG8_STAGE(PG8_SA(1, 0), a3, voffA);
            PG8_BAR; PG8_WAIT_L(0); PG8_MMA(1, 0, At, B0); PG8_BAR; PG8_SCHED;
            PG8_STAGE(PG8_SB(1, 1), b3 + hstep, voffB);
            PG8_WAIT_V(6); PG8_BAR; PG8_MMA(1, 1, At, B1); PG8_BAR;
            }
        }
        if constexpr (ALIGN_EPI) { if (wr == 0) PG8_BAR; }
        if constexpr (!Epi::AFTER_DRAIN) { E(acc, cur, wr, wc, fr, fq); S.done(cur); }
        if (!has_next) break;
#pragma unroll
        for (int a = 0; a < 2; ++a)
#pragma unroll
            for (int b = 0; b < 2; ++b)
#pragma unroll
                for (int m = 0; m < 4; ++m)
#pragma unroll
                    for (int n = 0; n < 2; ++n) acc[a][b][m][n] = (f32x4){0.f, 0.f, 0.f, 0.f};
        cur = nxt; cA = nA; cB = nB; ++ui;
        if constexpr (ALIGN_EPI) { if (wr == 1) PG8_BAR; }
    }
    PG8_WAIT_V(0);
    if constexpr (!ALIGN_EPI) { if (wr == 0) PG8_BAR; }
    PG8_BAR;
    if constexpr (Epi::AFTER_DRAIN) { E.fused(acc, cur, wr, wc, fr, fq, lds, wid, lane); S.done(cur); }
#undef PG8_SA
#undef PG8_SB
#undef PG8_STAGE
#undef PG8_LDA
#undef PG8_LDB
#undef PG8_MMA
#undef PG8_WAIT_V
#undef PG8_WAIT_L
#undef PG8_BAR
#undef PG8_SCHED
}
}

constexpr int DM = 1024, NB = 4, SEQ = 4096, NTOK = NB * SEQ;
constexpr int HD = 64, NH = 8, NKV = 2, QW = NH * HD  , GRIDW = 64;
constexpr int INW = 3584;
constexpr int PH = 8, NKEYS = 128, TOPK = 16, NEXP = NKEYS * NKEYS, SCW = PH * 2 * NKEYS  ;
constexpr float EPS = 1e-6f;
constexpr float LOG2E = 1.4426950408889634f;
constexpr float QSCALE = 0.125f * LOG2E;

typedef unsigned u32x2_t __attribute__((ext_vector_type(2)));
typedef float f32x2_t __attribute__((ext_vector_type(2)));
typedef __bf16 bf16x2_t __attribute__((ext_vector_type(2)));
__device__ __forceinline__ unsigned pkbf(float lo, float hi) { f32x2_t v = {lo, hi}; bf16x2_t b = __builtin_convertvector(v, bf16x2_t); return __builtin_bit_cast(unsigned, b); }
__device__ __forceinline__ float bflo(unsigned w) { return __builtin_bit_cast(float, w << 16); }
__device__ __forceinline__ float bfhi(unsigned w) { return __builtin_bit_cast(float, w & 0xffff0000u); }

__device__ __forceinline__ size_t kimg_off(int b, int kvh, int s, int dim) { return ((size_t)((b * NKV + kvh) * (SEQ / 64) + (s >> 6)) << 12) + (dim >> 3) * 512 + (s & 63) * 8 + (dim & 7); }
__device__ __forceinline__ size_t vimg_off(int b, int kvh, int s, int dim) { return ((size_t)((b * NKV + kvh) * (SEQ / 64) + (s >> 6)) << 12) + (dim >> 5) * 2048 + (s & 63) * 32 + (dim & 31); }

namespace pg8 {
struct EpiIn {
    static constexpr bool PERM = false, AFTER_DRAIN = false, HAS_MID = false;
    bf16_t *Qa, *Ka, *Va, *Qb, *Kb, *Vb, *Ga, *Gb;
    const float *qg, *kg, *bgate, *rope;
    __device__ __forceinline__ void operator()(const f32x4 (&acc)[2][2][4][2], const Unit& u, int wr, int wc, int fr, int fq) const {
        const int pn = u.pn;
        if (pn >= 6) {
            const bool isA = pn < 10; bf16_t* G = isA ? Ga : Gb; const int ct = (isA ? pn - 6 : pn - 10) * BM; const float* bb = bgate + (isA ? 0 : DM);
            f32x4 bv[2][2];
#pragma unroll
            for (int bj = 0; bj < 2; ++bj)
#pragma unroll
                for (int n = 0; n < 2; ++n) bv[bj][n] = *(const f32x4*)(bb + ct + bj * HALF + wc * 32 + n * 16 + 4 * fq);
#pragma unroll
            for (int ai = 0; ai < 2; ++ai)
#pragma unroll
                for (int m = 0; m < 4; ++m) { const int row = u.pm * BM + ai * HALF + wr * 64 + m * 16 + fr; bf16_t* rp = G + (size_t)row * DM + ct + wc * 32 + 4 * fq;
#pragma unroll
                    for (int bj = 0; bj < 2; ++bj)
#pragma unroll
                        for (int n = 0; n < 2; ++n) { const f32x4 z = acc[ai][bj][m][n] + bv[bj][n]; f32x4 g;
#pragma unroll
                            for (int j = 0; j < 4; ++j) g[j] = __builtin_amdgcn_rcpf(1.0f + __builtin_amdgcn_exp2f(-LOG2E * z[j]));
                            u32x2_t w; w.x = pkbf(g[0], g[1]); w.y = pkbf(g[2], g[3]); *(u32x2_t*)(rp + bj * HALF + n * 16) = w; } }
            return;
        }
        const bool brA = pn < 3; const int pl = brA ? pn : pn - 3;
        const bool isq = pl < 2, isk = (!isq) && wc < 2;
        const bool normrope = brA && (isq || isk);
        f32x4 gv[2][2];
        if (normrope) { const float* g = isq ? qg : kg;
#pragma unroll
            for (int bj = 0; bj < 2; ++bj)
#pragma unroll
                for (int n = 0; n < 2; ++n) gv[bj][n] = *(const f32x4*)(g + 32 * bj + 16 * n + 4 * fq); }
        const float osc = isq ? QSCALE : 1.0f;
#pragma unroll
        for (int ai = 0; ai < 2; ++ai)
#pragma unroll
            for (int m = 0; m < 4; ++m) {
                const int row = u.pm * BM + ai * HALF + wr * 64 + m * 16 + fr; const int b = row >> 12, s = row & (SEQ - 1);
                f32x4 v[2][2];
#pragma unroll
                for (int bj = 0; bj < 2; ++bj)
#pragma unroll
                    for (int n = 0; n < 2; ++n) v[bj][n] = acc[ai][bj][m][n];
                if (normrope) {
                    float ss = 0.f;
#pragma unroll
                    for (int bj = 0; bj < 2; ++bj)
#pragma unroll
                        for (int n = 0; n < 2; ++n) ss += (v[bj][n][0] * v[bj][n][0] + v[bj][n][1] * v[bj][n][1]) + (v[bj][n][2] * v[bj][n][2] + v[bj][n][3] * v[bj][n][3]);
                    ss += __shfl_xor(ss, 16); ss += __shfl_xor(ss, 32);
                    const float rstd = 1.0f / sqrtf(ss * (1.0f / 64.0f) + EPS);
#pragma unroll
                    for (int bj = 0; bj < 2; ++bj) {
                        const int pos = bj == 0 ? (s >> 6) : (s & (GRIDW - 1));
                        const f32x4 cs0 = *(const f32x4*)(rope + (pos * 16 + 4 * fq) * 2), cs1 = *(const f32x4*)(rope + (pos * 16 + 4 * fq) * 2 + 4);
                        const float cc[4] = {cs0[0], cs0[2], cs1[0], cs1[2]}, sn[4] = {cs0[1], cs0[3], cs1[1], cs1[3]};
#pragma unroll
                        for (int j = 0; j < 4; ++j) { const float u1 = v[bj][0][j] * rstd * gv[bj][0][j], u2 = v[bj][1][j] * rstd * gv[bj][1][j];
                            v[bj][0][j] = u1 * cc[j] - u2 * sn[j]; v[bj][1][j] = u2 * cc[j] + u1 * sn[j]; }
                    }
                }
#pragma unroll
                for (int bj = 0; bj < 2; ++bj)
#pragma unroll
                    for (int n = 0; n < 2; ++n) {
                        const f32x4 o = v[bj][n] * osc; u32x2_t w; w.x = pkbf(o[0], o[1]); w.y = pkbf(o[2], o[3]);
                        const int dim = 32 * bj + 16 * n + 4 * fq;
                        bf16_t* dst;
                        if (isq) dst = (brA ? Qa : Qb) + (size_t)row * (2 * QW) + (pl * 4 + wc) * HD + dim;
                        else if (wc < 2) dst = (brA ? Ka : Kb) + kimg_off(b, wc, s, dim);
                        else dst = (brA ? Va : Vb) + vimg_off(b, wc - 2, s, dim);
                        *(u32x2_t*)dst = w;
                    }
            }
    }
};

struct EpiMix {
    static constexpr bool PERM = false, AFTER_DRAIN = false, HAS_MID = true;
    const bf16_t* GA; const bf16_t* GB; bf16_t* OUT;
    __device__ __forceinline__ void mid(f32x4 (&acc)[2][2][4][2], const Unit& u, int wr, int wc, int fr, int fq) const {
        size_t off = (size_t)(u.pm * BM + wr * 64 + fr) * DM + u.pn * BM + wc * 32 + 4 * fq;
#pragma unroll
        for (int ai = 0; ai < 2; ++ai)
#pragma unroll
            for (int m = 0; m < 4; ++m) {
                asm volatile("" : "+v"(off));
#pragma unroll
                for (int bj = 0; bj < 2; ++bj)
#pragma unroll
                    for (int n = 0; n < 2; ++n) { const u32x2_t a = *(const u32x2_t*)(GA + off + bj * HALF + n * 16), b = *(const u32x2_t*)(GB + off + bj * HALF + n * 16);
                        f32x4& c = acc[ai][bj][m][n];
                        c[0] *= bflo(a.x) * __builtin_amdgcn_rcpf(fmaxf(bflo(b.x), 1e-20f)); c[1] *= bfhi(a.x) * __builtin_amdgcn_rcpf(fmaxf(bfhi(b.x), 1e-20f));
                        c[2] *= bflo(a.y) * __builtin_amdgcn_rcpf(fmaxf(bflo(b.y), 1e-20f)); c[3] *= bfhi(a.y) * __builtin_amdgcn_rcpf(fmaxf(bfhi(b.y), 1e-20f)); }
                off += (size_t)((m == 3) ? (HALF - 48) : 16) * DM;
            }
    }
    __device__ __forceinline__ void operator()(const f32x4 (&acc)[2][2][4][2], const Unit& u, int wr, int wc, int fr, int fq) const {
#pragma unroll
        for (int ai = 0; ai < 2; ++ai)
#pragma unroll
            for (int m = 0; m < 4; ++m) { const int row = u.pm * BM + ai * HALF + wr * 64 + m * 16 + fr; const size_t off = (size_t)row * DM + u.pn * BM + wc * 32 + 4 * fq;
#pragma unroll
                for (int bj = 0; bj < 2; ++bj)
#pragma unroll
                    for (int n = 0; n < 2; ++n) { const u32x2_t g = *(const u32x2_t*)(GB + off + bj * HALF + n * 16); const f32x4 a = acc[ai][bj][m][n];
                        u32x2_t w; w.x = pkbf(a[0] * bflo(g.x), a[1] * bfhi(g.x)); w.y = pkbf(a[2] * bflo(g.y), a[3] * bfhi(g.y)); *(u32x2_t*)(OUT + off + bj * HALF + n * 16) = w; } }
    }
};
struct EpiOut {
    static constexpr bool PERM = false, AFTER_DRAIN = false, HAS_MID = false;
    const float* X; bf16_t* HB; float* ssq;
    __device__ __forceinline__ void operator()(const f32x4 (&acc)[2][2][4][2], const Unit& u, int wr, int wc, int fr, int fq) const {
#pragma unroll
        for (int ai = 0; ai < 2; ++ai)
#pragma unroll
            for (int m = 0; m < 4; ++m) { const int row = u.pm * BM + ai * HALF + wr * 64 + m * 16 + fr; const size_t off = (size_t)row * DM + u.pn * BM + wc * 32 + 4 * fq; float ss = 0.f;
#pragma unroll
                for (int bj = 0; bj < 2; ++bj)
#pragma unroll
                    for (int n = 0; n < 2; ++n) { const size_t o2 = off + bj * HALF + n * 16; const f32x4 h = *(const f32x4*)(X + o2) + acc[ai][bj][m][n];
                        u32x2_t w; w.x = pkbf(h[0], h[1]); w.y = pkbf(h[2], h[3]); *(u32x2_t*)(HB + o2) = w;
                        ss += (h[0] * h[0] + h[1] * h[1]) + (h[2] * h[2] + h[3] * h[3]); }
                ss += __shfl_xor(ss, 16); ss += __shfl_xor(ss, 32);
                if (fq == 0) ssq[(size_t)row * 16 + u.pn * 4 + wc] = ss; }
    }
};
typedef _Float16 f16x2_t __attribute__((ext_vector_type(2)));
__device__ __forceinline__ unsigned pkh(float lo, float hi) { f16x2_t h = {(_Float16)lo, (_Float16)hi}; return __builtin_bit_cast(unsigned, h); }
struct EpiScore {
    static constexpr bool PERM = false, AFTER_DRAIN = false, HAS_MID = false;
    const float* ssq; unsigned short* SC;
    __device__ __forceinline__ void operator()(const f32x4 (&acc)[2][2][4][2], const Unit& u, int wr, int wc, int fr, int fq) const {
#pragma unroll
        for (int ai = 0; ai < 2; ++ai)
#pragma unroll
            for (int m = 0; m < 4; ++m) { const int row = u.pm * BM + ai * HALF + wr * 64 + m * 16 + fr;
                const f32x4* sp = (const f32x4*)(ssq + (size_t)row * 16); const f32x4 s0 = sp[0], s1 = sp[1], s2 = sp[2], s3 = sp[3];
                const float tot = (((s0[0] + s0[1]) + (s0[2] + s0[3])) + ((s1[0] + s1[1]) + (s1[2] + s1[3]))) + (((s2[0] + s2[1]) + (s2[2] + s2[3])) + ((s3[0] + s3[1]) + (s3[2] + s3[3])));
                const float rstd = 1.0f / sqrtf(tot * (1.0f / DM) + EPS);
                unsigned short* rp = SC + (size_t)row * SCW + u.pn * BM + wc * 32 + 4 * fq;
#pragma unroll
                for (int bj = 0; bj < 2; ++bj)
#pragma unroll
                    for (int n = 0; n < 2; ++n) { const f32x4 v = acc[ai][bj][m][n] * rstd; u32x2_t w; w.x = pkh(v[0], v[1]); w.y = pkh(v[2], v[3]); *(u32x2_t*)(rp + bj * HALF + n * 16) = w; } }
    }
};
}

#define LAS __attribute__((address_space(3)))
namespace attn {
typedef unsigned short bf16_t;
typedef short bf16x8 __attribute__((ext_vector_type(8)));
typedef short s16x4 __attribute__((ext_vector_type(4)));
typedef float f32x16 __attribute__((ext_vector_type(16)));
typedef unsigned u32x4 __attribute__((ext_vector_type(4)));
constexpr int LDS_K = 0, LDS_V = 32768;
constexpr int LDS_BIAS = 65536;
constexpr int LDS_BYTES = 65536 + 3072;
constexpr float THR = 8.0f;
__device__ __forceinline__ int crow(int r, int hi) { return (r & 3) + 8 * (r >> 2) + 4 * hi; }
__device__ __forceinline__ s16x4 vtr(const LAS char* p) { return __builtin_bit_cast(s16x4, __builtin_amdgcn_ds_read_tr16_b64_v4i16((LAS s16x4*)p)); }
__device__ __forceinline__ float xhalf_max(float v) { auto rr = __builtin_amdgcn_permlane32_swap(__float_as_uint(v), __float_as_uint(v), false, false); return fmaxf(__uint_as_float(rr[0]), __uint_as_float(rr[1])); }
__device__ __forceinline__ float xhalf_sum(float v) { auto rr = __builtin_amdgcn_permlane32_swap(__float_as_uint(v), __float_as_uint(v), false, false); return __uint_as_float(rr[0]) + __uint_as_float(rr[1]); }
#ifndef ATTN_CLEANM
#define ATTN_CLEANM 0
#endif
#ifndef ATTN_PRIO
#define ATTN_PRIO 1
#endif
__device__ __forceinline__ float max3f(float a, float b, float c) { float r; asm("v_max3_f32 %0, %1, %2, %3" : "=v"(r) : "v"(a), "v"(b), "v"(c)); return r; }
__device__ __forceinline__ float max2f(float a, float b) { float r; asm("v_max_f32_e32 %0, %1, %2" : "=v"(r) : "v"(a), "v"(b)); return r; }
#define ATT_BAR() do { asm volatile("s_waitcnt lgkmcnt(0)" ::: "memory"); __builtin_amdgcn_s_barrier(); asm volatile("" ::: "memory"); } while (0)

template <bool WIN, int XV = 0, bool NOMAX = false>
__device__ __forceinline__ void attn_unit(LAS char* lds, const bf16_t* Q, const bf16_t* Kimg, const bf16_t* Vimg, bf16_t* O, int b, int h, int qblk, const float* bias_h  , float sink_l2) {
    const int tid = threadIdx.x, lane = tid & 63, r32 = lane & 31, hi = lane >> 5; const int wid = __builtin_amdgcn_readfirstlane(tid >> 6); const int grp = wid >> 2;
    const int q0 = qblk * 256, qw0 = q0 + 32 * wid, qrow = qw0 + r32; const size_t grow = (size_t)b * SEQ + qrow;
    const int kvh = h >> 2;
    int t_lo = 0, t_hi = SEQ / 64 - 1;
    if (WIN) { t_lo = q0 / 64 - 2; if (t_lo < 0) t_lo = 0; t_hi = q0 / 64 + 5; if (t_hi > SEQ / 64 - 1) t_hi = SEQ / 64 - 1; }
    const int n = t_hi - t_lo + 1;
    const bf16_t* Kb = Kimg + ((size_t)((b * NKV + kvh) * (SEQ / 64) + t_lo) << 12) + tid * 8;
    const bf16_t* Vb = Vimg + ((size_t)((b * NKV + kvh) * (SEQ / 64) + t_lo) << 12) + tid * 8;
    bf16x8 qr[4];
#pragma unroll
    for (int d0 = 0; d0 < 4; ++d0) qr[d0] = *(const bf16x8*)(Q + grow * (2 * QW) + h * HD + d0 * 16 + hi * 8);
    LAS float* biasl = (LAS float*)(lds + LDS_BIAS);
    if (WIN) { for (int j = tid; j < 768; j += 512) biasl[j] = (j >= 256 && j <= 512) ? bias_h[j - 256] : -1e30f; }
    u32x4 kreg, vreg;
    { const u32x4 k0 = *(const u32x4*)Kb, v0 = *(const u32x4*)Vb, k1 = *(const u32x4*)(Kb + 4096), v1 = *(const u32x4*)(Vb + 4096);
      kreg = *(const u32x4*)(Kb + 2 * 4096); vreg = *(const u32x4*)(Vb + 2 * 4096);
      *(LAS u32x4*)(lds + LDS_K + tid * 16) = k0; *(LAS u32x4*)(lds + LDS_V + tid * 16) = v0;
      *(LAS u32x4*)(lds + LDS_K + 8192 + tid * 16) = k1; *(LAS u32x4*)(lds + LDS_V + 8192 + tid * 16) = v1; }
    ATT_BAR();
    if (grp) ATT_BAR();
    f32x16 o0 = {}, o1 = {}, p0, p1, negm;
    float mref = WIN ? sink_l2 : 0.0f, lsum = (WIN && hi == 0) ? 1.0f : 0.0f;
#pragma unroll
    for (int r = 0; r < 16; ++r) negm[r] = -mref;
    const int vlane = ((lane >> 4) & 1) * 32 + (lane & 3) * 8 + (4 * hi + ((lane & 15) >> 2)) * 64;
    const LAS char* kfr = lds + LDS_K + hi * 1024 + r32 * 16;
    u32x4 pk[4]; bf16x8 kf[8], vf[8];
#define ATT_LDK(sl) do { const LAS char* kp_ = kfr + (sl) * 8192; \
        _Pragma("unroll") for (int d0 = 0; d0 < 4; ++d0) { kf[2 * d0] = *(const LAS bf16x8*)(kp_ + d0 * 2048); kf[2 * d0 + 1] = *(const LAS bf16x8*)(kp_ + d0 * 2048 + 512); } } while (0)
#define ATT_LDV(sl) do { const LAS char* vp_ = lds + LDS_V + (sl) * 8192 + vlane; \
        _Pragma("unroll") for (int ks = 0; ks < 4; ++ks) { \
            const s16x4 l0 = vtr(vp_ + ks * 1024), h0 = vtr(vp_ + ks * 1024 + 512), l1 = vtr(vp_ + 4096 + ks * 1024), h1 = vtr(vp_ + 4096 + ks * 1024 + 512); \
            vf[2 * ks] = (bf16x8){l0[0], l0[1], l0[2], l0[3], h0[0], h0[1], h0[2], h0[3]}; vf[2 * ks + 1] = (bf16x8){l1[0], l1[1], l1[2], l1[3], h1[0], h1[1], h1[2], h1[3]}; } } while (0)
#define ATT_QK() do { \
        if (NOMAX) { const f32x16 z_ = {}; p0 = __builtin_amdgcn_mfma_f32_32x32x16_bf16(kf[0], qr[0], z_, 0, 0, 0); p1 = __builtin_amdgcn_mfma_f32_32x32x16_bf16(kf[1], qr[0], z_, 0, 0, 0); } \
        else { p0 = __builtin_amdgcn_mfma_f32_32x32x16_bf16(kf[0], qr[0], negm, 0, 0, 0); p1 = __builtin_amdgcn_mfma_f32_32x32x16_bf16(kf[1], qr[0], negm, 0, 0, 0); } \
        _Pragma("unroll") for (int d0 = 1; d0 < 4; ++d0) { p0 = __builtin_amdgcn_mfma_f32_32x32x16_bf16(kf[2 * d0], qr[d0], p0, 0, 0, 0); p1 = __builtin_amdgcn_mfma_f32_32x32x16_bf16(kf[2 * d0 + 1], qr[d0], p1, 0, 0, 0); } } while (0)
#define ATT_PV() do { \
        _Pragma("unroll") for (int ks = 0; ks < 4; ++ks) { const bf16x8 pf = __builtin_bit_cast(bf16x8, pk[ks]); \
            o0 = __builtin_amdgcn_mfma_f32_32x32x16_bf16(vf[2 * ks], pf, o0, 0, 0, 0); o1 = __builtin_amdgcn_mfma_f32_32x32x16_bf16(vf[2 * ks + 1], pf, o1, 0, 0, 0); } } while (0)
    int ia = 0, ib = n - 1;
    if (WIN) { int lo_t = (qw0 - 128) >> 6; if (lo_t < t_lo) lo_t = t_lo; int hi_t = (qw0 + 31 + 128) >> 6; if (hi_t > t_hi) hi_t = t_hi; ia = lo_t - t_lo; ib = hi_t - t_lo; }
#define ATT_STAGE(i) do { if ((i) + 2 < n) { const int sl_ = ((i) + 2) & 3; *(LAS u32x4*)(lds + LDS_K + sl_ * 8192 + tid * 16) = kreg; *(LAS u32x4*)(lds + LDS_V + sl_ * 8192 + tid * 16) = vreg; \
            if ((i) + 3 < n) { kreg = *(const u32x4*)(Kb + (size_t)((i) + 3) * 4096); vreg = *(const u32x4*)(Vb + (size_t)((i) + 3) * 4096); } } } while (0)
    bool first = !WIN;
    int i = 0;
    if (ia == 0) { ATT_LDK(0); asm volatile("s_waitcnt lgkmcnt(0)" ::: "memory"); ATT_QK(); }
    ATT_BAR();
    for (; i < ia; ++i) {
        ATT_STAGE(i);
        ATT_BAR();
        if (i + 1 == ia) { ATT_LDK((i + 1) & 3); asm volatile("s_waitcnt lgkmcnt(0)" ::: "memory"); ATT_QK(); }
        ATT_BAR();
    }
    for (; i <= ib; ++i) {
        ATT_LDV(i & 3);
        __builtin_amdgcn_sched_barrier(0);
        asm volatile("s_nop 7" : "+v"(p0), "+v"(p1));
        if (WIN) {
            const LAS float* bp = biasl + (64 * (t_lo + i) - qrow + 4 * hi + 384);
#pragma unroll
            for (int r = 0; r < 16; ++r) { p0[r] += bp[(r & 3) + 8 * (r >> 2)]; p1[r] += bp[32 + (r & 3) + 8 * (r >> 2)]; }
        }
        if (!NOMAX) {
        float ra = max3f(p0[0], p0[1], p1[0]), rb = max3f(p0[2], p0[3], p1[1]); ra = max3f(ra, p1[2], p1[3]);
#pragma unroll
        for (int r = 4; r < 16; r += 4) { ra = max3f(ra, p0[r], p0[r + 1]); rb = max3f(rb, p0[r + 2], p0[r + 3]); ra = max3f(ra, p1[r], p1[r + 1]); rb = max3f(rb, p1[r + 2], p1[r + 3]); }
        float rm = xhalf_max(max2f(ra, rb));
        if (first || __builtin_amdgcn_ballot_w64(rm > THR) != 0ull) {
            const float delta = first ? rm : fmaxf(rm, 0.0f); const float f = first ? 1.0f : __builtin_amdgcn_exp2f(-delta);
            mref += delta; lsum *= f;
#pragma unroll
            for (int r = 0; r < 16; ++r) { p0[r] -= delta; p1[r] -= delta; o0[r] *= f; o1[r] *= f; negm[r] = -mref; }
            first = false;
        }
        }
        float ps = 0.f;
#pragma unroll
        for (int r = 0; r < 16; ++r) { if (XV == 1) { p0[r] *= 0.5f; p1[r] *= 0.5f; } else { p0[r] = __builtin_amdgcn_exp2f(p0[r]); p1[r] = __builtin_amdgcn_exp2f(p1[r]); } ps += p0[r] + p1[r]; }
        lsum += ps;
#pragma unroll
        for (int q = 0; q < 4; ++q) { pk[0][q] = pkbf(p0[2 * q], p0[2 * q + 1]); pk[1][q] = pkbf(p0[8 + 2 * q], p0[9 + 2 * q]); pk[2][q] = pkbf(p1[2 * q], p1[2 * q + 1]); pk[3][q] = pkbf(p1[8 + 2 * q], p1[9 + 2 * q]); }
        ATT_STAGE(i);
        asm volatile("s_waitcnt lgkmcnt(0)" : "+v"(vf[0]), "+v"(vf[1]), "+v"(vf[2]), "+v"(vf[3]), "+v"(vf[4]), "+v"(vf[5]), "+v"(vf[6]), "+v"(vf[7]), "+v"(pk[0]), "+v"(pk[1]), "+v"(pk[2]), "+v"(pk[3]) : : "memory");
        if (XV != 3) ATT_BAR(); else asm volatile("s_waitcnt lgkmcnt(0)" ::: "memory");
        __builtin_amdgcn_s_setprio(ATTN_PRIO);
#if ATTN_CLEANM
        if (i < ib) { ATT_LDK((i + 1) & 3); __builtin_amdgcn_sched_barrier(0); }
#else
        if (i < ib) ATT_LDK((i + 1) & 3);
#endif
        if (XV != 2) { ATT_PV(); if (i < ib) ATT_QK(); } else { asm volatile("" : "+v"(kf[0]), "+v"(kf[7]), "+v"(vf[0]), "+v"(vf[7])); }
        __builtin_amdgcn_s_setprio(0);
        ATT_BAR();
    }
    for (; i < n; ++i) { ATT_STAGE(i); ATT_BAR(); ATT_BAR(); }
#undef ATT_STAGE
#undef ATT_QK
#undef ATT_PV
#undef ATT_LDK
#undef ATT_LDV
    const float inv = 1.0f / xhalf_sum(lsum);
    bf16_t* Orow = O + grow * (2 * QW) + h * HD + 4 * hi;
#pragma unroll
    for (int g = 0; g < 4; ++g) {
        u32x2_t w0, w1;
        w0.x = pkbf(o0[4 * g] * inv, o0[4 * g + 1] * inv); w0.y = pkbf(o0[4 * g + 2] * inv, o0[4 * g + 3] * inv);
        w1.x = pkbf(o1[4 * g] * inv, o1[4 * g + 1] * inv); w1.y = pkbf(o1[4 * g + 2] * inv, o1[4 * g + 3] * inv);
        *(u32x2_t*)(Orow + 8 * g) = w0; *(u32x2_t*)(Orow + 32 + 8 * g) = w1;
    }
    if (!grp) ATT_BAR();
}
}

namespace peer {
typedef unsigned u32x4 __attribute__((ext_vector_type(4)));
typedef float f32x4 __attribute__((ext_vector_type(4)));
constexpr int WAVE_LDS = 2048;

template <int CTRL> __device__ __forceinline__ int dppi(int x) { return __builtin_amdgcn_mov_dpp(x, CTRL, 0xf, 0xf, true); }
template <int CTRL> __device__ __forceinline__ float dppf(float x) { return __builtin_bit_cast(float, __builtin_amdgcn_mov_dpp(__builtin_bit_cast(int, x), CTRL, 0xf, 0xf, true)); }
constexpr int XOR1 = 0xB1, XOR2 = 0x4E, XOR7 = 0x141, XOR8 = 0x128;
__device__ __forceinline__ float wave_sum(float x) {
    x += dppf<XOR1>(x); x += dppf<XOR2>(x); x += dppf<XOR7>(x); x += dppf<XOR8>(x);
    auto s = __builtin_amdgcn_permlane16_swap(__float_as_uint(x), __float_as_uint(x), false, false); x = __uint_as_float(s[0]) + __uint_as_float(s[1]);
    auto t = __builtin_amdgcn_permlane32_swap(__float_as_uint(x), __float_as_uint(x), false, false); return __uint_as_float(t[0]) + __uint_as_float(t[1]);
}
__device__ __forceinline__ float dot2bf(unsigned a, unsigned b, float c) { return __builtin_amdgcn_fdot2_f32_bf16(__builtin_bit_cast(bf16x2_t, a), __builtin_bit_cast(bf16x2_t, b), c, false); }
__device__ __forceinline__ unsigned getw(const u32x4& v, int i) { return i == 0 ? v.x : i == 1 ? v.y : i == 2 ? v.z : v.w; }
__device__ __forceinline__ int okey(float f, int lowbits, int payload) { int b = __float_as_int(f); b ^= (b >> 31) & 0x7fffffff; return (b & ~((1 << lowbits) - 1)) | payload; }
__device__ __forceinline__ float kval(int k, int lowbits) { int b = (k & ~((1 << lowbits) - 1)) | (1 << (lowbits - 1)); b ^= (b >> 31) & 0x7fffffff; return __int_as_float(b); }
#define CE_DESC(a, b) do { const int _x = (a), _y = (b); (a) = _x > _y ? _x : _y; (b) = _x > _y ? _y : _x; } while (0)
template <int N> __device__ __forceinline__ void bitonic_sort_desc(int (&a)[N]) {
#pragma unroll
    for (int k = 2; k <= N; k <<= 1)
#pragma unroll
        for (int j = k >> 1; j > 0; j >>= 1)
#pragma unroll
            for (int i = 0; i < N; ++i) { const int l = i ^ j; if (l > i) { if ((i & k) == 0) CE_DESC(a[i], a[l]); else CE_DESC(a[l], a[i]); } }
}
template <int N> __device__ __forceinline__ void bitonic_merge_desc(int (&a)[N]) {
#pragma unroll
    for (int j = N >> 1; j > 0; j >>= 1)
#pragma unroll
        for (int i = 0; i < N; ++i) { const int l = i ^ j; if (l > i) CE_DESC(a[i], a[l]); }
}
__device__ __forceinline__ unsigned long long cand_table(int q8) {
    unsigned long long r = 0xFFFFFFFFFFFFFFFFull; int n = 0;
#pragma unroll
    for (int i = 0; i < 16; ++i)
#pragma unroll
        for (int j = 0; j < 16; ++j) if ((i + 1) * (j + 1) <= 16) { if (n / 7 == q8) { const int s = n % 7; r = (r & ~(0xFFull << (8 * s))) | ((unsigned long long)(i * 16 + j) << (8 * s)); } ++n; }
    return r;
}

__device__ __forceinline__ void route_token(LAS char* wl, int lane, int t, unsigned long long ct, const unsigned short* SC  , const unsigned short* H  , const float* gffn, unsigned short* E, float* G, unsigned short* XN2) {
    LAS int* skeys = (LAS int*)wl;
    {
        const int c = lane >> 2, qq = lane & 3; const u32x4* sp = (const u32x4*)(SC + (size_t)t * SCW + c * NKEYS + qq * 32);
        int a[16], bb[16];
#pragma unroll
        for (int i = 0; i < 2; ++i) { const u32x4 v = sp[i];
#pragma unroll
            for (int j = 0; j < 4; ++j) { const unsigned w = getw(v, j); const pg8::f16x2_t h = __builtin_bit_cast(pg8::f16x2_t, w);
                a[8 * i + 2 * j] = okey((float)h.x, 7, 127 - (qq * 32 + 8 * i + 2 * j)); a[8 * i + 2 * j + 1] = okey((float)h.y, 7, 127 - (qq * 32 + 8 * i + 2 * j + 1)); } }
#pragma unroll
        for (int i = 0; i < 2; ++i) { const u32x4 v = sp[2 + i];
#pragma unroll
            for (int j = 0; j < 4; ++j) { const unsigned w = getw(v, j); const pg8::f16x2_t h = __builtin_bit_cast(pg8::f16x2_t, w);
                bb[8 * i + 2 * j] = okey((float)h.x, 7, 127 - (qq * 32 + 16 + 8 * i + 2 * j)); bb[8 * i + 2 * j + 1] = okey((float)h.y, 7, 127 - (qq * 32 + 16 + 8 * i + 2 * j + 1)); } }
        bitonic_sort_desc<16>(a); bitonic_sort_desc<16>(bb);
#pragma unroll
        for (int i = 0; i < 16; ++i) a[i] = a[i] > bb[15 - i] ? a[i] : bb[15 - i];
        bitonic_merge_desc<16>(a);
#pragma unroll
        for (int i = 0; i < 16; ++i) bb[i] = dppi<XOR1>(a[15 - i]);
#pragma unroll
        for (int i = 0; i < 16; ++i) a[i] = a[i] > bb[i] ? a[i] : bb[i];
        bitonic_merge_desc<16>(a);
#pragma unroll
        for (int i = 0; i < 16; ++i) bb[i] = dppi<XOR2>(a[15 - i]);
#pragma unroll
        for (int i = 0; i < 16; ++i) a[i] = a[i] > bb[i] ? a[i] : bb[i];
        bitonic_merge_desc<16>(a);
        if (qq == 0) {
#pragma unroll
            for (int i = 0; i < 4; ++i) *(LAS u32x4*)(skeys + c * 16 + 4 * i) = (u32x4){(unsigned)a[4 * i], (unsigned)a[4 * i + 1], (unsigned)a[4 * i + 2], (unsigned)a[4 * i + 3]};
        }
    }
    asm volatile("s_waitcnt lgkmcnt(0)" ::: "memory");
    {
        const int hh = lane >> 3, q8 = lane & 7;
        int a[16];
#pragma unroll
        for (int s = 0; s < 8; ++s) {
            const int code = s < 7 ? (int)((ct >> (8 * s)) & 0xFF) : 0xFF;
            const int ci = code == 0xFF ? 0 : code;
            const int ka = skeys[(2 * hh) * 16 + (ci >> 4)], kb = skeys[(2 * hh + 1) * 16 + (ci & 15)];
            const float sum = kval(ka, 7) + kval(kb, 7);
            a[s] = code == 0xFF ? (int)0x80000000 : okey(sum, 8, 255 - code);
        }
        {
            int c8[8];
#pragma unroll
            for (int i = 0; i < 8; ++i) c8[i] = a[i];
            bitonic_sort_desc<8>(c8);
#pragma unroll
            for (int i = 0; i < 8; ++i) a[i] = c8[i];
        }
#pragma unroll
        for (int i = 0; i < 8; ++i) a[8 + i] = dppi<XOR1>(a[i]);
        { int tmp[8];
#pragma unroll
          for (int i = 0; i < 8; ++i) tmp[i] = a[8 + i];
#pragma unroll
          for (int i = 0; i < 8; ++i) a[8 + i] = tmp[7 - i]; }
        bitonic_merge_desc<16>(a);
        int bb[16];
#pragma unroll
        for (int i = 0; i < 16; ++i) bb[i] = dppi<XOR2>(a[15 - i]);
#pragma unroll
        for (int i = 0; i < 16; ++i) a[i] = a[i] > bb[i] ? a[i] : bb[i];
        bitonic_merge_desc<16>(a);
#pragma unroll
        for (int i = 0; i < 16; ++i) bb[i] = dppi<XOR7>(a[15 - i]);
#pragma unroll
        for (int i = 0; i < 16; ++i) a[i] = a[i] > bb[i] ? a[i] : bb[i];
        bitonic_merge_desc<16>(a);
        int k0 = a[0], k1 = a[1];
#pragma unroll
        for (int i = 1; i < 8; ++i) { k0 = q8 == i ? a[2 * i] : k0; k1 = q8 == i ? a[2 * i + 1] : k1; }
        const float mx = kval(a[0], 8);
        const int c0 = 255 - (k0 & 255), c1 = 255 - (k1 & 255);
        const int ka0 = skeys[(2 * hh) * 16 + (c0 >> 4)], kb0 = skeys[(2 * hh + 1) * 16 + (c0 & 15)];
        const int ka1 = skeys[(2 * hh) * 16 + (c1 >> 4)], kb1 = skeys[(2 * hh + 1) * 16 + (c1 & 15)];
        const float s0 = kval(ka0, 7) + kval(kb0, 7), s1 = kval(ka1, 7) + kval(kb1, 7);
        const float e0 = __expf(s0 - mx), e1 = __expf(s1 - mx);
        float z = e0 + e1; z += dppf<XOR1>(z); z += dppf<XOR2>(z); z += dppf<XOR7>(z);
        const float rz = 1.0f / z;
        const unsigned e0i = (unsigned)((127 - (ka0 & 127)) * NKEYS + (127 - (kb0 & 127))), e1i = (unsigned)((127 - (ka1 & 127)) * NKEYS + (127 - (kb1 & 127)));
        *(unsigned*)(E + (size_t)t * 128 + hh * 16 + 2 * q8) = e0i | (e1i << 16);
        *(f32x2_t*)(G + (size_t)t * 128 + hh * 16 + 2 * q8) = (f32x2_t){e0 * rz, e1 * rz};
    }
    {
        const u32x2_t* hr = (const u32x2_t*)(H + (size_t)t * DM) + lane; f32x4 v[4]; float ss = 0.f;
#pragma unroll
        for (int j = 0; j < 4; ++j) { const u32x2_t hw = hr[64 * j]; v[j] = (f32x4){bflo(hw.x), bfhi(hw.x), bflo(hw.y), bfhi(hw.y)}; ss += (v[j][0] * v[j][0] + v[j][1] * v[j][1]) + (v[j][2] * v[j][2] + v[j][3] * v[j][3]); }
        const float rstd = 1.0f / sqrtf(wave_sum(ss) * (1.0f / DM) + EPS);
        unsigned long long* o8 = (unsigned long long*)(XN2 + (size_t)t * DM) + lane;
#pragma unroll
        for (int j = 0; j < 4; ++j) { const f32x4 g = *((const f32x4*)gffn + lane + 64 * j);
            o8[64 * j] = (unsigned long long)pkbf(v[j][0] * rstd * g[0], v[j][1] * rstd * g[1]) | ((unsigned long long)pkbf(v[j][2] * rstd * g[2], v[j][3] * rstd * g[3]) << 32); }
    }
    asm volatile("s_waitcnt lgkmcnt(0)" ::: "memory");
}

constexpr size_t SLICE_BYTES = (size_t)NEXP * 128;
__device__ __forceinline__ float wave_max(float x) {
    x = fmaxf(x, dppf<XOR1>(x)); x = fmaxf(x, dppf<XOR2>(x)); x = fmaxf(x, dppf<XOR7>(x)); x = fmaxf(x, dppf<XOR8>(x));
    auto s = __builtin_amdgcn_permlane16_swap(__float_as_uint(x), __float_as_uint(x), false, false); x = fmaxf(__uint_as_float(s[0]), __uint_as_float(s[1]));
    auto t = __builtin_amdgcn_permlane32_swap(__float_as_uint(x), __float_as_uint(x), false, false); return fmaxf(__uint_as_float(t[0]), __uint_as_float(t[1]));
}
__device__ __forceinline__ void table_rows4_fp8(const float* src, unsigned char* T8, float* INV, int e0, int es, int lane) {
    f32x4 v[4][4];
#pragma unroll
    for (int i = 0; i < 4; ++i) { const f32x4* p = (const f32x4*)(src + (size_t)(e0 + i * es) * DM + 16 * lane);
#pragma unroll
        for (int q = 0; q < 4; ++q) v[i][q] = __builtin_nontemporal_load(p + q); }
#pragma unroll
    for (int i = 0; i < 4; ++i) {
        float mx = 0.f;
#pragma unroll
        for (int q = 0; q < 4; ++q) mx = fmaxf(mx, fmaxf(fmaxf(fabsf(v[i][q][0]), fabsf(v[i][q][1])), fmaxf(fabsf(v[i][q][2]), fabsf(v[i][q][3]))));
        mx = wave_max(mx);
        const float sc = mx > 0.f ? 448.0f / mx : 1.0f;
        unsigned o[4];
#pragma unroll
        for (int q = 0; q < 4; ++q) { unsigned w = 0; w = __builtin_amdgcn_cvt_pk_fp8_f32(v[i][q][0] * sc, v[i][q][1] * sc, w, false); w = __builtin_amdgcn_cvt_pk_fp8_f32(v[i][q][2] * sc, v[i][q][3] * sc, w, true); o[q] = w; }
        const int e = e0 + i * es;
        *(u32x4*)(T8 + (size_t)(lane >> 3) * SLICE_BYTES + (size_t)e * 128 + (lane & 7) * 16) = (u32x4){o[0], o[1], o[2], o[3]};
        if (lane == 0) INV[e] = mx > 0.f ? mx * (1.0f / 448.0f) : 1.0f;
    }
}
__device__ __forceinline__ void tables_fp8(const float* peer_u, const float* peer_v, unsigned char* U8, unsigned char* V8, float* INVU, float* INVV, int r0, int r1, int w, int nw, int lane) {
    for (int e = r0 + w; e < r1; e += 4 * nw) {
        if (e + 3 * nw < r1) { table_rows4_fp8(peer_u, U8, INVU, e, nw, lane); table_rows4_fp8(peer_v, V8, INVV, e, nw, lane); }
        else for (int e2 = e; e2 < r1; e2 += nw) { table_rows4_fp8(peer_u, U8, INVU, e2, 0, lane); table_rows4_fp8(peer_v, V8, INVV, e2, 0, lane); }
    }
}
struct ECtx { u32x4 ea, eb; };
struct XCtx { u32x4 xa, xb; };
__device__ __forceinline__ ECtx e_ctx(int lane, int t, const unsigned short* E) { ECtx c; c.ea = *(const u32x4*)(E + (size_t)t * 128 + (lane >> 3) * 16); c.eb = *(const u32x4*)(E + (size_t)t * 128 + (lane >> 3) * 16 + 8); return c; }
__device__ __forceinline__ XCtx x_ctx(int lane, int t, int s, const unsigned short* XN2) { XCtx c; c.xa = *(const u32x4*)(XN2 + (size_t)t * DM + s * 128 + (lane & 7) * 16); c.xb = *(const u32x4*)(XN2 + (size_t)t * DM + s * 128 + (lane & 7) * 16 + 8); return c; }
__device__ __forceinline__ void g_rows(u32x4 (&row)[16], const ECtx& c, const unsigned char* T8s, int c8) {
#pragma unroll
    for (int j = 0; j < 16; ++j) { const unsigned ew = getw(j < 8 ? c.ea : c.eb, (j & 7) >> 1); const unsigned e = (j & 1) ? (ew >> 16) : (ew & 0xffffu);
        row[j] = *(const u32x4*)(T8s + (size_t)e * 128 + c8 * 16); }
}
__device__ __forceinline__ void u_compute(int lane, int t, int s, const XCtx& c, const u32x4 (&row)[16], unsigned short* PA) {
    const int rs = lane >> 3, c8 = lane & 7;
    f32x2_t xf[8];
#pragma unroll
    for (int i = 0; i < 4; ++i) { const unsigned wa = getw(c.xa, i), wb = getw(c.xb, i); xf[i] = (f32x2_t){bflo(wa), bfhi(wa)}; xf[4 + i] = (f32x2_t){bflo(wb), bfhi(wb)}; }
    float part[16];
#pragma unroll
    for (int j = 0; j < 16; ++j) {
        f32x2_t acc = {0.f, 0.f};
#pragma unroll
        for (int w = 0; w < 4; ++w) { const unsigned q = getw(row[j], w);
            acc = __builtin_elementwise_fma(__builtin_amdgcn_cvt_pk_f32_fp8(q, false), xf[2 * w], acc); acc = __builtin_elementwise_fma(__builtin_amdgcn_cvt_pk_f32_fp8(q, true), xf[2 * w + 1], acc); }
        float p = acc.x + acc.y; p += dppf<XOR1>(p); p += dppf<XOR2>(p); p += dppf<XOR7>(p); part[j] = p;
    }
    float p0 = part[0], p1 = part[1];
#pragma unroll
    for (int i = 1; i < 8; ++i) { p0 = c8 == i ? part[2 * i] : p0; p1 = c8 == i ? part[2 * i + 1] : p1; }
    *(unsigned*)(PA + ((size_t)t * 8 + s) * 128 + rs * 16 + 2 * c8) = pkbf(p0, p1);
}
#define TCL(t_) ((t_) < NTOK ? (t_) : NTOK - 1)
__device__ __forceinline__ void upass_slice(int lane, int s, int wv, int nwv, const unsigned char* U8s, const unsigned short* E, const unsigned short* XN2, unsigned short* PA) {
    const int c8 = lane & 7;
    int t = wv; if (t >= NTOK) return;
    ECtx eA = e_ctx(lane, t, E), eB = e_ctx(lane, TCL(t + nwv), E); XCtx xA = x_ctx(lane, t, s, XN2), xB;
    u32x4 rA[16], rB[16];
    g_rows(rA, eA, U8s, c8);
    for (; t < NTOK; t += 2 * nwv) {
        eA = e_ctx(lane, TCL(t + 2 * nwv), E); xB = x_ctx(lane, TCL(t + nwv), s, XN2); g_rows(rB, eB, U8s, c8);
        u_compute(lane, t, s, xA, rA, PA);
        eB = e_ctx(lane, TCL(t + 3 * nwv), E); xA = x_ctx(lane, TCL(t + 2 * nwv), s, XN2); g_rows(rA, eA, U8s, c8);
        if (t + nwv < NTOK) u_compute(lane, t + nwv, s, xB, rB, PA);
    }
}
__device__ __forceinline__ void wpass_token(int lane, int t, const unsigned short* E, const float* G, const unsigned short* PA, const float* INVU, const float* INVV, float* W) {
    float a0 = 0.f, a1 = 0.f;
#pragma unroll
    for (int s = 0; s < 8; ++s) { const unsigned w = *(const unsigned*)(PA + ((size_t)t * 8 + s) * 128 + 2 * lane); a0 += bflo(w); a1 += bfhi(w); }
    const unsigned ew = *(const unsigned*)(E + (size_t)t * 128 + 2 * lane); const unsigned e0 = ew & 0xffffu, e1 = ew >> 16;
    const f32x2_t g = *(const f32x2_t*)(G + (size_t)t * 128 + 2 * lane);
    a0 *= INVU[e0]; a1 *= INVU[e1];
    const float w0 = g.x * 0.5f * a0 * (1.0f + erff(a0 * 0.70710678118654752f)) * INVV[e0], w1 = g.y * 0.5f * a1 * (1.0f + erff(a1 * 0.70710678118654752f)) * INVV[e1];
    *(f32x2_t*)(W + (size_t)t * 128 + 2 * lane) = (f32x2_t){w0, w1};
}
struct WCtx { f32x4 w0, w1, w2, w3; };
__device__ __forceinline__ WCtx w_ctx(int lane, int t, const float* W) { const f32x4* wp = (const f32x4*)(W + (size_t)t * 128 + (lane >> 3) * 16); WCtx c; c.w0 = wp[0]; c.w1 = wp[1]; c.w2 = wp[2]; c.w3 = wp[3]; return c; }
__device__ __forceinline__ void v_compute(int lane, int t, int s, const WCtx& wc, const u32x4 (&row)[16], unsigned short* PO) {
    const int rs = lane >> 3, c8 = lane & 7;
    f32x2_t o[8];
#pragma unroll
    for (int i = 0; i < 8; ++i) o[i] = (f32x2_t){0.f, 0.f};
#pragma unroll
    for (int j = 0; j < 16; ++j) {
        const f32x4 wq = j < 4 ? wc.w0 : j < 8 ? wc.w1 : j < 12 ? wc.w2 : wc.w3; const int jj = j & 3; const float wj = jj == 0 ? wq.x : jj == 1 ? wq.y : jj == 2 ? wq.z : wq.w; const f32x2_t w2v = {wj, wj};
#pragma unroll
        for (int w = 0; w < 4; ++w) { const unsigned q = getw(row[j], w);
            o[2 * w] = __builtin_elementwise_fma(__builtin_amdgcn_cvt_pk_f32_fp8(q, false), w2v, o[2 * w]); o[2 * w + 1] = __builtin_elementwise_fma(__builtin_amdgcn_cvt_pk_f32_fp8(q, true), w2v, o[2 * w + 1]); }
    }
    float of[16];
#pragma unroll
    for (int i = 0; i < 8; ++i) { of[2 * i] = o[i].x; of[2 * i + 1] = o[i].y; }
#pragma unroll
    for (int i = 0; i < 16; ++i) { float x = of[i]; x += dppf<XOR8>(x);
        auto s1 = __builtin_amdgcn_permlane16_swap(__float_as_uint(x), __float_as_uint(x), false, false); x = __uint_as_float(s1[0]) + __uint_as_float(s1[1]);
        auto s2 = __builtin_amdgcn_permlane32_swap(__float_as_uint(x), __float_as_uint(x), false, false); of[i] = __uint_as_float(s2[0]) + __uint_as_float(s2[1]); }
    if (rs == 0) {
        unsigned short* po = PO + (size_t)t * DM + s * 128 + c8 * 16;
        *(u32x4*)po = (u32x4){pkbf(of[0], of[1]), pkbf(of[2], of[3]), pkbf(of[4], of[5]), pkbf(of[6], of[7])};
        *(u32x4*)(po + 8) = (u32x4){pkbf(of[8], of[9]), pkbf(of[10], of[11]), pkbf(of[12], of[13]), pkbf(of[14], of[15])};
    }
}
__device__ __forceinline__ void vpass_slice(int lane, int s, int wv, int nwv, const unsigned char* V8s, const unsigned short* E, const float* W, unsigned short* PO) {
    const int c8 = lane & 7;
    int t = wv; if (t >= NTOK) return;
    ECtx eA = e_ctx(lane, t, E), eB = e_ctx(lane, TCL(t + nwv), E); WCtx wA = w_ctx(lane, t, W), wB;
    u32x4 rA[16], rB[16];
    g_rows(rA, eA, V8s, c8);
    for (; t < NTOK; t += 2 * nwv) {
        eA = e_ctx(lane, TCL(t + 2 * nwv), E); wB = w_ctx(lane, TCL(t + nwv), W); g_rows(rB, eB, V8s, c8);
        v_compute(lane, t, s, wA, rA, PO);
        eB = e_ctx(lane, TCL(t + 3 * nwv), E); wA = w_ctx(lane, TCL(t + 2 * nwv), W); g_rows(rA, eA, V8s, c8);
        if (t + nwv < NTOK) v_compute(lane, t + nwv, s, wB, rB, PO);
    }
}
#undef TCL
__device__ __forceinline__ void final_token(int lane, int t, float* Y, const unsigned short* HB, const unsigned short* PO, const float* gfin) {
    f32x4* yr = (f32x4*)(Y + (size_t)t * DM) + lane; const u32x2_t* pr = (const u32x2_t*)(PO + (size_t)t * DM) + lane; const u32x2_t* hr = (const u32x2_t*)(HB + (size_t)t * DM) + lane;
    f32x4 v[4]; float ss = 0.f;
#pragma unroll
    for (int j = 0; j < 4; ++j) { const u32x2_t hw = hr[64 * j]; v[j] = (f32x4){bflo(hw.x), bfhi(hw.x), bflo(hw.y), bfhi(hw.y)}; const u32x2_t p = pr[64 * j]; v[j][0] += bflo(p.x); v[j][1] += bfhi(p.x); v[j][2] += bflo(p.y); v[j][3] += bfhi(p.y);
        ss += (v[j][0] * v[j][0] + v[j][1] * v[j][1]) + (v[j][2] * v[j][2] + v[j][3] * v[j][3]); }
    const float rstd = 1.0f / sqrtf(wave_sum(ss) * (1.0f / DM) + EPS);
#pragma unroll
    for (int j = 0; j < 4; ++j) { const f32x4 g = *((const f32x4*)gfin + lane + 64 * j); yr[64 * j] = (f32x4){v[j][0] * rstd * g[0], v[j][1] * rstd * g[1], v[j][2] * rstd * g[2], v[j][3] * rstd * g[3]}; }
}
}

constexpr int NWAVES = 8;
#ifndef MK_N_LAUNCHES
#define MK_N_LAUNCHES 1
#endif
constexpr int N_LAUNCHES = MK_N_LAUNCHES;
constexpr int PER_PHASE = 7;
#ifndef PROBE
#define PROBE -1
#endif
#ifndef XVAR
#define XVAR 0
#endif
#define NREP(k) ((PROBE == (k)) ? 2 : 1)

typedef unsigned short bf16;
typedef unsigned v4u __attribute__((ext_vector_type(4)));
typedef float f32x4 __attribute__((ext_vector_type(4)));
#define LDS_WAIT() asm volatile("s_waitcnt lgkmcnt(0)" ::: "memory")
#define VM_WAIT() asm volatile("s_waitcnt vmcnt(0)" ::: "memory")

constexpr size_t MiB = 1u << 20;
constexpr size_t WS_CTL = 0, CTL_ZERO_BYTES = 64 * 1024;
constexpr size_t WS_TAB = 1 * MiB;
constexpr size_t WS_SSQ = 1 * MiB + 64 * 1024;
constexpr size_t WS_WIN = 3 * MiB;
constexpr size_t WS_WA = 10 * MiB, WS_WB = 11 * MiB;
constexpr size_t WS_WO = 12 * MiB;
constexpr size_t WS_WE = 14 * MiB;
constexpr size_t WS_U8 = 18 * MiB, WS_V8 = 34 * MiB;
constexpr size_t WS_PA = 50 * MiB;
constexpr size_t WS_INVU = 2 * MiB + 128 * 1024, WS_INVV = WS_INVU + 64 * 1024;
constexpr size_t WS_G = 3 * MiB, WS_E = 11 * MiB;
constexpr size_t WS_W = 114 * MiB, WS_PSS = 122 * MiB;
constexpr int CW_RANK = 8192;
constexpr size_t WS_XN = 82 * MiB;
constexpr size_t WS_ACT = 114 * MiB;
constexpr size_t WS_QA = WS_ACT, WS_QB = WS_ACT + 512 * 2;
constexpr size_t WS_KA = WS_ACT + 32 * MiB, WS_VA = WS_ACT + 36 * MiB, WS_KB = WS_ACT + 40 * MiB, WS_VB = WS_ACT + 44 * MiB;
constexpr size_t WS_GA = WS_ACT + 48 * MiB, WS_GB = WS_ACT + 80 * MiB;
constexpr size_t WS_SC = WS_ACT;
constexpr size_t WS_END = 242 * MiB;
static_assert(WS_GB + 32 * MiB <= WS_END && WS_SC + (size_t)NTOK * SCW * 4 <= WS_END, "d_ws map");

constexpr int RING_BYTES = 131072;
constexpr int MISC_OFF = RING_BYTES + 320;
constexpr int LDS_BYTES = 147456;

#define XB_TMO      128
#define XB_XCNT(j)  (256  + 64 * (j))
#define XB_XSUB(j)  (1280 + 64 * (j))
#define XB_XGEN(j)  (2304 + 64 * (j))
#define XB_TOP      3328
#define XB_TOPGEN   3392
#define XCD_BAR_WORDS 3456
#define XB_SPIN_CAP (1u << 18)

__device__ __forceinline__ unsigned xb_ld(unsigned* p)              { return __hip_atomic_load(p, __ATOMIC_RELAXED, __HIP_MEMORY_SCOPE_AGENT); }
__device__ __forceinline__ unsigned xb_add(unsigned* p, unsigned v) { return __hip_atomic_fetch_add(p, v, __ATOMIC_RELAXED, __HIP_MEMORY_SCOPE_AGENT); }
__device__ __forceinline__ unsigned xb_xcc_id() { return (unsigned)__builtin_amdgcn_s_getreg((3 << 11) | 20) & 0xFu; }
#define XB_SPIN(cond, bar) do { unsigned _sp = 0; while (cond) { __builtin_amdgcn_s_sleep(1); \
    if ((++_sp & 255u) == 0u) { if (xb_ld(&(bar)[XB_TMO])) break; if (_sp > XB_SPIN_CAP) { atomicAdd(&(bar)[XB_TMO], 1u); break; } } } } while (0)

struct XcdBarrier {
    unsigned* bar; unsigned x;
    volatile LAS unsigned* st;
};

__device__ __forceinline__ XcdBarrier xcd_barrier_post(unsigned* bar, volatile LAS unsigned* st) {
    XcdBarrier b; b.bar = bar; b.x = xb_xcc_id(); b.st = st;
    if (threadIdx.x == 0) (void)xb_add(&bar[XB_XCNT(b.x)], 1u);
    return b;
}
__device__ __forceinline__ void xcd_barrier_complete(unsigned* bar, unsigned x, unsigned& nloc, unsigned& nx) {
    const unsigned G = gridDim.x * gridDim.y * gridDim.z;
    unsigned sum, cnt, mine, sp = 0u;
    for (;;) {
        sum = 0u; cnt = 0u; mine = 0u;
#pragma unroll
        for (unsigned j = 0; j < 16; ++j) { const unsigned c = xb_ld(&bar[XB_XCNT(j)]); sum += c; cnt += (c > 0u) ? 1u : 0u; mine = (j == x) ? c : mine; }
        if (sum == G) break;
        __builtin_amdgcn_s_sleep(1);
        if ((++sp & 255u) == 0u) { if (xb_ld(&bar[XB_TMO])) break; if (sp > XB_SPIN_CAP) { atomicAdd(&bar[XB_TMO], 1u); break; } }
    }
    nloc = mine > 0u ? mine : 1u; nx = cnt > 0u ? cnt : 1u;
}

__device__ __forceinline__ void xcd_barrier(const XcdBarrier& b) {
    asm volatile("s_waitcnt vmcnt(0)" ::: "memory");
    __syncthreads();
    if (threadIdx.x == 0) {
        unsigned* bar = b.bar;
        __builtin_amdgcn_s_waitcnt(0);
        unsigned nloc = b.st[0], nx = b.st[1];
        if (nloc == 0u) { xcd_barrier_complete(bar, b.x, nloc, nx); b.st[0] = nloc; b.st[1] = nx; }
        const unsigned old = xb_add(&bar[XB_XSUB(b.x)], 1u);
        const unsigned gen = old / nloc;
        if (old + 1u == (gen + 1u) * nloc) {
            __builtin_amdgcn_fence(__ATOMIC_RELEASE, "agent");
            asm volatile("s_waitcnt vmcnt(0)" ::: "memory");
            const unsigned og = xb_add(&bar[XB_TOP], 1u);
            const unsigned tg = og / nx;
            if (og + 1u == (tg + 1u) * nx) xb_add(&bar[XB_TOPGEN], 1u);
            else XB_SPIN(xb_ld(&bar[XB_TOPGEN]) == tg, bar);
            __builtin_amdgcn_fence(__ATOMIC_ACQUIRE, "agent");
            xb_add(&bar[XB_XGEN(b.x)], 1u);
            asm volatile("s_waitcnt vmcnt(0)" ::: "memory");
        } else {
            XB_SPIN(xb_ld(&bar[XB_XGEN(b.x)]) == gen, bar);
            __builtin_amdgcn_fence(__ATOMIC_ACQUIRE, "agent");
            asm volatile("s_waitcnt vmcnt(0)" ::: "memory");
        }
    }
    __syncthreads();
}


struct Args { const float* in[17]; float* out; unsigned char* ws; int ph_lo, ph_hi, li, pad; };

__device__ __forceinline__ void p0_transpose_item(const float* W, int K, int N, bf16* WT, int k0, int src_n0, int dst_n0, LAS float* scr, int lane, int dpitch = 0, int dk0 = 0) {
    if (dpitch == 0) dpitch = K;
#pragma unroll 8
    for (int i = 0; i < 32; ++i) { const int kk = 2 * i + (lane >> 5); scr[kk * 33 + (lane & 31)] = W[(size_t)(k0 + kk) * N + src_n0 + (lane & 31)]; }
    LDS_WAIT();
    const int c = lane & 7;
#pragma unroll
    for (int j = 0; j < 4; ++j) { const int n = (lane >> 3) + 8 * j; const LAS float* s = scr + (8 * c) * 33 + n;
        v4u o; o.x = pkbf(s[0 * 33], s[1 * 33]); o.y = pkbf(s[2 * 33], s[3 * 33]); o.z = pkbf(s[4 * 33], s[5 * 33]); o.w = pkbf(s[6 * 33], s[7 * 33]);
        *(v4u*)(WT + (size_t)(dst_n0 + n) * dpitch + dk0 + k0 + 8 * c) = o; }
    LDS_WAIT();
}
__device__ __forceinline__ int win_src_col(int dst_n0) {
    if (dst_n0 >= 1536) return dst_n0;
    const int tile = dst_n0 >> 8, c = dst_n0 & 255;
    return tile * 256 + 64 * ((c >> 5) & 3) + 32 * (c >> 7);
}
__device__ __forceinline__ int t5_bucket(int rel) {
    const int n = rel < 0 ? -rel : rel; int bkt;
    if (n < 8) bkt = n; else { int v = 8 + (31 - __builtin_clz(n * n)) - 6; bkt = v > 15 ? 15 : v; }
    return bkt + (rel > 0 ? 16 : 0);
}

__global__ void __launch_bounds__(NWAVES * 64, 2) mk_fwd(Args args) {
    extern __shared__ __attribute__((aligned(16))) unsigned char lds_raw[];
    LAS unsigned char* lds = (LAS unsigned char*)lds_raw;
    volatile LAS unsigned* MISC = (volatile LAS unsigned*)(lds + MISC_OFF);
    const int tid = threadIdx.x, lane = tid & 63, wave = __builtin_amdgcn_readfirstlane(tid >> 6);
    const int G = gridDim.x, bx = blockIdx.x; const int vcu = (G % 8 == 0) ? (bx % 8) * (G / 8) + bx / 8 : bx;
    const int gw = vcu * NWAVES + wave, NGW = G * NWAVES;
    unsigned char* ws = args.ws;
    const float* x = args.in[0]; const float* g_mix = args.in[1]; const float* w_in = args.in[2]; const float* b_gate = args.in[3];
    const float* q_norm_g = args.in[4]; const float* k_norm_g = args.in[5]; const float* rel_bias = args.in[6]; const float* sink = args.in[7];
    const float* w_a = args.in[8]; const float* w_b = args.in[9]; const float* w_out = args.in[10]; const float* g_ffn = args.in[11];
    const float* peer_wq = args.in[12]; const float* subkeys = args.in[13]; const float* peer_u = args.in[14]; const float* peer_v = args.in[15]; const float* g_final = args.in[16];
    float* out = args.out;
    float* ROPE = (float*)(ws + WS_TAB); float* BIAS = (float*)(ws + WS_TAB + 16384); float* SSQ = (float*)(ws + WS_SSQ);
    bf16 *WIN_T = (bf16*)(ws + WS_WIN), *WA_T = (bf16*)(ws + WS_WA), *WB_T = (bf16*)(ws + WS_WB), *WO_T = (bf16*)(ws + WS_WO), *WE_T = (bf16*)(ws + WS_WE);
    unsigned char *U8 = ws + WS_U8, *V8 = ws + WS_V8; bf16 *PA = (bf16*)(ws + WS_PA), *XN = (bf16*)(ws + WS_XN);
    float *INVU = (float*)(ws + WS_INVU), *INVV = (float*)(ws + WS_INVV), *RG = (float*)(ws + WS_G), *RW = (float*)(ws + WS_W), *PSS = (float*)(ws + WS_PSS); bf16* RE = (bf16*)(ws + WS_E);
    bf16 *QA = (bf16*)(ws + WS_QA), *QB = (bf16*)(ws + WS_QB), *KA = (bf16*)(ws + WS_KA), *VA = (bf16*)(ws + WS_VA), *KB = (bf16*)(ws + WS_KB), *VB = (bf16*)(ws + WS_VB);
    bf16 *GA = (bf16*)(ws + WS_GA), *GB = (bf16*)(ws + WS_GB); bf16* SC = (bf16*)(ws + WS_SC);

    for (int u = tid; u < (LDS_BYTES - RING_BYTES) / 4; u += NWAVES * 64) ((LAS unsigned*)(lds + RING_BYTES))[u] = 0u;
    __syncthreads();
    XcdBarrier bar; bar.bar = (unsigned*)(ws + WS_CTL) + 1024; bar.x = 0; bar.st = nullptr;
    if (N_LAUNCHES != PER_PHASE) bar = xcd_barrier_post((unsigned*)(ws + WS_CTL) + 1024, MISC + 8);
    if (tid == 0) { const unsigned xc = xb_xcc_id(); MISC[13] = xc; MISC[12] = xb_add((unsigned*)(ws + WS_CTL) + CW_RANK + 64 * xc, 1u); }
    const bool tail_tables = (G == 256);
    const int lo = args.ph_lo, hi = args.ph_hi;
#define IN(k) (lo <= (k) && (k) < hi)
#define BOTH(k) (IN(k) && IN((k) + 1))
#define GRID_BAR() do { if (N_LAUNCHES != PER_PHASE) xcd_barrier(bar); STAMP(); } while (0)
#ifdef TSEL
    int n_stamp_ = 0;
#define STAMP() do { if (tid == 0) MISC[16 + n_stamp_] = (unsigned)__builtin_amdgcn_s_memrealtime(); ++n_stamp_; } while (0)
#else
#define STAMP() do { } while (0)
#endif
    STAMP();

    if (IN(0)) for (int rep_ = 0; rep_ < NREP(0); ++rep_) {
        if (rep_) { VM_WAIT(); __syncthreads(); }
        LAS float* scr = (LAS float*)(lds + wave * 16384);
        {
            constexpr int I_IN = (DM / 64) * (INW / 32), I_AB = (QW / 64) * (DM / 32), I_O = (DM / 64) * (DM / 32);
            constexpr int NITEMS = I_IN + 2 * I_AB + I_O;
            for (int it = gw; it < NITEMS; it += NGW) {
                int r = it;
                if (r < I_IN) { const int nblk = INW / 32, kb = r / nblk, nb = r % nblk; p0_transpose_item(w_in, DM, INW, WIN_T, 64 * kb, win_src_col(32 * nb), 32 * nb, scr, lane); continue; } r -= I_IN;
                if (r < I_AB) { const int nblk = DM / 32, kb = r / nblk, nb = r % nblk; p0_transpose_item(w_a, QW, DM, WA_T, 64 * kb, 32 * nb, 32 * nb, scr, lane, DM, 0); continue; } r -= I_AB;
                if (r < I_AB) { const int nblk = DM / 32, kb = r / nblk, nb = r % nblk; p0_transpose_item(w_b, QW, DM, WA_T, 64 * kb, 32 * nb, 32 * nb, scr, lane, DM, QW); continue; }   r -= I_AB;
                { const int nblk = DM / 32, kb = r / nblk, nb = r % nblk; p0_transpose_item(w_out, DM, DM, WO_T, 64 * kb, 32 * nb, 32 * nb, scr, lane); }
            }
        }
        __syncthreads();
        {
            LAS float* sk_s = (LAS float*)lds;
            LAS float* wq_s = (LAS float*)(lds + 128 * 129 * 4);
            for (int it = vcu; it < 16 * 16; it += G) {
                const int c = it >> 4, k0 = (it & 15) * 64;
                for (int i = tid; i < 128 * 32; i += NWAVES * 64) { const int n = i >> 5, d4 = (i & 31) * 4; const f32x4 v = *(const f32x4*)(subkeys + ((size_t)c * NKEYS + n) * 128 + d4);
                    sk_s[n * 129 + d4] = v[0]; sk_s[n * 129 + d4 + 1] = v[1]; sk_s[n * 129 + d4 + 2] = v[2]; sk_s[n * 129 + d4 + 3] = v[3]; }
                for (int i = tid; i < 64 * 32; i += NWAVES * 64) { const int k = i >> 5, d4 = (i & 31) * 4; const f32x4 v = *(const f32x4*)(peer_wq + (size_t)(k0 + k) * SCW + c * 128 + d4);
                    wq_s[k * 129 + d4] = v[0]; wq_s[k * 129 + d4 + 1] = v[1]; wq_s[k * 129 + d4 + 2] = v[2]; wq_s[k * 129 + d4 + 3] = v[3]; }
                __syncthreads();
                {
                    typedef float f32x16_t __attribute__((ext_vector_type(16)));
                    const int tn = wave >> 1, tk = wave & 1; f32x16_t acc = {};
                    const LAS float* ap = sk_s + (32 * tn + (lane & 31)) * 129 + (lane >> 5); const LAS float* bp = wq_s + (32 * tk + (lane & 31)) * 129 + (lane >> 5);
#pragma unroll 8
                    for (int s = 0; s < 64; ++s) acc = __builtin_amdgcn_mfma_f32_32x32x2f32(ap[2 * s], bp[2 * s], acc, 0, 0, 0);
                    const float gk = g_ffn[k0 + 32 * tk + (lane & 31)];
#pragma unroll
                    for (int r = 0; r < 16; ++r) { const int n = 32 * tn + (r & 3) + 8 * (r >> 2) + 4 * (lane >> 5);
                        WE_T[(size_t)(c * 128 + n) * DM + k0 + 32 * tk + (lane & 31)] = (bf16)(pkbf(acc[r] * gk, 0.f) & 0xffffu); }
                }
                __syncthreads();
            }
        }
        peer::tables_fp8(peer_u, peer_v, U8, V8, INVU, INVV, 0, tail_tables ? NEXP / 2 : NEXP, gw, NGW, lane);
        for (int m = gw; m < NTOK; m += 2 * NGW) {
            const int m2 = (m + NGW < NTOK) ? m + NGW : m;
            const f32x4* xr = (const f32x4*)(x + (size_t)m * DM) + lane; const f32x4* xr2 = (const f32x4*)(x + (size_t)m2 * DM) + lane; f32x4 v[4], v2[4]; float s = 0.f, s2 = 0.f;
#pragma unroll
            for (int j = 0; j < 4; ++j) { v[j] = __builtin_nontemporal_load(xr + 64 * j); v2[j] = __builtin_nontemporal_load(xr2 + 64 * j); }
#pragma unroll
            for (int j = 0; j < 4; ++j) { s += (v[j][0] * v[j][0] + v[j][1] * v[j][1]) + (v[j][2] * v[j][2] + v[j][3] * v[j][3]); s2 += (v2[j][0] * v2[j][0] + v2[j][1] * v2[j][1]) + (v2[j][2] * v2[j][2] + v2[j][3] * v2[j][3]); }
            const float rstd = 1.0f / sqrtf(peer::wave_sum(s) * (1.0f / DM) + EPS), rstd2 = 1.0f / sqrtf(peer::wave_sum(s2) * (1.0f / DM) + EPS);
            unsigned long long* o8 = (unsigned long long*)(XN + (size_t)m * DM) + lane; unsigned long long* o82 = (unsigned long long*)(XN + (size_t)m2 * DM) + lane;
#pragma unroll
            for (int j = 0; j < 4; ++j) { const f32x4 g = *((const f32x4*)g_mix + lane + 64 * j);
                o8[64 * j] = (unsigned long long)pkbf(v[j][0] * rstd * g[0], v[j][1] * rstd * g[1]) | ((unsigned long long)pkbf(v[j][2] * rstd * g[2], v[j][3] * rstd * g[3]) << 32);
                o82[64 * j] = (unsigned long long)pkbf(v2[j][0] * rstd2 * g[0], v2[j][1] * rstd2 * g[1]) | ((unsigned long long)pkbf(v2[j][2] * rstd2 * g[2], v2[j][3] * rstd2 * g[3]) << 32); }
        }
        if (vcu == 0) {
            for (int i = tid; i < 64 * 16; i += NWAVES * 64) { const int pos = i >> 4, f = i & 15; const float fr = powf(10000.0f, -(float)f / 16.0f); const float ang = (float)pos * fr; ROPE[2 * i] = cosf(ang); ROPE[2 * i + 1] = sinf(ang); }
            for (int i = tid; i < 8 * 257; i += NWAVES * 64) { const int h = i / 257, rel = i % 257 - 128; BIAS[i] = rel_bias[t5_bucket(rel) * NH + h] * LOG2E; }
        }
        if (BOTH(0) && rep_ == NREP(0) - 1) GRID_BAR();
    }

    if (IN(1)) {
        pg8::Gemm g{XN, WIN_T, NTOK, INW, DM}; pg8::StaticOrder S; S.init(NTOK, INW, G, bx);
        pg8::EpiIn E{QA, KA, VA, QB, KB, VB, GA, GB, q_norm_g, k_norm_g, b_gate, ROPE};
        if (PROBE == 1) { pg8::gemm_phase<pg8::EpiIn, pg8::StaticOrder, true, true>(lds, g, S, E); VM_WAIT(); __syncthreads(); }
        pg8::gemm_phase<pg8::EpiIn, pg8::StaticOrder, true, true>(lds, g, S, E);
        if (tail_tables && bx >= 128) peer::tables_fp8(peer_u, peer_v, U8, V8, INVU, INVV, NEXP / 2, NEXP, (bx - 128) * NWAVES + wave, 128 * NWAVES, lane);
        if (BOTH(1)) GRID_BAR();
    }

    if (IN(2)) {
        if (PROBE == 21) {
            bf16* DUM = XN;
            for (int u = vcu; u < 512; u += G) { const int xg = u >> 6, i = u & 63; const int b = xg >> 1, h = 4 * (xg & 1) + (i >> 4), qblk = i & 15;
                attn::attn_unit<false, XVAR>((LAS char*)lds, QA, KA, VA, DUM, b, h, qblk, nullptr, 0.f); }
        }
        if (PROBE == 22) {
            bf16* DUM = XN;
            for (int u = vcu; u < 512; u += G) { const int xg = u >> 6, i = u & 63; const int b = xg >> 1, h = 4 * (xg & 1) + (i >> 4), qblk = i & 15;
                attn::attn_unit<true>((LAS char*)lds, QB, KB, VB, DUM, b, h, qblk, BIAS + h * 257, sink[h] * LOG2E); }
        }
        float lbound;
        { const float gq = tid < HD ? fabsf(q_norm_g[tid]) : 0.f, gk = tid < HD ? fabsf(k_norm_g[tid]) : 0.f;
          const float mq = peer::wave_max(gq), mk = peer::wave_max(gk); LAS float* lb = (LAS float*)(lds + 70000);
          if (tid == 0) lb[0] = 64.0f * mq * mk * QSCALE * 1.02f; __syncthreads(); lbound = lb[0]; __syncthreads(); }
        const bool nomax = lbound <= 100.0f;
        for (int u = vcu; u < 512; u += G) { const int xg = u >> 6, i = u & 63; const int b = xg >> 1, h = 4 * (xg & 1) + (i >> 4), qblk = i & 15;
            if (nomax) attn::attn_unit<false, 0, true>((LAS char*)lds, QA, KA, VA, QA, b, h, qblk, nullptr, 0.f);
            else attn::attn_unit<false>((LAS char*)lds, QA, KA, VA, QA, b, h, qblk, nullptr, 0.f); }
        for (int u = vcu; u < 512; u += G) { const int xg = u >> 6, i = u & 63; const int b = xg >> 1, h = 4 * (xg & 1) + (i >> 4), qblk = i & 15;
            attn::attn_unit<true>((LAS char*)lds, QB, KB, VB, QB, b, h, qblk, BIAS + h * 257, sink[h] * LOG2E); }
        if (BOTH(2)) GRID_BAR();
    }

    if (IN(3)) {
        pg8::Gemm g{QA, WA_T, NTOK, DM, DM}; pg8::StaticOrder S; S.init(NTOK, DM, G, bx); pg8::EpiMix E{GA, GB, GB};
        if (PROBE == 3) { pg8::EpiMix E2{GA, GB, XN}; pg8::gemm_phase<pg8::EpiMix, pg8::StaticOrder, true, true>(lds, g, S, E2); VM_WAIT(); __syncthreads(); }
        pg8::gemm_phase<pg8::EpiMix, pg8::StaticOrder, true, true>(lds, g, S, E);
        if (BOTH(3)) GRID_BAR();
    }

    if (IN(4)) {
        pg8::Gemm g{GB, WO_T, NTOK, DM, DM}; pg8::StaticOrder S; S.init(NTOK, DM, G, bx); pg8::EpiOut E{x, XN, SSQ};
        for (int rep_ = 0; rep_ < NREP(4); ++rep_) pg8::gemm_phase<pg8::EpiOut, pg8::StaticOrder, true, true>(lds, g, S, E);
        if (BOTH(4)) GRID_BAR();
    }

    if (IN(5)) {
        pg8::Gemm g{XN, WE_T, NTOK, SCW, DM}; pg8::StaticOrder S; S.init(NTOK, SCW, G, bx); pg8::EpiScore E{SSQ, SC};
        for (int rep_ = 0; rep_ < NREP(5); ++rep_) pg8::gemm_phase<pg8::EpiScore, pg8::StaticOrder, true, true>(lds, g, S, E);
        if (BOTH(5)) GRID_BAR();
    }

    if (IN(6)) {
        LAS char* wl = (LAS char*)lds + wave * peer::WAVE_LDS;
        const unsigned long long ct = peer::cand_table(lane & 7);
        for (int rep_ = 0; rep_ < NREP(60); ++rep_) for (int t = gw; t < NTOK; t += NGW) peer::route_token(wl, lane, t, ct, SC, XN, g_ffn, RE, RG, (bf16*)out);
        GRID_BAR();
        int nloc = 0, nx = 0, ox = 0; const int myx = (int)MISC[13], rank = (int)MISC[12];
#pragma unroll
        for (int j = 0; j < 16; ++j) { const int c = (int)xb_ld((unsigned*)(ws + WS_CTL) + CW_RANK + 64 * j); nx += c > 0; ox += (c > 0 && j < myx); nloc = j == myx ? c : nloc; }
        const int wv = rank * NWAVES + wave, nwv = nloc * NWAVES;
        for (int rep_ = 0; rep_ < NREP(61); ++rep_) for (int s = ox; s < 8; s += nx) { const unsigned char* U8s = U8 + (size_t)s * peer::SLICE_BYTES;
            peer::upass_slice(lane, s, wv, nwv, U8s, RE, (const bf16*)out, PA); }
        GRID_BAR();
        for (int rep_ = 0; rep_ < NREP(62); ++rep_) for (int t = gw; t < NTOK; t += NGW) peer::wpass_token(lane, t, RE, RG, PA, INVU, INVV, RW);
        GRID_BAR();
        for (int s = ox; s < 8; s += nx) { const unsigned char* V8s = V8 + (size_t)s * peer::SLICE_BYTES;
            for (int rep_ = 0; rep_ < NREP(63); ++rep_) peer::vpass_slice(lane, s, wv, nwv, V8s, RE, RW, PA); }
        GRID_BAR();
        for (int t = gw; t < NTOK; t += NGW) peer::final_token(lane, t, out, XN, PA, g_final);
#ifdef TSEL
        STAMP();
        if (bx == 0 && tid == 0) { VM_WAIT(); const unsigned d = MISC[16 + TSEL + 1] - MISC[16 + TSEL]; out[0] += (float)d * 0.001f; }
#endif
    }
#undef IN
#undef BOTH
#undef GRID_BAR
}

extern "C" void kernel_launch(void* const* d_in, const int* in_sizes, int n_in, void* d_out, int out_size, void* d_ws, size_t ws_size, hipStream_t stream) {
    static int grid = 0;
    if (grid == 0) {
        if (n_in != 17 || in_sizes[0] != NTOK * DM || out_size != NTOK * DM || ws_size < WS_END) { fprintf(stderr, "kernel_launch: unexpected shapes (n_in %d, in0 %d, out %d, ws %zu); nothing launched\n", n_in, n_in > 0 ? in_sizes[0] : -1, out_size, ws_size); grid = -1; return; }
        int dev = 0, cus = 0, per_cu = 0;
        if (hipGetDevice(&dev) != hipSuccess || hipDeviceGetAttribute(&cus, hipDeviceAttributeMultiprocessorCount, dev) != hipSuccess) { grid = -1; return; }
        if (hipFuncSetAttribute((const void*)mk_fwd, hipFuncAttributeMaxDynamicSharedMemorySize, LDS_BYTES) != hipSuccess) { fprintf(stderr, "kernel_launch: hipFuncSetAttribute failed\n"); grid = -1; return; }
        if (hipOccupancyMaxActiveBlocksPerMultiprocessor(&per_cu, (const void*)mk_fwd, NWAVES * 64, LDS_BYTES) != hipSuccess || per_cu < 1) { fprintf(stderr, "kernel_launch: occupancy query says %d blocks per CU; nothing launched\n", per_cu); (void)hipGetLastError(); grid = -1; return; }
        grid = cus;
    }
    if (grid < 0) return;
    if (hipMemsetAsync((char*)d_ws + WS_CTL, 0, CTL_ZERO_BYTES, stream) != hipSuccess) { fprintf(stderr, "kernel_launch: hipMemsetAsync failed\n"); return; }
    Args a{};
    for (int i = 0; i < 17; ++i) a.in[i] = (const float*)d_in[i];
    a.out = (float*)d_out; a.ws = (unsigned char*)d_ws;
    if (N_LAUNCHES == 1) {
        a.ph_lo = 0; a.ph_hi = PER_PHASE; a.li = 0;
#if defined(COOP_LAUNCH)
        void* kargs[] = {&a};
        hipError_t e = hipLaunchCooperativeKernel((const void*)mk_fwd, dim3(grid), dim3(NWAVES * 64), kargs, LDS_BYTES, stream);
        if (e != hipSuccess) fprintf(stderr, "kernel_launch: cooperative launch failed: %s (grid %d)\n", hipGetErrorString(e), grid);
#else
        if (PROBE == 100) { hipLaunchKernelGGL(mk_fwd, dim3(grid), dim3(NWAVES * 64), LDS_BYTES, stream, a); (void)hipMemsetAsync((char*)d_ws + WS_CTL, 0, CTL_ZERO_BYTES, stream); }
        hipLaunchKernelGGL(mk_fwd, dim3(grid), dim3(NWAVES * 64), LDS_BYTES, stream, a);
#endif
    } else {
        for (int li = 0; li < PER_PHASE; ++li) { a.ph_lo = li; a.ph_hi = li + 1; a.li = li;
            hipLaunchKernelGGL(mk_fwd, dim3(grid), dim3(NWAVES * 64), LDS_BYTES, stream, a); }
    }
}
```

```cpp
#include <hip/hip_runtime.h>
#include <cstdio>
#include <cstdint>
#include <cmath>
namespace pg8 {
#define PG8_LAS __attribute__((address_space(3)))
typedef unsigned short bf16_t;
typedef short bf16x8 __attribute__((ext_vector_type(8)));
typedef float f32x4 __attribute__((ext_vector_type(4)));
typedef unsigned u32x4 __attribute__((ext_vector_type(4)));
constexpr int BM = 256, BK = 64, HALF = 128, HTB = HALF * BK * 2  , STAGE_BYTES = 8 * HTB, NXCD = 8, WGM = 8;

__host__ __device__ __forceinline__ int lds_byte(int r, int c) { const int st = (r >> 4) * 2 + (c >> 5), rr = r & 15, cc = c & 31, ob = rr * 64 + cc * 2; return st * 1024 + (ob ^ (((ob >> 9) & 1) << 5)); }
__host__ __device__ __forceinline__ void stage_rc(int b, int& R, int& C) { const int st = b / 1024, sb = b % 1024, swz = sb ^ (((sb >> 9) & 1) << 5); R = (st >> 1) * 16 + swz / 64; C = (st & 1) * 32 + (swz % 64) / 2; }
__host__ __device__ __forceinline__ int perm32(int rho) { const int n = rho >> 4, i = rho & 15; return 8 * (i >> 2) + 4 * n + (i & 3); }

struct Unit { int pm, pn; };
struct Gemm { const bf16_t* A; const bf16_t* Bt; int M, N, K; };

struct StaticOrder {
    int nM, nN, nwg, G, c;
    __host__ __device__ void init(int M, int N, int G_, int c_) { nM = M / BM; nN = N / BM; nwg = nM * nN; G = G_; c = c_; }
    __host__ __device__ bool next(int i, Unit& u) const {
        const long L = (long)i * G + c; if (L >= nwg) return false;
        int wgid = (int)L; { const int q = nwg / NXCD, r = nwg % NXCD, xcd = wgid % NXCD, off = wgid / NXCD; wgid = (xcd < r ? xcd * (q + 1) : r * (q + 1) + (xcd - r) * q) + off; }
        const int nig = WGM * nN, gid = wgid / nig, fm = gid * WGM, gsz = (nM - fm) < WGM ? (nM - fm) : WGM;
        u.pm = fm + ((wgid % nig) % gsz); u.pn = (wgid % nig) / gsz; return true;
    }
    __device__ __forceinline__ void a_ready(const Unit&) const {}
    __device__ __forceinline__ void done(const Unit&) const {}
};

__device__ __forceinline__ unsigned cvt_pk_bf16(float lo, float hi) { unsigned r; asm volatile("v_cvt_pk_bf16_f32 %0, %1, %2" : "=v"(r) : "v"(lo), "v"(hi)); return r; }
typedef float f32x2 __attribute__((ext_vector_type(2)));
template <class Epi, class Sched, bool ALIGN_EPI = false, bool SP2 = false>
__device__ __forceinline__ void gemm_phase(PG8_LAS unsigned char* lds, const Gemm g, const Sched& S, const Epi& E) {
    const int tid = threadIdx.x, wid = __builtin_amdgcn_readfirstlane(tid >> 6), lane = tid & 63, wr = wid >> 2, wc = wid & 3, fr = lane & 15, fq = lane >> 4;
    const int K = g.K, nt = K / BK;
    unsigned voffA[2], voffB[2];
#pragma unroll
    for (int i = 0; i < 2; ++i) { int R, C; stage_rc(tid * 16 + i * 8192, R, C); const int Rb = Epi::PERM ? ((R & ~31) + perm32(R & 31)) : R;
        voffA[i] = (unsigned)(R * K + C) * 2u; voffB[i] = (unsigned)(Rb * K + C) * 2u; }
    const size_t kstep = (size_t)(BK * 2);
    const size_t hstep = (size_t)HALF * K * 2;
    const size_t tstep = 2 * hstep;
    const unsigned ldsw = (unsigned)wid * 1024u;
    const int aoff = lds_byte(wr * 64 + fr, fq * 8), boff = lds_byte(wc * 32 + fr, fq * 8);
#define PG8_SA(b, h) (((b) * 2 + (h)) * HTB)
#define PG8_SB(b, h) ((4 + (b) * 2 + (h)) * HTB)
#define PG8_STAGE(bufoff, gbase, voff) do { _Pragma("unroll") for (int _i = 0; _i < 2; ++_i) \
        __builtin_amdgcn_global_load_lds((const unsigned*)((const char*)(gbase) + (voff)[_i]), (PG8_LAS unsigned*)(lds + (bufoff) + ldsw + _i * 8192), 16, 0, 0); } while (0)
#define PG8_LDA(dst, b, h) do { _Pragma("unroll") for (int m = 0; m < 4; ++m) _Pragma("unroll") for (int k = 0; k < 2; ++k) dst[m][k] = *(const PG8_LAS bf16x8*)(lds + PG8_SA(b, h) + aoff + m * 2048 + k * 1024); } while (0)
#define PG8_LDB(dst, b, h) do { _Pragma("unroll") for (int n = 0; n < 2; ++n) _Pragma("unroll") for (int k = 0; k < 2; ++k) dst[n][k] = *(const PG8_LAS bf16x8*)(lds + PG8_SB(b, h) + boff + n * 2048 + k * 1024); } while (0)
#define PG8_MMA(ai, bj, At, Bt) do { __builtin_amdgcn_s_setprio(1); _Pragma("unroll") for (int m = 0; m < 4; ++m) _Pragma("unroll") for (int n = 0; n < 2; ++n) _Pragma("unroll") for (int k = 0; k < 2; ++k) \
        acc[ai][bj][m][n] = __builtin_amdgcn_mfma_f32_16x16x32_bf16(Bt[n][k], At[m][k], acc[ai][bj][m][n], 0, 0, 0); __builtin_amdgcn_s_setprio(0); } while (0)
#define PG8_WAIT_V(n) asm volatile("s_waitcnt vmcnt(" #n ")" ::: "memory")
#define PG8_WAIT_L(n) asm volatile("s_waitcnt lgkmcnt(" #n ")" ::: "memory")
#define PG8_BAR __builtin_amdgcn_s_barrier()
#define PG8_SCHED __builtin_amdgcn_sched_barrier(0)
    Unit cur, nxt; int ui = 0;
    if (!S.next(0, cur)) return;
    f32x4 acc[2][2][4][2];
#pragma unroll
    for (int a = 0; a < 2; ++a)
#pragma unroll
        for (int b = 0; b < 2; ++b)
#pragma unroll
            for (int m = 0; m < 4; ++m)
#pragma unroll
                for (int n = 0; n < 2; ++n) acc[a][b][m][n] = (f32x4){0.f, 0.f, 0.f, 0.f};
    bf16x8 At[4][2], B0[2][2], B1[2][2];
    const char* cA = (const char*)g.A + (size_t)cur.pm * tstep; const char* cB = (const char*)g.Bt + (size_t)cur.pn * tstep;
    S.a_ready(cur);
    if constexpr (SP2) {
        PG8_STAGE(PG8_SB(0, 0), cB, voffB); PG8_STAGE(PG8_SB(0, 1), cB + hstep, voffB); PG8_STAGE(PG8_SA(0, 0), cA, voffA); PG8_STAGE(PG8_SA(0, 1), cA + hstep, voffA);
        if (wr == 1) PG8_BAR;
        PG8_WAIT_V(2); PG8_BAR;
        PG8_STAGE(PG8_SB(1, 0), cB + kstep, voffB); PG8_STAGE(PG8_SA(1, 0), cA + kstep, voffA); PG8_STAGE(PG8_SB(1, 1), cB + hstep + kstep, voffB);
        PG8_WAIT_V(6); PG8_BAR;
    } else {
        PG8_STAGE(PG8_SB(0, 0), cB, voffB); PG8_STAGE(PG8_SA(0, 0), cA, voffA); PG8_STAGE(PG8_SB(0, 1), cB + hstep, voffB); PG8_STAGE(PG8_SA(0, 1), cA + hstep, voffA);
        if (wr == 1) PG8_BAR;
        PG8_WAIT_V(4); PG8_BAR;
        PG8_STAGE(PG8_SB(1, 0), cB + kstep, voffB); PG8_STAGE(PG8_SA(1, 0), cA + kstep, voffA); PG8_STAGE(PG8_SB(1, 1), cB + hstep + kstep, voffB);
        PG8_WAIT_V(6); PG8_BAR;
    }
    for (;;) {
        const bool has_next = S.next(ui + 1, nxt);
        const char* nA = has_next ? (const char*)g.A + (size_t)nxt.pm * tstep : cA; const char* nB = has_next ? (const char*)g.Bt + (size_t)nxt.pn * tstep : cB;
        for (int t = 0; t < nt; t += 2) {
            if constexpr (Epi::HAS_MID) { if (t == (nt >> 1)) E.mid(acc, cur, wr, wc, fr, fq); }
            const bool last = (t == nt - 2);
            const char* a1 = cA + (size_t)(t + 1) * kstep;
            const char* a2 = last ? nA : cA + (size_t)(t + 2) * kstep; const char* b2 = last ? nB : cB + (size_t)(t + 2) * kstep;
            const char* a3 = a2 + kstep; const char* b3 = b2 + kstep;
            if (last && has_next) S.a_ready(nxt);
            if constexpr (SP2) {
            PG8_LDB(B0, 0, 0); PG8_LDB(B1, 0, 1); PG8_SCHED; PG8_LDA(At, 0, 0); PG8_STAGE(PG8_SA(1, 1), a1 + hstep, voffA);
            PG8_WAIT_V(8); PG8_WAIT_L(0); PG8_BAR; PG8_MMA(0, 0, At, B0); PG8_MMA(0, 1, At, B1); PG8_BAR; PG8_SCHED;
            PG8_LDA(At, 0, 1); PG8_STAGE(PG8_SB(0, 0), b2, voffB); PG8_STAGE(PG8_SB(0, 1), b2 + hstep, voffB); PG8_STAGE(PG8_SA(0, 0), a2, voffA);
            PG8_WAIT_V(8); PG8_WAIT_L(0); PG8_BAR; PG8_MMA(1, 0, At, B0); PG8_MMA(1, 1, At, B1); PG8_BAR; PG8_SCHED;
            PG8_LDB(B0, 1, 0); PG8_LDB(B1, 1, 1); PG8_SCHED; PG8_LDA(At, 1, 0); PG8_STAGE(PG8_SA(0, 1), a2 + hstep, voffA);
            PG8_WAIT_V(8); PG8_WAIT_L(0); PG8_BAR; PG8_MMA(0, 0, At, B0); PG8_MMA(0, 1, At, B1); PG8_BAR; PG8_SCHED;
            PG8_LDA(At, 1, 1); PG8_STAGE(PG8_SB(1, 0), b3, voffB); PG8_STAGE(PG8_SB(1, 1), b3 + hstep, voffB); PG8_STAGE(PG8_SA(1, 0), a3, voffA);
            PG8_WAIT_V(8); PG8_WAIT_L(0); PG8_BAR; PG8_MMA(1, 0, At, B0); PG8_MMA(1, 1, At, B1); PG8_BAR; PG8_SCHED;
            } else {
            PG8_LDB(B0, 0, 0); PG8_SCHED; PG8_LDA(At, 0, 0); PG8_STAGE(PG8_SA(1, 1), a1 + hstep, voffA);
            PG8_WAIT_L(8); PG8_BAR; PG8_WAIT_L(0); PG8_MMA(0, 0, At, B0); PG8_BAR; PG8_SCHED;
            PG8_LDB(B1, 0, 1); PG8_STAGE(PG8_SB(0, 0), b2, voffB);
            PG8_BAR; PG8_WAIT_L(0); PG8_MMA(0, 1, At, B1); PG8_BAR;
            PG8_LDA(At, 0, 1); PG8_STAGE(PG8_SA(0, 0), a2, voffA);
            PG8_BAR; PG8_WAIT_L(0); PG8_MMA(1, 0, At, B0); PG8_BAR; PG8_SCHED;
            PG8_STAGE(PG8_SB(0, 1), b2 + hstep, voffB);
            PG8_WAIT_V(6); PG8_BAR; PG8_MMA(1, 1, At, B1); PG8_BAR;
            PG8_LDB(B0, 1, 0); PG8_SCHED; PG8_LDA(At, 1, 0); PG8_STAGE(PG8_SA(0, 1), a2 + hstep, voffA);
            PG8_WAIT_L(8); PG8_BAR; PG8_WAIT_L(0); PG8_MMA(0, 0, At, B0); PG8_BAR; PG8_SCHED;
            PG8_LDB(B1, 1, 1); PG8_STAGE(PG8_SB(1, 0), b3, voffB);
            PG8_BAR; PG8_WAIT_L(0); PG8_MMA(0, 1, At, B1); PG8_BAR;
            PG8_LDA(At, 1, 1); PG8_STAGE(PG8_SA(1, 0), a3, voffA);
            PG8_BAR; PG8_WAIT_L(0); PG8_MMA(1, 0, At, B0); PG8_BAR; PG8_SCHED;
            PG8_STAGE(PG8_SB(1, 1), b3 + hstep, voffB);
            PG8_WAIT_V(6); PG8_BAR; PG8_MMA(1, 1, At, B1); PG8_BAR;
            }
        }
        if constexpr (ALIGN_EPI) { if (wr == 0) PG8_BAR; }
        if constexpr (!Epi::AFTER_DRAIN) { E(acc, cur, wr, wc, fr, fq); S.done(cur); }
        if (!has_next) break;
#pragma unroll
        for (int a = 0; a < 2; ++a)
#pragma unroll
            for (int b = 0; b < 2; ++b)
#pragma unroll
                for (int m = 0; m < 4; ++m)
#pragma unroll
                    for (int n = 0; n < 2; ++n) acc[a][b][m][n] = (f32x4){0.f, 0.f, 0.f, 0.f};
        cur = nxt; cA = nA; cB = nB; ++ui;
        if constexpr (ALIGN_EPI) { if (wr == 1) PG8_BAR; }
    }
    PG8_WAIT_V(0);
    if constexpr (!ALIGN_EPI) { if (wr == 0) PG8_BAR; }
    PG8_BAR;
    if constexpr (Epi::AFTER_DRAIN) { E.fused(acc, cur, wr, wc, fr, fq, lds, wid, lane); S.done(cur); }
#undef PG8_SA
#undef PG8_SB
#undef PG8_STAGE
#undef PG8_LDA
#undef PG8_LDB
#undef PG8_MMA
#undef PG8_WAIT_V
#undef PG8_WAIT_L
#undef PG8_BAR
#undef PG8_SCHED
}
}

constexpr int DM = 1024, NB = 4, SEQ = 4096, NTOK = NB * SEQ;
constexpr int HD = 64, NH = 8, NKV = 2, QW = NH * HD  , GRIDW = 64;
constexpr int INW = 3584;
constexpr int PH = 8, NKEYS = 128, TOPK = 16, NEXP = NKEYS * NKEYS, SCW = PH * 2 * NKEYS  ;
constexpr float EPS = 1e-6f;
constexpr float LOG2E = 1.4426950408889634f;
constexpr float QSCALE = 0.125f * LOG2E;

typedef unsigned u32x2_t __attribute__((ext_vector_type(2)));
typedef float f32x2_t __attribute__((ext_vector_type(2)));
typedef __bf16 bf16x2_t __attribute__((ext_vector_type(2)));
__device__ __forceinline__ unsigned pkbf(float lo, float hi) { f32x2_t v = {lo, hi}; bf16x2_t b = __builtin_convertvector(v, bf16x2_t); return __builtin_bit_cast(unsigned, b); }
__device__ __forceinline__ float bflo(unsigned w) { return __builtin_bit_cast(float, w << 16); }
__device__ __forceinline__ float bfhi(unsigned w) { return __builtin_bit_cast(float, w & 0xffff0000u); }

__device__ __forceinline__ size_t kimg_off(int b, int kvh, int s, int dim) { return ((size_t)((b * NKV + kvh) * (SEQ / 64) + (s >> 6)) << 12) + (dim >> 3) * 512 + (s & 63) * 8 + (dim & 7); }
__device__ __forceinline__ size_t vimg_off(int b, int kvh, int s, int dim) { return ((size_t)((b * NKV + kvh) * (SEQ / 64) + (s >> 6)) << 12) + (dim >> 5) * 2048 + (s & 63) * 32 + (dim & 31); }

namespace pg8 {
__device__ __forceinline__ u32x4 pk8(const f32x4& a, const f32x4& b) { return (u32x4){pkbf(a[0], a[1]), pkbf(a[2], a[3]), pkbf(b[0], b[1]), pkbf(b[2], b[3])}; }
struct EpiIn {
    static constexpr bool PERM = true, AFTER_DRAIN = false, HAS_MID = false;
    bf16_t *Qa, *Ka, *Va, *Qb, *Kb, *Vb, *Ga, *Gb;
    const float *qg, *kg, *bgate, *rope;
    __device__ __forceinline__ void operator()(const f32x4 (&acc)[2][2][4][2], const Unit& u, int wr, int wc, int fr, int fq) const {
        const int pn = u.pn;
        if (pn >= 6) {
            const bool isA = pn < 10; bf16_t* G = isA ? Ga : Gb; const int ct = (isA ? pn - 6 : pn - 10) * BM; const float* bb = bgate + (isA ? 0 : DM);
            f32x4 bv[2][2];
#pragma unroll
            for (int bj = 0; bj < 2; ++bj)
#pragma unroll
                for (int n = 0; n < 2; ++n) bv[bj][n] = *(const f32x4*)(bb + ct + bj * HALF + wc * 32 + 8 * fq + 4 * n);
#pragma unroll
            for (int ai = 0; ai < 2; ++ai)
#pragma unroll
                for (int m = 0; m < 4; ++m) { const int row = u.pm * BM + ai * HALF + wr * 64 + m * 16 + fr; bf16_t* rp = G + (size_t)row * DM + ct + wc * 32 + 8 * fq;
#pragma unroll
                    for (int bj = 0; bj < 2; ++bj) { f32x4 g[2];
#pragma unroll
                        for (int n = 0; n < 2; ++n) { const f32x4 z = acc[ai][bj][m][n] + bv[bj][n];
#pragma unroll
                            for (int j = 0; j < 4; ++j) g[n][j] = __builtin_amdgcn_rcpf(1.0f + __builtin_amdgcn_exp2f(-LOG2E * z[j])); }
                        *(u32x4*)(rp + bj * HALF) = pk8(g[0], g[1]); } }
            return;
        }
        const bool brA = pn < 3; const int pl = brA ? pn : pn - 3;
        const bool isq = pl < 2, isk = (!isq) && wc < 2;
        const bool normrope = brA && (isq || isk);
        const int part = fq >> 1, base = 8 * (fq & 1);
        f32x4 gv[2][2];
        if (normrope) { const float* g = isq ? qg : kg;
#pragma unroll
            for (int bj = 0; bj < 2; ++bj)
#pragma unroll
                for (int n = 0; n < 2; ++n) gv[bj][n] = *(const f32x4*)(g + 32 * part + 16 * bj + base + 4 * n); }
        const float osc = isq ? QSCALE : 1.0f;
#pragma unroll
        for (int ai = 0; ai < 2; ++ai)
#pragma unroll
            for (int m = 0; m < 4; ++m) {
                const int row = u.pm * BM + ai * HALF + wr * 64 + m * 16 + fr; const int b = row >> 12, s = row & (SEQ - 1);
                f32x4 v[2][2];
#pragma unroll
                for (int bj = 0; bj < 2; ++bj)
#pragma unroll
                    for (int n = 0; n < 2; ++n) v[bj][n] = acc[ai][bj][m][n];
                if (normrope) {
                    float ss = 0.f;
#pragma unroll
                    for (int bj = 0; bj < 2; ++bj)
#pragma unroll
                        for (int n = 0; n < 2; ++n) ss += (v[bj][n][0] * v[bj][n][0] + v[bj][n][1] * v[bj][n][1]) + (v[bj][n][2] * v[bj][n][2] + v[bj][n][3] * v[bj][n][3]);
                    ss += __shfl_xor(ss, 16); ss += __shfl_xor(ss, 32);
                    const float rstd = 1.0f / sqrtf(ss * (1.0f / 64.0f) + EPS);
                    const int pos = part == 0 ? (s >> 6) : (s & (GRIDW - 1));
                    const float* rp = rope + (pos * 16 + base) * 2;
#pragma unroll
                    for (int n = 0; n < 2; ++n) { const f32x4 cs0 = *(const f32x4*)(rp + 8 * n), cs1 = *(const f32x4*)(rp + 8 * n + 4);
                        const float cc[4] = {cs0[0], cs0[2], cs1[0], cs1[2]}, sn[4] = {cs0[1], cs0[3], cs1[1], cs1[3]};
#pragma unroll
                        for (int j = 0; j < 4; ++j) { const float u1 = v[0][n][j] * rstd * gv[0][n][j], u2 = v[1][n][j] * rstd * gv[1][n][j];
                            v[0][n][j] = u1 * cc[j] - u2 * sn[j]; v[1][n][j] = u2 * cc[j] + u1 * sn[j]; } }
                }
#pragma unroll
                for (int bj = 0; bj < 2; ++bj) {
                    const u32x4 w = pk8(v[bj][0] * osc, v[bj][1] * osc);
                    const int dim = 32 * part + 16 * bj + base;
                    bf16_t* dst;
                    if (isq) dst = (brA ? Qa : Qb) + (size_t)row * (2 * QW) + (pl * 4 + wc) * HD + dim;
                    else if (wc < 2) dst = (brA ? Ka : Kb) + kimg_off(b, wc, s, dim);
                    else dst = (brA ? Va : Vb) + vimg_off(b, wc - 2, s, dim);
                    *(u32x4*)dst = w;
                }
            }
    }
};

struct EpiMix {
    static constexpr bool PERM = true, AFTER_DRAIN = false, HAS_MID = true;
    const bf16_t* GA; const bf16_t* GB; bf16_t* OUT;
    __device__ __forceinline__ void mid(f32x4 (&acc)[2][2][4][2], const Unit& u, int wr, int wc, int fr, int fq) const {
        size_t off = (size_t)(u.pm * BM + wr * 64 + fr) * DM + u.pn * BM + wc * 32 + 8 * fq;
#pragma unroll
        for (int ai = 0; ai < 2; ++ai)
#pragma unroll
            for (int m = 0; m < 4; ++m) {
                asm volatile("" : "+v"(off));
#pragma unroll
                for (int bj = 0; bj < 2; ++bj) { const u32x4 a = *(const u32x4*)(GA + off + bj * HALF), b = *(const u32x4*)(GB + off + bj * HALF);
#pragma unroll
                    for (int n = 0; n < 2; ++n) { f32x4& c = acc[ai][bj][m][n]; const unsigned a0 = n ? a.z : a.x, a1 = n ? a.w : a.y, b0 = n ? b.z : b.x, b1 = n ? b.w : b.y;
                        c[0] *= bflo(a0) * __builtin_amdgcn_rcpf(fmaxf(bflo(b0), 1e-20f)); c[1] *= bfhi(a0) * __builtin_amdgcn_rcpf(fmaxf(bfhi(b0), 1e-20f));
                        c[2] *= bflo(a1) * __builtin_amdgcn_rcpf(fmaxf(bflo(b1), 1e-20f)); c[3] *= bfhi(a1) * __builtin_amdgcn_rcpf(fmaxf(bfhi(b1), 1e-20f)); } }
                off += (size_t)((m == 3) ? (HALF - 48) : 16) * DM;
            }
    }
    __device__ __forceinline__ void operator()(const f32x4 (&acc)[2][2][4][2], const Unit& u, int wr, int wc, int fr, int fq) const {
#pragma unroll
        for (int ai = 0; ai < 2; ++ai)
#pragma unroll
            for (int m = 0; m < 4; ++m) { const int row = u.pm * BM + ai * HALF + wr * 64 + m * 16 + fr; const size_t off = (size_t)row * DM + u.pn * BM + wc * 32 + 8 * fq;
#pragma unroll
                for (int bj = 0; bj < 2; ++bj) { const u32x4 g = *(const u32x4*)(GB + off + bj * HALF); const f32x4 a0 = acc[ai][bj][m][0], a1 = acc[ai][bj][m][1];
                    *(u32x4*)(OUT + off + bj * HALF) = (u32x4){pkbf(a0[0] * bflo(g.x), a0[1] * bfhi(g.x)), pkbf(a0[2] * bflo(g.y), a0[3] * bfhi(g.y)), pkbf(a1[0] * bflo(g.z), a1[1] * bfhi(g.z)), pkbf(a1[2] * bflo(g.w), a1[3] * bfhi(g.w))}; } }
    }
};
struct EpiOut {
    static constexpr bool PERM = true, AFTER_DRAIN = false, HAS_MID = false;
    const float* X; bf16_t* HB; float* ssq;
    __device__ __forceinline__ void operator()(const f32x4 (&acc)[2][2][4][2], const Unit& u, int wr, int wc, int fr, int fq) const {
#pragma unroll
        for (int ai = 0; ai < 2; ++ai)
#pragma unroll
            for (int m = 0; m < 4; ++m) { const int row = u.pm * BM + ai * HALF + wr * 64 + m * 16 + fr; const size_t off = (size_t)row * DM + u.pn * BM + wc * 32 + 8 * fq; float ss = 0.f;
#pragma unroll
                for (int bj = 0; bj < 2; ++bj) { const size_t o2 = off + bj * HALF; const f32x4 h0 = *(const f32x4*)(X + o2) + acc[ai][bj][m][0], h1 = *(const f32x4*)(X + o2 + 4) + acc[ai][bj][m][1];
                    *(u32x4*)(HB + o2) = pk8(h0, h1);
                    ss += ((h0[0] * h0[0] + h0[1] * h0[1]) + (h0[2] * h0[2] + h0[3] * h0[3])) + ((h1[0] * h1[0] + h1[1] * h1[1]) + (h1[2] * h1[2] + h1[3] * h1[3])); }
                ss += __shfl_xor(ss, 16); ss += __shfl_xor(ss, 32);
                if (fq == 0) ssq[(size_t)row * 16 + u.pn * 4 + wc] = ss; }
    }
};
typedef _Float16 f16x2_t __attribute__((ext_vector_type(2)));
__device__ __forceinline__ unsigned pkh(float lo, float hi) { f16x2_t h = {(_Float16)lo, (_Float16)hi}; return __builtin_bit_cast(unsigned, h); }
struct EpiScore {
    static constexpr bool PERM = true, AFTER_DRAIN = false, HAS_MID = false;
    const float* ssq; unsigned short* SC;
    __device__ __forceinline__ void operator()(const f32x4 (&acc)[2][2][4][2], const Unit& u, int wr, int wc, int fr, int fq) const {
#pragma unroll
        for (int ai = 0; ai < 2; ++ai)
#pragma unroll
            for (int m = 0; m < 4; ++m) { const int row = u.pm * BM + ai * HALF + wr * 64 + m * 16 + fr;
                const f32x4* sp = (const f32x4*)(ssq + (size_t)row * 16); const f32x4 s0 = sp[0], s1 = sp[1], s2 = sp[2], s3 = sp[3];
                const float tot = (((s0[0] + s0[1]) + (s0[2] + s0[3])) + ((s1[0] + s1[1]) + (s1[2] + s1[3]))) + (((s2[0] + s2[1]) + (s2[2] + s2[3])) + ((s3[0] + s3[1]) + (s3[2] + s3[3])));
                const float rstd = 1.0f / sqrtf(tot * (1.0f / DM) + EPS);
                unsigned short* rp = SC + (size_t)row * SCW + u.pn * BM + wc * 32 + 8 * fq;
#pragma unroll
                for (int bj = 0; bj < 2; ++bj) { const f32x4 v0 = acc[ai][bj][m][0] * rstd, v1 = acc[ai][bj][m][1] * rstd;
                    *(u32x4*)(rp + bj * HALF) = (u32x4){pkh(v0[0], v0[1]), pkh(v0[2], v0[3]), pkh(v1[0], v1[1]), pkh(v1[2], v1[3])}; } }
    }
};
}

#define LAS __attribute__((address_space(3)))
namespace attn {
typedef unsigned short bf16_t;
typedef short bf16x8 __attribute__((ext_vector_type(8)));
typedef short s16x4 __attribute__((ext_vector_type(4)));
typedef float f32x16 __attribute__((ext_vector_type(16)));
typedef unsigned u32x4 __attribute__((ext_vector_type(4)));
constexpr int LDS_K = 0, LDS_V = 32768;
constexpr int LDS_BIAS = 65536;
constexpr int LDS_BYTES = 65536 + 3072;
constexpr float THR = 8.0f;
__device__ __forceinline__ int crow(int r, int hi) { return (r & 3) + 8 * (r >> 2) + 4 * hi; }
__device__ __forceinline__ s16x4 vtr(const LAS char* p) { return __builtin_bit_cast(s16x4, __builtin_amdgcn_ds_read_tr16_b64_v4i16((LAS s16x4*)p)); }
__device__ __forceinline__ float xhalf_max(float v) { auto rr = __builtin_amdgcn_permlane32_swap(__float_as_uint(v), __float_as_uint(v), false, false); return fmaxf(__uint_as_float(rr[0]), __uint_as_float(rr[1])); }
__device__ __forceinline__ float xhalf_sum(float v) { auto rr = __builtin_amdgcn_permlane32_swap(__float_as_uint(v), __float_as_uint(v), false, false); return __uint_as_float(rr[0]) + __uint_as_float(rr[1]); }
#ifndef ATTN_CLEANM
#define ATTN_CLEANM 0
#endif
#ifndef ATTN_PRIO
#define ATTN_PRIO 1
#endif
__device__ __forceinline__ float max3f(float a, float b, float c) { float r; asm("v_max3_f32 %0, %1, %2, %3" : "=v"(r) : "v"(a), "v"(b), "v"(c)); return r; }
__device__ __forceinline__ float max2f(float a, float b) { float r; asm("v_max_f32_e32 %0, %1, %2" : "=v"(r) : "v"(a), "v"(b)); return r; }
#define ATT_BAR() do { asm volatile("s_waitcnt lgkmcnt(0)" ::: "memory"); __builtin_amdgcn_s_barrier(); asm volatile("" ::: "memory"); } while (0)

template <bool WIN, int XV = 0, bool NOMAX = false>
__device__ __forceinline__ void attn_unit(LAS char* lds, const bf16_t* Q, const bf16_t* Kimg, const bf16_t* Vimg, bf16_t* O, int b, int h, int qblk, const float* bias_h  , float sink_l2) {
    const int tid = threadIdx.x, lane = tid & 63, r32 = lane & 31, hi = lane >> 5; const int wid = __builtin_amdgcn_readfirstlane(tid >> 6); const int grp = wid >> 2;
    const int q0 = qblk * 256, qw0 = q0 + 32 * wid, qrow = qw0 + r32; const size_t grow = (size_t)b * SEQ + qrow;
    const int kvh = h >> 2;
    int t_lo = 0, t_hi = SEQ / 64 - 1;
    if (WIN) { t_lo = q0 / 64 - 2; if (t_lo < 0) t_lo = 0; t_hi = q0 / 64 + 5; if (t_hi > SEQ / 64 - 1) t_hi = SEQ / 64 - 1; }
    const int n = t_hi - t_lo + 1;
    const bf16_t* Kb = Kimg + ((size_t)((b * NKV + kvh) * (SEQ / 64) + t_lo) << 12) + tid * 8;
    const bf16_t* Vb = Vimg + ((size_t)((b * NKV + kvh) * (SEQ / 64) + t_lo) << 12) + tid * 8;
    bf16x8 qr[4];
#pragma unroll
    for (int d0 = 0; d0 < 4; ++d0) qr[d0] = *(const bf16x8*)(Q + grow * (2 * QW) + h * HD + d0 * 16 + hi * 8);
    LAS float* biasl = (LAS float*)(lds + LDS_BIAS);
    if (WIN) { for (int j = tid; j < 768; j += 512) biasl[j] = (j >= 256 && j <= 512) ? bias_h[j - 256] : -1e30f; }
    u32x4 kreg, vreg;
    { const u32x4 k0 = *(const u32x4*)Kb, v0 = *(const u32x4*)Vb, k1 = *(const u32x4*)(Kb + 4096), v1 = *(const u32x4*)(Vb + 4096);
      kreg = *(const u32x4*)(Kb + 2 * 4096); vreg = *(const u32x4*)(Vb + 2 * 4096);
      *(LAS u32x4*)(lds + LDS_K + tid * 16) = k0; *(LAS u32x4*)(lds + LDS_V + tid * 16) = v0;
      *(LAS u32x4*)(lds + LDS_K + 8192 + tid * 16) = k1; *(LAS u32x4*)(lds + LDS_V + 8192 + tid * 16) = v1; }
    ATT_BAR();
    if (grp) ATT_BAR();
    f32x16 o0 = {}, o1 = {}, p0, p1, negm;
    float mref = WIN ? sink_l2 : 0.0f, lsum = (WIN && hi == 0) ? 1.0f : 0.0f;
#pragma unroll
    for (int r = 0; r < 16; ++r) negm[r] = -mref;
    const int vlane = ((lane >> 4) & 1) * 32 + (lane & 3) * 8 + (4 * hi + ((lane & 15) >> 2)) * 64;
    const LAS char* kfr = lds + LDS_K + hi * 1024 + r32 * 16;
    u32x4 pk[4]; bf16x8 kf[8], vf[8];
#define ATT_LDK(sl) do { const LAS char* kp_ = kfr + (sl) * 8192; \
        _Pragma("unroll") for (int d0 = 0; d0 < 4; ++d0) { kf[2 * d0] = *(const LAS bf16x8*)(kp_ + d0 * 2048); kf[2 * d0 + 1] = *(const LAS bf16x8*)(kp_ + d0 * 2048 + 512); } } while (0)
#define ATT_LDV(sl) do { const LAS char* vp_ = lds + LDS_V + (sl) * 8192 + vlane; \
        _Pragma("unroll") for (int ks = 0; ks < 4; ++ks) { \
            const s16x4 l0 = vtr(vp_ + ks * 1024), h0 = vtr(vp_ + ks * 1024 + 512), l1 = vtr(vp_ + 4096 + ks * 1024), h1 = vtr(vp_ + 4096 + ks * 1024 + 512); \
            vf[2 * ks] = (bf16x8){l0[0], l0[1], l0[2], l0[3], h0[0], h0[1], h0[2], h0[3]}; vf[2 * ks + 1] = (bf16x8){l1[0], l1[1], l1[2], l1[3], h1[0], h1[1], h1[2], h1[3]}; } } while (0)
#define ATT_QK() do { \
        if (NOMAX) { const f32x16 z_ = {}; p0 = __builtin_amdgcn_mfma_f32_32x32x16_bf16(kf[0], qr[0], z_, 0, 0, 0); p1 = __builtin_amdgcn_mfma_f32_32x32x16_bf16(kf[1], qr[0], z_, 0, 0, 0); } \
        else { p0 = __builtin_amdgcn_mfma_f32_32x32x16_bf16(kf[0], qr[0], negm, 0, 0, 0); p1 = __builtin_amdgcn_mfma_f32_32x32x16_bf16(kf[1], qr[0], negm, 0, 0, 0); } \
        _Pragma("unroll") for (int d0 = 1; d0 < 4; ++d0) { p0 = __builtin_amdgcn_mfma_f32_32x32x16_bf16(kf[2 * d0], qr[d0], p0, 0, 0, 0); p1 = __builtin_amdgcn_mfma_f32_32x32x16_bf16(kf[2 * d0 + 1], qr[d0], p1, 0, 0, 0); } } while (0)
#define ATT_PV() do { \
        _Pragma("unroll") for (int ks = 0; ks < 4; ++ks) { const bf16x8 pf = __builtin_bit_cast(bf16x8, pk[ks]); \
            o0 = __builtin_amdgcn_mfma_f32_32x32x16_bf16(vf[2 * ks], pf, o0, 0, 0, 0); o1 = __builtin_amdgcn_mfma_f32_32x32x16_bf16(vf[2 * ks + 1], pf, o1, 0, 0, 0); } } while (0)
    int ia = 0, ib = n - 1;
    if (WIN) { int lo_t = (qw0 - 128) >> 6; if (lo_t < t_lo) lo_t = t_lo; int hi_t = (qw0 + 31 + 128) >> 6; if (hi_t > t_hi) hi_t = t_hi; ia = lo_t - t_lo; ib = hi_t - t_lo; }
#define ATT_STAGE(i) do { if ((i) + 2 < n) { const int sl_ = ((i) + 2) & 3; *(LAS u32x4*)(lds + LDS_K + sl_ * 8192 + tid * 16) = kreg; *(LAS u32x4*)(lds + LDS_V + sl_ * 8192 + tid * 16) = vreg; \
            if ((i) + 3 < n) { kreg = *(const u32x4*)(Kb + (size_t)((i) + 3) * 4096); vreg = *(const u32x4*)(Vb + (size_t)((i) + 3) * 4096); } } } while (0)
    bool first = !WIN;
    int i = 0;
    if (ia == 0) { ATT_LDK(0); asm volatile("s_waitcnt lgkmcnt(0)" ::: "memory"); ATT_QK(); }
    ATT_BAR();
    for (; i < ia; ++i) {
        ATT_STAGE(i);
        ATT_BAR();
        if (i + 1 == ia) { ATT_LDK((i + 1) & 3); asm volatile("s_waitcnt lgkmcnt(0)" ::: "memory"); ATT_QK(); }
        ATT_BAR();
    }
    for (; i <= ib; ++i) {
        ATT_LDV(i & 3);
        __builtin_amdgcn_sched_barrier(0);
        asm volatile("s_nop 7" : "+v"(p0), "+v"(p1));
        if (WIN) {
            const LAS float* bp = biasl + (64 * (t_lo + i) - qrow + 4 * hi + 384);
#pragma unroll
            for (int r = 0; r < 16; ++r) { p0[r] += bp[(r & 3) + 8 * (r >> 2)]; p1[r] += bp[32 + (r & 3) + 8 * (r >> 2)]; }
        }
        if (!NOMAX) {
        float ra = max3f(p0[0], p0[1], p1[0]), rb = max3f(p0[2], p0[3], p1[1]); ra = max3f(ra, p1[2], p1[3]);
#pragma unroll
        for (int r = 4; r < 16; r += 4) { ra = max3f(ra, p0[r], p0[r + 1]); rb = max3f(rb, p0[r + 2], p0[r + 3]); ra = max3f(ra, p1[r], p1[r + 1]); rb = max3f(rb, p1[r + 2], p1[r + 3]); }
        float rm = xhalf_max(max2f(ra, rb));
        if (first || __builtin_amdgcn_ballot_w64(rm > THR) != 0ull) {
            const float delta = first ? rm : fmaxf(rm, 0.0f); const float f = first ? 1.0f : __builtin_amdgcn_exp2f(-delta);
            mref += delta; lsum *= f;
#pragma unroll
            for (int r = 0; r < 16; ++r) { p0[r] -= delta; p1[r] -= delta; o0[r] *= f; o1[r] *= f; negm[r] = -mref; }
            first = false;
        }
        }
        float ps = 0.f;
#pragma unroll
        for (int r = 0; r < 16; ++r) { if (XV == 1) { p0[r] *= 0.5f; p1[r] *= 0.5f; } else { p0[r] = __builtin_amdgcn_exp2f(p0[r]); p1[r] = __builtin_amdgcn_exp2f(p1[r]); } ps += p0[r] + p1[r]; }
        lsum += ps;
#pragma unroll
        for (int q = 0; q < 4; ++q) { pk[0][q] = pkbf(p0[2 * q], p0[2 * q + 1]); pk[1][q] = pkbf(p0[8 + 2 * q], p0[9 + 2 * q]); pk[2][q] = pkbf(p1[2 * q], p1[2 * q + 1]); pk[3][q] = pkbf(p1[8 + 2 * q], p1[9 + 2 * q]); }
        ATT_STAGE(i);
        asm volatile("s_waitcnt lgkmcnt(0)" : "+v"(vf[0]), "+v"(vf[1]), "+v"(vf[2]), "+v"(vf[3]), "+v"(vf[4]), "+v"(vf[5]), "+v"(vf[6]), "+v"(vf[7]), "+v"(pk[0]), "+v"(pk[1]), "+v"(pk[2]), "+v"(pk[3]) : : "memory");
        if (XV != 3) ATT_BAR(); else asm volatile("s_waitcnt lgkmcnt(0)" ::: "memory");
        __builtin_amdgcn_s_setprio(ATTN_PRIO);
#if ATTN_CLEANM
        if (i < ib) { ATT_LDK((i + 1) & 3); __builtin_amdgcn_sched_barrier(0); }
#else
        if (i < ib) ATT_LDK((i + 1) & 3);
#endif
        if (XV != 2) { ATT_PV(); if (i < ib) ATT_QK(); } else { asm volatile("" : "+v"(kf[0]), "+v"(kf[7]), "+v"(vf[0]), "+v"(vf[7])); }
        __builtin_amdgcn_s_setprio(0);
        ATT_BAR();
    }
    for (; i < n; ++i) { ATT_STAGE(i); ATT_BAR(); ATT_BAR(); }
#undef ATT_STAGE
#undef ATT_QK
#undef ATT_PV
#undef ATT_LDK
#undef ATT_LDV
    const float inv = 1.0f / xhalf_sum(lsum);
    bf16_t* Orow = O + grow * (2 * QW) + h * HD + 4 * hi;
#pragma unroll
    for (int g = 0; g < 4; ++g) {
        u32x2_t w0, w1;
        w0.x = pkbf(o0[4 * g] * inv, o0[4 * g + 1] * inv); w0.y = pkbf(o0[4 * g + 2] * inv, o0[4 * g + 3] * inv);
        w1.x = pkbf(o1[4 * g] * inv, o1[4 * g + 1] * inv); w1.y = pkbf(o1[4 * g + 2] * inv, o1[4 * g + 3] * inv);
        *(u32x2_t*)(Orow + 8 * g) = w0; *(u32x2_t*)(Orow + 32 + 8 * g) = w1;
    }
    if (!grp) ATT_BAR();
}
}

namespace peer {
typedef unsigned u32x4 __attribute__((ext_vector_type(4)));
typedef float f32x4 __attribute__((ext_vector_type(4)));
constexpr int WAVE_LDS = 2048;

template <int CTRL> __device__ __forceinline__ int dppi(int x) { return __builtin_amdgcn_mov_dpp(x, CTRL, 0xf, 0xf, true); }
template <int CTRL> __device__ __forceinline__ float dppf(float x) { return __builtin_bit_cast(float, __builtin_amdgcn_mov_dpp(__builtin_bit_cast(int, x), CTRL, 0xf, 0xf, true)); }
constexpr int XOR1 = 0xB1, XOR2 = 0x4E, XOR7 = 0x141, XOR8 = 0x128;
__device__ __forceinline__ float wave_sum(float x) {
    x += dppf<XOR1>(x); x += dppf<XOR2>(x); x += dppf<XOR7>(x); x += dppf<XOR8>(x);
    auto s = __builtin_amdgcn_permlane16_swap(__float_as_uint(x), __float_as_uint(x), false, false); x = __uint_as_float(s[0]) + __uint_as_float(s[1]);
    auto t = __builtin_amdgcn_permlane32_swap(__float_as_uint(x), __float_as_uint(x), false, false); return __uint_as_float(t[0]) + __uint_as_float(t[1]);
}
__device__ __forceinline__ float dot2bf(unsigned a, unsigned b, float c) { return __builtin_amdgcn_fdot2_f32_bf16(__builtin_bit_cast(bf16x2_t, a), __builtin_bit_cast(bf16x2_t, b), c, false); }
__device__ __forceinline__ unsigned getw(const u32x4& v, int i) { return i == 0 ? v.x : i == 1 ? v.y : i == 2 ? v.z : v.w; }
__device__ __forceinline__ int okey(float f, int lowbits, int payload) { int b = __float_as_int(f); b ^= (b >> 31) & 0x7fffffff; return (b & ~((1 << lowbits) - 1)) | payload; }
__device__ __forceinline__ float kval(int k, int lowbits) { int b = (k & ~((1 << lowbits) - 1)) | (1 << (lowbits - 1)); b ^= (b >> 31) & 0x7fffffff; return __int_as_float(b); }
#define CE_DESC(a, b) do { const int _x = (a), _y = (b); (a) = _x > _y ? _x : _y; (b) = _x > _y ? _y : _x; } while (0)
template <int N> __device__ __forceinline__ void bitonic_sort_desc(int (&a)[N]) {
#pragma unroll
    for (int k = 2; k <= N; k <<= 1)
#pragma unroll
        for (int j = k >> 1; j > 0; j >>= 1)
#pragma unroll
            for (int i = 0; i < N; ++i) { const int l = i ^ j; if (l > i) { if ((i & k) == 0) CE_DESC(a[i], a[l]); else CE_DESC(a[l], a[i]); } }
}
template <int N> __device__ __forceinline__ void bitonic_merge_desc(int (&a)[N]) {
#pragma unroll
    for (int j = N >> 1; j > 0; j >>= 1)
#pragma unroll
        for (int i = 0; i < N; ++i) { const int l = i ^ j; if (l > i) CE_DESC(a[i], a[l]); }
}
__device__ __forceinline__ unsigned long long cand_table(int q8) {
    unsigned long long r = 0xFFFFFFFFFFFFFFFFull; int n = 0;
#pragma unroll
    for (int i = 0; i < 16; ++i)
#pragma unroll
        for (int j = 0; j < 16; ++j) if ((i + 1) * (j + 1) <= 16) { if (n / 7 == q8) { const int s = n % 7; r = (r & ~(0xFFull << (8 * s))) | ((unsigned long long)(i * 16 + j) << (8 * s)); } ++n; }
    return r;
}

struct SCtx { u32x4 v[4]; };
__device__ __forceinline__ SCtx s_ctx(int lane, int t, const unsigned short* SC) { SCtx c; const u32x4* p = (const u32x4*)(SC + (size_t)t * SCW + (lane >> 2) * NKEYS + (lane & 3) * 32);
#pragma unroll
    for (int i = 0; i < 4; ++i) c.v[i] = p[i];
    return c; }
__device__ __forceinline__ void route_token(LAS char* wl, int lane, int t, unsigned long long ct, const SCtx& scx  , const float* SSQ, unsigned short* E, float* G, float* RSTD) {
    LAS int* skeys = (LAS int*)wl;
    {
        const int c = lane >> 2, qq = lane & 3;
        int a[16], bb[16];
#pragma unroll
        for (int i = 0; i < 2; ++i) { const u32x4 v = scx.v[i];
#pragma unroll
            for (int j = 0; j < 4; ++j) { const unsigned w = getw(v, j); const pg8::f16x2_t h = __builtin_bit_cast(pg8::f16x2_t, w);
                a[8 * i + 2 * j] = okey((float)h.x, 7, 127 - (qq * 32 + 8 * i + 2 * j)); a[8 * i + 2 * j + 1] = okey((float)h.y, 7, 127 - (qq * 32 + 8 * i + 2 * j + 1)); } }
#pragma unroll
        for (int i = 0; i < 2; ++i) { const u32x4 v = scx.v[2 + i];
#pragma unroll
            for (int j = 0; j < 4; ++j) { const unsigned w = getw(v, j); const pg8::f16x2_t h = __builtin_bit_cast(pg8::f16x2_t, w);
                bb[8 * i + 2 * j] = okey((float)h.x, 7, 127 - (qq * 32 + 16 + 8 * i + 2 * j)); bb[8 * i + 2 * j + 1] = okey((float)h.y, 7, 127 - (qq * 32 + 16 + 8 * i + 2 * j + 1)); } }
        bitonic_sort_desc<16>(a); bitonic_sort_desc<16>(bb);
#pragma unroll
        for (int i = 0; i < 16; ++i) a[i] = a[i] > bb[15 - i] ? a[i] : bb[15 - i];
        bitonic_merge_desc<16>(a);
#pragma unroll
        for (int i = 0; i < 16; ++i) bb[i] = dppi<XOR1>(a[15 - i]);
#pragma unroll
        for (int i = 0; i < 16; ++i) a[i] = a[i] > bb[i] ? a[i] : bb[i];
        bitonic_merge_desc<16>(a);
#pragma unroll
        for (int i = 0; i < 16; ++i) bb[i] = dppi<XOR2>(a[15 - i]);
#pragma unroll
        for (int i = 0; i < 16; ++i) a[i] = a[i] > bb[i] ? a[i] : bb[i];
        bitonic_merge_desc<16>(a);
        if (qq == 0) {
#pragma unroll
            for (int i = 0; i < 4; ++i) *(LAS u32x4*)(skeys + c * 16 + 4 * i) = (u32x4){(unsigned)a[4 * i], (unsigned)a[4 * i + 1], (unsigned)a[4 * i + 2], (unsigned)a[4 * i + 3]};
        }
    }
    asm volatile("s_waitcnt lgkmcnt(0)" ::: "memory");
    {
        const int hh = lane >> 3, q8 = lane & 7;
        int a[16];
#pragma unroll
        for (int s = 0; s < 8; ++s) {
            const int code = s < 7 ? (int)((ct >> (8 * s)) & 0xFF) : 0xFF;
            const int ci = code == 0xFF ? 0 : code;
            const int ka = skeys[(2 * hh) * 16 + (ci >> 4)], kb = skeys[(2 * hh + 1) * 16 + (ci & 15)];
            const float sum = kval(ka, 7) + kval(kb, 7);
            a[s] = code == 0xFF ? (int)0x80000000 : okey(sum, 8, 255 - code);
        }
        {
            int c8[8];
#pragma unroll
            for (int i = 0; i < 8; ++i) c8[i] = a[i];
            bitonic_sort_desc<8>(c8);
#pragma unroll
            for (int i = 0; i < 8; ++i) a[i] = c8[i];
        }
#pragma unroll
        for (int i = 0; i < 8; ++i) a[8 + i] = dppi<XOR1>(a[i]);
        { int tmp[8];
#pragma unroll
          for (int i = 0; i < 8; ++i) tmp[i] = a[8 + i];
#pragma unroll
          for (int i = 0; i < 8; ++i) a[8 + i] = tmp[7 - i]; }
        bitonic_merge_desc<16>(a);
        int bb[16];
#pragma unroll
        for (int i = 0; i < 16; ++i) bb[i] = dppi<XOR2>(a[15 - i]);
#pragma unroll
        for (int i = 0; i < 16; ++i) a[i] = a[i] > bb[i] ? a[i] : bb[i];
        bitonic_merge_desc<16>(a);
#pragma unroll
        for (int i = 0; i < 16; ++i) bb[i] = dppi<XOR7>(a[15 - i]);
#pragma unroll
        for (int i = 0; i < 16; ++i) a[i] = a[i] > bb[i] ? a[i] : bb[i];
        bitonic_merge_desc<16>(a);
        int k0 = a[0], k1 = a[1];
#pragma unroll
        for (int i = 1; i < 8; ++i) { k0 = q8 == i ? a[2 * i] : k0; k1 = q8 == i ? a[2 * i + 1] : k1; }
        const float mx = kval(a[0], 8);
        const int c0 = 255 - (k0 & 255), c1 = 255 - (k1 & 255);
        const int ka0 = skeys[(2 * hh) * 16 + (c0 >> 4)], kb0 = skeys[(2 * hh + 1) * 16 + (c0 & 15)];
        const int ka1 = skeys[(2 * hh) * 16 + (c1 >> 4)], kb1 = skeys[(2 * hh + 1) * 16 + (c1 & 15)];
        const float s0 = kval(ka0, 7) + kval(kb0, 7), s1 = kval(ka1, 7) + kval(kb1, 7);
        const float e0 = __expf(s0 - mx), e1 = __expf(s1 - mx);
        float z = e0 + e1; z += dppf<XOR1>(z); z += dppf<XOR2>(z); z += dppf<XOR7>(z);
        const float rz = 1.0f / z;
        const unsigned e0i = (unsigned)((127 - (ka0 & 127)) * NKEYS + (127 - (kb0 & 127))), e1i = (unsigned)((127 - (ka1 & 127)) * NKEYS + (127 - (kb1 & 127)));
        *(unsigned*)(E + (size_t)t * 128 + hh * 16 + 2 * q8) = e0i | (e1i << 16);
        *(f32x2_t*)(G + (size_t)t * 128 + hh * 16 + 2 * q8) = (f32x2_t){e0 * rz, e1 * rz};
    }
    if (lane == 0) { const f32x4* sp = (const f32x4*)(SSQ + (size_t)t * 16); const f32x4 s0 = sp[0], s1 = sp[1], s2 = sp[2], s3 = sp[3];
        const float tot = (((s0[0] + s0[1]) + (s0[2] + s0[3])) + ((s1[0] + s1[1]) + (s1[2] + s1[3]))) + (((s2[0] + s2[1]) + (s2[2] + s2[3])) + ((s3[0] + s3[1]) + (s3[2] + s3[3])));
        RSTD[t] = 1.0f / sqrtf(tot * (1.0f / DM) + EPS); }
    asm volatile("s_waitcnt lgkmcnt(0)" ::: "memory");
}

constexpr size_t SLICE_BYTES = (size_t)NEXP * 128;
__device__ __forceinline__ float wave_max(float x) {
    x = fmaxf(x, dppf<XOR1>(x)); x = fmaxf(x, dppf<XOR2>(x)); x = fmaxf(x, dppf<XOR7>(x)); x = fmaxf(x, dppf<XOR8>(x));
    auto s = __builtin_amdgcn_permlane16_swap(__float_as_uint(x), __float_as_uint(x), false, false); x = fmaxf(__uint_as_float(s[0]), __uint_as_float(s[1]));
    auto t = __builtin_amdgcn_permlane32_swap(__float_as_uint(x), __float_as_uint(x), false, false); return fmaxf(__uint_as_float(t[0]), __uint_as_float(t[1]));
}
__device__ __forceinline__ void table_rows4_fp8(const float* src, unsigned char* T8, float* INV, int e0, int es, int lane) {
    f32x4 v[4][4];
#pragma unroll
    for (int i = 0; i < 4; ++i) { const f32x4* p = (const f32x4*)(src + (size_t)(e0 + i * es) * DM + 16 * lane);
#pragma unroll
        for (int q = 0; q < 4; ++q) v[i][q] = __builtin_nontemporal_load(p + q); }
#pragma unroll
    for (int i = 0; i < 4; ++i) {
        float mx = 0.f;
#pragma unroll
        for (int q = 0; q < 4; ++q) mx = fmaxf(mx, fmaxf(fmaxf(fabsf(v[i][q][0]), fabsf(v[i][q][1])), fmaxf(fabsf(v[i][q][2]), fabsf(v[i][q][3]))));
        mx = wave_max(mx);
        const float sc = mx > 0.f ? 448.0f / mx : 1.0f;
        unsigned o[4];
#pragma unroll
        for (int q = 0; q < 4; ++q) { unsigned w = 0; w = __builtin_amdgcn_cvt_pk_fp8_f32(v[i][q][0] * sc, v[i][q][1] * sc, w, false); w = __builtin_amdgcn_cvt_pk_fp8_f32(v[i][q][2] * sc, v[i][q][3] * sc, w, true); o[q] = w; }
        const int e = e0 + i * es;
        *(u32x4*)(T8 + (size_t)(lane >> 3) * SLICE_BYTES + (size_t)e * 128 + (lane & 7) * 16) = (u32x4){o[0], o[1], o[2], o[3]};
        if (lane == 0) INV[e] = mx > 0.f ? mx * (1.0f / 448.0f) : 1.0f;
    }
}
__device__ __forceinline__ void tables_fp8(const float* peer_u, const float* peer_v, unsigned char* U8, unsigned char* V8, float* INVU, float* INVV, int r0, int r1, int w, int nw, int lane) {
    for (int e = r0 + w; e < r1; e += 4 * nw) {
        if (e + 3 * nw < r1) { table_rows4_fp8(peer_u, U8, INVU, e, nw, lane); table_rows4_fp8(peer_v, V8, INVV, e, nw, lane); }
        else for (int e2 = e; e2 < r1; e2 += nw) { table_rows4_fp8(peer_u, U8, INVU, e2, 0, lane); table_rows4_fp8(peer_v, V8, INVV, e2, 0, lane); }
    }
}
struct ECtx { u32x4 ea, eb; };
struct XCtx { u32x4 xa, xb; float rs; };
__device__ __forceinline__ ECtx e_ctx(int lane, int t, const unsigned short* E) { ECtx c; c.ea = *(const u32x4*)(E + (size_t)t * 128 + (lane >> 3) * 16); c.eb = *(const u32x4*)(E + (size_t)t * 128 + (lane >> 3) * 16 + 8); return c; }
__device__ __forceinline__ XCtx x_ctx(int lane, int t, int s, const unsigned short* HB, const float* RSTD) { XCtx c; c.xa = *(const u32x4*)(HB + (size_t)t * DM + s * 128 + (lane & 7) * 16); c.xb = *(const u32x4*)(HB + (size_t)t * DM + s * 128 + (lane & 7) * 16 + 8); c.rs = RSTD[t]; return c; }
__device__ __forceinline__ void g_rows(u32x4 (&row)[16], const ECtx& c, const unsigned char* T8s, int c8) {
#pragma unroll
    for (int j = 0; j < 16; ++j) { const unsigned ew = getw(j < 8 ? c.ea : c.eb, (j & 7) >> 1); const unsigned e = (j & 1) ? (ew >> 16) : (ew & 0xffffu);
        row[j] = *(const u32x4*)(T8s + (size_t)e * 128 + c8 * 16); }
}
__device__ __forceinline__ void u_compute(int lane, int t, int s, const XCtx& c, const f32x2_t (&gch)[8], const u32x4 (&row)[16], unsigned short* PA) {
    const int rs = lane >> 3, c8 = lane & 7;
    f32x2_t xf[8];
#pragma unroll
    for (int i = 0; i < 4; ++i) { const unsigned wa = getw(c.xa, i), wb = getw(c.xb, i); xf[i] = (f32x2_t){bflo(wa), bfhi(wa)} * gch[i] * c.rs; xf[4 + i] = (f32x2_t){bflo(wb), bfhi(wb)} * gch[4 + i] * c.rs; }
    float part[16];
#pragma unroll
    for (int j = 0; j < 16; ++j) {
        f32x2_t acc = {0.f, 0.f};
#pragma unroll
        for (int w = 0; w < 4; ++w) { const unsigned q = getw(row[j], w);
            acc = __builtin_elementwise_fma(__builtin_amdgcn_cvt_pk_f32_fp8(q, false), xf[2 * w], acc); acc = __builtin_elementwise_fma(__builtin_amdgcn_cvt_pk_f32_fp8(q, true), xf[2 * w + 1], acc); }
        float p = acc.x + acc.y; p += dppf<XOR1>(p); p += dppf<XOR2>(p); p += dppf<XOR7>(p); part[j] = p;
    }
    float p0 = part[0], p1 = part[1];
#pragma unroll
    for (int i = 1; i < 8; ++i) { p0 = c8 == i ? part[2 * i] : p0; p1 = c8 == i ? part[2 * i + 1] : p1; }
    *(unsigned*)(PA + ((size_t)t * 8 + s) * 128 + rs * 16 + 2 * c8) = pkbf(p0, p1);
}
#define TCL(t_) ((t_) < NTOK ? (t_) : NTOK - 1)
__device__ __forceinline__ void upass_slice(int lane, int s, int wv, int nwv, const unsigned char* U8s, const unsigned short* E, const unsigned short* HB, const float* RSTD, const float* gffn, unsigned short* PA) {
    const int c8 = lane & 7;
    int t = wv; if (t >= NTOK) return;
    f32x2_t gch[8];
#pragma unroll
    for (int i = 0; i < 4; ++i) { const f32x4 g = *(const f32x4*)(gffn + s * 128 + c8 * 16 + 4 * i); gch[2 * i] = (f32x2_t){g[0], g[1]}; gch[2 * i + 1] = (f32x2_t){g[2], g[3]}; }
    ECtx eA = e_ctx(lane, t, E), eB = e_ctx(lane, TCL(t + nwv), E); XCtx xA = x_ctx(lane, t, s, HB, RSTD), xB;
    u32x4 rA[16], rB[16];
    g_rows(rA, eA, U8s, c8);
    for (; t < NTOK; t += 2 * nwv) {
        eA = e_ctx(lane, TCL(t + 2 * nwv), E); xB = x_ctx(lane, TCL(t + nwv), s, HB, RSTD); g_rows(rB, eB, U8s, c8);
        u_compute(lane, t, s, xA, gch, rA, PA);
        eB = e_ctx(lane, TCL(t + 3 * nwv), E); xA = x_ctx(lane, TCL(t + 2 * nwv), s, HB, RSTD); g_rows(rA, eA, U8s, c8);
        if (t + nwv < NTOK) u_compute(lane, t + nwv, s, xB, gch, rB, PA);
    }
}
__device__ __forceinline__ void wpass_token(int lane, int t, const unsigned short* E, const float* G, const unsigned short* PA, const float* INVU, const float* INVV, float* W) {
    float a0 = 0.f, a1 = 0.f;
#pragma unroll
    for (int s = 0; s < 8; ++s) { const unsigned w = *(const unsigned*)(PA + ((size_t)t * 8 + s) * 128 + 2 * lane); a0 += bflo(w); a1 += bfhi(w); }
    const unsigned ew = *(const unsigned*)(E + (size_t)t * 128 + 2 * lane); const unsigned e0 = ew & 0xffffu, e1 = ew >> 16;
    const f32x2_t g = *(const f32x2_t*)(G + (size_t)t * 128 + 2 * lane);
    a0 *= INVU[e0]; a1 *= INVU[e1];
    const float w0 = g.x * 0.5f * a0 * (1.0f + erff(a0 * 0.70710678118654752f)) * INVV[e0], w1 = g.y * 0.5f * a1 * (1.0f + erff(a1 * 0.70710678118654752f)) * INVV[e1];
    *(f32x2_t*)(W + (size_t)t * 128 + 2 * lane) = (f32x2_t){w0, w1};
}
struct WCtx { f32x4 w0, w1, w2, w3; };
__device__ __forceinline__ WCtx w_ctx(int lane, int t, const float* W) { const f32x4* wp = (const f32x4*)(W + (size_t)t * 128 + (lane >> 3) * 16); WCtx c; c.w0 = wp[0]; c.w1 = wp[1]; c.w2 = wp[2]; c.w3 = wp[3]; return c; }
__device__ __forceinline__ void v_compute(int lane, int t, int s, const WCtx& wc, const u32x4 (&row)[16], unsigned short* PO) {
    const int rs = lane >> 3, c8 = lane & 7;
    f32x2_t o[8];
#pragma unroll
    for (int i = 0; i < 8; ++i) o[i] = (f32x2_t){0.f, 0.f};
#pragma unroll
    for (int j = 0; j < 16; ++j) {
        const f32x4 wq = j < 4 ? wc.w0 : j < 8 ? wc.w1 : j < 12 ? wc.w2 : wc.w3; const int jj = j & 3; const float wj = jj == 0 ? wq.x : jj == 1 ? wq.y : jj == 2 ? wq.z : wq.w; const f32x2_t w2v = {wj, wj};
#pragma unroll
        for (int w = 0; w < 4; ++w) { const unsigned q = getw(row[j], w);
            o[2 * w] = __builtin_elementwise_fma(__builtin_amdgcn_cvt_pk_f32_fp8(q, false), w2v, o[2 * w]); o[2 * w + 1] = __builtin_elementwise_fma(__builtin_amdgcn_cvt_pk_f32_fp8(q, true), w2v, o[2 * w + 1]); }
    }
    float of[16];
#pragma unroll
    for (int i = 0; i < 8; ++i) { of[2 * i] = o[i].x; of[2 * i + 1] = o[i].y; }
#pragma unroll
    for (int i = 0; i < 16; ++i) { float x = of[i]; x += dppf<XOR8>(x);
        auto s1 = __builtin_amdgcn_permlane16_swap(__float_as_uint(x), __float_as_uint(x), false, false); x = __uint_as_float(s1[0]) + __uint_as_float(s1[1]);
        auto s2 = __builtin_amdgcn_permlane32_swap(__float_as_uint(x), __float_as_uint(x), false, false); of[i] = __uint_as_float(s2[0]) + __uint_as_float(s2[1]); }
    if (rs == 0) {
        unsigned short* po = PO + (size_t)t * DM + s * 128 + c8 * 16;
        *(u32x4*)po = (u32x4){pkbf(of[0], of[1]), pkbf(of[2], of[3]), pkbf(of[4], of[5]), pkbf(of[6], of[7])};
        *(u32x4*)(po + 8) = (u32x4){pkbf(of[8], of[9]), pkbf(of[10], of[11]), pkbf(of[12], of[13]), pkbf(of[14], of[15])};
    }
}
__device__ __forceinline__ void vpass_slice(int lane, int s, int wv, int nwv, const unsigned char* V8s, const unsigned short* E, const float* W, unsigned short* PO) {
    const int c8 = lane & 7;
    int t = wv; if (t >= NTOK) return;
    ECtx eA = e_ctx(lane, t, E), eB = e_ctx(lane, TCL(t + nwv), E); WCtx wA = w_ctx(lane, t, W), wB;
    u32x4 rA[16], rB[16];
    g_rows(rA, eA, V8s, c8);
    for (; t < NTOK; t += 2 * nwv) {
        eA = e_ctx(lane, TCL(t + 2 * nwv), E); wB = w_ctx(lane, TCL(t + nwv), W); g_rows(rB, eB, V8s, c8);
        v_compute(lane, t, s, wA, rA, PO);
        eB = e_ctx(lane, TCL(t + 3 * nwv), E); wA = w_ctx(lane, TCL(t + 2 * nwv), W); g_rows(rA, eA, V8s, c8);
        if (t + nwv < NTOK) v_compute(lane, t + nwv, s, wB, rB, PO);
    }
}
#undef TCL
__device__ __forceinline__ void final_token(int lane, int t, float* Y, const unsigned short* HB, const unsigned short* PO, const float* gfin) {
    f32x4* yr = (f32x4*)(Y + (size_t)t * DM) + lane; const u32x2_t* pr = (const u32x2_t*)(PO + (size_t)t * DM) + lane; const u32x2_t* hr = (const u32x2_t*)(HB + (size_t)t * DM) + lane;
    f32x4 v[4]; float ss = 0.f;
#pragma unroll
    for (int j = 0; j < 4; ++j) { const u32x2_t hw = hr[64 * j]; v[j] = (f32x4){bflo(hw.x), bfhi(hw.x), bflo(hw.y), bfhi(hw.y)}; const u32x2_t p = pr[64 * j]; v[j][0] += bflo(p.x); v[j][1] += bfhi(p.x); v[j][2] += bflo(p.y); v[j][3] += bfhi(p.y);
        ss += (v[j][0] * v[j][0] + v[j][1] * v[j][1]) + (v[j][2] * v[j][2] + v[j][3] * v[j][3]); }
    const float rstd = 1.0f / sqrtf(wave_sum(ss) * (1.0f / DM) + EPS);
#pragma unroll
    for (int j = 0; j < 4; ++j) { const f32x4 g = *((const f32x4*)gfin + lane + 64 * j); yr[64 * j] = (f32x4){v[j][0] * rstd * g[0], v[j][1] * rstd * g[1], v[j][2] * rstd * g[2], v[j][3] * rstd * g[3]}; }
}
}

constexpr int NWAVES = 8;
#ifndef MK_N_LAUNCHES
#define MK_N_LAUNCHES 1
#endif
constexpr int N_LAUNCHES = MK_N_LAUNCHES;
constexpr int PER_PHASE = 7;
#ifndef PROBE
#define PROBE -1
#endif
#ifndef DIAG_SEL
#define DIAG_SEL -1
#endif
#ifndef XVAR
#define XVAR 0
#endif
#define NREP(k) ((PROBE == (k)) ? 2 : 1)

typedef unsigned short bf16;
typedef unsigned v4u __attribute__((ext_vector_type(4)));
typedef float f32x4 __attribute__((ext_vector_type(4)));
#define LDS_WAIT() asm volatile("s_waitcnt lgkmcnt(0)" ::: "memory")
#define VM_WAIT() asm volatile("s_waitcnt vmcnt(0)" ::: "memory")

constexpr size_t MiB = 1u << 20;
constexpr size_t WS_CTL = 0, CTL_ZERO_BYTES = 64 * 1024;
constexpr size_t WS_TAB = 1 * MiB;
constexpr size_t WS_SSQ = 1 * MiB + 64 * 1024;
constexpr size_t WS_WIN = 3 * MiB;
constexpr size_t WS_WA = 10 * MiB, WS_WB = 11 * MiB;
constexpr size_t WS_WO = 12 * MiB;
constexpr size_t WS_WE = 14 * MiB;
constexpr size_t WS_U8 = 18 * MiB, WS_V8 = 34 * MiB;
constexpr size_t WS_PA = 50 * MiB;
constexpr size_t WS_INVU = 2 * MiB + 128 * 1024, WS_INVV = WS_INVU + 64 * 1024;
constexpr size_t WS_RSTD = WS_INVV + 64 * 1024;
constexpr size_t WS_G = 3 * MiB, WS_E = 11 * MiB;
constexpr size_t WS_W = 114 * MiB, WS_PSS = 122 * MiB;
constexpr int CW_RANK = 8192;
constexpr size_t WS_XN = 82 * MiB;
constexpr size_t WS_ACT = 114 * MiB;
constexpr size_t WS_QA = WS_ACT, WS_QB = WS_ACT + 512 * 2;
constexpr size_t WS_KA = WS_ACT + 32 * MiB, WS_VA = WS_ACT + 36 * MiB, WS_KB = WS_ACT + 40 * MiB, WS_VB = WS_ACT + 44 * MiB;
constexpr size_t WS_GA = WS_ACT + 48 * MiB, WS_GB = WS_ACT + 80 * MiB;
constexpr size_t WS_SC = WS_ACT;
constexpr size_t WS_END = 242 * MiB;
static_assert(WS_GB + 32 * MiB <= WS_END && WS_SC + (size_t)NTOK * SCW * 4 <= WS_END, "d_ws map");

constexpr int RING_BYTES = 131072;
constexpr int MISC_OFF = RING_BYTES + 320;
constexpr int LDS_BYTES = 147456;

#define XB_TMO      128
#define XB_XCNT(j)  (256  + 64 * (j))
#define XB_XSUB(j)  (1280 + 64 * (j))
#define XB_XGEN(j)  (2304 + 64 * (j))
#define XB_TOP      3328
#define XB_TOPGEN   3392
#define XCD_BAR_WORDS 3456
#define XB_SPIN_CAP (1u << 18)

__device__ __forceinline__ unsigned xb_ld(unsigned* p)              { return __hip_atomic_load(p, __ATOMIC_RELAXED, __HIP_MEMORY_SCOPE_AGENT); }
__device__ __forceinline__ unsigned xb_add(unsigned* p, unsigned v) { return __hip_atomic_fetch_add(p, v, __ATOMIC_RELAXED, __HIP_MEMORY_SCOPE_AGENT); }
__device__ __forceinline__ unsigned xb_xcc_id() { return (unsigned)__builtin_amdgcn_s_getreg((3 << 11) | 20) & 0xFu; }
#define XB_SPIN(cond, bar) do { unsigned _sp = 0; while (cond) { __builtin_amdgcn_s_sleep(1); \
    if ((++_sp & 255u) == 0u) { if (xb_ld(&(bar)[XB_TMO])) break; if (_sp > XB_SPIN_CAP) { atomicAdd(&(bar)[XB_TMO], 1u); break; } } } } while (0)

struct XcdBarrier {
    unsigned* bar; unsigned x;
    volatile LAS unsigned* st;
};

__device__ __forceinline__ XcdBarrier xcd_barrier_post(unsigned* bar, volatile LAS unsigned* st) {
    XcdBarrier b; b.bar = bar; b.x = xb_xcc_id(); b.st = st;
    if (threadIdx.x == 0) (void)xb_add(&bar[XB_XCNT(b.x)], 1u);
    return b;
}
__device__ __forceinline__ void xcd_barrier_complete(unsigned* bar, unsigned x, unsigned& nloc, unsigned& nx) {
    const unsigned G = gridDim.x * gridDim.y * gridDim.z;
    unsigned sum, cnt, mine, sp = 0u;
    for (;;) {
        sum = 0u; cnt = 0u; mine = 0u;
#pragma unroll
        for (unsigned j = 0; j < 16; ++j) { const unsigned c = xb_ld(&bar[XB_XCNT(j)]); sum += c; cnt += (c > 0u) ? 1u : 0u; mine = (j == x) ? c : mine; }
        if (sum == G) break;
        __builtin_amdgcn_s_sleep(1);
        if ((++sp & 255u) == 0u) { if (xb_ld(&bar[XB_TMO])) break; if (sp > XB_SPIN_CAP) { atomicAdd(&bar[XB_TMO], 1u); break; } }
    }
    nloc = mine > 0u ? mine : 1u; nx = cnt > 0u ? cnt : 1u;
}

__device__ __forceinline__ void xcd_barrier(const XcdBarrier& b) {
    asm volatile("s_waitcnt vmcnt(0)" ::: "memory");
    __syncthreads();
    if (threadIdx.x == 0) {
        unsigned* bar = b.bar;
        __builtin_amdgcn_s_waitcnt(0);
        unsigned nloc = b.st[0], nx = b.st[1];
        if (nloc == 0u) { xcd_barrier_complete(bar, b.x, nloc, nx); b.st[0] = nloc; b.st[1] = nx; }
        const unsigned old = xb_add(&bar[XB_XSUB(b.x)], 1u);
        const unsigned gen = old / nloc;
        if (old + 1u == (gen + 1u) * nloc) {
            __builtin_amdgcn_fence(__ATOMIC_RELEASE, "agent");
            asm volatile("s_waitcnt vmcnt(0)" ::: "memory");
            const unsigned og = xb_add(&bar[XB_TOP], 1u);
            const unsigned tg = og / nx;
            if (og + 1u == (tg + 1u) * nx) xb_add(&bar[XB_TOPGEN], 1u);
            else XB_SPIN(xb_ld(&bar[XB_TOPGEN]) == tg, bar);
            __builtin_amdgcn_fence(__ATOMIC_ACQUIRE, "agent");
            xb_add(&bar[XB_XGEN(b.x)], 1u);
            asm volatile("s_waitcnt vmcnt(0)" ::: "memory");
        } else {
            XB_SPIN(xb_ld(&bar[XB_XGEN(b.x)]) == gen, bar);
            __builtin_amdgcn_fence(__ATOMIC_ACQUIRE, "agent");
            asm volatile("s_waitcnt vmcnt(0)" ::: "memory");
        }
    }
    __syncthreads();
}


struct Args { const float* in[17]; float* out; unsigned char* ws; int ph_lo, ph_hi, li, pad; };

__device__ __forceinline__ void p0_transpose_item(const float* W, int K, int N, bf16* WT, int k0, int src_n0, int dst_n0, LAS float* scr, int lane, int dpitch = 0, int dk0 = 0, bool split16 = false) {
    if (dpitch == 0) dpitch = K;
    const int sl = split16 ? ((lane & 15) + ((lane & 16) << 1)) : (lane & 31);
#pragma unroll 8
    for (int i = 0; i < 32; ++i) { const int kk = 2 * i + (lane >> 5); scr[kk * 33 + (lane & 31)] = W[(size_t)(k0 + kk) * N + src_n0 + sl]; }
    LDS_WAIT();
    const int c = lane & 7;
#pragma unroll
    for (int j = 0; j < 4; ++j) { const int n = (lane >> 3) + 8 * j; const LAS float* s = scr + (8 * c) * 33 + n;
        v4u o; o.x = pkbf(s[0 * 33], s[1 * 33]); o.y = pkbf(s[2 * 33], s[3 * 33]); o.z = pkbf(s[4 * 33], s[5 * 33]); o.w = pkbf(s[6 * 33], s[7 * 33]);
        *(v4u*)(WT + (size_t)(dst_n0 + n) * dpitch + dk0 + k0 + 8 * c) = o; }
    LDS_WAIT();
}
__device__ __forceinline__ int win_src_col(int dst_n0) {
    if (dst_n0 >= 1536) return dst_n0;
    const int tile = dst_n0 >> 8, c = dst_n0 & 255;
    return tile * 256 + 64 * ((c >> 5) & 3) + 16 * (c >> 7);
}
__device__ __forceinline__ int t5_bucket(int rel) {
    const int n = rel < 0 ? -rel : rel; int bkt;
    if (n < 8) bkt = n; else { int v = 8 + (31 - __builtin_clz(n * n)) - 6; bkt = v > 15 ? 15 : v; }
    return bkt + (rel > 0 ? 16 : 0);
}

__global__ void __launch_bounds__(NWAVES * 64, 2) mk_fwd(Args args) {
    extern __shared__ __attribute__((aligned(16))) unsigned char lds_raw[];
    LAS unsigned char* lds = (LAS unsigned char*)lds_raw;
    volatile LAS unsigned* MISC = (volatile LAS unsigned*)(lds + MISC_OFF);
    const int tid = threadIdx.x, lane = tid & 63, wave = __builtin_amdgcn_readfirstlane(tid >> 6);
    const int G = gridDim.x, bx = blockIdx.x; const int vcu = (G % 8 == 0) ? (bx % 8) * (G / 8) + bx / 8 : bx;
    const int gw = vcu * NWAVES + wave, NGW = G * NWAVES;
    unsigned char* ws = args.ws;
    const float* x = args.in[0]; const float* g_mix = args.in[1]; const float* w_in = args.in[2]; const float* b_gate = args.in[3];
    const float* q_norm_g = args.in[4]; const float* k_norm_g = args.in[5]; const float* rel_bias = args.in[6]; const float* sink = args.in[7];
    const float* w_a = args.in[8]; const float* w_b = args.in[9]; const float* w_out = args.in[10]; const float* g_ffn = args.in[11];
    const float* peer_wq = args.in[12]; const float* subkeys = args.in[13]; const float* peer_u = args.in[14]; const float* peer_v = args.in[15]; const float* g_final = args.in[16];
    float* out = args.out;
    float* ROPE = (float*)(ws + WS_TAB); float* BIAS = (float*)(ws + WS_TAB + 16384); float* SSQ = (float*)(ws + WS_SSQ);
    bf16 *WIN_T = (bf16*)(ws + WS_WIN), *WA_T = (bf16*)(ws + WS_WA), *WB_T = (bf16*)(ws + WS_WB), *WO_T = (bf16*)(ws + WS_WO), *WE_T = (bf16*)(ws + WS_WE);
    unsigned char *U8 = ws + WS_U8, *V8 = ws + WS_V8; bf16 *PA = (bf16*)(ws + WS_PA), *XN = (bf16*)(ws + WS_XN);
    float* RSTD = (float*)(ws + WS_RSTD); float *INVU = (float*)(ws + WS_INVU), *INVV = (float*)(ws + WS_INVV), *RG = (float*)(ws + WS_G), *RW = (float*)(ws + WS_W), *PSS = (float*)(ws + WS_PSS); bf16* RE = (bf16*)(ws + WS_E);
    bf16 *QA = (bf16*)(ws + WS_QA), *QB = (bf16*)(ws + WS_QB), *KA = (bf16*)(ws + WS_KA), *VA = (bf16*)(ws + WS_VA), *KB = (bf16*)(ws + WS_KB), *VB = (bf16*)(ws + WS_VB);
    bf16 *GA = (bf16*)(ws + WS_GA), *GB = (bf16*)(ws + WS_GB); bf16* SC = (bf16*)(ws + WS_SC);

    for (int u = tid; u < (LDS_BYTES - RING_BYTES) / 4; u += NWAVES * 64) ((LAS unsigned*)(lds + RING_BYTES))[u] = 0u;
    __syncthreads();
    XcdBarrier bar; bar.bar = (unsigned*)(ws + WS_CTL) + 1024; bar.x = 0; bar.st = nullptr;
    if (N_LAUNCHES != PER_PHASE) bar = xcd_barrier_post((unsigned*)(ws + WS_CTL) + 1024, MISC + 8);
    if (tid == 0) { const unsigned xc = xb_xcc_id(); MISC[13] = xc; MISC[12] = xb_add((unsigned*)(ws + WS_CTL) + CW_RANK + 64 * xc, 1u); }
    const bool tail_tables = (G == 256);
    const int lo = args.ph_lo, hi = args.ph_hi;
#define IN(k) (lo <= (k) && (k) < hi)
#define BOTH(k) (IN(k) && IN((k) + 1))
#define GRID_BAR() do { if (N_LAUNCHES != PER_PHASE) xcd_barrier(bar); STAMP(); } while (0)
#ifdef TSEL
    int n_stamp_ = 0;
#define STAMP() do { if (tid == 0) MISC[16 + n_stamp_] = (unsigned)__builtin_amdgcn_s_memrealtime(); ++n_stamp_; } while (0)
#else
#define STAMP() do { } while (0)
#endif
    STAMP();

    if (IN(0)) for (int rep_ = 0; rep_ < NREP(0); ++rep_) {
        if (rep_) { VM_WAIT(); __syncthreads(); }
        LAS float* scr = (LAS float*)(lds + wave * 16384);
        {
            constexpr int I_IN = (DM / 64) * (INW / 32), I_AB = (QW / 64) * (DM / 32), I_O = (DM / 64) * (DM / 32);
            constexpr int NITEMS = I_IN + 2 * I_AB + I_O;
            for (int it = gw; it < NITEMS; it += NGW) {
                int r = it;
                if (r < I_IN) { const int nblk = INW / 32, kb = r / nblk, nb = r % nblk; p0_transpose_item(w_in, DM, INW, WIN_T, 64 * kb, win_src_col(32 * nb), 32 * nb, scr, lane, 0, 0, 32 * nb < 1536); continue; } r -= I_IN;
                if (r < I_AB) { const int nblk = DM / 32, kb = r / nblk, nb = r % nblk; p0_transpose_item(w_a, QW, DM, WA_T, 64 * kb, 32 * nb, 32 * nb, scr, lane, DM, 0); continue; } r -= I_AB;
                if (r < I_AB) { const int nblk = DM / 32, kb = r / nblk, nb = r % nblk; p0_transpose_item(w_b, QW, DM, WA_T, 64 * kb, 32 * nb, 32 * nb, scr, lane, DM, QW); continue; }   r -= I_AB;
                { const int nblk = DM / 32, kb = r / nblk, nb = r % nblk; p0_transpose_item(w_out, DM, DM, WO_T, 64 * kb, 32 * nb, 32 * nb, scr, lane); }
            }
        }
        __syncthreads();
        {
            LAS float* sk_s = (LAS float*)lds;
            LAS float* wq_s = (LAS float*)(lds + 128 * 129 * 4);
            for (int it = vcu; it < 16 * 16; it += G) {
                const int c = it >> 4, k0 = (it & 15) * 64;
                for (int i = tid; i < 128 * 32; i += NWAVES * 64) { const int n = i >> 5, d4 = (i & 31) * 4; const f32x4 v = *(const f32x4*)(subkeys + ((size_t)c * NKEYS + n) * 128 + d4);
                    sk_s[n * 129 + d4] = v[0]; sk_s[n * 129 + d4 + 1] = v[1]; sk_s[n * 129 + d4 + 2] = v[2]; sk_s[n * 129 + d4 + 3] = v[3]; }
                for (int i = tid; i < 64 * 32; i += NWAVES * 64) { const int k = i >> 5, d4 = (i & 31) * 4; const f32x4 v = *(const f32x4*)(peer_wq + (size_t)(k0 + k) * SCW + c * 128 + d4);
                    wq_s[k * 129 + d4] = v[0]; wq_s[k * 129 + d4 + 1] = v[1]; wq_s[k * 129 + d4 + 2] = v[2]; wq_s[k * 129 + d4 + 3] = v[3]; }
                __syncthreads();
                {
                    typedef float f32x16_t __attribute__((ext_vector_type(16)));
                    const int tn = wave >> 1, tk = wave & 1; f32x16_t acc = {};
                    const LAS float* ap = sk_s + (32 * tn + (lane & 31)) * 129 + (lane >> 5); const LAS float* bp = wq_s + (32 * tk + (lane & 31)) * 129 + (lane >> 5);
#pragma unroll 8
                    for (int s = 0; s < 64; ++s) acc = __builtin_amdgcn_mfma_f32_32x32x2f32(ap[2 * s], bp[2 * s], acc, 0, 0, 0);
                    const float gk = g_ffn[k0 + 32 * tk + (lane & 31)];
#pragma unroll
                    for (int r = 0; r < 16; ++r) { const int n = 32 * tn + (r & 3) + 8 * (r >> 2) + 4 * (lane >> 5);
                        WE_T[(size_t)(c * 128 + n) * DM + k0 + 32 * tk + (lane & 31)] = (bf16)(pkbf(acc[r] * gk, 0.f) & 0xffffu); }
                }
                __syncthreads();
            }
        }
        peer::tables_fp8(peer_u, peer_v, U8, V8, INVU, INVV, 0, tail_tables ? NEXP / 2 : NEXP, gw, NGW, lane);
        for (int m = gw; m < NTOK; m += 2 * NGW) {
            const int m2 = (m + NGW < NTOK) ? m + NGW : m;
            const f32x4* xr = (const f32x4*)(x + (size_t)m * DM) + lane; const f32x4* xr2 = (const f32x4*)(x + (size_t)m2 * DM) + lane; f32x4 v[4], v2[4]; float s = 0.f, s2 = 0.f;
#pragma unroll
            for (int j = 0; j < 4; ++j) { v[j] = __builtin_nontemporal_load(xr + 64 * j); v2[j] = __builtin_nontemporal_load(xr2 + 64 * j); }
#pragma unroll
            for (int j = 0; j < 4; ++j) { s += (v[j][0] * v[j][0] + v[j][1] * v[j][1]) + (v[j][2] * v[j][2] + v[j][3] * v[j][3]); s2 += (v2[j][0] * v2[j][0] + v2[j][1] * v2[j][1]) + (v2[j][2] * v2[j][2] + v2[j][3] * v2[j][3]); }
            const float rstd = 1.0f / sqrtf(peer::wave_sum(s) * (1.0f / DM) + EPS), rstd2 = 1.0f / sqrtf(peer::wave_sum(s2) * (1.0f / DM) + EPS);
            unsigned long long* o8 = (unsigned long long*)(XN + (size_t)m * DM) + lane; unsigned long long* o82 = (unsigned long long*)(XN + (size_t)m2 * DM) + lane;
#pragma unroll
            for (int j = 0; j < 4; ++j) { const f32x4 g = *((const f32x4*)g_mix + lane + 64 * j);
                o8[64 * j] = (unsigned long long)pkbf(v[j][0] * rstd * g[0], v[j][1] * rstd * g[1]) | ((unsigned long long)pkbf(v[j][2] * rstd * g[2], v[j][3] * rstd * g[3]) << 32);
                o82[64 * j] = (unsigned long long)pkbf(v2[j][0] * rstd2 * g[0], v2[j][1] * rstd2 * g[1]) | ((unsigned long long)pkbf(v2[j][2] * rstd2 * g[2], v2[j][3] * rstd2 * g[3]) << 32); }
        }
        if (vcu == 0) {
            for (int i = tid; i < 64 * 16; i += NWAVES * 64) { const int pos = i >> 4, f = i & 15; const float fr = powf(10000.0f, -(float)f / 16.0f); const float ang = (float)pos * fr; ROPE[2 * i] = cosf(ang); ROPE[2 * i + 1] = sinf(ang); }
            for (int i = tid; i < 8 * 257; i += NWAVES * 64) { const int h = i / 257, rel = i % 257 - 128; BIAS[i] = rel_bias[t5_bucket(rel) * NH + h] * LOG2E; }
        }
        if (BOTH(0) && rep_ == NREP(0) - 1) GRID_BAR();
    }

    if (IN(1)) {
        pg8::Gemm g{XN, WIN_T, NTOK, INW, DM}; pg8::StaticOrder S; S.init(NTOK, INW, G, bx);
        pg8::EpiIn E{QA, KA, VA, QB, KB, VB, GA, GB, q_norm_g, k_norm_g, b_gate, ROPE};
        if (PROBE == 1) { pg8::gemm_phase<pg8::EpiIn, pg8::StaticOrder, true, true>(lds, g, S, E); VM_WAIT(); __syncthreads(); }
        pg8::gemm_phase<pg8::EpiIn, pg8::StaticOrder, true, true>(lds, g, S, E);
        if (tail_tables && bx >= 128) peer::tables_fp8(peer_u, peer_v, U8, V8, INVU, INVV, NEXP / 2, NEXP, (bx - 128) * NWAVES + wave, 128 * NWAVES, lane);
        if (BOTH(1)) GRID_BAR();
    }

    if (IN(2)) {
#ifdef DIAG_QK
        if (bx == 0) {
            LAS float* red = (LAS float*)lds; float worst = 0.f;
            for (int smp = 0; smp < 10; ++smp) {
                const int row = (smp * 2741 + 77) & (NTOK - 1), b = row >> 12, s = row & (SEQ - 1); const int kind = smp % 5;
                const int hh = (smp * 3 + 1) & 7, kh = smp & 1;
                float ref = 0.f, got = 0.f; const int d = tid & 63;
                if (tid < 64) {
                    int col;
                    if (kind == 0) col = hh * 64 + d; else if (kind == 1) col = 512 + kh * 64 + d; else if (kind == 2) col = (smp < 5 ? 640 : 1408) + kh * 64 + d; else if (kind == 3) col = (smp < 5 ? 768 + hh * 64 : 1280 + kh * 64) + d; else col = (smp < 5 ? 1536 : 2560) + hh * 64 + d;
                    float z = 0.f; for (int k = 0; k < DM; ++k) z += __builtin_bit_cast(float, (unsigned)XN[(size_t)row * DM + k] << 16) * w_in[(size_t)k * INW + col];
                    red[tid] = z;
                }
                __syncthreads();
                if (tid < 64) {
                    float z = red[tid];
                    if (kind == 0 || kind == 1) {
                        float ss = 0.f; for (int i = 0; i < 64; ++i) ss += red[i] * red[i];
                        const float rstd = 1.0f / sqrtf(ss / 64.0f + EPS); const float* g = kind == 0 ? q_norm_g : k_norm_g;
                        const int part = d >> 5, dd = d & 31, f = dd & 15; const int pos = part == 0 ? (s >> 6) : (s & 63);
                        const float ang = (float)pos * powf(10000.0f, -(float)f / 16.0f), cs = cosf(ang), sn = sinf(ang);
                        const float u1 = red[part * 32 + f] * rstd * g[part * 32 + f], u2 = red[part * 32 + 16 + f] * rstd * g[part * 32 + 16 + f];
                        z = dd < 16 ? u1 * cs - u2 * sn : u2 * cs + u1 * sn; if (kind == 0) z *= QSCALE;
                        got = kind == 0 ? __builtin_bit_cast(float, (unsigned)QA[(size_t)row * 1024 + hh * 64 + d] << 16) : __builtin_bit_cast(float, (unsigned)KA[kimg_off(b, kh, s, d)] << 16);
                    } else if (kind == 2) { got = __builtin_bit_cast(float, (unsigned)(smp < 5 ? VA : VB)[vimg_off(b, kh, s, d)] << 16);
                    } else if (kind == 3) { if (smp < 5) { z *= QSCALE; got = __builtin_bit_cast(float, (unsigned)QB[(size_t)row * 1024 + hh * 64 + d] << 16); } else got = __builtin_bit_cast(float, (unsigned)KB[kimg_off(b, kh, s, d)] << 16);
                    } else { z = 1.0f / (1.0f + expf(-(z + b_gate[(smp < 5 ? 0 : DM) + hh * 64 + d]))); got = __builtin_bit_cast(float, (unsigned)(smp < 5 ? GA : GB)[(size_t)row * DM + hh * 64 + d] << 16); }
                    ref = z;
                }
                __syncthreads();
                if (tid < 64) { red[128 + tid] = fabsf(ref - got); red[256 + tid] = fabsf(ref); }
                __syncthreads();
                if (tid == 0) { float e = 0.f, a = 0.f; for (int i = 0; i < 64; ++i) { e = fmaxf(e, red[128 + i]); a = fmaxf(a, red[256 + i]); } const float rel = e / fmaxf(a, 1e-20f); if (DIAG_SEL < 0 || DIAG_SEL == smp) worst = fmaxf(worst, rel); }
                __syncthreads();
            }
            if (tid == 0) MISC[41] = __float_as_uint(worst);
        }
        GRID_BAR();
#endif
        if (PROBE == 21) {
            bf16* DUM = XN;
            for (int u = vcu; u < 512; u += G) { const int xg = u >> 6, i = u & 63; const int b = xg >> 1, h = 4 * (xg & 1) + (i >> 4), qblk = i & 15;
                attn::attn_unit<false, XVAR>((LAS char*)lds, QA, KA, VA, DUM, b, h, qblk, nullptr, 0.f); }
        }
        if (PROBE == 22) {
            bf16* DUM = XN;
            for (int u = vcu; u < 512; u += G) { const int xg = u >> 6, i = u & 63; const int b = xg >> 1, h = 4 * (xg & 1) + (i >> 4), qblk = i & 15;
                attn::attn_unit<true>((LAS char*)lds, QB, KB, VB, DUM, b, h, qblk, BIAS + h * 257, sink[h] * LOG2E); }
        }
#ifdef DIAG_ATTN
        {
            bf16* DUM = XN;
            for (int u = vcu; u < 512; u += G) { const int xg = u >> 6, i = u & 63; const int b = xg >> 1, h = 4 * (xg & 1) + (i >> 4), qblk = i & 15;
                attn::attn_unit<false, 0, DIAG_ATTN == 1>((LAS char*)lds, QA, KA, VA, DUM, b, h, qblk, nullptr, 0.f); }
            for (int u = vcu; u < 512; u += G) { const int xg = u >> 6, i = u & 63; const int b = xg >> 1, h = 4 * (xg & 1) + (i >> 4), qblk = i & 15;
                attn::attn_unit<true>((LAS char*)lds, QB, KB, VB, DUM + 512, b, h, qblk, BIAS + h * 257, sink[h] * LOG2E); }
            GRID_BAR();
            if (bx == 0) {
                LAS float* sc = (LAS float*)lds; LAS float* red = (LAS float*)(lds + 32768); float worst = 0.f;
                for (int smp = 0; smp < 12; ++smp) {
                    const int win = smp & 1; const int b = (smp * 7 + 1) & 3, h = (smp * 5 + 3) & 7, q = smp == 1 ? 5 : smp == 3 ? 4090 : smp == 4 ? 4095 : (smp * 977 + 131 * win + (smp == 2 ? 0 : 17)) & 4095; const int kvh = h >> 2;
                    const bf16* Qp = (win ? QB : QA) + ((size_t)b * SEQ + q) * 1024 + h * HD; const bf16* Kp = win ? KB : KA; const bf16* Vp = win ? VB : VA;
                    float mx = -1e30f;
                    for (int j = tid; j < SEQ; j += 512) { float s = 0.f;
                        for (int d = 0; d < HD; ++d) s += __builtin_bit_cast(float, (unsigned)Qp[d] << 16) * __builtin_bit_cast(float, (unsigned)Kp[kimg_off(b, kvh, j, d)] << 16);
                        if (win) { const int rel = j - q; s = (rel >= -128 && rel <= 128) ? s + BIAS[h * 257 + rel + 128] : -1e30f; }
                        sc[j] = s; mx = fmaxf(mx, s); }
                    red[tid] = mx; __syncthreads();
                    if (tid == 0) { float m = -1e30f; for (int i = 0; i < 512; ++i) m = fmaxf(m, red[i]); if (win) m = fmaxf(m, sink[h] * LOG2E); red[512] = m; } __syncthreads();
                    const float m = red[512]; float ls = 0.f;
                    for (int j = tid; j < SEQ; j += 512) { const float p = exp2f(sc[j] - m); sc[j] = p; ls += p; }
                    __syncthreads(); red[tid] = ls; __syncthreads();
                    if (tid == 0) { float l = 0.f; for (int i = 0; i < 512; ++i) l += red[i]; if (win) l += exp2f(sink[h] * LOG2E - m); red[513] = l; } __syncthreads();
                    if (tid < HD) { float o = 0.f; for (int j = 0; j < SEQ; ++j) o += sc[j] * __builtin_bit_cast(float, (unsigned)Vp[vimg_off(b, kvh, j, tid)] << 16);
                        o /= red[513]; const float t = __builtin_bit_cast(float, (unsigned)DUM[((size_t)b * SEQ + q) * 1024 + win * 512 + h * HD + tid] << 16);
                        red[600 + tid] = fabsf(o - t); red[700 + tid] = fabsf(o); }
                    __syncthreads();
                    if (tid == 0) { float e = 0.f, a = 0.f; for (int i = 0; i < HD; ++i) { e = fmaxf(e, red[600 + i]); a = fmaxf(a, red[700 + i]); } const float rel = e / fmaxf(a, 1e-20f); if (DIAG_SEL < 0 || DIAG_SEL == smp) worst = fmaxf(worst, rel); }
                    __syncthreads();
                }
                if (tid == 0) MISC[40] = __float_as_uint(worst);
            }
            GRID_BAR();
        }
#endif
        float lbound;
        { const float gq = tid < HD ? fabsf(q_norm_g[tid]) : 0.f, gk = tid < HD ? fabsf(k_norm_g[tid]) : 0.f;
          const float mq = peer::wave_max(gq), mk = peer::wave_max(gk); LAS float* lb = (LAS float*)(lds + 70000);
          if (tid == 0) lb[0] = 64.0f * mq * mk * QSCALE * 1.02f; __syncthreads(); lbound = lb[0]; __syncthreads(); }
        const bool nomax = lbound <= 100.0f;
        for (int u = vcu; u < 512; u += G) { const int xg = u >> 6, i = u & 63; const int b = xg >> 1, h = 4 * (xg & 1) + (i >> 4), qblk = i & 15;
            if (nomax) attn::attn_unit<false, 0, true>((LAS char*)lds, QA, KA, VA, QA, b, h, qblk, nullptr, 0.f);
            else attn::attn_unit<false>((LAS char*)lds, QA, KA, VA, QA, b, h, qblk, nullptr, 0.f); }
        for (int u = vcu; u < 512; u += G) { const int xg = u >> 6, i = u & 63; const int b = xg >> 1, h = 4 * (xg & 1) + (i >> 4), qblk = i & 15;
            attn::attn_unit<true>((LAS char*)lds, QB, KB, VB, QB, b, h, qblk, BIAS + h * 257, sink[h] * LOG2E); }
        if (BOTH(2)) GRID_BAR();
    }

    if (IN(3)) {
        pg8::Gemm g{QA, WA_T, NTOK, DM, DM}; pg8::StaticOrder S; S.init(NTOK, DM, G, bx); pg8::EpiMix E{GA, GB, GB};
        if (PROBE == 3) { pg8::EpiMix E2{GA, GB, XN}; pg8::gemm_phase<pg8::EpiMix, pg8::StaticOrder, true, true>(lds, g, S, E2); VM_WAIT(); __syncthreads(); }
        pg8::gemm_phase<pg8::EpiMix, pg8::StaticOrder, true, true>(lds, g, S, E);
        if (BOTH(3)) GRID_BAR();
    }

    if (IN(4)) {
        pg8::Gemm g{GB, WO_T, NTOK, DM, DM}; pg8::StaticOrder S; S.init(NTOK, DM, G, bx); pg8::EpiOut E{x, XN, SSQ};
        for (int rep_ = 0; rep_ < NREP(4); ++rep_) pg8::gemm_phase<pg8::EpiOut, pg8::StaticOrder, true, true>(lds, g, S, E);
        if (BOTH(4)) GRID_BAR();
    }

    if (IN(5)) {
        pg8::Gemm g{XN, WE_T, NTOK, SCW, DM}; pg8::StaticOrder S; S.init(NTOK, SCW, G, bx); pg8::EpiScore E{SSQ, SC};
        for (int rep_ = 0; rep_ < NREP(5); ++rep_) pg8::gemm_phase<pg8::EpiScore, pg8::StaticOrder, true, true>(lds, g, S, E);
        if (BOTH(5)) GRID_BAR();
    }

    if (IN(6)) {
        LAS char* wl = (LAS char*)lds + wave * peer::WAVE_LDS;
        const unsigned long long ct = peer::cand_table(lane & 7);
        for (int rep_ = 0; rep_ < NREP(60); ++rep_) {
            peer::SCtx sA = peer::s_ctx(lane, gw < NTOK ? gw : 0, SC), sB;
            for (int t = gw; t < NTOK; t += 2 * NGW) {
                sB = peer::s_ctx(lane, t + NGW < NTOK ? t + NGW : t, SC);
                peer::route_token(wl, lane, t, ct, sA, SSQ, RE, RG, RSTD);
                sA = peer::s_ctx(lane, t + 2 * NGW < NTOK ? t + 2 * NGW : t, SC);
                if (t + NGW < NTOK) peer::route_token(wl, lane, t + NGW, ct, sB, SSQ, RE, RG, RSTD);
            }
        }
        GRID_BAR();
        int nloc = 0, nx = 0, ox = 0; const int myx = (int)MISC[13], rank = (int)MISC[12];
#pragma unroll
        for (int j = 0; j < 16; ++j) { const int c = (int)xb_ld((unsigned*)(ws + WS_CTL) + CW_RANK + 64 * j); nx += c > 0; ox += (c > 0 && j < myx); nloc = j == myx ? c : nloc; }
        const int wv = rank * NWAVES + wave, nwv = nloc * NWAVES;
        for (int rep_ = 0; rep_ < NREP(61); ++rep_) for (int s = ox; s < 8; s += nx) { const unsigned char* U8s = U8 + (size_t)s * peer::SLICE_BYTES;
            peer::upass_slice(lane, s, wv, nwv, U8s, RE, XN, RSTD, g_ffn, PA); }
        GRID_BAR();
        for (int rep_ = 0; rep_ < NREP(62); ++rep_) for (int t = gw; t < NTOK; t += NGW) peer::wpass_token(lane, t, RE, RG, PA, INVU, INVV, RW);
        GRID_BAR();
        for (int s = ox; s < 8; s += nx) { const unsigned char* V8s = V8 + (size_t)s * peer::SLICE_BYTES;
            for (int rep_ = 0; rep_ < NREP(63); ++rep_) peer::vpass_slice(lane, s, wv, nwv, V8s, RE, RW, PA); }
        GRID_BAR();
        if (PROBE == 200) { for (int r_ = 0; r_ < 10; ++r_) GRID_BAR(); }
        for (int t = gw; t < NTOK; t += NGW) peer::final_token(lane, t, out, XN, PA, g_final);
#ifdef DIAG_ATTN
        if (bx == 0 && tid == 0) { VM_WAIT(); out[0] += 1000.0f * __uint_as_float(MISC[40]); }
#endif
#ifdef DIAG_QK
        if (bx == 0 && tid == 0) { VM_WAIT(); out[0] += 1000.0f * __uint_as_float(MISC[41]); }
#endif
#ifdef TSEL
        STAMP();
        if (bx == 0 && tid == 0) { VM_WAIT(); const unsigned d = MISC[16 + TSEL + 1] - MISC[16 + TSEL]; out[0] += (float)d * 0.001f; }
#endif
    }
#undef IN
#undef BOTH
#undef GRID_BAR
}

extern "C" void kernel_launch(void* const* d_in, const int* in_sizes, int n_in, void* d_out, int out_size, void* d_ws, size_t ws_size, hipStream_t stream) {
    static int grid = 0;
    if (grid == 0) {
        if (n_in != 17 || in_sizes[0] != NTOK * DM || out_size != NTOK * DM || ws_size < WS_END) { fprintf(stderr, "kernel_launch: unexpected shapes (n_in %d, in0 %d, out %d, ws %zu); nothing launched\n", n_in, n_in > 0 ? in_sizes[0] : -1, out_size, ws_size); grid = -1; return; }
        int dev = 0, cus = 0, per_cu = 0;
        if (hipGetDevice(&dev) != hipSuccess || hipDeviceGetAttribute(&cus, hipDeviceAttributeMultiprocessorCount, dev) != hipSuccess) { grid = -1; return; }
        if (hipFuncSetAttribute((const void*)mk_fwd, hipFuncAttributeMaxDynamicSharedMemorySize, LDS_BYTES) != hipSuccess) { fprintf(stderr, "kernel_launch: hipFuncSetAttribute failed\n"); grid = -1; return; }
        if (hipOccupancyMaxActiveBlocksPerMultiprocessor(&per_cu, (const void*)mk_fwd, NWAVES * 64, LDS_BYTES) != hipSuccess || per_cu < 1) { fprintf(stderr, "kernel_launch: occupancy query says %d blocks per CU; nothing launched\n", per_cu); (void)hipGetLastError(); grid = -1; return; }
        grid = cus;
    }
    if (grid < 0) return;
    if (hipMemsetAsync((char*)d_ws + WS_CTL, 0, CTL_ZERO_BYTES, stream) != hipSuccess) { fprintf(stderr, "kernel_launch: hipMemsetAsync failed\n"); return; }
    Args a{};
    for (int i = 0; i < 17; ++i) a.in[i] = (const float*)d_in[i];
    a.out = (float*)d_out; a.ws = (unsigned char*)d_ws;
    if (N_LAUNCHES == 1) {
        a.ph_lo = 0; a.ph_hi = PER_PHASE; a.li = 0;
#if defined(COOP_LAUNCH)
        void* kargs[] = {&a};
        hipError_t e = hipLaunchCooperativeKernel((const void*)mk_fwd, dim3(grid), dim3(NWAVES * 64), kargs, LDS_BYTES, stream);
        if (e != hipSuccess) fprintf(stderr, "kernel_launch: cooperative launch failed: %s (grid %d)\n", hipGetErrorString(e), grid);
#else
        if (PROBE == 100) { hipLaunchKernelGGL(mk_fwd, dim3(grid), dim3(NWAVES * 64), LDS_BYTES, stream, a); (void)hipMemsetAsync((char*)d_ws + WS_CTL, 0, CTL_ZERO_BYTES, stream); }
        hipLaunchKernelGGL(mk_fwd, dim3(grid), dim3(NWAVES * 64), LDS_BYTES, stream, a);
#endif
    } else {
        for (int li = 0; li < PER_PHASE; ++li) { a.ph_lo = li; a.ph_hi = li + 1; a.li = li;
            hipLaunchKernelGGL(mk_fwd, dim3(grid), dim3(NWAVES * 64), LDS_BYTES, stream, a); }
    }
}
```

```cpp
#include <hip/hip_runtime.h>
#include <cstdio>
#include <cstdint>
#include <cmath>
namespace pg8 {
#define PG8_LAS __attribute__((address_space(3)))
typedef unsigned short bf16_t;
typedef short bf16x8 __attribute__((ext_vector_type(8)));
typedef float f32x4 __attribute__((ext_vector_type(4)));
typedef unsigned u32x4 __attribute__((ext_vector_type(4)));
constexpr int BM = 256, BK = 64, HALF = 128, HTB = HALF * BK * 2  , STAGE_BYTES = 8 * HTB, NXCD = 8, WGM = 8;

__host__ __device__ __forceinline__ int lds_byte(int r, int c) { const int st = (r >> 4) * 2 + (c >> 5), rr = r & 15, cc = c & 31, ob = rr * 64 + cc * 2; return st * 1024 + (ob ^ (((ob >> 9) & 1) << 5)); }
__host__ __device__ __forceinline__ void stage_rc(int b, int& R, int& C) { const int st = b / 1024, sb = b % 1024, swz = sb ^ (((sb >> 9) & 1) << 5); R = (st >> 1) * 16 + swz / 64; C = (st & 1) * 32 + (swz % 64) / 2; }
__host__ __device__ __forceinline__ int perm32(int rho) { const int n = rho >> 4, i = rho & 15; return 8 * (i >> 2) + 4 * n + (i & 3); }

struct Unit { int pm, pn; };
struct Gemm { const bf16_t* A; const bf16_t* Bt; int M, N, K; };

struct StaticOrder {
    int nM, nN, nwg, G, c;
    __host__ __device__ void init(int M, int N, int G_, int c_) { nM = M / BM; nN = N / BM; nwg = nM * nN; G = G_; c = c_; }
    __host__ __device__ bool next(int i, Unit& u) const {
        const long L = (long)i * G + c; if (L >= nwg) return false;
        int wgid = (int)L; { const int q = nwg / NXCD, r = nwg % NXCD, xcd = wgid % NXCD, off = wgid / NXCD; wgid = (xcd < r ? xcd * (q + 1) : r * (q + 1) + (xcd - r) * q) + off; }
        const int nig = WGM * nN, gid = wgid / nig, fm = gid * WGM, gsz = (nM - fm) < WGM ? (nM - fm) : WGM;
        u.pm = fm + ((wgid % nig) % gsz); u.pn = (wgid % nig) / gsz; return true;
    }
    __device__ __forceinline__ void a_ready(const Unit&) const {}
    __device__ __forceinline__ void done(const Unit&) const {}
};

__device__ __forceinline__ unsigned cvt_pk_bf16(float lo, float hi) { unsigned r; asm volatile("v_cvt_pk_bf16_f32 %0, %1, %2" : "=v"(r) : "v"(lo), "v"(hi)); return r; }
typedef float f32x2 __attribute__((ext_vector_type(2)));
template <class Epi, class Sched, bool ALIGN_EPI = false, bool SP2 = false>
__device__ __forceinline__ void gemm_phase(PG8_LAS unsigned char* lds, const Gemm g, const Sched& S, const Epi& E) {
    const int tid = threadIdx.x, wid = __builtin_amdgcn_readfirstlane(tid >> 6), lane = tid & 63, wr = wid >> 2, wc = wid & 3, fr = lane & 15, fq = lane >> 4;
    const int K = g.K, nt = K / BK;
    unsigned voffA[2], voffB[2];
#pragma unroll
    for (int i = 0; i < 2; ++i) { int R, C; stage_rc(tid * 16 + i * 8192, R, C); const int Rb = Epi::PERM ? ((R & ~31) + perm32(R & 31)) : R;
        voffA[i] = (unsigned)(R * K + C) * 2u; voffB[i] = (unsigned)(Rb * K + C) * 2u; }
    const size_t kstep = (size_t)(BK * 2);
    const size_t hstep = (size_t)HALF * K * 2;
    const size_t tstep = 2 * hstep;
    const unsigned ldsw = (unsigned)wid * 1024u;
    const int aoff = lds_byte(wr * 64 + fr, fq * 8), boff = lds_byte(wc * 32 + fr, fq * 8);
#define PG8_SA(b, h) (((b) * 2 + (h)) * HTB)
#define PG8_SB(b, h) ((4 + (b) * 2 + (h)) * HTB)
#define PG8_STAGE(bufoff, gbase, voff) do { _Pragma("unroll") for (int _i = 0; _i < 2; ++_i) \
        __builtin_amdgcn_global_load_lds((const unsigned*)((const char*)(gbase) + (voff)[_i]), (PG8_LAS unsigned*)(lds + (bufoff) + ldsw + _i * 8192), 16, 0, 0); } while (0)
#define PG8_LDA(dst, b, h) do { _Pragma("unroll") for (int m = 0; m < 4; ++m) _Pragma("unroll") for (int k = 0; k < 2; ++k) dst[m][k] = *(const PG8_LAS bf16x8*)(lds + PG8_SA(b, h) + aoff + m * 2048 + k * 1024); } while (0)
#define PG8_LDB(dst, b, h) do { _Pragma("unroll") for (int n = 0; n < 2; ++n) _Pragma("unroll") for (int k = 0; k < 2; ++k) dst[n][k] = *(const PG8_LAS bf16x8*)(lds + PG8_SB(b, h) + boff + n * 2048 + k * 1024); } while (0)
#define PG8_MMA(ai, bj, At, Bt) do { __builtin_amdgcn_s_setprio(1); _Pragma("unroll") for (int m = 0; m < 4; ++m) _Pragma("unroll") for (int n = 0; n < 2; ++n) _Pragma("unroll") for (int k = 0; k < 2; ++k) \
        acc[ai][bj][m][n] = __builtin_amdgcn_mfma_f32_16x16x32_bf16(Bt[n][k], At[m][k], acc[ai][bj][m][n], 0, 0, 0); __builtin_amdgcn_s_setprio(0); } while (0)
#define PG8_WAIT_V(n) asm volatile("s_waitcnt vmcnt(" #n ")" ::: "memory")
#define PG8_WAIT_L(n) asm volatile("s_waitcnt lgkmcnt(" #n ")" ::: "memory")
#define PG8_BAR __builtin_amdgcn_s_barrier()
#define PG8_SCHED __builtin_amdgcn_sched_barrier(0)
    Unit cur, nxt; int ui = 0;
    if (!S.next(0, cur)) return;
    f32x4 acc[2][2][4][2];
#pragma unroll
    for (int a = 0; a < 2; ++a)
#pragma unroll
        for (int b = 0; b < 2; ++b)
#pragma unroll
            for (int m = 0; m < 4; ++m)
#pragma unroll
                for (int n = 0; n < 2; ++n) acc[a][b][m][n] = (f32x4){0.f, 0.f, 0.f, 0.f};
    bf16x8 At[4][2], B0[2][2], B1[2][2];
    const char* cA = (const char*)g.A + (size_t)cur.pm * tstep; const char* cB = (const char*)g.Bt + (size_t)cur.pn * tstep;
    S.a_ready(cur);
    if constexpr (SP2) {
        PG8_STAGE(PG8_SB(0, 0), cB, voffB); PG8_STAGE(PG8_SB(0, 1), cB + hstep, voffB); PG8_STAGE(PG8_SA(0, 0), cA, voffA); PG8_STAGE(PG8_SA(0, 1), cA + hstep, voffA);
        if (wr == 1) PG8_BAR;
        PG8_WAIT_V(2); PG8_BAR;
        PG8_STAGE(PG8_SB(1, 0), cB + kstep, voffB); PG8_STAGE(PG8_SA(1, 0), cA + kstep, voffA); PG8_STAGE(PG8_SB(1, 1), cB + hstep + kstep, voffB);
        PG8_WAIT_V(6); PG8_BAR;
    } else {
        PG8_STAGE(PG8_SB(0, 0), cB, voffB); PG8_STAGE(PG8_SA(0, 0), cA, voffA); PG8_STAGE(PG8_SB(0, 1), cB + hstep, voffB); PG8_STAGE(PG8_SA(0, 1), cA + hstep, voffA);
        if (wr == 1) PG8_BAR;
        PG8_WAIT_V(4); PG8_BAR;
        PG8_STAGE(PG8_SB(1, 0), cB + kstep, voffB); PG8_STAGE(PG8_SA(1, 0), cA + kstep, voffA); PG8_STAGE(PG8_SB(1, 1), cB + hstep + kstep, voffB);
        PG8_WAIT_V(6); PG8_BAR;
    }
    for (;;) {
        const bool has_next = S.next(ui + 1, nxt);
        const char* nA = has_next ? (const char*)g.A + (size_t)nxt.pm * tstep : cA; const char* nB = has_next ? (const char*)g.Bt + (size_t)nxt.pn * tstep : cB;
        for (int t = 0; t < nt; t += 2) {
            if constexpr (Epi::HAS_MID) { if (t == (nt >> 1)) E.mid(acc, cur, wr, wc, fr, fq); }
            const bool last = (t == nt - 2);
            const char* a1 = cA + (size_t)(t + 1) * kstep;
            const char* a2 = last ? nA : cA + (size_t)(t + 2) * kstep; const char* b2 = last ? nB : cB + (size_t)(t + 2) * kstep;
            const char* a3 = a2 + kstep; const char* b3 = b2 + kstep;
            if (last && has_next) S.a_ready(nxt);
            if constexpr (SP2) {
            PG8_LDB(B0, 0, 0); PG8_LDB(B1, 0, 1); PG8_SCHED; PG8_LDA(At, 0, 0); PG8_STAGE(PG8_SA(1, 1), a1 + hstep, voffA);
            PG8_WAIT_V(8); PG8_WAIT_L(0); PG8_BAR; PG8_MMA(0, 0, At, B0); PG8_MMA(0, 1, At, B1); PG8_BAR; PG8_SCHED;
            PG8_LDA(At, 0, 1); PG8_STAGE(PG8_SB(0, 0), b2, voffB); PG8_STAGE(PG8_SB(0, 1), b2 + hstep, voffB); PG8_STAGE(PG8_SA(0, 0), a2, voffA);
            PG8_WAIT_V(8); PG8_WAIT_L(0); PG8_BAR; PG8_MMA(1, 0, At, B0); PG8_MMA(1, 1, At, B1); PG8_BAR; PG8_SCHED;
            PG8_LDB(B0, 1, 0); PG8_LDB(B1, 1, 1); PG8_SCHED; PG8_LDA(At, 1, 0); PG8_STAGE(PG8_SA(0, 1), a2 + hstep, voffA);
            PG8_WAIT_V(8); PG8_WAIT_L(0); PG8_BAR; PG8_MMA(0, 0, At, B0); PG8_MMA(0, 1, At, B1); PG8_BAR; PG8_SCHED;
            PG8_LDA(At, 1, 1); PG8_STAGE(PG8_SB(1, 0), b3, voffB); PG8_STAGE(PG8_SB(1, 1), b3 + hstep, voffB); PG8_STAGE(PG8_SA(1, 0), a3, voffA);
            PG8_WAIT_V(8); PG8_WAIT_L(0); PG8_BAR; PG8_MMA(1, 0, At, B0); PG8_MMA(1, 1, At, B1); PG8_BAR; PG8_SCHED;
            } else {
            PG8_LDB(B0, 0, 0); PG8_SCHED; PG8_LDA(At, 0, 0); PG8_STAGE(PG8_SA(1, 1), a1 + hstep, voffA);
            PG8_WAIT_L(8); PG8_BAR; PG8_WAIT_L(0); PG8_MMA(0, 0, At, B0); PG8_BAR; PG8_SCHED;
            PG8_LDB(B1, 0, 1); PG8_STAGE(PG8_SB(0, 0), b2, voffB);
            PG8_BAR; PG8_WAIT_L(0); PG8_MMA(0, 1, At, B1); PG8_BAR;
            PG8_LDA(At, 0, 1); PG8_STAGE(PG8_SA(0, 0), a2, voffA);
            PG8_BAR; PG8_WAIT_L(0); PG8_MMA(1, 0, At, B0); PG8_BAR; PG8_SCHED;
            PG8_STAGE(PG8_SB(0, 1), b2 + hstep, voffB);
            PG8_WAIT_V(6); PG8_BAR; PG8_MMA(1, 1, At, B1); PG8_BAR;
            PG8_LDB(B0, 1, 0); PG8_SCHED; PG8_LDA(At, 1, 0); PG8_STAGE(PG8_SA(0, 1), a2 + hstep, voffA);
            PG8_WAIT_L(8); PG8_BAR; PG8_WAIT_L(0); PG8_MMA(0, 0, At, B0); PG8_BAR; PG8_SCHED;
            PG8_LDB(B1, 1, 1); PG8_STAGE(PG8_SB(1, 0), b3, voffB);
            PG8_BAR; PG8_WAIT_L(0); PG8_MMA(0, 1, At, B1); PG8_BAR;
            PG8_LDA(At, 1, 1); PG8_STAGE(PG8_SA(1, 0), a3, voffA);
            PG8_BAR; PG8_WAIT_L(0); PG8_MMA(1, 0, At, B0); PG8_BAR; PG8_SCHED;
            PG8_STAGE(PG8_SB(1, 1), b3 + hstep, voffB);
            PG8_WAIT_V(6); PG8_BAR; PG8_MMA(1, 1, At, B1); PG8_BAR;
            }
        }
        if constexpr (ALIGN_EPI) { if (wr == 0) PG8_BAR; }
        if constexpr (!Epi::AFTER_DRAIN) { E(acc, cur, wr, wc, fr, fq); S.done(cur); }
        if (!has_next) break;
#pragma unroll
        for (int a = 0; a < 2; ++a)
#pragma unroll
            for (int b = 0; b < 2; ++b)
#pragma unroll
                for (int m = 0; m < 4; ++m)
#pragma unroll
                    for (int n = 0; n < 2; ++n) acc[a][b][m][n] = (f32x4){0.f, 0.f, 0.f, 0.f};
        cur = nxt; cA = nA; cB = nB; ++ui;
        if constexpr (ALIGN_EPI) { if (wr == 1) PG8_BAR; }
    }
    PG8_WAIT_V(0);
    if constexpr (!ALIGN_EPI) { if (wr == 0) PG8_BAR; }
    PG8_BAR;
    if constexpr (Epi::AFTER_DRAIN) { E.fused(acc, cur, wr, wc, fr, fq, lds, wid, lane); S.done(cur); }
#undef PG8_SA
#undef PG8_SB
#undef PG8_STAGE
#undef PG8_LDA
#undef PG8_LDB
#undef PG8_MMA
#undef PG8_WAIT_V
#undef PG8_WAIT_L
#undef PG8_BAR
#undef PG8_SCHED
}
}

constexpr int DM = 1024, NB = 4, SEQ = 4096, NTOK = NB * SEQ;
constexpr int HD = 64, NH = 8, NKV = 2, QW = NH * HD  , GRIDW = 64;
constexpr int INW = 3584;
constexpr int PH = 8, NKEYS = 128, TOPK = 16, NEXP = NKEYS * NKEYS, SCW = PH * 2 * NKEYS  ;
constexpr float EPS = 1e-6f;
constexpr float LOG2E = 1.4426950408889634f;
constexpr float QSCALE = 0.125f * LOG2E;

typedef unsigned u32x2_t __attribute__((ext_vector_type(2)));
typedef float f32x2_t __attribute__((ext_vector_type(2)));
typedef __bf16 bf16x2_t __attribute__((ext_vector_type(2)));
__device__ __forceinline__ unsigned pkbf(float lo, float hi) { f32x2_t v = {lo, hi}; bf16x2_t b = __builtin_convertvector(v, bf16x2_t); return __builtin_bit_cast(unsigned, b); }
__device__ __forceinline__ float bflo(unsigned w) { return __builtin_bit_cast(float, w << 16); }
__device__ __forceinline__ float bfhi(unsigned w) { return __builtin_bit_cast(float, w & 0xffff0000u); }

__device__ __forceinline__ size_t kimg_off(int b, int kvh, int s, int dim) { return ((size_t)((b * NKV + kvh) * (SEQ / 64) + (s >> 6)) << 12) + (dim >> 3) * 512 + (s & 63) * 8 + (dim & 7); }
__device__ __forceinline__ size_t vimg_off(int b, int kvh, int s, int dim) { return ((size_t)((b * NKV + kvh) * (SEQ / 64) + (s >> 6)) << 12) + (dim >> 5) * 2048 + (s & 63) * 32 + (dim & 31); }

namespace pg8 {
__device__ __forceinline__ u32x4 pk8(const f32x4& a, const f32x4& b) { return (u32x4){pkbf(a[0], a[1]), pkbf(a[2], a[3]), pkbf(b[0], b[1]), pkbf(b[2], b[3])}; }
struct EpiIn {
    static constexpr bool PERM = true, AFTER_DRAIN = false, HAS_MID = false;
    bf16_t *Qa, *Ka, *Va, *Qb, *Kb, *Vb, *Ga, *Gb;
    const float *qg, *kg, *bgate, *rope;
    __device__ __forceinline__ void operator()(const f32x4 (&acc)[2][2][4][2], const Unit& u, int wr, int wc, int fr, int fq) const {
        const int pn = u.pn;
        if (pn >= 6) {
            const bool isA = pn < 10; bf16_t* G = isA ? Ga : Gb; const int ct = (isA ? pn - 6 : pn - 10) * BM; const float* bb = bgate + (isA ? 0 : DM);
            f32x4 bv[2][2];
#pragma unroll
            for (int bj = 0; bj < 2; ++bj)
#pragma unroll
                for (int n = 0; n < 2; ++n) bv[bj][n] = *(const f32x4*)(bb + ct + bj * HALF + wc * 32 + 8 * fq + 4 * n);
#pragma unroll
            for (int ai = 0; ai < 2; ++ai)
#pragma unroll
                for (int m = 0; m < 4; ++m) { const int row = u.pm * BM + ai * HALF + wr * 64 + m * 16 + fr; bf16_t* rp = G + (size_t)row * DM + ct + wc * 32 + 8 * fq;
#pragma unroll
                    for (int bj = 0; bj < 2; ++bj) { f32x4 g[2];
#pragma unroll
                        for (int n = 0; n < 2; ++n) { const f32x4 z = acc[ai][bj][m][n] + bv[bj][n];
#pragma unroll
                            for (int j = 0; j < 4; ++j) g[n][j] = __builtin_amdgcn_rcpf(1.0f + __builtin_amdgcn_exp2f(-LOG2E * z[j])); }
                        *(u32x4*)(rp + bj * HALF) = pk8(g[0], g[1]); } }
            return;
        }
        const bool brA = pn < 3; const int pl = brA ? pn : pn - 3;
        const bool isq = pl < 2, isk = (!isq) && wc < 2;
        const bool normrope = brA && (isq || isk);
        const int part = fq >> 1, base = 8 * (fq & 1);
        f32x4 gv[2][2];
        if (normrope) { const float* g = isq ? qg : kg;
#pragma unroll
            for (int bj = 0; bj < 2; ++bj)
#pragma unroll
                for (int n = 0; n < 2; ++n) gv[bj][n] = *(const f32x4*)(g + 32 * part + 16 * bj + base + 4 * n); }
        const float osc = isq ? QSCALE : 1.0f;
#pragma unroll
        for (int ai = 0; ai < 2; ++ai)
#pragma unroll
            for (int m = 0; m < 4; ++m) {
                const int row = u.pm * BM + ai * HALF + wr * 64 + m * 16 + fr; const int b = row >> 12, s = row & (SEQ - 1);
                f32x4 v[2][2];
#pragma unroll
                for (int bj = 0; bj < 2; ++bj)
#pragma unroll
                    for (int n = 0; n < 2; ++n) v[bj][n] = acc[ai][bj][m][n];
                if (normrope) {
                    float ss = 0.f;
#pragma unroll
                    for (int bj = 0; bj < 2; ++bj)
#pragma unroll
                        for (int n = 0; n < 2; ++n) ss += (v[bj][n][0] * v[bj][n][0] + v[bj][n][1] * v[bj][n][1]) + (v[bj][n][2] * v[bj][n][2] + v[bj][n][3] * v[bj][n][3]);
                    ss += __shfl_xor(ss, 16); ss += __shfl_xor(ss, 32);
                    const float rstd = 1.0f / sqrtf(ss * (1.0f / 64.0f) + EPS);
                    const int pos = part == 0 ? (s >> 6) : (s & (GRIDW - 1));
                    const float* rp = rope + (pos * 16 + base) * 2;
#pragma unroll
                    for (int n = 0; n < 2; ++n) { const f32x4 cs0 = *(const f32x4*)(rp + 8 * n), cs1 = *(const f32x4*)(rp + 8 * n + 4);
                        const float cc[4] = {cs0[0], cs0[2], cs1[0], cs1[2]}, sn[4] = {cs0[1], cs0[3], cs1[1], cs1[3]};
#pragma unroll
                        for (int j = 0; j < 4; ++j) { const float u1 = v[0][n][j] * rstd * gv[0][n][j], u2 = v[1][n][j] * rstd * gv[1][n][j];
                            v[0][n][j] = u1 * cc[j] - u2 * sn[j]; v[1][n][j] = u2 * cc[j] + u1 * sn[j]; } }
                }
#pragma unroll
                for (int bj = 0; bj < 2; ++bj) {
                    const u32x4 w = pk8(v[bj][0] * osc, v[bj][1] * osc);
                    const int dim = 32 * part + 16 * bj + base;
                    bf16_t* dst;
                    if (isq) dst = (brA ? Qa : Qb) + (size_t)row * (2 * QW) + (pl * 4 + wc) * HD + dim;
                    else if (wc < 2) dst = (brA ? Ka : Kb) + kimg_off(b, wc, s, dim);
                    else dst = (brA ? Va : Vb) + vimg_off(b, wc - 2, s, dim);
                    *(u32x4*)dst = w;
                }
            }
    }
};

struct EpiMix {
    static constexpr bool PERM = true, AFTER_DRAIN = false, HAS_MID = true;
    const bf16_t* GA; const bf16_t* GB; bf16_t* OUT;
    __device__ __forceinline__ void mid(f32x4 (&acc)[2][2][4][2], const Unit& u, int wr, int wc, int fr, int fq) const {
        size_t off = (size_t)(u.pm * BM + wr * 64 + fr) * DM + u.pn * BM + wc * 32 + 8 * fq;
#pragma unroll
        for (int ai = 0; ai < 2; ++ai)
#pragma unroll
            for (int m = 0; m < 4; ++m) {
                asm volatile("" : "+v"(off));
#pragma unroll
                for (int bj = 0; bj < 2; ++bj) { const u32x4 a = *(const u32x4*)(GA + off + bj * HALF), b = *(const u32x4*)(GB + off + bj * HALF);
#pragma unroll
                    for (int n = 0; n < 2; ++n) { f32x4& c = acc[ai][bj][m][n]; const unsigned a0 = n ? a.z : a.x, a1 = n ? a.w : a.y, b0 = n ? b.z : b.x, b1 = n ? b.w : b.y;
                        c[0] *= bflo(a0) * __builtin_amdgcn_rcpf(fmaxf(bflo(b0), 1e-20f)); c[1] *= bfhi(a0) * __builtin_amdgcn_rcpf(fmaxf(bfhi(b0), 1e-20f));
                        c[2] *= bflo(a1) * __builtin_amdgcn_rcpf(fmaxf(bflo(b1), 1e-20f)); c[3] *= bfhi(a1) * __builtin_amdgcn_rcpf(fmaxf(bfhi(b1), 1e-20f)); } }
                off += (size_t)((m == 3) ? (HALF - 48) : 16) * DM;
            }
    }
    __device__ __forceinline__ void operator()(const f32x4 (&acc)[2][2][4][2], const Unit& u, int wr, int wc, int fr, int fq) const {
#pragma unroll
        for (int ai = 0; ai < 2; ++ai)
#pragma unroll
            for (int m = 0; m < 4; ++m) { const int row = u.pm * BM + ai * HALF + wr * 64 + m * 16 + fr; const size_t off = (size_t)row * DM + u.pn * BM + wc * 32 + 8 * fq;
#pragma unroll
                for (int bj = 0; bj < 2; ++bj) { const u32x4 g = *(const u32x4*)(GB + off + bj * HALF); const f32x4 a0 = acc[ai][bj][m][0], a1 = acc[ai][bj][m][1];
                    *(u32x4*)(OUT + off + bj * HALF) = (u32x4){pkbf(a0[0] * bflo(g.x), a0[1] * bfhi(g.x)), pkbf(a0[2] * bflo(g.y), a0[3] * bfhi(g.y)), pkbf(a1[0] * bflo(g.z), a1[1] * bfhi(g.z)), pkbf(a1[2] * bflo(g.w), a1[3] * bfhi(g.w))}; } }
    }
};
struct EpiOut {
    static constexpr bool PERM = true, AFTER_DRAIN = false, HAS_MID = false;
    const float* X; bf16_t* HB; float* ssq;
    __device__ __forceinline__ void operator()(const f32x4 (&acc)[2][2][4][2], const Unit& u, int wr, int wc, int fr, int fq) const {
#pragma unroll
        for (int ai = 0; ai < 2; ++ai)
#pragma unroll
            for (int m = 0; m < 4; ++m) { const int row = u.pm * BM + ai * HALF + wr * 64 + m * 16 + fr; const size_t off = (size_t)row * DM + u.pn * BM + wc * 32 + 8 * fq; float ss = 0.f;
#pragma unroll
                for (int bj = 0; bj < 2; ++bj) { const size_t o2 = off + bj * HALF; const f32x4 h0 = *(const f32x4*)(X + o2) + acc[ai][bj][m][0], h1 = *(const f32x4*)(X + o2 + 4) + acc[ai][bj][m][1];
                    *(u32x4*)(HB + o2) = pk8(h0, h1);
                    ss += ((h0[0] * h0[0] + h0[1] * h0[1]) + (h0[2] * h0[2] + h0[3] * h0[3])) + ((h1[0] * h1[0] + h1[1] * h1[1]) + (h1[2] * h1[2] + h1[3] * h1[3])); }
                ss += __shfl_xor(ss, 16); ss += __shfl_xor(ss, 32);
                if (fq == 0) ssq[(size_t)row * 16 + u.pn * 4 + wc] = ss; }
    }
};
typedef _Float16 f16x2_t __attribute__((ext_vector_type(2)));
__device__ __forceinline__ unsigned pkh(float lo, float hi) { f16x2_t h = {(_Float16)lo, (_Float16)hi}; return __builtin_bit_cast(unsigned, h); }
struct EpiScore {
    static constexpr bool PERM = true, AFTER_DRAIN = false, HAS_MID = false;
    const float* ssq; unsigned short* SC;
    __device__ __forceinline__ void operator()(const f32x4 (&acc)[2][2][4][2], const Unit& u, int wr, int wc, int fr, int fq) const {
#pragma unroll
        for (int ai = 0; ai < 2; ++ai)
#pragma unroll
            for (int m = 0; m < 4; ++m) { const int row = u.pm * BM + ai * HALF + wr * 64 + m * 16 + fr;
                const f32x4* sp = (const f32x4*)(ssq + (size_t)row * 16); const f32x4 s0 = sp[0], s1 = sp[1], s2 = sp[2], s3 = sp[3];
                const float tot = (((s0[0] + s0[1]) + (s0[2] + s0[3])) + ((s1[0] + s1[1]) + (s1[2] + s1[3]))) + (((s2[0] + s2[1]) + (s2[2] + s2[3])) + ((s3[0] + s3[1]) + (s3[2] + s3[3])));
                const float rstd = 1.0f / sqrtf(tot * (1.0f / DM) + EPS);
                unsigned short* rp = SC + (size_t)row * SCW + u.pn * BM + wc * 32 + 8 * fq;
#pragma unroll
                for (int bj = 0; bj < 2; ++bj) { const f32x4 v0 = acc[ai][bj][m][0] * rstd, v1 = acc[ai][bj][m][1] * rstd;
                    *(u32x4*)(rp + bj * HALF) = (u32x4){pkh(v0[0], v0[1]), pkh(v0[2], v0[3]), pkh(v1[0], v1[1]), pkh(v1[2], v1[3])}; } }
    }
};
}

#define LAS __attribute__((address_space(3)))
namespace attn {
typedef unsigned short bf16_t;
typedef short bf16x8 __attribute__((ext_vector_type(8)));
typedef short s16x4 __attribute__((ext_vector_type(4)));
typedef float f32x16 __attribute__((ext_vector_type(16)));
typedef unsigned u32x4 __attribute__((ext_vector_type(4)));
constexpr int LDS_K = 0, LDS_V = 32768;
constexpr int LDS_BIAS = 65536;
constexpr int LDS_BYTES = 65536 + 3072;
constexpr float THR = 8.0f;
__device__ __forceinline__ int crow(int r, int hi) { return (r & 3) + 8 * (r >> 2) + 4 * hi; }
__device__ __forceinline__ s16x4 vtr(const LAS char* p) { return __builtin_bit_cast(s16x4, __builtin_amdgcn_ds_read_tr16_b64_v4i16((LAS s16x4*)p)); }
__device__ __forceinline__ float xhalf_max(float v) { auto rr = __builtin_amdgcn_permlane32_swap(__float_as_uint(v), __float_as_uint(v), false, false); return fmaxf(__uint_as_float(rr[0]), __uint_as_float(rr[1])); }
__device__ __forceinline__ float xhalf_sum(float v) { auto rr = __builtin_amdgcn_permlane32_swap(__float_as_uint(v), __float_as_uint(v), false, false); return __uint_as_float(rr[0]) + __uint_as_float(rr[1]); }
#ifndef ATTN_CLEANM
#define ATTN_CLEANM 0
#endif
#ifndef ATTN_PRIO
#define ATTN_PRIO 1
#endif
__device__ __forceinline__ float max3f(float a, float b, float c) { float r; asm("v_max3_f32 %0, %1, %2, %3" : "=v"(r) : "v"(a), "v"(b), "v"(c)); return r; }
__device__ __forceinline__ float max2f(float a, float b) { float r; asm("v_max_f32_e32 %0, %1, %2" : "=v"(r) : "v"(a), "v"(b)); return r; }
#define ATT_BAR() do { asm volatile("s_waitcnt lgkmcnt(0)" ::: "memory"); __builtin_amdgcn_s_barrier(); asm volatile("" ::: "memory"); } while (0)

template <bool WIN, int XV = 0, bool NOMAX = false>
__device__ __forceinline__ void attn_unit(LAS char* lds, const bf16_t* Q, const bf16_t* Kimg, const bf16_t* Vimg, bf16_t* O, int b, int h, int qblk, const float* bias_h  , float sink_l2) {
    const int tid = threadIdx.x, lane = tid & 63, r32 = lane & 31, hi = lane >> 5; const int wid = __builtin_amdgcn_readfirstlane(tid >> 6); const int grp = wid >> 2;
    const int q0 = qblk * 256, qw0 = q0 + 32 * wid, qrow = qw0 + r32; const size_t grow = (size_t)b * SEQ + qrow;
    const int kvh = h >> 2;
    int t_lo = 0, t_hi = SEQ / 64 - 1;
    if (WIN) { t_lo = q0 / 64 - 2; if (t_lo < 0) t_lo = 0; t_hi = q0 / 64 + 5; if (t_hi > SEQ / 64 - 1) t_hi = SEQ / 64 - 1; }
    const int n = t_hi - t_lo + 1;
    const bf16_t* Kb = Kimg + ((size_t)((b * NKV + kvh) * (SEQ / 64) + t_lo) << 12) + tid * 8;
    const bf16_t* Vb = Vimg + ((size_t)((b * NKV + kvh) * (SEQ / 64) + t_lo) << 12) + tid * 8;
    bf16x8 qr[4];
#pragma unroll
    for (int d0 = 0; d0 < 4; ++d0) qr[d0] = *(const bf16x8*)(Q + grow * (2 * QW) + h * HD + d0 * 16 + hi * 8);
    LAS float* biasl = (LAS float*)(lds + LDS_BIAS);
    if (WIN) { for (int j = tid; j < 768; j += 512) biasl[j] = (j >= 256 && j <= 512) ? bias_h[j - 256] : -1e30f; }
    u32x4 kreg, vreg;
    { const u32x4 k0 = *(const u32x4*)Kb, v0 = *(const u32x4*)Vb, k1 = *(const u32x4*)(Kb + 4096), v1 = *(const u32x4*)(Vb + 4096);
      kreg = *(const u32x4*)(Kb + 2 * 4096); vreg = *(const u32x4*)(Vb + 2 * 4096);
      *(LAS u32x4*)(lds + LDS_K + tid * 16) = k0; *(LAS u32x4*)(lds + LDS_V + tid * 16) = v0;
      *(LAS u32x4*)(lds + LDS_K + 8192 + tid * 16) = k1; *(LAS u32x4*)(lds + LDS_V + 8192 + tid * 16) = v1; }
    ATT_BAR();
    if (grp) ATT_BAR();
    f32x16 o0 = {}, o1 = {}, o2, p0, p1, negm;
    float mref = WIN ? sink_l2 : 0.0f;
#pragma unroll
    for (int r = 0; r < 16; ++r) o2[r] = WIN ? 1.0f : 0.0f;
    const bf16x8 ones = {0x3F80, 0x3F80, 0x3F80, 0x3F80, 0x3F80, 0x3F80, 0x3F80, 0x3F80};
#pragma unroll
    for (int r = 0; r < 16; ++r) negm[r] = -mref;
    const int vlane = ((lane >> 4) & 1) * 32 + (lane & 3) * 8 + (4 * hi + ((lane & 15) >> 2)) * 64;
    const LAS char* kfr = lds + LDS_K + hi * 1024 + r32 * 16;
    u32x4 pk[4]; bf16x8 kf[8], vf[8];
#define ATT_LDK(sl) do { const LAS char* kp_ = kfr + (sl) * 8192; \
        _Pragma("unroll") for (int d0 = 0; d0 < 4; ++d0) { kf[2 * d0] = *(const LAS bf16x8*)(kp_ + d0 * 2048); kf[2 * d0 + 1] = *(const LAS bf16x8*)(kp_ + d0 * 2048 + 512); } } while (0)
#define ATT_LDV(sl) do { const LAS char* vp_ = lds + LDS_V + (sl) * 8192 + vlane; \
        _Pragma("unroll") for (int ks = 0; ks < 4; ++ks) { \
            const s16x4 l0 = vtr(vp_ + ks * 1024), h0 = vtr(vp_ + ks * 1024 + 512), l1 = vtr(vp_ + 4096 + ks * 1024), h1 = vtr(vp_ + 4096 + ks * 1024 + 512); \
            vf[2 * ks] = (bf16x8){l0[0], l0[1], l0[2], l0[3], h0[0], h0[1], h0[2], h0[3]}; vf[2 * ks + 1] = (bf16x8){l1[0], l1[1], l1[2], l1[3], h1[0], h1[1], h1[2], h1[3]}; } } while (0)
#define ATT_QK() do { \
        if (NOMAX) { const f32x16 z_ = {}; p0 = __builtin_amdgcn_mfma_f32_32x32x16_bf16(kf[0], qr[0], z_, 0, 0, 0); p1 = __builtin_amdgcn_mfma_f32_32x32x16_bf16(kf[1], qr[0], z_, 0, 0, 0); } \
        else { p0 = __builtin_amdgcn_mfma_f32_32x32x16_bf16(kf[0], qr[0], negm, 0, 0, 0); p1 = __builtin_amdgcn_mfma_f32_32x32x16_bf16(kf[1], qr[0], negm, 0, 0, 0); } \
        _Pragma("unroll") for (int d0 = 1; d0 < 4; ++d0) { p0 = __builtin_amdgcn_mfma_f32_32x32x16_bf16(kf[2 * d0], qr[d0], p0, 0, 0, 0); p1 = __builtin_amdgcn_mfma_f32_32x32x16_bf16(kf[2 * d0 + 1], qr[d0], p1, 0, 0, 0); } } while (0)
#define ATT_PV() do { \
        _Pragma("unroll") for (int ks = 0; ks < 4; ++ks) { const bf16x8 pf = __builtin_bit_cast(bf16x8, pk[ks]); \
            o0 = __builtin_amdgcn_mfma_f32_32x32x16_bf16(vf[2 * ks], pf, o0, 0, 0, 0); o1 = __builtin_amdgcn_mfma_f32_32x32x16_bf16(vf[2 * ks + 1], pf, o1, 0, 0, 0); \
            o2 = __builtin_amdgcn_mfma_f32_32x32x16_bf16(ones, pf, o2, 0, 0, 0); } } while (0)
    int ia = 0, ib = n - 1;
    if (WIN) { int lo_t = (qw0 - 128) >> 6; if (lo_t < t_lo) lo_t = t_lo; int hi_t = (qw0 + 31 + 128) >> 6; if (hi_t > t_hi) hi_t = t_hi; ia = lo_t - t_lo; ib = hi_t - t_lo; }
#define ATT_STAGE(i) do { if ((i) + 2 < n) { const int sl_ = ((i) + 2) & 3; *(LAS u32x4*)(lds + LDS_K + sl_ * 8192 + tid * 16) = kreg; *(LAS u32x4*)(lds + LDS_V + sl_ * 8192 + tid * 16) = vreg; \
            if ((i) + 3 < n) { kreg = *(const u32x4*)(Kb + (size_t)((i) + 3) * 4096); vreg = *(const u32x4*)(Vb + (size_t)((i) + 3) * 4096); } } } while (0)
    bool first = !WIN;
    int i = 0;
    if (ia == 0) { ATT_LDK(0); asm volatile("s_waitcnt lgkmcnt(0)" ::: "memory"); ATT_QK(); }
    ATT_BAR();
    for (; i < ia; ++i) {
        ATT_STAGE(i);
        ATT_BAR();
        if (i + 1 == ia) { ATT_LDK((i + 1) & 3); asm volatile("s_waitcnt lgkmcnt(0)" ::: "memory"); ATT_QK(); }
        ATT_BAR();
    }
    for (; i <= ib; ++i) {
        ATT_LDV(i & 3);
        __builtin_amdgcn_sched_barrier(0);
        asm volatile("s_nop 7" : "+v"(p0), "+v"(p1));
        if (WIN) {
            const LAS float* bp = biasl + (64 * (t_lo + i) - qrow + 4 * hi + 384);
#pragma unroll
            for (int r = 0; r < 16; ++r) { p0[r] += bp[(r & 3) + 8 * (r >> 2)]; p1[r] += bp[32 + (r & 3) + 8 * (r >> 2)]; }
        }
        if (!NOMAX) {
        float ra = max3f(p0[0], p0[1], p1[0]), rb = max3f(p0[2], p0[3], p1[1]); ra = max3f(ra, p1[2], p1[3]);
#pragma unroll
        for (int r = 4; r < 16; r += 4) { ra = max3f(ra, p0[r], p0[r + 1]); rb = max3f(rb, p0[r + 2], p0[r + 3]); ra = max3f(ra, p1[r], p1[r + 1]); rb = max3f(rb, p1[r + 2], p1[r + 3]); }
        float rm = xhalf_max(max2f(ra, rb));
        if (first || __builtin_amdgcn_ballot_w64(rm > THR) != 0ull) {
            const float delta = first ? rm : fmaxf(rm, 0.0f); const float f = first ? 1.0f : __builtin_amdgcn_exp2f(-delta);
            mref += delta;
#pragma unroll
            for (int r = 0; r < 16; ++r) { p0[r] -= delta; p1[r] -= delta; o0[r] *= f; o1[r] *= f; o2[r] *= f; negm[r] = -mref; }
            first = false;
        }
        }
#pragma unroll
        for (int r = 0; r < 16; ++r) { if (XV == 1) { p0[r] *= 0.5f; p1[r] *= 0.5f; } else { p0[r] = __builtin_amdgcn_exp2f(p0[r]); p1[r] = __builtin_amdgcn_exp2f(p1[r]); } }
#pragma unroll
        for (int q = 0; q < 4; ++q) { pk[0][q] = pkbf(p0[2 * q], p0[2 * q + 1]); pk[1][q] = pkbf(p0[8 + 2 * q], p0[9 + 2 * q]); pk[2][q] = pkbf(p1[2 * q], p1[2 * q + 1]); pk[3][q] = pkbf(p1[8 + 2 * q], p1[9 + 2 * q]); }
        ATT_STAGE(i);
        asm volatile("s_waitcnt lgkmcnt(0)" : "+v"(vf[0]), "+v"(vf[1]), "+v"(vf[2]), "+v"(vf[3]), "+v"(vf[4]), "+v"(vf[5]), "+v"(vf[6]), "+v"(vf[7]), "+v"(pk[0]), "+v"(pk[1]), "+v"(pk[2]), "+v"(pk[3]) : : "memory");
        if (XV != 3) ATT_BAR(); else asm volatile("s_waitcnt lgkmcnt(0)" ::: "memory");
        __builtin_amdgcn_s_setprio(ATTN_PRIO);
#if ATTN_CLEANM
        if (i < ib) { ATT_LDK((i + 1) & 3); __builtin_amdgcn_sched_barrier(0); }
#else
        if (i < ib) ATT_LDK((i + 1) & 3);
#endif
        if (XV != 2) { ATT_PV(); if (i < ib) ATT_QK(); } else { asm volatile("" : "+v"(kf[0]), "+v"(kf[7]), "+v"(vf[0]), "+v"(vf[7])); }
        __builtin_amdgcn_s_setprio(0);
        ATT_BAR();
    }
    for (; i < n; ++i) { ATT_STAGE(i); ATT_BAR(); ATT_BAR(); }
#undef ATT_STAGE
#undef ATT_QK
#undef ATT_PV
#undef ATT_LDK
#undef ATT_LDV
    const float inv = 1.0f / o2[0];
    bf16_t* Orow = O + grow * (2 * QW) + h * HD + 4 * hi;
#pragma unroll
    for (int g = 0; g < 4; ++g) {
        u32x2_t w0, w1;
        w0.x = pkbf(o0[4 * g] * inv, o0[4 * g + 1] * inv); w0.y = pkbf(o0[4 * g + 2] * inv, o0[4 * g + 3] * inv);
        w1.x = pkbf(o1[4 * g] * inv, o1[4 * g + 1] * inv); w1.y = pkbf(o1[4 * g + 2] * inv, o1[4 * g + 3] * inv);
        *(u32x2_t*)(Orow + 8 * g) = w0; *(u32x2_t*)(Orow + 32 + 8 * g) = w1;
    }
    if (!grp) ATT_BAR();
}
}

namespace peer {
typedef unsigned u32x4 __attribute__((ext_vector_type(4)));
typedef float f32x4 __attribute__((ext_vector_type(4)));
constexpr int WAVE_LDS = 2048;

template <int CTRL> __device__ __forceinline__ int dppi(int x) { return __builtin_amdgcn_mov_dpp(x, CTRL, 0xf, 0xf, true); }
template <int CTRL> __device__ __forceinline__ float dppf(float x) { return __builtin_bit_cast(float, __builtin_amdgcn_mov_dpp(__builtin_bit_cast(int, x), CTRL, 0xf, 0xf, true)); }
constexpr int XOR1 = 0xB1, XOR2 = 0x4E, XOR7 = 0x141, XOR8 = 0x128;
__device__ __forceinline__ float wave_sum(float x) {
    x += dppf<XOR1>(x); x += dppf<XOR2>(x); x += dppf<XOR7>(x); x += dppf<XOR8>(x);
    auto s = __builtin_amdgcn_permlane16_swap(__float_as_uint(x), __float_as_uint(x), false, false); x = __uint_as_float(s[0]) + __uint_as_float(s[1]);
    auto t = __builtin_amdgcn_permlane32_swap(__float_as_uint(x), __float_as_uint(x), false, false); return __uint_as_float(t[0]) + __uint_as_float(t[1]);
}
__device__ __forceinline__ float dot2bf(unsigned a, unsigned b, float c) { return __builtin_amdgcn_fdot2_f32_bf16(__builtin_bit_cast(bf16x2_t, a), __builtin_bit_cast(bf16x2_t, b), c, false); }
__device__ __forceinline__ unsigned getw(const u32x4& v, int i) { return i == 0 ? v.x : i == 1 ? v.y : i == 2 ? v.z : v.w; }
__device__ __forceinline__ int okey(float f, int lowbits, int payload) { int b = __float_as_int(f); b ^= (b >> 31) & 0x7fffffff; return (b & ~((1 << lowbits) - 1)) | payload; }
__device__ __forceinline__ float kval(int k, int lowbits) { int b = (k & ~((1 << lowbits) - 1)) | (1 << (lowbits - 1)); b ^= (b >> 31) & 0x7fffffff; return __int_as_float(b); }
#define CE_DESC(a, b) do { const int _x = (a), _y = (b); (a) = _x > _y ? _x : _y; (b) = _x > _y ? _y : _x; } while (0)
template <int N> __device__ __forceinline__ void bitonic_sort_desc(int (&a)[N]) {
#pragma unroll
    for (int k = 2; k <= N; k <<= 1)
#pragma unroll
        for (int j = k >> 1; j > 0; j >>= 1)
#pragma unroll
            for (int i = 0; i < N; ++i) { const int l = i ^ j; if (l > i) { if ((i & k) == 0) CE_DESC(a[i], a[l]); else CE_DESC(a[l], a[i]); } }
}
template <int N> __device__ __forceinline__ void bitonic_merge_desc(int (&a)[N]) {
#pragma unroll
    for (int j = N >> 1; j > 0; j >>= 1)
#pragma unroll
        for (int i = 0; i < N; ++i) { const int l = i ^ j; if (l > i) CE_DESC(a[i], a[l]); }
}
__device__ __forceinline__ unsigned long long cand_table(int q8) {
    unsigned long long r = 0xFFFFFFFFFFFFFFFFull; int n = 0;
#pragma unroll
    for (int i = 0; i < 16; ++i)
#pragma unroll
        for (int j = 0; j < 16; ++j) if ((i + 1) * (j + 1) <= 16) { if (n / 7 == q8) { const int s = n % 7; r = (r & ~(0xFFull << (8 * s))) | ((unsigned long long)(i * 16 + j) << (8 * s)); } ++n; }
    return r;
}

struct SCtx { u32x4 v[4]; };
__device__ __forceinline__ SCtx s_ctx(int lane, int t, const unsigned short* SC) { SCtx c; const u32x4* p = (const u32x4*)(SC + (size_t)t * SCW + (lane >> 2) * NKEYS + (lane & 3) * 32);
#pragma unroll
    for (int i = 0; i < 4; ++i) c.v[i] = p[i];
    return c; }
__device__ __forceinline__ void route_token(LAS char* wl, int lane, int t, unsigned long long ct, const SCtx& scx  , const float* SSQ, unsigned short* E, float* G, float* RSTD) {
    LAS int* skeys = (LAS int*)wl;
    {
        const int c = lane >> 2, qq = lane & 3;
        int a[16], bb[16];
#pragma unroll
        for (int i = 0; i < 2; ++i) { const u32x4 v = scx.v[i];
#pragma unroll
            for (int j = 0; j < 4; ++j) { const unsigned w = getw(v, j); const pg8::f16x2_t h = __builtin_bit_cast(pg8::f16x2_t, w);
                a[8 * i + 2 * j] = okey((float)h.x, 7, 127 - (qq * 32 + 8 * i + 2 * j)); a[8 * i + 2 * j + 1] = okey((float)h.y, 7, 127 - (qq * 32 + 8 * i + 2 * j + 1)); } }
#pragma unroll
        for (int i = 0; i < 2; ++i) { const u32x4 v = scx.v[2 + i];
#pragma unroll
            for (int j = 0; j < 4; ++j) { const unsigned w = getw(v, j); const pg8::f16x2_t h = __builtin_bit_cast(pg8::f16x2_t, w);
                bb[8 * i + 2 * j] = okey((float)h.x, 7, 127 - (qq * 32 + 16 + 8 * i + 2 * j)); bb[8 * i + 2 * j + 1] = okey((float)h.y, 7, 127 - (qq * 32 + 16 + 8 * i + 2 * j + 1)); } }
        bitonic_sort_desc<16>(a); bitonic_sort_desc<16>(bb);
#pragma unroll
        for (int i = 0; i < 16; ++i) a[i] = a[i] > bb[15 - i] ? a[i] : bb[15 - i];
        bitonic_merge_desc<16>(a);
#pragma unroll
        for (int i = 0; i < 16; ++i) bb[i] = dppi<XOR1>(a[15 - i]);
#pragma unroll
        for (int i = 0; i < 16; ++i) a[i] = a[i] > bb[i] ? a[i] : bb[i];
        bitonic_merge_desc<16>(a);
#pragma unroll
        for (int i = 0; i < 16; ++i) bb[i] = dppi<XOR2>(a[15 - i]);
#pragma unroll
        for (int i = 0; i < 16; ++i) a[i] = a[i] > bb[i] ? a[i] : bb[i];
        bitonic_merge_desc<16>(a);
        if (qq == 0) {
#pragma unroll
            for (int i = 0; i < 4; ++i) *(LAS u32x4*)(skeys + c * 16 + 4 * i) = (u32x4){(unsigned)a[4 * i], (unsigned)a[4 * i + 1], (unsigned)a[4 * i + 2], (unsigned)a[4 * i + 3]};
        }
    }
    asm volatile("s_waitcnt lgkmcnt(0)" ::: "memory");
    {
        const int hh = lane >> 3, q8 = lane & 7;
        int a[16];
#pragma unroll
        for (int s = 0; s < 8; ++s) {
            const int code = s < 7 ? (int)((ct >> (8 * s)) & 0xFF) : 0xFF;
            const int ci = code == 0xFF ? 0 : code;
            const int ka = skeys[(2 * hh) * 16 + (ci >> 4)], kb = skeys[(2 * hh + 1) * 16 + (ci & 15)];
            const float sum = kval(ka, 7) + kval(kb, 7);
            a[s] = code == 0xFF ? (int)0x80000000 : okey(sum, 8, 255 - code);
        }
        {
            int c8[8];
#pragma unroll
            for (int i = 0; i < 8; ++i) c8[i] = a[i];
            bitonic_sort_desc<8>(c8);
#pragma unroll
            for (int i = 0; i < 8; ++i) a[i] = c8[i];
        }
#pragma unroll
        for (int i = 0; i < 8; ++i) a[8 + i] = dppi<XOR1>(a[i]);
        { int tmp[8];
#pragma unroll
          for (int i = 0; i < 8; ++i) tmp[i] = a[8 + i];
#pragma unroll
          for (int i = 0; i < 8; ++i) a[8 + i] = tmp[7 - i]; }
        bitonic_merge_desc<16>(a);
        int bb[16];
#pragma unroll
        for (int i = 0; i < 16; ++i) bb[i] = dppi<XOR2>(a[15 - i]);
#pragma unroll
        for (int i = 0; i < 16; ++i) a[i] = a[i] > bb[i] ? a[i] : bb[i];
        bitonic_merge_desc<16>(a);
#pragma unroll
        for (int i = 0; i < 16; ++i) bb[i] = dppi<XOR7>(a[15 - i]);
#pragma unroll
        for (int i = 0; i < 16; ++i) a[i] = a[i] > bb[i] ? a[i] : bb[i];
        bitonic_merge_desc<16>(a);
        int k0 = a[0], k1 = a[1];
#pragma unroll
        for (int i = 1; i < 8; ++i) { k0 = q8 == i ? a[2 * i] : k0; k1 = q8 == i ? a[2 * i + 1] : k1; }
        const float mx = kval(a[0], 8);
        const int c0 = 255 - (k0 & 255), c1 = 255 - (k1 & 255);
        const int ka0 = skeys[(2 * hh) * 16 + (c0 >> 4)], kb0 = skeys[(2 * hh + 1) * 16 + (c0 & 15)];
        const int ka1 = skeys[(2 * hh) * 16 + (c1 >> 4)], kb1 = skeys[(2 * hh + 1) * 16 + (c1 & 15)];
        const float s0 = kval(ka0, 7) + kval(kb0, 7), s1 = kval(ka1, 7) + kval(kb1, 7);
        const float e0 = __expf(s0 - mx), e1 = __expf(s1 - mx);
        float z = e0 + e1; z += dppf<XOR1>(z); z += dppf<XOR2>(z); z += dppf<XOR7>(z);
        const float rz = 1.0f / z;
        const unsigned e0i = (unsigned)((127 - (ka0 & 127)) * NKEYS + (127 - (kb0 & 127))), e1i = (unsigned)((127 - (ka1 & 127)) * NKEYS + (127 - (kb1 & 127)));
        *(unsigned*)(E + (size_t)t * 128 + hh * 16 + 2 * q8) = e0i | (e1i << 16);
        *(f32x2_t*)(G + (size_t)t * 128 + hh * 16 + 2 * q8) = (f32x2_t){e0 * rz, e1 * rz};
    }
    if (lane == 0) { const f32x4* sp = (const f32x4*)(SSQ + (size_t)t * 16); const f32x4 s0 = sp[0], s1 = sp[1], s2 = sp[2], s3 = sp[3];
        const float tot = (((s0[0] + s0[1]) + (s0[2] + s0[3])) + ((s1[0] + s1[1]) + (s1[2] + s1[3]))) + (((s2[0] + s2[1]) + (s2[2] + s2[3])) + ((s3[0] + s3[1]) + (s3[2] + s3[3])));
        RSTD[t] = 1.0f / sqrtf(tot * (1.0f / DM) + EPS); }
    asm volatile("s_waitcnt lgkmcnt(0)" ::: "memory");
}

constexpr size_t SLICE_BYTES = (size_t)NEXP * 128;
__device__ __forceinline__ float wave_max(float x) {
    x = fmaxf(x, dppf<XOR1>(x)); x = fmaxf(x, dppf<XOR2>(x)); x = fmaxf(x, dppf<XOR7>(x)); x = fmaxf(x, dppf<XOR8>(x));
    auto s = __builtin_amdgcn_permlane16_swap(__float_as_uint(x), __float_as_uint(x), false, false); x = fmaxf(__uint_as_float(s[0]), __uint_as_float(s[1]));
    auto t = __builtin_amdgcn_permlane32_swap(__float_as_uint(x), __float_as_uint(x), false, false); return fmaxf(__uint_as_float(t[0]), __uint_as_float(t[1]));
}
__device__ __forceinline__ void table_rows4_fp8(const float* src, unsigned char* T8, float* INV, int e0, int es, int lane) {
    f32x4 v[4][4];
#pragma unroll
    for (int i = 0; i < 4; ++i) { const f32x4* p = (const f32x4*)(src + (size_t)(e0 + i * es) * DM + 16 * lane);
#pragma unroll
        for (int q = 0; q < 4; ++q) v[i][q] = __builtin_nontemporal_load(p + q); }
#pragma unroll
    for (int i = 0; i < 4; ++i) {
        float mx = 0.f;
#pragma unroll
        for (int q = 0; q < 4; ++q) mx = fmaxf(mx, fmaxf(fmaxf(fabsf(v[i][q][0]), fabsf(v[i][q][1])), fmaxf(fabsf(v[i][q][2]), fabsf(v[i][q][3]))));
        mx = wave_max(mx);
        const float sc = mx > 0.f ? 448.0f / mx : 1.0f;
        unsigned o[4];
#pragma unroll
        for (int q = 0; q < 4; ++q) { unsigned w = 0; w = __builtin_amdgcn_cvt_pk_fp8_f32(v[i][q][0] * sc, v[i][q][1] * sc, w, false); w = __builtin_amdgcn_cvt_pk_fp8_f32(v[i][q][2] * sc, v[i][q][3] * sc, w, true); o[q] = w; }
        const int e = e0 + i * es;
        *(u32x4*)(T8 + (size_t)(lane >> 3) * SLICE_BYTES + (size_t)e * 128 + (lane & 7) * 16) = (u32x4){o[0], o[1], o[2], o[3]};
        if (lane == 0) INV[e] = mx > 0.f ? mx * (1.0f / 448.0f) : 1.0f;
    }
}
__device__ __forceinline__ void tables_fp8(const float* peer_u, const float* peer_v, unsigned char* U8, unsigned char* V8, float* INVU, float* INVV, int r0, int r1, int w, int nw, int lane) {
    for (int e = r0 + w; e < r1; e += 4 * nw) {
        if (e + 3 * nw < r1) { table_rows4_fp8(peer_u, U8, INVU, e, nw, lane); table_rows4_fp8(peer_v, V8, INVV, e, nw, lane); }
        else for (int e2 = e; e2 < r1; e2 += nw) { table_rows4_fp8(peer_u, U8, INVU, e2, 0, lane); table_rows4_fp8(peer_v, V8, INVV, e2, 0, lane); }
    }
}
struct ECtx { u32x4 ea, eb; };
struct XCtx { u32x4 xa, xb; float rs; };
__device__ __forceinline__ ECtx e_ctx(int lane, int t, const unsigned short* E) { ECtx c; c.ea = *(const u32x4*)(E + (size_t)t * 128 + (lane >> 3) * 16); c.eb = *(const u32x4*)(E + (size_t)t * 128 + (lane >> 3) * 16 + 8); return c; }
__device__ __forceinline__ XCtx x_ctx(int lane, int t, int s, const unsigned short* HB, const float* RSTD) { XCtx c; c.xa = *(const u32x4*)(HB + (size_t)t * DM + s * 128 + (lane & 7) * 16); c.xb = *(const u32x4*)(HB + (size_t)t * DM + s * 128 + (lane & 7) * 16 + 8); c.rs = RSTD[t]; return c; }
__device__ __forceinline__ void g_rows(u32x4 (&row)[16], const ECtx& c, const unsigned char* T8s, int c8) {
#pragma unroll
    for (int j = 0; j < 16; ++j) { const unsigned ew = getw(j < 8 ? c.ea : c.eb, (j & 7) >> 1); const unsigned e = (j & 1) ? (ew >> 16) : (ew & 0xffffu);
        row[j] = *(const u32x4*)(T8s + (size_t)e * 128 + c8 * 16); }
}
__device__ __forceinline__ void u_compute(int lane, int t, int s, const XCtx& c, const f32x2_t (&gch)[8], const u32x4 (&row)[16], unsigned short* PA) {
    const int rs = lane >> 3, c8 = lane & 7;
    f32x2_t xf[8];
#pragma unroll
    for (int i = 0; i < 4; ++i) { const unsigned wa = getw(c.xa, i), wb = getw(c.xb, i); xf[i] = (f32x2_t){bflo(wa), bfhi(wa)} * gch[i] * c.rs; xf[4 + i] = (f32x2_t){bflo(wb), bfhi(wb)} * gch[4 + i] * c.rs; }
    float part[16];
#pragma unroll
    for (int j = 0; j < 16; ++j) {
        f32x2_t acc = {0.f, 0.f};
#pragma unroll
        for (int w = 0; w < 4; ++w) { const unsigned q = getw(row[j], w);
            acc = __builtin_elementwise_fma(__builtin_amdgcn_cvt_pk_f32_fp8(q, false), xf[2 * w], acc); acc = __builtin_elementwise_fma(__builtin_amdgcn_cvt_pk_f32_fp8(q, true), xf[2 * w + 1], acc); }
        float p = acc.x + acc.y; p += dppf<XOR1>(p); p += dppf<XOR2>(p); p += dppf<XOR7>(p); part[j] = p;
    }
    float p0 = part[0], p1 = part[1];
#pragma unroll
    for (int i = 1; i < 8; ++i) { p0 = c8 == i ? part[2 * i] : p0; p1 = c8 == i ? part[2 * i + 1] : p1; }
    *(unsigned*)(PA + ((size_t)t * 8 + s) * 128 + rs * 16 + 2 * c8) = pkbf(p0, p1);
}
#define TCL(t_) ((t_) < NTOK ? (t_) : NTOK - 1)
__device__ __forceinline__ void upass_slice(int lane, int s, int wv, int nwv, const unsigned char* U8s, const unsigned short* E, const unsigned short* HB, const float* RSTD, const float* gffn, unsigned short* PA) {
    const int c8 = lane & 7;
    int t = wv; if (t >= NTOK) return;
    f32x2_t gch[8];
#pragma unroll
    for (int i = 0; i < 4; ++i) { const f32x4 g = *(const f32x4*)(gffn + s * 128 + c8 * 16 + 4 * i); gch[2 * i] = (f32x2_t){g[0], g[1]}; gch[2 * i + 1] = (f32x2_t){g[2], g[3]}; }
    ECtx eA = e_ctx(lane, t, E), eB = e_ctx(lane, TCL(t + nwv), E); XCtx xA = x_ctx(lane, t, s, HB, RSTD), xB;
    u32x4 rA[16], rB[16];
    g_rows(rA, eA, U8s, c8);
    for (; t < NTOK; t += 2 * nwv) {
        eA = e_ctx(lane, TCL(t + 2 * nwv), E); xB = x_ctx(lane, TCL(t + nwv), s, HB, RSTD); g_rows(rB, eB, U8s, c8);
        u_compute(lane, t, s, xA, gch, rA, PA);
        eB = e_ctx(lane, TCL(t + 3 * nwv), E); xA = x_ctx(lane, TCL(t + 2 * nwv), s, HB, RSTD); g_rows(rA, eA, U8s, c8);
        if (t + nwv < NTOK) u_compute(lane, t + nwv, s, xB, gch, rB, PA);
    }
}
template <int NT>
__device__ __forceinline__ void wpass_tokens(int lane, int t0, int ts, const unsigned short* E, const float* G, const unsigned short* PA, const float* INVU, const float* INVV, float* W) {
    unsigned pw[NT][8], ew[NT]; f32x2_t g[NT];
#pragma unroll
    for (int i = 0; i < NT; ++i) { const int t = t0 + i * ts;
#pragma unroll
        for (int s = 0; s < 8; ++s) pw[i][s] = *(const unsigned*)(PA + ((size_t)t * 8 + s) * 128 + 2 * lane);
        ew[i] = *(const unsigned*)(E + (size_t)t * 128 + 2 * lane); g[i] = *(const f32x2_t*)(G + (size_t)t * 128 + 2 * lane); }
    float iu0[NT], iu1[NT], iv0[NT], iv1[NT];
#pragma unroll
    for (int i = 0; i < NT; ++i) { const unsigned e0 = ew[i] & 0xffffu, e1 = ew[i] >> 16; iu0[i] = INVU[e0]; iu1[i] = INVU[e1]; iv0[i] = INVV[e0]; iv1[i] = INVV[e1]; }
#pragma unroll
    for (int i = 0; i < NT; ++i) { float a0 = 0.f, a1 = 0.f;
#pragma unroll
        for (int s = 0; s < 8; ++s) { a0 += bflo(pw[i][s]); a1 += bfhi(pw[i][s]); }
        a0 *= iu0[i]; a1 *= iu1[i];
        const float w0 = g[i].x * 0.5f * a0 * (1.0f + erff(a0 * 0.70710678118654752f)) * iv0[i], w1 = g[i].y * 0.5f * a1 * (1.0f + erff(a1 * 0.70710678118654752f)) * iv1[i];
        *(f32x2_t*)(W + (size_t)(t0 + i * ts) * 128 + 2 * lane) = (f32x2_t){w0, w1}; }
}
struct WCtx { f32x4 w0, w1, w2, w3; };
__device__ __forceinline__ WCtx w_ctx(int lane, int t, const float* W) { const f32x4* wp = (const f32x4*)(W + (size_t)t * 128 + (lane >> 3) * 16); WCtx c; c.w0 = wp[0]; c.w1 = wp[1]; c.w2 = wp[2]; c.w3 = wp[3]; return c; }
__device__ __forceinline__ void v_compute(int lane, int t, int s, const WCtx& wc, const u32x4 (&row)[16], unsigned short* PO) {
    const int rs = lane >> 3, c8 = lane & 7;
    f32x2_t o[8];
#pragma unroll
    for (int i = 0; i < 8; ++i) o[i] = (f32x2_t){0.f, 0.f};
#pragma unroll
    for (int j = 0; j < 16; ++j) {
        const f32x4 wq = j < 4 ? wc.w0 : j < 8 ? wc.w1 : j < 12 ? wc.w2 : wc.w3; const int jj = j & 3; const float wj = jj == 0 ? wq.x : jj == 1 ? wq.y : jj == 2 ? wq.z : wq.w; const f32x2_t w2v = {wj, wj};
#pragma unroll
        for (int w = 0; w < 4; ++w) { const unsigned q = getw(row[j], w);
            o[2 * w] = __builtin_elementwise_fma(__builtin_amdgcn_cvt_pk_f32_fp8(q, false), w2v, o[2 * w]); o[2 * w + 1] = __builtin_elementwise_fma(__builtin_amdgcn_cvt_pk_f32_fp8(q, true), w2v, o[2 * w + 1]); }
    }
    float of[16];
#pragma unroll
    for (int i = 0; i < 8; ++i) { of[2 * i] = o[i].x; of[2 * i + 1] = o[i].y; }
#pragma unroll
    for (int i = 0; i < 16; ++i) { float x = of[i]; x += dppf<XOR8>(x);
        auto s1 = __builtin_amdgcn_permlane16_swap(__float_as_uint(x), __float_as_uint(x), false, false); x = __uint_as_float(s1[0]) + __uint_as_float(s1[1]);
        auto s2 = __builtin_amdgcn_permlane32_swap(__float_as_uint(x), __float_as_uint(x), false, false); of[i] = __uint_as_float(s2[0]) + __uint_as_float(s2[1]); }
    if (rs == 0) {
        unsigned short* po = PO + (size_t)t * DM + s * 128 + c8 * 16;
        *(u32x4*)po = (u32x4){pkbf(of[0], of[1]), pkbf(of[2], of[3]), pkbf(of[4], of[5]), pkbf(of[6], of[7])};
        *(u32x4*)(po + 8) = (u32x4){pkbf(of[8], of[9]), pkbf(of[10], of[11]), pkbf(of[12], of[13]), pkbf(of[14], of[15])};
    }
}
__device__ __forceinline__ void vpass_slice(int lane, int s, int wv, int nwv, const unsigned char* V8s, const unsigned short* E, const float* W, unsigned short* PO) {
    const int c8 = lane & 7;
    int t = wv; if (t >= NTOK) return;
    ECtx eA = e_ctx(lane, t, E), eB = e_ctx(lane, TCL(t + nwv), E); WCtx wA = w_ctx(lane, t, W), wB;
    u32x4 rA[16], rB[16];
    g_rows(rA, eA, V8s, c8);
    for (; t < NTOK; t += 2 * nwv) {
        eA = e_ctx(lane, TCL(t + 2 * nwv), E); wB = w_ctx(lane, TCL(t + nwv), W); g_rows(rB, eB, V8s, c8);
        v_compute(lane, t, s, wA, rA, PO);
        eB = e_ctx(lane, TCL(t + 3 * nwv), E); wA = w_ctx(lane, TCL(t + 2 * nwv), W); g_rows(rA, eA, V8s, c8);
        if (t + nwv < NTOK) v_compute(lane, t + nwv, s, wB, rB, PO);
    }
}
#undef TCL
__device__ __forceinline__ void final_token(int lane, int t, float* Y, const unsigned short* HB, const unsigned short* PO, const float* gfin) {
    f32x4* yr = (f32x4*)(Y + (size_t)t * DM) + lane; const u32x2_t* pr = (const u32x2_t*)(PO + (size_t)t * DM) + lane; const u32x2_t* hr = (const u32x2_t*)(HB + (size_t)t * DM) + lane;
    f32x4 v[4]; float ss = 0.f;
#pragma unroll
    for (int j = 0; j < 4; ++j) { const u32x2_t hw = hr[64 * j]; v[j] = (f32x4){bflo(hw.x), bfhi(hw.x), bflo(hw.y), bfhi(hw.y)}; const u32x2_t p = pr[64 * j]; v[j][0] += bflo(p.x); v[j][1] += bfhi(p.x); v[j][2] += bflo(p.y); v[j][3] += bfhi(p.y);
        ss += (v[j][0] * v[j][0] + v[j][1] * v[j][1]) + (v[j][2] * v[j][2] + v[j][3] * v[j][3]); }
    const float rstd = 1.0f / sqrtf(wave_sum(ss) * (1.0f / DM) + EPS);
#pragma unroll
    for (int j = 0; j < 4; ++j) { const f32x4 g = *((const f32x4*)gfin + lane + 64 * j); yr[64 * j] = (f32x4){v[j][0] * rstd * g[0], v[j][1] * rstd * g[1], v[j][2] * rstd * g[2], v[j][3] * rstd * g[3]}; }
}
}

constexpr int NWAVES = 8;
#ifndef MK_N_LAUNCHES
#define MK_N_LAUNCHES 1
#endif
constexpr int N_LAUNCHES = MK_N_LAUNCHES;
constexpr int PER_PHASE = 7;
#ifndef PROBE
#define PROBE -1
#endif
#ifndef DIAG_SEL
#define DIAG_SEL -1
#endif
#ifndef XVAR
#define XVAR 0
#endif
#define NREP(k) ((PROBE == (k)) ? 2 : 1)

typedef unsigned short bf16;
typedef unsigned v4u __attribute__((ext_vector_type(4)));
typedef float f32x4 __attribute__((ext_vector_type(4)));
#define LDS_WAIT() asm volatile("s_waitcnt lgkmcnt(0)" ::: "memory")
#define VM_WAIT() asm volatile("s_waitcnt vmcnt(0)" ::: "memory")

constexpr size_t MiB = 1u << 20;
constexpr size_t WS_CTL = 0, CTL_ZERO_BYTES = 64 * 1024;
constexpr size_t WS_TAB = 1 * MiB;
constexpr size_t WS_SSQ = 1 * MiB + 64 * 1024;
constexpr size_t WS_WIN = 3 * MiB;
constexpr size_t WS_WA = 10 * MiB, WS_WB = 11 * MiB;
constexpr size_t WS_WO = 12 * MiB;
constexpr size_t WS_WE = 14 * MiB;
constexpr size_t WS_U8 = 18 * MiB, WS_V8 = 34 * MiB;
constexpr size_t WS_PA = 50 * MiB;
constexpr size_t WS_INVU = 2 * MiB + 128 * 1024, WS_INVV = WS_INVU + 64 * 1024;
constexpr size_t WS_RSTD = WS_INVV + 64 * 1024;
constexpr size_t WS_G = 3 * MiB, WS_E = 11 * MiB;
constexpr size_t WS_W = 114 * MiB, WS_PSS = 122 * MiB;
constexpr int CW_RANK = 8192;
constexpr size_t WS_XN = 82 * MiB;
constexpr size_t WS_ACT = 114 * MiB;
constexpr size_t WS_QA = WS_ACT, WS_QB = WS_ACT + 512 * 2;
constexpr size_t WS_KA = WS_ACT + 32 * MiB, WS_VA = WS_ACT + 36 * MiB, WS_KB = WS_ACT + 40 * MiB, WS_VB = WS_ACT + 44 * MiB;
constexpr size_t WS_GA = WS_ACT + 48 * MiB, WS_GB = WS_ACT + 80 * MiB;
constexpr size_t WS_SC = WS_ACT;
constexpr size_t WS_END = 242 * MiB;
static_assert(WS_GB + 32 * MiB <= WS_END && WS_SC + (size_t)NTOK * SCW * 4 <= WS_END, "d_ws map");

constexpr int RING_BYTES = 131072;
constexpr int MISC_OFF = RING_BYTES + 320;
constexpr int LDS_BYTES = 147456;

#define XB_TMO      128
#define XB_XCNT(j)  (256  + 64 * (j))
#define XB_XSUB(j)  (1280 + 64 * (j))
#define XB_XGEN(j)  (2304 + 64 * (j))
#define XB_TOP      3328
#define XB_TOPGEN   3392
#define XCD_BAR_WORDS 3456
#define XB_SPIN_CAP (1u << 18)

__device__ __forceinline__ unsigned xb_ld(unsigned* p)              { return __hip_atomic_load(p, __ATOMIC_RELAXED, __HIP_MEMORY_SCOPE_AGENT); }
__device__ __forceinline__ unsigned xb_add(unsigned* p, unsigned v) { return __hip_atomic_fetch_add(p, v, __ATOMIC_RELAXED, __HIP_MEMORY_SCOPE_AGENT); }
__device__ __forceinline__ unsigned xb_xcc_id() { return (unsigned)__builtin_amdgcn_s_getreg((3 << 11) | 20) & 0xFu; }
#define XB_SPIN(cond, bar) do { unsigned _sp = 0; while (cond) { __builtin_amdgcn_s_sleep(1); \
    if ((++_sp & 255u) == 0u) { if (xb_ld(&(bar)[XB_TMO])) break; if (_sp > XB_SPIN_CAP) { atomicAdd(&(bar)[XB_TMO], 1u); break; } } } } while (0)

struct XcdBarrier {
    unsigned* bar; unsigned x;
    volatile LAS unsigned* st;
};

__device__ __forceinline__ XcdBarrier xcd_barrier_post(unsigned* bar, volatile LAS unsigned* st) {
    XcdBarrier b; b.bar = bar; b.x = xb_xcc_id(); b.st = st;
    if (threadIdx.x == 0) (void)xb_add(&bar[XB_XCNT(b.x)], 1u);
    return b;
}
__device__ __forceinline__ void xcd_barrier_complete(unsigned* bar, unsigned x, unsigned& nloc, unsigned& nx) {
    const unsigned G = gridDim.x * gridDim.y * gridDim.z;
    unsigned sum, cnt, mine, sp = 0u;
    for (;;) {
        sum = 0u; cnt = 0u; mine = 0u;
#pragma unroll
        for (unsigned j = 0; j < 16; ++j) { const unsigned c = xb_ld(&bar[XB_XCNT(j)]); sum += c; cnt += (c > 0u) ? 1u : 0u; mine = (j == x) ? c : mine; }
        if (sum == G) break;
        __builtin_amdgcn_s_sleep(1);
        if ((++sp & 255u) == 0u) { if (xb_ld(&bar[XB_TMO])) break; if (sp > XB_SPIN_CAP) { atomicAdd(&bar[XB_TMO], 1u); break; } }
    }
    nloc = mine > 0u ? mine : 1u; nx = cnt > 0u ? cnt : 1u;
}

__device__ __forceinline__ void xcd_barrier(const XcdBarrier& b) {
    asm volatile("s_waitcnt vmcnt(0)" ::: "memory");
    __syncthreads();
    if (threadIdx.x == 0) {
        unsigned* bar = b.bar;
        __builtin_amdgcn_s_waitcnt(0);
        unsigned nloc = b.st[0], nx = b.st[1];
        if (nloc == 0u) { xcd_barrier_complete(bar, b.x, nloc, nx); b.st[0] = nloc; b.st[1] = nx; }
        const unsigned old = xb_add(&bar[XB_XSUB(b.x)], 1u);
        const unsigned gen = old / nloc;
        if (old + 1u == (gen + 1u) * nloc) {
            __builtin_amdgcn_fence(__ATOMIC_RELEASE, "agent");
            asm volatile("s_waitcnt vmcnt(0)" ::: "memory");
            const unsigned og = xb_add(&bar[XB_TOP], 1u);
            const unsigned tg = og / nx;
            if (og + 1u == (tg + 1u) * nx) xb_add(&bar[XB_TOPGEN], 1u);
            else XB_SPIN(xb_ld(&bar[XB_TOPGEN]) == tg, bar);
            __builtin_amdgcn_fence(__ATOMIC_ACQUIRE, "agent");
            xb_add(&bar[XB_XGEN(b.x)], 1u);
            asm volatile("s_waitcnt vmcnt(0)" ::: "memory");
        } else {
            XB_SPIN(xb_ld(&bar[XB_XGEN(b.x)]) == gen, bar);
            __builtin_amdgcn_fence(__ATOMIC_ACQUIRE, "agent");
            asm volatile("s_waitcnt vmcnt(0)" ::: "memory");
        }
    }
    __syncthreads();
}


struct Args { const float* in[17]; float* out; unsigned char* ws; int ph_lo, ph_hi, li, pad; };

__device__ __forceinline__ void p0_transpose_item(const float* W, int K, int N, bf16* WT, int k0, int src_n0, int dst_n0, LAS float* scr, int lane, int dpitch = 0, int dk0 = 0, bool split16 = false) {
    if (dpitch == 0) dpitch = K;
    const int sl = split16 ? ((lane & 15) + ((lane & 16) << 1)) : (lane & 31);
#pragma unroll 8
    for (int i = 0; i < 32; ++i) { const int kk = 2 * i + (lane >> 5); scr[kk * 33 + (lane & 31)] = W[(size_t)(k0 + kk) * N + src_n0 + sl]; }
    LDS_WAIT();
    const int c = lane & 7;
#pragma unroll
    for (int j = 0; j < 4; ++j) { const int n = (lane >> 3) + 8 * j; const LAS float* s = scr + (8 * c) * 33 + n;
        v4u o; o.x = pkbf(s[0 * 33], s[1 * 33]); o.y = pkbf(s[2 * 33], s[3 * 33]); o.z = pkbf(s[4 * 33], s[5 * 33]); o.w = pkbf(s[6 * 33], s[7 * 33]);
        *(v4u*)(WT + (size_t)(dst_n0 + n) * dpitch + dk0 + k0 + 8 * c) = o; }
    LDS_WAIT();
}
__device__ __forceinline__ int win_src_col(int dst_n0) {
    if (dst_n0 >= 1536) return dst_n0;
    const int tile = dst_n0 >> 8, c = dst_n0 & 255;
    return tile * 256 + 64 * ((c >> 5) & 3) + 16 * (c >> 7);
}
__device__ __forceinline__ int t5_bucket(int rel) {
    const int n = rel < 0 ? -rel : rel; int bkt;
    if (n < 8) bkt = n; else { int v = 8 + (31 - __builtin_clz(n * n)) - 6; bkt = v > 15 ? 15 : v; }
    return bkt + (rel > 0 ? 16 : 0);
}

__global__ void __launch_bounds__(NWAVES * 64, 2) mk_fwd(Args args) {
    extern __shared__ __attribute__((aligned(16))) unsigned char lds_raw[];
    LAS unsigned char* lds = (LAS unsigned char*)lds_raw;
    volatile LAS unsigned* MISC = (volatile LAS unsigned*)(lds + MISC_OFF);
    const int tid = threadIdx.x, lane = tid & 63, wave = __builtin_amdgcn_readfirstlane(tid >> 6);
    const int G = gridDim.x, bx = blockIdx.x; const int vcu = (G % 8 == 0) ? (bx % 8) * (G / 8) + bx / 8 : bx;
    const int gw = vcu * NWAVES + wave, NGW = G * NWAVES;
    unsigned char* ws = args.ws;
    const float* x = args.in[0]; const float* g_mix = args.in[1]; const float* w_in = args.in[2]; const float* b_gate = args.in[3];
    const float* q_norm_g = args.in[4]; const float* k_norm_g = args.in[5]; const float* rel_bias = args.in[6]; const float* sink = args.in[7];
    const float* w_a = args.in[8]; const float* w_b = args.in[9]; const float* w_out = args.in[10]; const float* g_ffn = args.in[11];
    const float* peer_wq = args.in[12]; const float* subkeys = args.in[13]; const float* peer_u = args.in[14]; const float* peer_v = args.in[15]; const float* g_final = args.in[16];
    float* out = args.out;
    float* ROPE = (float*)(ws + WS_TAB); float* BIAS = (float*)(ws + WS_TAB + 16384); float* SSQ = (float*)(ws + WS_SSQ);
    bf16 *WIN_T = (bf16*)(ws + WS_WIN), *WA_T = (bf16*)(ws + WS_WA), *WB_T = (bf16*)(ws + WS_WB), *WO_T = (bf16*)(ws + WS_WO), *WE_T = (bf16*)(ws + WS_WE);
    unsigned char *U8 = ws + WS_U8, *V8 = ws + WS_V8; bf16 *PA = (bf16*)(ws + WS_PA), *XN = (bf16*)(ws + WS_XN);
    float* RSTD = (float*)(ws + WS_RSTD); float *INVU = (float*)(ws + WS_INVU), *INVV = (float*)(ws + WS_INVV), *RG = (float*)(ws + WS_G), *RW = (float*)(ws + WS_W), *PSS = (float*)(ws + WS_PSS); bf16* RE = (bf16*)(ws + WS_E);
    bf16 *QA = (bf16*)(ws + WS_QA), *QB = (bf16*)(ws + WS_QB), *KA = (bf16*)(ws + WS_KA), *VA = (bf16*)(ws + WS_VA), *KB = (bf16*)(ws + WS_KB), *VB = (bf16*)(ws + WS_VB);
    bf16 *GA = (bf16*)(ws + WS_GA), *GB = (bf16*)(ws + WS_GB); bf16* SC = (bf16*)(ws + WS_SC);

    for (int u = tid; u < (LDS_BYTES - RING_BYTES) / 4; u += NWAVES * 64) ((LAS unsigned*)(lds + RING_BYTES))[u] = 0u;
    __syncthreads();
    XcdBarrier bar; bar.bar = (unsigned*)(ws + WS_CTL) + 1024; bar.x = 0; bar.st = nullptr;
    if (N_LAUNCHES != PER_PHASE) bar = xcd_barrier_post((unsigned*)(ws + WS_CTL) + 1024, MISC + 8);
    if (tid == 0) { const unsigned xc = xb_xcc_id(); MISC[13] = xc; MISC[12] = xb_add((unsigned*)(ws + WS_CTL) + CW_RANK + 64 * xc, 1u); }
    const bool tail_tables = (G == 256);
    const int lo = args.ph_lo, hi = args.ph_hi;
#define IN(k) (lo <= (k) && (k) < hi)
#define BOTH(k) (IN(k) && IN((k) + 1))
#define GRID_BAR() do { if (N_LAUNCHES != PER_PHASE) xcd_barrier(bar); STAMP(); } while (0)
#ifdef TSEL
    int n_stamp_ = 0;
#define STAMP() do { if (tid == 0) MISC[16 + n_stamp_] = (unsigned)__builtin_amdgcn_s_memrealtime(); ++n_stamp_; } while (0)
#else
#define STAMP() do { } while (0)
#endif
    STAMP();

    if (IN(0)) for (int rep_ = 0; rep_ < NREP(0); ++rep_) {
        if (rep_) { VM_WAIT(); __syncthreads(); }
        LAS float* scr = (LAS float*)(lds + wave * 16384);
        {
            constexpr int I_IN = (DM / 64) * (INW / 32), I_AB = (QW / 64) * (DM / 32), I_O = (DM / 64) * (DM / 32);
            constexpr int NITEMS = I_IN + 2 * I_AB + I_O;
            for (int it = gw; it < NITEMS; it += NGW) {
                int r = it;
                if (r < I_IN) { const int nblk = INW / 32, kb = r / nblk, nb = r % nblk; p0_transpose_item(w_in, DM, INW, WIN_T, 64 * kb, win_src_col(32 * nb), 32 * nb, scr, lane, 0, 0, 32 * nb < 1536); continue; } r -= I_IN;
                if (r < I_AB) { const int nblk = DM / 32, kb = r / nblk, nb = r % nblk; p0_transpose_item(w_a, QW, DM, WA_T, 64 * kb, 32 * nb, 32 * nb, scr, lane, DM, 0); continue; } r -= I_AB;
                if (r < I_AB) { const int nblk = DM / 32, kb = r / nblk, nb = r % nblk; p0_transpose_item(w_b, QW, DM, WA_T, 64 * kb, 32 * nb, 32 * nb, scr, lane, DM, QW); continue; }   r -= I_AB;
                { const int nblk = DM / 32, kb = r / nblk, nb = r % nblk; p0_transpose_item(w_out, DM, DM, WO_T, 64 * kb, 32 * nb, 32 * nb, scr, lane); }
            }
        }
        __syncthreads();
        {
            LAS float* sk_s = (LAS float*)lds;
            LAS float* wq_s = (LAS float*)(lds + 128 * 129 * 4);
            for (int it = vcu; it < 16 * 16; it += G) {
                const int c = it >> 4, k0 = (it & 15) * 64;
                for (int i = tid; i < 128 * 32; i += NWAVES * 64) { const int n = i >> 5, d4 = (i & 31) * 4; const f32x4 v = *(const f32x4*)(subkeys + ((size_t)c * NKEYS + n) * 128 + d4);
                    sk_s[n * 129 + d4] = v[0]; sk_s[n * 129 + d4 + 1] = v[1]; sk_s[n * 129 + d4 + 2] = v[2]; sk_s[n * 129 + d4 + 3] = v[3]; }
                for (int i = tid; i < 64 * 32; i += NWAVES * 64) { const int k = i >> 5, d4 = (i & 31) * 4; const f32x4 v = *(const f32x4*)(peer_wq + (size_t)(k0 + k) * SCW + c * 128 + d4);
                    wq_s[k * 129 + d4] = v[0]; wq_s[k * 129 + d4 + 1] = v[1]; wq_s[k * 129 + d4 + 2] = v[2]; wq_s[k * 129 + d4 + 3] = v[3]; }
                __syncthreads();
                {
                    typedef float f32x16_t __attribute__((ext_vector_type(16)));
                    const int tn = wave >> 1, tk = wave & 1; f32x16_t acc = {};
                    const LAS float* ap = sk_s + (32 * tn + (lane & 31)) * 129 + (lane >> 5); const LAS float* bp = wq_s + (32 * tk + (lane & 31)) * 129 + (lane >> 5);
#pragma unroll 8
                    for (int s = 0; s < 64; ++s) acc = __builtin_amdgcn_mfma_f32_32x32x2f32(ap[2 * s], bp[2 * s], acc, 0, 0, 0);
                    const float gk = g_ffn[k0 + 32 * tk + (lane & 31)];
#pragma unroll
                    for (int r = 0; r < 16; ++r) { const int n = 32 * tn + (r & 3) + 8 * (r >> 2) + 4 * (lane >> 5);
                        WE_T[(size_t)(c * 128 + n) * DM + k0 + 32 * tk + (lane & 31)] = (bf16)(pkbf(acc[r] * gk, 0.f) & 0xffffu); }
                }
                __syncthreads();
            }
        }
        peer::tables_fp8(peer_u, peer_v, U8, V8, INVU, INVV, 0, tail_tables ? NEXP / 2 : NEXP, gw, NGW, lane);
        for (int m = gw; m < NTOK; m += 2 * NGW) {
            const int m2 = (m + NGW < NTOK) ? m + NGW : m;
            const f32x4* xr = (const f32x4*)(x + (size_t)m * DM) + lane; const f32x4* xr2 = (const f32x4*)(x + (size_t)m2 * DM) + lane; f32x4 v[4], v2[4]; float s = 0.f, s2 = 0.f;
#pragma unroll
            for (int j = 0; j < 4; ++j) { v[j] = __builtin_nontemporal_load(xr + 64 * j); v2[j] = __builtin_nontemporal_load(xr2 + 64 * j); }
#pragma unroll
            for (int j = 0; j < 4; ++j) { s += (v[j][0] * v[j][0] + v[j][1] * v[j][1]) + (v[j][2] * v[j][2] + v[j][3] * v[j][3]); s2 += (v2[j][0] * v2[j][0] + v2[j][1] * v2[j][1]) + (v2[j][2] * v2[j][2] + v2[j][3] * v2[j][3]); }
            const float rstd = 1.0f / sqrtf(peer::wave_sum(s) * (1.0f / DM) + EPS), rstd2 = 1.0f / sqrtf(peer::wave_sum(s2) * (1.0f / DM) + EPS);
            unsigned long long* o8 = (unsigned long long*)(XN + (size_t)m * DM) + lane; unsigned long long* o82 = (unsigned long long*)(XN + (size_t)m2 * DM) + lane;
#pragma unroll
            for (int j = 0; j < 4; ++j) { const f32x4 g = *((const f32x4*)g_mix + lane + 64 * j);
                o8[64 * j] = (unsigned long long)pkbf(v[j][0] * rstd * g[0], v[j][1] * rstd * g[1]) | ((unsigned long long)pkbf(v[j][2] * rstd * g[2], v[j][3] * rstd * g[3]) << 32);
                o82[64 * j] = (unsigned long long)pkbf(v2[j][0] * rstd2 * g[0], v2[j][1] * rstd2 * g[1]) | ((unsigned long long)pkbf(v2[j][2] * rstd2 * g[2], v2[j][3] * rstd2 * g[3]) << 32); }
        }
        if (vcu == 0) {
            for (int i = tid; i < 64 * 16; i += NWAVES * 64) { const int pos = i >> 4, f = i & 15; const float fr = powf(10000.0f, -(float)f / 16.0f); const float ang = (float)pos * fr; ROPE[2 * i] = cosf(ang); ROPE[2 * i + 1] = sinf(ang); }
            for (int i = tid; i < 8 * 257; i += NWAVES * 64) { const int h = i / 257, rel = i % 257 - 128; BIAS[i] = rel_bias[t5_bucket(rel) * NH + h] * LOG2E; }
        }
        if (BOTH(0) && rep_ == NREP(0) - 1) GRID_BAR();
    }

    if (IN(1)) {
        pg8::Gemm g{XN, WIN_T, NTOK, INW, DM}; pg8::StaticOrder S; S.init(NTOK, INW, G, bx);
        pg8::EpiIn E{QA, KA, VA, QB, KB, VB, GA, GB, q_norm_g, k_norm_g, b_gate, ROPE};
        if (PROBE == 1) { pg8::gemm_phase<pg8::EpiIn, pg8::StaticOrder, true, true>(lds, g, S, E); VM_WAIT(); __syncthreads(); }
        pg8::gemm_phase<pg8::EpiIn, pg8::StaticOrder, true, true>(lds, g, S, E);
        if (tail_tables && bx >= 128) peer::tables_fp8(peer_u, peer_v, U8, V8, INVU, INVV, NEXP / 2, NEXP, (bx - 128) * NWAVES + wave, 128 * NWAVES, lane);
        if (BOTH(1)) GRID_BAR();
    }

    if (IN(2)) {
#ifdef DIAG_QK
        if (bx == 0) {
            LAS float* red = (LAS float*)lds; float worst = 0.f;
            for (int smp = 0; smp < 10; ++smp) {
                const int row = (smp * 2741 + 77) & (NTOK - 1), b = row >> 12, s = row & (SEQ - 1); const int kind = smp % 5;
                const int hh = (smp * 3 + 1) & 7, kh = smp & 1;
                float ref = 0.f, got = 0.f; const int d = tid & 63;
                if (tid < 64) {
                    int col;
                    if (kind == 0) col = hh * 64 + d; else if (kind == 1) col = 512 + kh * 64 + d; else if (kind == 2) col = (smp < 5 ? 640 : 1408) + kh * 64 + d; else if (kind == 3) col = (smp < 5 ? 768 + hh * 64 : 1280 + kh * 64) + d; else col = (smp < 5 ? 1536 : 2560) + hh * 64 + d;
                    float z = 0.f; for (int k = 0; k < DM; ++k) z += __builtin_bit_cast(float, (unsigned)XN[(size_t)row * DM + k] << 16) * w_in[(size_t)k * INW + col];
                    red[tid] = z;
                }
                __syncthreads();
                if (tid < 64) {
                    float z = red[tid];
                    if (kind == 0 || kind == 1) {
                        float ss = 0.f; for (int i = 0; i < 64; ++i) ss += red[i] * red[i];
                        const float rstd = 1.0f / sqrtf(ss / 64.0f + EPS); const float* g = kind == 0 ? q_norm_g : k_norm_g;
                        const int part = d >> 5, dd = d & 31, f = dd & 15; const int pos = part == 0 ? (s >> 6) : (s & 63);
                        const float ang = (float)pos * powf(10000.0f, -(float)f / 16.0f), cs = cosf(ang), sn = sinf(ang);
                        const float u1 = red[part * 32 + f] * rstd * g[part * 32 + f], u2 = red[part * 32 + 16 + f] * rstd * g[part * 32 + 16 + f];
                        z = dd < 16 ? u1 * cs - u2 * sn : u2 * cs + u1 * sn; if (kind == 0) z *= QSCALE;
                        got = kind == 0 ? __builtin_bit_cast(float, (unsigned)QA[(size_t)row * 1024 + hh * 64 + d] << 16) : __builtin_bit_cast(float, (unsigned)KA[kimg_off(b, kh, s, d)] << 16);
                    } else if (kind == 2) { got = __builtin_bit_cast(float, (unsigned)(smp < 5 ? VA : VB)[vimg_off(b, kh, s, d)] << 16);
                    } else if (kind == 3) { if (smp < 5) { z *= QSCALE; got = __builtin_bit_cast(float, (unsigned)QB[(size_t)row * 1024 + hh * 64 + d] << 16); } else got = __builtin_bit_cast(float, (unsigned)KB[kimg_off(b, kh, s, d)] << 16);
                    } else { z = 1.0f / (1.0f + expf(-(z + b_gate[(smp < 5 ? 0 : DM) + hh * 64 + d]))); got = __builtin_bit_cast(float, (unsigned)(smp < 5 ? GA : GB)[(size_t)row * DM + hh * 64 + d] << 16); }
                    ref = z;
                }
                __syncthreads();
                if (tid < 64) { red[128 + tid] = fabsf(ref - got); red[256 + tid] = fabsf(ref); }
                __syncthreads();
                if (tid == 0) { float e = 0.f, a = 0.f; for (int i = 0; i < 64; ++i) { e = fmaxf(e, red[128 + i]); a = fmaxf(a, red[256 + i]); } const float rel = e / fmaxf(a, 1e-20f); if (DIAG_SEL < 0 || DIAG_SEL == smp) worst = fmaxf(worst, rel); }
                __syncthreads();
            }
            if (tid == 0) MISC[41] = __float_as_uint(worst);
        }
        GRID_BAR();
#endif
        if (PROBE == 21) {
            bf16* DUM = XN;
            for (int u = vcu; u < 512; u += G) { const int xg = u >> 6, i = u & 63; const int b = xg >> 1, h = 4 * (xg & 1) + (i >> 4), qblk = i & 15;
                attn::attn_unit<false, XVAR>((LAS char*)lds, QA, KA, VA, DUM, b, h, qblk, nullptr, 0.f); }
        }
        if (PROBE == 22) {
            bf16* DUM = XN;
            for (int u = vcu; u < 512; u += G) { const int xg = u >> 6, i = u & 63; const int b = xg >> 1, h = 4 * (xg & 1) + (i >> 4), qblk = i & 15;
                attn::attn_unit<true>((LAS char*)lds, QB, KB, VB, DUM, b, h, qblk, BIAS + h * 257, sink[h] * LOG2E); }
        }
#ifdef DIAG_ATTN
        {
            bf16* DUM = XN;
            for (int u = vcu; u < 512; u += G) { const int xg = u >> 6, i = u & 63; const int b = xg >> 1, h = 4 * (xg & 1) + (i >> 4), qblk = i & 15;
                attn::attn_unit<false, 0, DIAG_ATTN == 1>((LAS char*)lds, QA, KA, VA, DUM, b, h, qblk, nullptr, 0.f); }
            for (int u = vcu; u < 512; u += G) { const int xg = u >> 6, i = u & 63; const int b = xg >> 1, h = 4 * (xg & 1) + (i >> 4), qblk = i & 15;
                attn::attn_unit<true>((LAS char*)lds, QB, KB, VB, DUM + 512, b, h, qblk, BIAS + h * 257, sink[h] * LOG2E); }
            GRID_BAR();
            if (bx == 0) {
                LAS float* sc = (LAS float*)lds; LAS float* red = (LAS float*)(lds + 32768); float worst = 0.f;
                for (int smp = 0; smp < 12; ++smp) {
                    const int win = smp & 1; const int b = (smp * 7 + 1) & 3, h = (smp * 5 + 3) & 7, q = smp == 1 ? 5 : smp == 3 ? 4090 : smp == 4 ? 4095 : (smp * 977 + 131 * win + (smp == 2 ? 0 : 17)) & 4095; const int kvh = h >> 2;
                    const bf16* Qp = (win ? QB : QA) + ((size_t)b * SEQ + q) * 1024 + h * HD; const bf16* Kp = win ? KB : KA; const bf16* Vp = win ? VB : VA;
                    float mx = -1e30f;
                    for (int j = tid; j < SEQ; j += 512) { float s = 0.f;
                        for (int d = 0; d < HD; ++d) s += __builtin_bit_cast(float, (unsigned)Qp[d] << 16) * __builtin_bit_cast(float, (unsigned)Kp[kimg_off(b, kvh, j, d)] << 16);
                        if (win) { const int rel = j - q; s = (rel >= -128 && rel <= 128) ? s + BIAS[h * 257 + rel + 128] : -1e30f; }
                        sc[j] = s; mx = fmaxf(mx, s); }
                    red[tid] = mx; __syncthreads();
                    if (tid == 0) { float m = -1e30f; for (int i = 0; i < 512; ++i) m = fmaxf(m, red[i]); if (win) m = fmaxf(m, sink[h] * LOG2E); red[512] = m; } __syncthreads();
                    const float m = red[512]; float ls = 0.f;
                    for (int j = tid; j < SEQ; j += 512) { const float p = exp2f(sc[j] - m); sc[j] = p; ls += p; }
                    __syncthreads(); red[tid] = ls; __syncthreads();
                    if (tid == 0) { float l = 0.f; for (int i = 0; i < 512; ++i) l += red[i]; if (win) l += exp2f(sink[h] * LOG2E - m); red[513] = l; } __syncthreads();
                    if (tid < HD) { float o = 0.f; for (int j = 0; j < SEQ; ++j) o += sc[j] * __builtin_bit_cast(float, (unsigned)Vp[vimg_off(b, kvh, j, tid)] << 16);
                        o /= red[513]; const float t = __builtin_bit_cast(float, (unsigned)DUM[((size_t)b * SEQ + q) * 1024 + win * 512 + h * HD + tid] << 16);
                        red[600 + tid] = fabsf(o - t); red[700 + tid] = fabsf(o); }
                    __syncthreads();
                    if (tid == 0) { float e = 0.f, a = 0.f; for (int i = 0; i < HD; ++i) { e = fmaxf(e, red[600 + i]); a = fmaxf(a, red[700 + i]); } const float rel = e / fmaxf(a, 1e-20f); if (DIAG_SEL < 0 || DIAG_SEL == smp) worst = fmaxf(worst, rel); }
                    __syncthreads();
                }
                if (tid == 0) MISC[40] = __float_as_uint(worst);
            }
            GRID_BAR();
        }
#endif
        float lbound;
        { const float gq = tid < HD ? fabsf(q_norm_g[tid]) : 0.f, gk = tid < HD ? fabsf(k_norm_g[tid]) : 0.f;
          const float mq = peer::wave_max(gq), mk = peer::wave_max(gk); LAS float* lb = (LAS float*)(lds + 70000);
          if (tid == 0) lb[0] = 64.0f * mq * mk * QSCALE * 1.02f; __syncthreads(); lbound = lb[0]; __syncthreads(); }
        const bool nomax = lbound <= 100.0f;
        for (int u = vcu; u < 512; u += G) { const int xg = u >> 6, i = u & 63; const int b = xg >> 1, h = 4 * (xg & 1) + (i >> 4), qblk = i & 15;
            if (nomax) attn::attn_unit<false, 0, true>((LAS char*)lds, QA, KA, VA, QA, b, h, qblk, nullptr, 0.f);
            else attn::attn_unit<false>((LAS char*)lds, QA, KA, VA, QA, b, h, qblk, nullptr, 0.f); }
        for (int u = vcu; u < 512; u += G) { const int xg = u >> 6, i = u & 63; const int b = xg >> 1, h = 4 * (xg & 1) + (i >> 4), qblk = i & 15;
            attn::attn_unit<true>((LAS char*)lds, QB, KB, VB, QB, b, h, qblk, BIAS + h * 257, sink[h] * LOG2E); }
        if (BOTH(2)) GRID_BAR();
    }

    if (IN(3)) {
        pg8::Gemm g{QA, WA_T, NTOK, DM, DM}; pg8::StaticOrder S; S.init(NTOK, DM, G, bx); pg8::EpiMix E{GA, GB, GB};
        if (PROBE == 3) { pg8::EpiMix E2{GA, GB, XN}; pg8::gemm_phase<pg8::EpiMix, pg8::StaticOrder, true, true>(lds, g, S, E2); VM_WAIT(); __syncthreads(); }
        pg8::gemm_phase<pg8::EpiMix, pg8::StaticOrder, true, true>(lds, g, S, E);
        if (BOTH(3)) GRID_BAR();
    }

    if (IN(4)) {
        pg8::Gemm g{GB, WO_T, NTOK, DM, DM}; pg8::StaticOrder S; S.init(NTOK, DM, G, bx); pg8::EpiOut E{x, XN, SSQ};
        for (int rep_ = 0; rep_ < NREP(4); ++rep_) pg8::gemm_phase<pg8::EpiOut, pg8::StaticOrder, true, true>(lds, g, S, E);
        if (BOTH(4)) GRID_BAR();
    }

    if (IN(5)) {
        pg8::Gemm g{XN, WE_T, NTOK, SCW, DM}; pg8::StaticOrder S; S.init(NTOK, SCW, G, bx); pg8::EpiScore E{SSQ, SC};
        for (int rep_ = 0; rep_ < NREP(5); ++rep_) pg8::gemm_phase<pg8::EpiScore, pg8::StaticOrder, true, true>(lds, g, S, E);
        if (BOTH(5)) GRID_BAR();
    }

    if (IN(6)) {
        LAS char* wl = (LAS char*)lds + wave * peer::WAVE_LDS;
        const unsigned long long ct = peer::cand_table(lane & 7);
        for (int rep_ = 0; rep_ < NREP(60); ++rep_) {
            peer::SCtx sA = peer::s_ctx(lane, gw < NTOK ? gw : 0, SC), sB;
            for (int t = gw; t < NTOK; t += 2 * NGW) {
                sB = peer::s_ctx(lane, t + NGW < NTOK ? t + NGW : t, SC);
                peer::route_token(wl, lane, t, ct, sA, SSQ, RE, RG, RSTD);
                sA = peer::s_ctx(lane, t + 2 * NGW < NTOK ? t + 2 * NGW : t, SC);
                if (t + NGW < NTOK) peer::route_token(wl, lane, t + NGW, ct, sB, SSQ, RE, RG, RSTD);
            }
        }
        GRID_BAR();
        int nloc = 0, nx = 0, ox = 0; const int myx = (int)MISC[13], rank = (int)MISC[12];
#pragma unroll
        for (int j = 0; j < 16; ++j) { const int c = (int)xb_ld((unsigned*)(ws + WS_CTL) + CW_RANK + 64 * j); nx += c > 0; ox += (c > 0 && j < myx); nloc = j == myx ? c : nloc; }
        const int wv = rank * NWAVES + wave, nwv = nloc * NWAVES;
        for (int rep_ = 0; rep_ < NREP(61); ++rep_) for (int s = ox; s < 8; s += nx) { const unsigned char* U8s = U8 + (size_t)s * peer::SLICE_BYTES;
            peer::upass_slice(lane, s, wv, nwv, U8s, RE, XN, RSTD, g_ffn, PA); }
        GRID_BAR();
        for (int rep_ = 0; rep_ < NREP(62); ++rep_) for (int t = gw; t < NTOK; t += NGW) peer::wpass_tokens<1>(lane, t, NGW, RE, RG, PA, INVU, INVV, RW);
        GRID_BAR();
        for (int s = ox; s < 8; s += nx) { const unsigned char* V8s = V8 + (size_t)s * peer::SLICE_BYTES;
            for (int rep_ = 0; rep_ < NREP(63); ++rep_) peer::vpass_slice(lane, s, wv, nwv, V8s, RE, RW, PA); }
        GRID_BAR();
        if (PROBE == 200) { for (int r_ = 0; r_ < 10; ++r_) GRID_BAR(); }
        for (int t = gw; t < NTOK; t += NGW) peer::final_token(lane, t, out, XN, PA, g_final);
#ifdef DIAG_ATTN
        if (bx == 0 && tid == 0) { VM_WAIT(); out[0] += 1000.0f * __uint_as_float(MISC[40]); }
#endif
#ifdef DIAG_QK
        if (bx == 0 && tid == 0) { VM_WAIT(); out[0] += 1000.0f * __uint_as_float(MISC[41]); }
#endif
#ifdef TSEL
        STAMP();
        if (bx == 0 && tid == 0) { VM_WAIT(); const unsigned d = MISC[16 + TSEL + 1] - MISC[16 + TSEL]; out[0] += (float)d * 0.001f; }
#endif
    }
#undef IN
#undef BOTH
#undef GRID_BAR
}

extern "C" void kernel_launch(void* const* d_in, const int* in_sizes, int n_in, void* d_out, int out_size, void* d_ws, size_t ws_size, hipStream_t stream) {
    static int grid = 0;
    if (grid == 0) {
        if (n_in != 17 || in_sizes[0] != NTOK * DM || out_size != NTOK * DM || ws_size < WS_END) { fprintf(stderr, "kernel_launch: unexpected shapes (n_in %d, in0 %d, out %d, ws %zu); nothing launched\n", n_in, n_in > 0 ? in_sizes[0] : -1, out_size, ws_size); grid = -1; return; }
        int dev = 0, cus = 0, per_cu = 0;
        if (hipGetDevice(&dev) != hipSuccess || hipDeviceGetAttribute(&cus, hipDeviceAttributeMultiprocessorCount, dev) != hipSuccess) { grid = -1; return; }
        if (hipFuncSetAttribute((const void*)mk_fwd, hipFuncAttributeMaxDynamicSharedMemorySize, LDS_BYTES) != hipSuccess) { fprintf(stderr, "kernel_launch: hipFuncSetAttribute failed\n"); grid = -1; return; }
        if (hipOccupancyMaxActiveBlocksPerMultiprocessor(&per_cu, (const void*)mk_fwd, NWAVES * 64, LDS_BYTES) != hipSuccess || per_cu < 1) { fprintf(stderr, "kernel_launch: occupancy query says %d blocks per CU; nothing launched\n", per_cu); (void)hipGetLastError(); grid = -1; return; }
        grid = cus;
    }
    if (grid < 0) return;
    if (hipMemsetAsync((char*)d_ws + WS_CTL, 0, CTL_ZERO_BYTES, stream) != hipSuccess) { fprintf(stderr, "kernel_launch: hipMemsetAsync failed\n"); return; }
    Args a{};
    for (int i = 0; i < 17; ++i) a.in[i] = (const float*)d_in[i];
    a.out = (float*)d_out; a.ws = (unsigned char*)d_ws;
    if (N_LAUNCHES == 1) {
        a.ph_lo = 0; a.ph_hi = PER_PHASE; a.li = 0;
#if defined(COOP_LAUNCH)
        void* kargs[] = {&a};
        hipError_t e = hipLaunchCooperativeKernel((const void*)mk_fwd, dim3(grid), dim3(NWAVES * 64), kargs, LDS_BYTES, stream);
        if (e != hipSuccess) fprintf(stderr, "kernel_launch: cooperative launch failed: %s (grid %d)\n", hipGetErrorString(e), grid);
#else
        if (PROBE == 100) { hipLaunchKernelGGL(mk_fwd, dim3(grid), dim3(NWAVES * 64), LDS_BYTES, stream, a); (void)hipMemsetAsync((char*)d_ws + WS_CTL, 0, CTL_ZERO_BYTES, stream); }
        hipLaunchKernelGGL(mk_fwd, dim3(grid), dim3(NWAVES * 64), LDS_BYTES, stream, a);
#endif
    } else {
        for (int li = 0; li < PER_PHASE; ++li) { a.ph_lo = li; a.ph_hi = li + 1; a.li = li;
            hipLaunchKernelGGL(mk_fwd, dim3(grid), dim3(NWAVES * 64), LDS_BYTES, stream, a); }
    }
}
```

```cpp
#include <hip/hip_runtime.h>
#include <cstdio>
#include <cstdint>
#include <cmath>
namespace pg8 {
#define PG8_LAS __attribute__((address_space(3)))
typedef unsigned short bf16_t;
typedef short bf16x8 __attribute__((ext_vector_type(8)));
typedef float f32x4 __attribute__((ext_vector_type(4)));
typedef unsigned u32x4 __attribute__((ext_vector_type(4)));
constexpr int BM = 256, BK = 64, HALF = 128, HTB = HALF * BK * 2  , STAGE_BYTES = 8 * HTB, NXCD = 8, WGM = 8;

__host__ __device__ __forceinline__ int lds_byte(int r, int c) { const int st = (r >> 4) * 2 + (c >> 5), rr = r & 15, cc = c & 31, ob = rr * 64 + cc * 2; return st * 1024 + (ob ^ (((ob >> 9) & 1) << 5)); }
__host__ __device__ __forceinline__ void stage_rc(int b, int& R, int& C) { const int st = b / 1024, sb = b % 1024, swz = sb ^ (((sb >> 9) & 1) << 5); R = (st >> 1) * 16 + swz / 64; C = (st & 1) * 32 + (swz % 64) / 2; }
__host__ __device__ __forceinline__ int perm32(int rho) { const int n = rho >> 4, i = rho & 15; return 8 * (i >> 2) + 4 * n + (i & 3); }

struct Unit { int pm, pn; };
struct Gemm { const bf16_t* A; const bf16_t* Bt; int M, N, K; };

struct StaticOrder {
    int nM, nN, nwg, G, c;
    __host__ __device__ void init(int M, int N, int G_, int c_) { nM = M / BM; nN = N / BM; nwg = nM * nN; G = G_; c = c_; }
    __host__ __device__ bool next(int i, Unit& u) const {
        const long L = (long)i * G + c; if (L >= nwg) return false;
        int wgid = (int)L; { const int q = nwg / NXCD, r = nwg % NXCD, xcd = wgid % NXCD, off = wgid / NXCD; wgid = (xcd < r ? xcd * (q + 1) : r * (q + 1) + (xcd - r) * q) + off; }
        const int nig = WGM * nN, gid = wgid / nig, fm = gid * WGM, gsz = (nM - fm) < WGM ? (nM - fm) : WGM;
        u.pm = fm + ((wgid % nig) % gsz); u.pn = (wgid % nig) / gsz; return true;
    }
    __device__ __forceinline__ void a_ready(const Unit&) const {}
    __device__ __forceinline__ void done(const Unit&) const {}
};

__device__ __forceinline__ unsigned cvt_pk_bf16(float lo, float hi) { unsigned r; asm volatile("v_cvt_pk_bf16_f32 %0, %1, %2" : "=v"(r) : "v"(lo), "v"(hi)); return r; }
typedef float f32x2 __attribute__((ext_vector_type(2)));
template <class Epi, class Sched, bool ALIGN_EPI = false, bool SP2 = false>
__device__ __forceinline__ void gemm_phase(PG8_LAS unsigned char* lds, const Gemm g, const Sched& S, const Epi& E) {
    const int tid = threadIdx.x, wid = __builtin_amdgcn_readfirstlane(tid >> 6), lane = tid & 63, wr = wid >> 2, wc = wid & 3, fr = lane & 15, fq = lane >> 4;
    const int K = g.K, nt = K / BK;
    unsigned voffA[2], voffB[2];
#pragma unroll
    for (int i = 0; i < 2; ++i) { int R, C; stage_rc(tid * 16 + i * 8192, R, C); const int Rb = Epi::PERM ? ((R & ~31) + perm32(R & 31)) : R;
        voffA[i] = (unsigned)(R * K + C) * 2u; voffB[i] = (unsigned)(Rb * K + C) * 2u; }
    const size_t kstep = (size_t)(BK * 2);
    const size_t hstep = (size_t)HALF * K * 2;
    const size_t tstep = 2 * hstep;
    const unsigned ldsw = (unsigned)wid * 1024u;
    const int aoff = lds_byte(wr * 64 + fr, fq * 8), boff = lds_byte(wc * 32 + fr, fq * 8);
#define PG8_SA(b, h) (((b) * 2 + (h)) * HTB)
#define PG8_SB(b, h) ((4 + (b) * 2 + (h)) * HTB)
#define PG8_STAGE(bufoff, gbase, voff) do { _Pragma("unroll") for (int _i = 0; _i < 2; ++_i) \
        __builtin_amdgcn_global_load_lds((const unsigned*)((const char*)(gbase) + (voff)[_i]), (PG8_LAS unsigned*)(lds + (bufoff) + ldsw + _i * 8192), 16, 0, 0); } while (0)
#define PG8_LDA(dst, b, h) do { _Pragma("unroll") for (int m = 0; m < 4; ++m) _Pragma("unroll") for (int k = 0; k < 2; ++k) dst[m][k] = *(const PG8_LAS bf16x8*)(lds + PG8_SA(b, h) + aoff + m * 2048 + k * 1024); } while (0)
#define PG8_LDB(dst, b, h) do { _Pragma("unroll") for (int n = 0; n < 2; ++n) _Pragma("unroll") for (int k = 0; k < 2; ++k) dst[n][k] = *(const PG8_LAS bf16x8*)(lds + PG8_SB(b, h) + boff + n * 2048 + k * 1024); } while (0)
#define PG8_MMA(ai, bj, At, Bt) do { __builtin_amdgcn_s_setprio(1); _Pragma("unroll") for (int m = 0; m < 4; ++m) _Pragma("unroll") for (int n = 0; n < 2; ++n) _Pragma("unroll") for (int k = 0; k < 2; ++k) \
        acc[ai][bj][m][n] = __builtin_amdgcn_mfma_f32_16x16x32_bf16(Bt[n][k], At[m][k], acc[ai][bj][m][n], 0, 0, 0); __builtin_amdgcn_s_setprio(0); } while (0)
#define PG8_WAIT_V(n) asm volatile("s_waitcnt vmcnt(" #n ")" ::: "memory")
#define PG8_WAIT_L(n) asm volatile("s_waitcnt lgkmcnt(" #n ")" ::: "memory")
#define PG8_BAR __builtin_amdgcn_s_barrier()
#define PG8_SCHED __builtin_amdgcn_sched_barrier(0)
    Unit cur, nxt; int ui = 0;
    if (!S.next(0, cur)) return;
    f32x4 acc[2][2][4][2];
#pragma unroll
    for (int a = 0; a < 2; ++a)
#pragma unroll
        for (int b = 0; b < 2; ++b)
#pragma unroll
            for (int m = 0; m < 4; ++m)
#pragma unroll
                for (int n = 0; n < 2; ++n) acc[a][b][m][n] = (f32x4){0.f, 0.f, 0.f, 0.f};
    bf16x8 At[4][2], B0[2][2], B1[2][2];
    const char* cA = (const char*)g.A + (size_t)cur.pm * tstep; const char* cB = (const char*)g.Bt + (size_t)cur.pn * tstep;
    S.a_ready(cur);
    if constexpr (SP2) {
        PG8_STAGE(PG8_SB(0, 0), cB, voffB); PG8_STAGE(PG8_SB(0, 1), cB + hstep, voffB); PG8_STAGE(PG8_SA(0, 0), cA, voffA); PG8_STAGE(PG8_SA(0, 1), cA + hstep, voffA);
        if (wr == 1) PG8_BAR;
        PG8_WAIT_V(2); PG8_BAR;
        PG8_STAGE(PG8_SB(1, 0), cB + kstep, voffB); PG8_STAGE(PG8_SA(1, 0), cA + kstep, voffA); PG8_STAGE(PG8_SB(1, 1), cB + hstep + kstep, voffB);
        PG8_WAIT_V(6); PG8_BAR;
    } else {
        PG8_STAGE(PG8_SB(0, 0), cB, voffB); PG8_STAGE(PG8_SA(0, 0), cA, voffA); PG8_STAGE(PG8_SB(0, 1), cB + hstep, voffB); PG8_STAGE(PG8_SA(0, 1), cA + hstep, voffA);
        if (wr == 1) PG8_BAR;
        PG8_WAIT_V(4); PG8_BAR;
        PG8_STAGE(PG8_SB(1, 0), cB + kstep, voffB); PG8_STAGE(PG8_SA(1, 0), cA + kstep, voffA); PG8_STAGE(PG8_SB(1, 1), cB + hstep + kstep, voffB);
        PG8_WAIT_V(6); PG8_BAR;
    }
    for (;;) {
        const bool has_next = S.next(ui + 1, nxt);
        const char* nA = has_next ? (const char*)g.A + (size_t)nxt.pm * tstep : cA; const char* nB = has_next ? (const char*)g.Bt + (size_t)nxt.pn * tstep : cB;
        for (int t = 0; t < nt; t += 2) {
            if constexpr (Epi::HAS_MID) { if (t == (nt >> 1)) E.mid(acc, cur, wr, wc, fr, fq); }
            const bool last = (t == nt - 2);
            const char* a1 = cA + (size_t)(t + 1) * kstep;
            const char* a2 = last ? nA : cA + (size_t)(t + 2) * kstep; const char* b2 = last ? nB : cB + (size_t)(t + 2) * kstep;
            const char* a3 = a2 + kstep; const char* b3 = b2 + kstep;
            if (last && has_next) S.a_ready(nxt);
            if constexpr (SP2) {
            PG8_LDB(B0, 0, 0); PG8_LDB(B1, 0, 1); PG8_SCHED; PG8_LDA(At, 0, 0); PG8_STAGE(PG8_SA(1, 1), a1 + hstep, voffA);
            PG8_WAIT_V(8); PG8_WAIT_L(0); PG8_BAR; PG8_MMA(0, 0, At, B0); PG8_MMA(0, 1, At, B1); PG8_BAR; PG8_SCHED;
            PG8_LDA(At, 0, 1); PG8_STAGE(PG8_SB(0, 0), b2, voffB); PG8_STAGE(PG8_SB(0, 1), b2 + hstep, voffB); PG8_STAGE(PG8_SA(0, 0), a2, voffA);
            PG8_WAIT_V(8); PG8_WAIT_L(0); PG8_BAR; PG8_MMA(1, 0, At, B0); PG8_MMA(1, 1, At, B1); PG8_BAR; PG8_SCHED;
            PG8_LDB(B0, 1, 0); PG8_LDB(B1, 1, 1); PG8_SCHED; PG8_LDA(At, 1, 0); PG8_STAGE(PG8_SA(0, 1), a2 + hstep, voffA);
            PG8_WAIT_V(8); PG8_WAIT_L(0); PG8_BAR; PG8_MMA(0, 0, At, B0); PG8_MMA(0, 1, At, B1); PG8_BAR; PG8_SCHED;
            PG8_LDA(At, 1, 1); PG8_STAGE(PG8_SB(1, 0), b3, voffB); PG8_STAGE(PG8_SB(1, 1), b3 + hstep, voffB); PG8_STAGE(PG8_SA(1, 0), a3, voffA);
            PG8_WAIT_V(8); PG8_WAIT_L(0); PG8_BAR; PG8_MMA(1, 0, At, B0); PG8_MMA(1, 1, At, B1); PG8_BAR; PG8_SCHED;
            } else {
            PG8_LDB(B0, 0, 0); PG8_SCHED; PG8_LDA(At, 0, 0); PG8_STAGE(PG8_SA(1, 1), a1 + hstep, voffA);
            PG8_WAIT_L(8); PG8_BAR; PG8_WAIT_L(0); PG8_MMA(0, 0, At, B0); PG8_BAR; PG8_SCHED;
            PG8_LDB(B1, 0, 1); PG8_STAGE(PG8_SB(0, 0), b2, voffB);
            PG8_BAR; PG8_WAIT_L(0); PG8_MMA(0, 1, At, B1); PG8_BAR;
            PG8_LDA(At, 0, 1); PG8_STAGE(PG8_SA(0, 0), a2, voffA);
            PG8_BAR; PG8_WAIT_L(0); PG8_MMA(1, 0, At, B0); PG8_BAR; PG8_SCHED;
            PG8_STAGE(PG8_SB(0, 1), b2 + hstep, voffB);
            PG8_WAIT_V(6); PG8_BAR; PG8_MMA(1, 1, At, B1); PG8_BAR;
            PG8_LDB(B0, 1, 0); PG8_SCHED; PG8_LDA(At, 1, 0); PG8_STAGE(PG8_SA(0, 1), a2 + hstep, voffA);
            PG8_WAIT_L(8); PG8_BAR; PG8_WAIT_L(0); PG8_MMA(0, 0, At, B0); PG8_BAR; PG8_SCHED;
            PG8_LDB(B1, 1, 1); PG8_STAGE(PG8_SB(1, 0), b3, voffB);
            PG8_BAR; PG8_WAIT_L(0); PG8_MMA(0, 1, At, B1); PG8_BAR;
            PG8_LDA(At, 1, 1); PG8_STAGE(PG8_SA(1, 0), a3, voffA);
            PG8_BAR; PG8_WAIT_L(0); PG8_MMA(1, 0, At, B0); PG8_BAR; PG8_SCHED;
            PG8_STAGE(PG8_SB(1, 1), b3 + hstep, voffB);
            PG8_WAIT_V(6); PG8_BAR; PG8_MMA(1, 1, At, B1); PG8_BAR;
            }
        }
        if constexpr (ALIGN_EPI) { if (wr == 0) PG8_BAR; }
        if constexpr (!Epi::AFTER_DRAIN) { E(acc, cur, wr, wc, fr, fq); S.done(cur); }
        if (!has_next) break;
#pragma unroll
        for (int a = 0; a < 2; ++a)
#pragma unroll
            for (int b = 0; b < 2; ++b)
#pragma unroll
                for (int m = 0; m < 4; ++m)
#pragma unroll
                    for (int n = 0; n < 2; ++n) acc[a][b][m][n] = (f32x4){0.f, 0.f, 0.f, 0.f};
        cur = nxt; cA = nA; cB = nB; ++ui;
        if constexpr (ALIGN_EPI) { if (wr == 1) PG8_BAR; }
    }
    PG8_WAIT_V(0);
    if constexpr (!ALIGN_EPI) { if (wr == 0) PG8_BAR; }
    PG8_BAR;
    if constexpr (Epi::AFTER_DRAIN) { E.fused(acc, cur, wr, wc, fr, fq, lds, wid, lane); S.done(cur); }
#undef PG8_SA
#undef PG8_SB
#undef PG8_STAGE
#undef PG8_LDA
#undef PG8_LDB
#undef PG8_MMA
#undef PG8_WAIT_V
#undef PG8_WAIT_L
#undef PG8_BAR
#undef PG8_SCHED
}
}

constexpr int DM = 1024, NB = 4, SEQ = 4096, NTOK = NB * SEQ;
constexpr int HD = 64, NH = 8, NKV = 2, QW = NH * HD  , GRIDW = 64;
constexpr int INW = 3584;
constexpr int PH = 8, NKEYS = 128, TOPK = 16, NEXP = NKEYS * NKEYS, SCW = PH * 2 * NKEYS  ;
constexpr float EPS = 1e-6f;
constexpr float LOG2E = 1.4426950408889634f;
constexpr float QSCALE = 0.125f * LOG2E;

typedef unsigned u32x2_t __attribute__((ext_vector_type(2)));
typedef float f32x2_t __attribute__((ext_vector_type(2)));
typedef __bf16 bf16x2_t __attribute__((ext_vector_type(2)));
__device__ __forceinline__ unsigned pkbf(float lo, float hi) { f32x2_t v = {lo, hi}; bf16x2_t b = __builtin_convertvector(v, bf16x2_t); return __builtin_bit_cast(unsigned, b); }
__device__ __forceinline__ float bflo(unsigned w) { return __builtin_bit_cast(float, w << 16); }
__device__ __forceinline__ float bfhi(unsigned w) { return __builtin_bit_cast(float, w & 0xffff0000u); }

__device__ __forceinline__ size_t kimg_off(int b, int kvh, int s, int dim) { return ((size_t)((b * NKV + kvh) * (SEQ / 64) + (s >> 6)) << 12) + (dim >> 3) * 512 + (s & 63) * 8 + (dim & 7); }
__device__ __forceinline__ size_t vimg_off(int b, int kvh, int s, int dim) { return ((size_t)((b * NKV + kvh) * (SEQ / 64) + (s >> 6)) << 12) + (dim >> 5) * 2048 + (s & 63) * 32 + (dim & 31); }

namespace pg8 {
#ifndef ST_WT
#define ST_WT 0
#endif
__device__ __forceinline__ void st16(void* p, const u32x4& v) {
#if ST_WT
    asm volatile("global_store_dwordx4 %0, %1, off sc1\n\ts_nop 1" :: "v"(p), "v"(v) : "memory");
#else
    *(u32x4*)p = v;
#endif
}
__device__ __forceinline__ u32x4 pk8(const f32x4& a, const f32x4& b) { return (u32x4){pkbf(a[0], a[1]), pkbf(a[2], a[3]), pkbf(b[0], b[1]), pkbf(b[2], b[3])}; }
struct EpiIn {
    static constexpr bool PERM = true, AFTER_DRAIN = false, HAS_MID = false;
    bf16_t *Qa, *Ka, *Va, *Qb, *Kb, *Vb, *Ga, *Gb;
    const float *qg, *kg, *bgate, *rope;
    __device__ __forceinline__ void operator()(const f32x4 (&acc)[2][2][4][2], const Unit& u, int wr, int wc, int fr, int fq) const {
        const int pn = u.pn;
        if (pn >= 6) {
            const bool isA = pn < 10; bf16_t* G = isA ? Ga : Gb; const int ct = (isA ? pn - 6 : pn - 10) * BM; const float* bb = bgate + (isA ? 0 : DM);
            f32x4 bv[2][2];
#pragma unroll
            for (int bj = 0; bj < 2; ++bj)
#pragma unroll
                for (int n = 0; n < 2; ++n) bv[bj][n] = *(const f32x4*)(bb + ct + bj * HALF + wc * 32 + 8 * fq + 4 * n);
#pragma unroll
            for (int ai = 0; ai < 2; ++ai)
#pragma unroll
                for (int m = 0; m < 4; ++m) { const int row = u.pm * BM + ai * HALF + wr * 64 + m * 16 + fr; bf16_t* rp = G + (size_t)row * DM + ct + wc * 32 + 8 * fq;
#pragma unroll
                    for (int bj = 0; bj < 2; ++bj) { f32x4 g[2];
#pragma unroll
                        for (int n = 0; n < 2; ++n) { const f32x4 z = acc[ai][bj][m][n] + bv[bj][n];
#pragma unroll
                            for (int j = 0; j < 4; ++j) g[n][j] = __builtin_amdgcn_rcpf(1.0f + __builtin_amdgcn_exp2f(-LOG2E * z[j])); }
                        st16(rp + bj * HALF, pk8(g[0], g[1])); } }
            return;
        }
        const bool brA = pn < 3; const int pl = brA ? pn : pn - 3;
        const bool isq = pl < 2, isk = (!isq) && wc < 2;
        const bool normrope = brA && (isq || isk);
        const int part = fq >> 1, base = 8 * (fq & 1);
        f32x4 gv[2][2];
        if (normrope) { const float* g = isq ? qg : kg;
#pragma unroll
            for (int bj = 0; bj < 2; ++bj)
#pragma unroll
                for (int n = 0; n < 2; ++n) gv[bj][n] = *(const f32x4*)(g + 32 * part + 16 * bj + base + 4 * n); }
        const float osc = isq ? QSCALE : 1.0f;
#pragma unroll
        for (int ai = 0; ai < 2; ++ai)
#pragma unroll
            for (int m = 0; m < 4; ++m) {
                const int row = u.pm * BM + ai * HALF + wr * 64 + m * 16 + fr; const int b = row >> 12, s = row & (SEQ - 1);
                f32x4 v[2][2];
#pragma unroll
                for (int bj = 0; bj < 2; ++bj)
#pragma unroll
                    for (int n = 0; n < 2; ++n) v[bj][n] = acc[ai][bj][m][n];
                if (normrope) {
                    float ss = 0.f;
#pragma unroll
                    for (int bj = 0; bj < 2; ++bj)
#pragma unroll
                        for (int n = 0; n < 2; ++n) ss += (v[bj][n][0] * v[bj][n][0] + v[bj][n][1] * v[bj][n][1]) + (v[bj][n][2] * v[bj][n][2] + v[bj][n][3] * v[bj][n][3]);
                    ss += __shfl_xor(ss, 16); ss += __shfl_xor(ss, 32);
                    const float rstd = 1.0f / sqrtf(ss * (1.0f / 64.0f) + EPS);
                    const int pos = part == 0 ? (s >> 6) : (s & (GRIDW - 1));
                    const float* rp = rope + (pos * 16 + base) * 2;
#pragma unroll
                    for (int n = 0; n < 2; ++n) { const f32x4 cs0 = *(const f32x4*)(rp + 8 * n), cs1 = *(const f32x4*)(rp + 8 * n + 4);
                        const float cc[4] = {cs0[0], cs0[2], cs1[0], cs1[2]}, sn[4] = {cs0[1], cs0[3], cs1[1], cs1[3]};
#pragma unroll
                        for (int j = 0; j < 4; ++j) { const float u1 = v[0][n][j] * rstd * gv[0][n][j], u2 = v[1][n][j] * rstd * gv[1][n][j];
                            v[0][n][j] = u1 * cc[j] - u2 * sn[j]; v[1][n][j] = u2 * cc[j] + u1 * sn[j]; } }
                }
#pragma unroll
                for (int bj = 0; bj < 2; ++bj) {
                    const u32x4 w = pk8(v[bj][0] * osc, v[bj][1] * osc);
                    const int dim = 32 * part + 16 * bj + base;
                    bf16_t* dst;
                    if (isq) dst = (brA ? Qa : Qb) + (size_t)row * (2 * QW) + (pl * 4 + wc) * HD + dim;
                    else if (wc < 2) dst = (brA ? Ka : Kb) + kimg_off(b, wc, s, dim);
                    else dst = (brA ? Va : Vb) + vimg_off(b, wc - 2, s, dim);
                    st16(dst, w);
                }
            }
    }
};

struct EpiMix {
    static constexpr bool PERM = true, AFTER_DRAIN = false, HAS_MID = true;
    const bf16_t* GA; const bf16_t* GB; bf16_t* OUT;
    __device__ __forceinline__ void mid(f32x4 (&acc)[2][2][4][2], const Unit& u, int wr, int wc, int fr, int fq) const {
        size_t off = (size_t)(u.pm * BM + wr * 64 + fr) * DM + u.pn * BM + wc * 32 + 8 * fq;
#pragma unroll
        for (int ai = 0; ai < 2; ++ai)
#pragma unroll
            for (int m = 0; m < 4; ++m) {
                asm volatile("" : "+v"(off));
#pragma unroll
                for (int bj = 0; bj < 2; ++bj) { const u32x4 a = *(const u32x4*)(GA + off + bj * HALF), b = *(const u32x4*)(GB + off + bj * HALF);
#pragma unroll
                    for (int n = 0; n < 2; ++n) { f32x4& c = acc[ai][bj][m][n]; const unsigned a0 = n ? a.z : a.x, a1 = n ? a.w : a.y, b0 = n ? b.z : b.x, b1 = n ? b.w : b.y;
                        c[0] *= bflo(a0) * __builtin_amdgcn_rcpf(fmaxf(bflo(b0), 1e-20f)); c[1] *= bfhi(a0) * __builtin_amdgcn_rcpf(fmaxf(bfhi(b0), 1e-20f));
                        c[2] *= bflo(a1) * __builtin_amdgcn_rcpf(fmaxf(bflo(b1), 1e-20f)); c[3] *= bfhi(a1) * __builtin_amdgcn_rcpf(fmaxf(bfhi(b1), 1e-20f)); } }
                off += (size_t)((m == 3) ? (HALF - 48) : 16) * DM;
            }
    }
    __device__ __forceinline__ void operator()(const f32x4 (&acc)[2][2][4][2], const Unit& u, int wr, int wc, int fr, int fq) const {
#pragma unroll
        for (int ai = 0; ai < 2; ++ai)
#pragma unroll
            for (int m = 0; m < 4; ++m) { const int row = u.pm * BM + ai * HALF + wr * 64 + m * 16 + fr; const size_t off = (size_t)row * DM + u.pn * BM + wc * 32 + 8 * fq;
#pragma unroll
                for (int bj = 0; bj < 2; ++bj) { const u32x4 g = *(const u32x4*)(GB + off + bj * HALF); const f32x4 a0 = acc[ai][bj][m][0], a1 = acc[ai][bj][m][1];
                    st16(OUT + off + bj * HALF, (u32x4){pkbf(a0[0] * bflo(g.x), a0[1] * bfhi(g.x)), pkbf(a0[2] * bflo(g.y), a0[3] * bfhi(g.y)), pkbf(a1[0] * bflo(g.z), a1[1] * bfhi(g.z)), pkbf(a1[2] * bflo(g.w), a1[3] * bfhi(g.w))}); } }
    }
};
struct EpiOut {
    static constexpr bool PERM = true, AFTER_DRAIN = false, HAS_MID = false;
    const float* X; bf16_t* HB; float* ssq;
    __device__ __forceinline__ void operator()(const f32x4 (&acc)[2][2][4][2], const Unit& u, int wr, int wc, int fr, int fq) const {
#pragma unroll
        for (int ai = 0; ai < 2; ++ai)
#pragma unroll
            for (int m = 0; m < 4; ++m) { const int row = u.pm * BM + ai * HALF + wr * 64 + m * 16 + fr; const size_t off = (size_t)row * DM + u.pn * BM + wc * 32 + 8 * fq; float ss = 0.f;
#pragma unroll
                for (int bj = 0; bj < 2; ++bj) { const size_t o2 = off + bj * HALF; const f32x4 h0 = *(const f32x4*)(X + o2) + acc[ai][bj][m][0], h1 = *(const f32x4*)(X + o2 + 4) + acc[ai][bj][m][1];
                    st16(HB + o2, pk8(h0, h1));
                    ss += ((h0[0] * h0[0] + h0[1] * h0[1]) + (h0[2] * h0[2] + h0[3] * h0[3])) + ((h1[0] * h1[0] + h1[1] * h1[1]) + (h1[2] * h1[2] + h1[3] * h1[3])); }
                ss += __shfl_xor(ss, 16); ss += __shfl_xor(ss, 32);
                if (fq == 0) ssq[(size_t)row * 16 + u.pn * 4 + wc] = ss; }
    }
};
typedef _Float16 f16x2_t __attribute__((ext_vector_type(2)));
__device__ __forceinline__ unsigned pkh(float lo, float hi) { f16x2_t h = {(_Float16)lo, (_Float16)hi}; return __builtin_bit_cast(unsigned, h); }
struct EpiScore {
    static constexpr bool PERM = true, AFTER_DRAIN = false, HAS_MID = false;
    const float* ssq; unsigned short* SC;
    __device__ __forceinline__ void operator()(const f32x4 (&acc)[2][2][4][2], const Unit& u, int wr, int wc, int fr, int fq) const {
#pragma unroll
        for (int ai = 0; ai < 2; ++ai)
#pragma unroll
            for (int m = 0; m < 4; ++m) { const int row = u.pm * BM + ai * HALF + wr * 64 + m * 16 + fr;
                const f32x4* sp = (const f32x4*)(ssq + (size_t)row * 16); const f32x4 s0 = sp[0], s1 = sp[1], s2 = sp[2], s3 = sp[3];
                const float tot = (((s0[0] + s0[1]) + (s0[2] + s0[3])) + ((s1[0] + s1[1]) + (s1[2] + s1[3]))) + (((s2[0] + s2[1]) + (s2[2] + s2[3])) + ((s3[0] + s3[1]) + (s3[2] + s3[3])));
                const float rstd = 1.0f / sqrtf(tot * (1.0f / DM) + EPS);
                unsigned short* rp = SC + (size_t)row * SCW + u.pn * BM + wc * 32 + 8 * fq;
#pragma unroll
                for (int bj = 0; bj < 2; ++bj) { const f32x4 v0 = acc[ai][bj][m][0] * rstd, v1 = acc[ai][bj][m][1] * rstd;
                    st16(rp + bj * HALF, (u32x4){pkh(v0[0], v0[1]), pkh(v0[2], v0[3]), pkh(v1[0], v1[1]), pkh(v1[2], v1[3])}); } }
    }
};
struct EpiNull {
    static constexpr bool PERM = true, AFTER_DRAIN = false, HAS_MID = false;
    float* sink;
    __device__ __forceinline__ void operator()(const f32x4 (&acc)[2][2][4][2], const Unit& u, int wr, int wc, int fr, int fq) const {
        f32x4 s = acc[0][0][0][0];
#pragma unroll
        for (int ai = 0; ai < 2; ++ai)
#pragma unroll
            for (int bj = 0; bj < 2; ++bj)
#pragma unroll
                for (int m = 0; m < 4; ++m)
#pragma unroll
                    for (int n = 0; n < 2; ++n) s += acc[ai][bj][m][n];
        if (s[0] + s[1] + s[2] + s[3] == 1.2345e30f) sink[0] = 1.f;
    }
};
}

#define LAS __attribute__((address_space(3)))
namespace attn {
typedef unsigned short bf16_t;
typedef short bf16x8 __attribute__((ext_vector_type(8)));
typedef short s16x4 __attribute__((ext_vector_type(4)));
typedef float f32x16 __attribute__((ext_vector_type(16)));
typedef unsigned u32x4 __attribute__((ext_vector_type(4)));
constexpr int LDS_K = 0, LDS_V = 32768;
constexpr int LDS_BIAS = 65536;
constexpr int LDS_BYTES = 65536 + 3072;
constexpr float THR = 8.0f;
__device__ __forceinline__ int crow(int r, int hi) { return (r & 3) + 8 * (r >> 2) + 4 * hi; }
__device__ __forceinline__ s16x4 vtr(const LAS char* p) { return __builtin_bit_cast(s16x4, __builtin_amdgcn_ds_read_tr16_b64_v4i16((LAS s16x4*)p)); }
__device__ __forceinline__ float xhalf_max(float v) { auto rr = __builtin_amdgcn_permlane32_swap(__float_as_uint(v), __float_as_uint(v), false, false); return fmaxf(__uint_as_float(rr[0]), __uint_as_float(rr[1])); }
__device__ __forceinline__ float xhalf_sum(float v) { auto rr = __builtin_amdgcn_permlane32_swap(__float_as_uint(v), __float_as_uint(v), false, false); return __uint_as_float(rr[0]) + __uint_as_float(rr[1]); }
#ifndef ATTN_CLEANM
#define ATTN_CLEANM 0
#endif
#ifndef ATTN_PRIO
#define ATTN_PRIO 1
#endif
__device__ __forceinline__ float max3f(float a, float b, float c) { float r; asm("v_max3_f32 %0, %1, %2, %3" : "=v"(r) : "v"(a), "v"(b), "v"(c)); return r; }
__device__ __forceinline__ float max2f(float a, float b) { float r; asm("v_max_f32_e32 %0, %1, %2" : "=v"(r) : "v"(a), "v"(b)); return r; }
#define ATT_BAR() do { asm volatile("s_waitcnt lgkmcnt(0)" ::: "memory"); __builtin_amdgcn_s_barrier(); asm volatile("" ::: "memory"); } while (0)

template <bool WIN, int XV = 0, bool NOMAX = false>
__device__ __forceinline__ void attn_unit(LAS char* lds, const bf16_t* Q, const bf16_t* Kimg, const bf16_t* Vimg, bf16_t* O, int b, int h, int qblk, const float* bias_h  , float sink_l2) {
    const int tid = threadIdx.x, lane = tid & 63, r32 = lane & 31, hi = lane >> 5; const int wid = __builtin_amdgcn_readfirstlane(tid >> 6); const int grp = wid >> 2;
    const int q0 = qblk * 256, qw0 = q0 + 32 * wid, qrow = qw0 + r32; const size_t grow = (size_t)b * SEQ + qrow;
    const int kvh = h >> 2;
    int t_lo = 0, t_hi = SEQ / 64 - 1;
    if (WIN) { t_lo = q0 / 64 - 2; if (t_lo < 0) t_lo = 0; t_hi = q0 / 64 + 5; if (t_hi > SEQ / 64 - 1) t_hi = SEQ / 64 - 1; }
    const int n = t_hi - t_lo + 1;
    const bf16_t* Kb = Kimg + ((size_t)((b * NKV + kvh) * (SEQ / 64) + t_lo) << 12) + tid * 8;
    const bf16_t* Vb = Vimg + ((size_t)((b * NKV + kvh) * (SEQ / 64) + t_lo) << 12) + tid * 8;
    bf16x8 qr[4];
#pragma unroll
    for (int d0 = 0; d0 < 4; ++d0) qr[d0] = *(const bf16x8*)(Q + grow * (2 * QW) + h * HD + d0 * 16 + hi * 8);
    LAS float* biasl = (LAS float*)(lds + LDS_BIAS);
    if (WIN) { for (int j = tid; j < 768; j += 512) biasl[j] = (j >= 256 && j <= 512) ? bias_h[j - 256] : -1e30f; }
    u32x4 kreg, vreg;
    { const u32x4 k0 = *(const u32x4*)Kb, v0 = *(const u32x4*)Vb, k1 = *(const u32x4*)(Kb + 4096), v1 = *(const u32x4*)(Vb + 4096);
      kreg = *(const u32x4*)(Kb + 2 * 4096); vreg = *(const u32x4*)(Vb + 2 * 4096);
      *(LAS u32x4*)(lds + LDS_K + tid * 16) = k0; *(LAS u32x4*)(lds + LDS_V + tid * 16) = v0;
      *(LAS u32x4*)(lds + LDS_K + 8192 + tid * 16) = k1; *(LAS u32x4*)(lds + LDS_V + 8192 + tid * 16) = v1; }
    ATT_BAR();
    if (grp) ATT_BAR();
    f32x16 o0 = {}, o1 = {}, o2, p0, p1, negm;
    float mref = WIN ? sink_l2 : 0.0f;
#pragma unroll
    for (int r = 0; r < 16; ++r) o2[r] = WIN ? 1.0f : 0.0f;
    const bf16x8 ones = {0x3F80, 0x3F80, 0x3F80, 0x3F80, 0x3F80, 0x3F80, 0x3F80, 0x3F80};
#pragma unroll
    for (int r = 0; r < 16; ++r) negm[r] = -mref;
    const int vlane = ((lane >> 4) & 1) * 32 + (lane & 3) * 8 + (4 * hi + ((lane & 15) >> 2)) * 64;
    const LAS char* kfr = lds + LDS_K + hi * 1024 + r32 * 16;
    u32x4 pk[4]; bf16x8 kf[8], vf[8];
#define ATT_LDK(sl) do { const LAS char* kp_ = kfr + (sl) * 8192; \
        _Pragma("unroll") for (int d0 = 0; d0 < 4; ++d0) { kf[2 * d0] = *(const LAS bf16x8*)(kp_ + d0 * 2048); kf[2 * d0 + 1] = *(const LAS bf16x8*)(kp_ + d0 * 2048 + 512); } } while (0)
#define ATT_LDV(sl) do { const LAS char* vp_ = lds + LDS_V + (sl) * 8192 + vlane; \
        _Pragma("unroll") for (int ks = 0; ks < 4; ++ks) { \
            const s16x4 l0 = vtr(vp_ + ks * 1024), h0 = vtr(vp_ + ks * 1024 + 512), l1 = vtr(vp_ + 4096 + ks * 1024), h1 = vtr(vp_ + 4096 + ks * 1024 + 512); \
            vf[2 * ks] = (bf16x8){l0[0], l0[1], l0[2], l0[3], h0[0], h0[1], h0[2], h0[3]}; vf[2 * ks + 1] = (bf16x8){l1[0], l1[1], l1[2], l1[3], h1[0], h1[1], h1[2], h1[3]}; } } while (0)
#define ATT_QK() do { \
        if (NOMAX) { const f32x16 z_ = {}; p0 = __builtin_amdgcn_mfma_f32_32x32x16_bf16(kf[0], qr[0], z_, 0, 0, 0); p1 = __builtin_amdgcn_mfma_f32_32x32x16_bf16(kf[1], qr[0], z_, 0, 0, 0); } \
        else { p0 = __builtin_amdgcn_mfma_f32_32x32x16_bf16(kf[0], qr[0], negm, 0, 0, 0); p1 = __builtin_amdgcn_mfma_f32_32x32x16_bf16(kf[1], qr[0], negm, 0, 0, 0); } \
        _Pragma("unroll") for (int d0 = 1; d0 < 4; ++d0) { p0 = __builtin_amdgcn_mfma_f32_32x32x16_bf16(kf[2 * d0], qr[d0], p0, 0, 0, 0); p1 = __builtin_amdgcn_mfma_f32_32x32x16_bf16(kf[2 * d0 + 1], qr[d0], p1, 0, 0, 0); } } while (0)
#define ATT_PV() do { \
        _Pragma("unroll") for (int ks = 0; ks < 4; ++ks) { const bf16x8 pf = __builtin_bit_cast(bf16x8, pk[ks]); \
            o0 = __builtin_amdgcn_mfma_f32_32x32x16_bf16(vf[2 * ks], pf, o0, 0, 0, 0); o1 = __builtin_amdgcn_mfma_f32_32x32x16_bf16(vf[2 * ks + 1], pf, o1, 0, 0, 0); \
            o2 = __builtin_amdgcn_mfma_f32_32x32x16_bf16(ones, pf, o2, 0, 0, 0); } } while (0)
    int ia = 0, ib = n - 1;
    if (WIN) { int lo_t = (qw0 - 128) >> 6; if (lo_t < t_lo) lo_t = t_lo; int hi_t = (qw0 + 31 + 128) >> 6; if (hi_t > t_hi) hi_t = t_hi; ia = lo_t - t_lo; ib = hi_t - t_lo; }
#define ATT_STAGE(i) do { if ((i) + 2 < n) { const int sl_ = ((i) + 2) & 3; *(LAS u32x4*)(lds + LDS_K + sl_ * 8192 + tid * 16) = kreg; *(LAS u32x4*)(lds + LDS_V + sl_ * 8192 + tid * 16) = vreg; \
            if ((i) + 3 < n) { kreg = *(const u32x4*)(Kb + (size_t)((i) + 3) * 4096); vreg = *(const u32x4*)(Vb + (size_t)((i) + 3) * 4096); } } } while (0)
    bool first = !WIN;
    int i = 0;
    if (ia == 0) { ATT_LDK(0); asm volatile("s_waitcnt lgkmcnt(0)" ::: "memory"); ATT_QK(); }
    ATT_BAR();
    for (; i < ia; ++i) {
        ATT_STAGE(i);
        ATT_BAR();
        if (i + 1 == ia) { ATT_LDK((i + 1) & 3); asm volatile("s_waitcnt lgkmcnt(0)" ::: "memory"); ATT_QK(); }
        ATT_BAR();
    }
    for (; i <= ib; ++i) {
        ATT_LDV(i & 3);
        __builtin_amdgcn_sched_barrier(0);
        asm volatile("s_nop 7" : "+v"(p0), "+v"(p1));
        if (WIN) {
            const LAS float* bp = biasl + (64 * (t_lo + i) - qrow + 4 * hi + 384);
#pragma unroll
            for (int r = 0; r < 16; ++r) { p0[r] += bp[(r & 3) + 8 * (r >> 2)]; p1[r] += bp[32 + (r & 3) + 8 * (r >> 2)]; }
        }
        if (!NOMAX) {
        float ra = max3f(p0[0], p0[1], p1[0]), rb = max3f(p0[2], p0[3], p1[1]); ra = max3f(ra, p1[2], p1[3]);
#pragma unroll
        for (int r = 4; r < 16; r += 4) { ra = max3f(ra, p0[r], p0[r + 1]); rb = max3f(rb, p0[r + 2], p0[r + 3]); ra = max3f(ra, p1[r], p1[r + 1]); rb = max3f(rb, p1[r + 2], p1[r + 3]); }
        float rm = xhalf_max(max2f(ra, rb));
        if (first || __builtin_amdgcn_ballot_w64(rm > THR) != 0ull) {
            const float delta = first ? rm : fmaxf(rm, 0.0f); const float f = first ? 1.0f : __builtin_amdgcn_exp2f(-delta);
            mref += delta;
#pragma unroll
            for (int r = 0; r < 16; ++r) { p0[r] -= delta; p1[r] -= delta; o0[r] *= f; o1[r] *= f; o2[r] *= f; negm[r] = -mref; }
            first = false;
        }
        }
#pragma unroll
        for (int r = 0; r < 16; ++r) { if (XV == 1 || XV == 4) { p0[r] *= 0.5f; p1[r] *= 0.5f; } else { p0[r] = __builtin_amdgcn_exp2f(p0[r]); p1[r] = __builtin_amdgcn_exp2f(p1[r]); } }
#pragma unroll
        for (int q = 0; q < 4; ++q) { pk[0][q] = pkbf(p0[2 * q], p0[2 * q + 1]); pk[1][q] = pkbf(p0[8 + 2 * q], p0[9 + 2 * q]); pk[2][q] = pkbf(p1[2 * q], p1[2 * q + 1]); pk[3][q] = pkbf(p1[8 + 2 * q], p1[9 + 2 * q]); }
        ATT_STAGE(i);
        asm volatile("s_waitcnt lgkmcnt(0)" : "+v"(vf[0]), "+v"(vf[1]), "+v"(vf[2]), "+v"(vf[3]), "+v"(vf[4]), "+v"(vf[5]), "+v"(vf[6]), "+v"(vf[7]), "+v"(pk[0]), "+v"(pk[1]), "+v"(pk[2]), "+v"(pk[3]) : : "memory");
        if (XV != 3) ATT_BAR(); else asm volatile("s_waitcnt lgkmcnt(0)" ::: "memory");
        __builtin_amdgcn_s_setprio(ATTN_PRIO);
#if ATTN_CLEANM
        if (i < ib) { ATT_LDK((i + 1) & 3); __builtin_amdgcn_sched_barrier(0); }
#else
        if (i < ib) ATT_LDK((i + 1) & 3);
#endif
        if (XV != 2 && XV != 4) { ATT_PV(); if (i < ib) ATT_QK(); } else { asm volatile("" : "+v"(kf[0]), "+v"(kf[7]), "+v"(vf[0]), "+v"(vf[7])); }
        __builtin_amdgcn_s_setprio(0);
        ATT_BAR();
    }
    for (; i < n; ++i) { ATT_STAGE(i); ATT_BAR(); ATT_BAR(); }
#undef ATT_STAGE
#undef ATT_QK
#undef ATT_PV
#undef ATT_LDK
#undef ATT_LDV
    const float inv = 1.0f / o2[0];
    bf16_t* Orow = O + grow * (2 * QW) + h * HD + 4 * hi;
#pragma unroll
    for (int g = 0; g < 4; ++g) {
        u32x2_t w0, w1;
        w0.x = pkbf(o0[4 * g] * inv, o0[4 * g + 1] * inv); w0.y = pkbf(o0[4 * g + 2] * inv, o0[4 * g + 3] * inv);
        w1.x = pkbf(o1[4 * g] * inv, o1[4 * g + 1] * inv); w1.y = pkbf(o1[4 * g + 2] * inv, o1[4 * g + 3] * inv);
        *(u32x2_t*)(Orow + 8 * g) = w0; *(u32x2_t*)(Orow + 32 + 8 * g) = w1;
    }
    if (!grp) ATT_BAR();
}
}

namespace peer {
typedef unsigned u32x4 __attribute__((ext_vector_type(4)));
typedef float f32x4 __attribute__((ext_vector_type(4)));
constexpr int WAVE_LDS = 2048;

template <int CTRL> __device__ __forceinline__ int dppi(int x) { return __builtin_amdgcn_mov_dpp(x, CTRL, 0xf, 0xf, true); }
template <int CTRL> __device__ __forceinline__ float dppf(float x) { return __builtin_bit_cast(float, __builtin_amdgcn_mov_dpp(__builtin_bit_cast(int, x), CTRL, 0xf, 0xf, true)); }
constexpr int XOR1 = 0xB1, XOR2 = 0x4E, XOR7 = 0x141, XOR8 = 0x128;
__device__ __forceinline__ float wave_sum(float x) {
    x += dppf<XOR1>(x); x += dppf<XOR2>(x); x += dppf<XOR7>(x); x += dppf<XOR8>(x);
    auto s = __builtin_amdgcn_permlane16_swap(__float_as_uint(x), __float_as_uint(x), false, false); x = __uint_as_float(s[0]) + __uint_as_float(s[1]);
    auto t = __builtin_amdgcn_permlane32_swap(__float_as_uint(x), __float_as_uint(x), false, false); return __uint_as_float(t[0]) + __uint_as_float(t[1]);
}
__device__ __forceinline__ float dot2bf(unsigned a, unsigned b, float c) { return __builtin_amdgcn_fdot2_f32_bf16(__builtin_bit_cast(bf16x2_t, a), __builtin_bit_cast(bf16x2_t, b), c, false); }
__device__ __forceinline__ unsigned getw(const u32x4& v, int i) { return i == 0 ? v.x : i == 1 ? v.y : i == 2 ? v.z : v.w; }
__device__ __forceinline__ int okey(float f, int lowbits, int payload) { int b = __float_as_int(f); b ^= (b >> 31) & 0x7fffffff; return (b & ~((1 << lowbits) - 1)) | payload; }
__device__ __forceinline__ float kval(int k, int lowbits) { int b = (k & ~((1 << lowbits) - 1)) | (1 << (lowbits - 1)); b ^= (b >> 31) & 0x7fffffff; return __int_as_float(b); }
#define CE_DESC(a, b) do { const int _x = (a), _y = (b); (a) = _x > _y ? _x : _y; (b) = _x > _y ? _y : _x; } while (0)
template <int N> __device__ __forceinline__ void bitonic_sort_desc(int (&a)[N]) {
#pragma unroll
    for (int k = 2; k <= N; k <<= 1)
#pragma unroll
        for (int j = k >> 1; j > 0; j >>= 1)
#pragma unroll
            for (int i = 0; i < N; ++i) { const int l = i ^ j; if (l > i) { if ((i & k) == 0) CE_DESC(a[i], a[l]); else CE_DESC(a[l], a[i]); } }
}
template <int N> __device__ __forceinline__ void bitonic_merge_desc(int (&a)[N]) {
#pragma unroll
    for (int j = N >> 1; j > 0; j >>= 1)
#pragma unroll
        for (int i = 0; i < N; ++i) { const int l = i ^ j; if (l > i) CE_DESC(a[i], a[l]); }
}
__device__ __forceinline__ unsigned long long cand_table(int q8) {
    unsigned long long r = 0xFFFFFFFFFFFFFFFFull; int n = 0;
#pragma unroll
    for (int i = 0; i < 16; ++i)
#pragma unroll
        for (int j = 0; j < 16; ++j) if ((i + 1) * (j + 1) <= 16) { if (n / 7 == q8) { const int s = n % 7; r = (r & ~(0xFFull << (8 * s))) | ((unsigned long long)(i * 16 + j) << (8 * s)); } ++n; }
    return r;
}

struct SCtx { u32x4 v[4]; };
__device__ __forceinline__ SCtx s_ctx(int lane, int t, const unsigned short* SC) { SCtx c; const u32x4* p = (const u32x4*)(SC + (size_t)t * SCW + (lane >> 2) * NKEYS + (lane & 3) * 32);
#pragma unroll
    for (int i = 0; i < 4; ++i) c.v[i] = p[i];
    return c; }
__device__ __forceinline__ void route_token(LAS char* wl, int lane, int t, unsigned long long ct, const SCtx& scx  , const float* SSQ, unsigned short* E, float* G, float* RSTD) {
    LAS int* skeys = (LAS int*)wl;
    {
        const int c = lane >> 2, qq = lane & 3;
        int a[16], bb[16];
#pragma unroll
        for (int i = 0; i < 2; ++i) { const u32x4 v = scx.v[i];
#pragma unroll
            for (int j = 0; j < 4; ++j) { const unsigned w = getw(v, j); const pg8::f16x2_t h = __builtin_bit_cast(pg8::f16x2_t, w);
                a[8 * i + 2 * j] = okey((float)h.x, 7, 127 - (qq * 32 + 8 * i + 2 * j)); a[8 * i + 2 * j + 1] = okey((float)h.y, 7, 127 - (qq * 32 + 8 * i + 2 * j + 1)); } }
#pragma unroll
        for (int i = 0; i < 2; ++i) { const u32x4 v = scx.v[2 + i];
#pragma unroll
            for (int j = 0; j < 4; ++j) { const unsigned w = getw(v, j); const pg8::f16x2_t h = __builtin_bit_cast(pg8::f16x2_t, w);
                bb[8 * i + 2 * j] = okey((float)h.x, 7, 127 - (qq * 32 + 16 + 8 * i + 2 * j)); bb[8 * i + 2 * j + 1] = okey((float)h.y, 7, 127 - (qq * 32 + 16 + 8 * i + 2 * j + 1)); } }
        bitonic_sort_desc<16>(a); bitonic_sort_desc<16>(bb);
#pragma unroll
        for (int i = 0; i < 16; ++i) a[i] = a[i] > bb[15 - i] ? a[i] : bb[15 - i];
        bitonic_merge_desc<16>(a);
#pragma unroll
        for (int i = 0; i < 16; ++i) bb[i] = dppi<XOR1>(a[15 - i]);
#pragma unroll
        for (int i = 0; i < 16; ++i) a[i] = a[i] > bb[i] ? a[i] : bb[i];
        bitonic_merge_desc<16>(a);
#pragma unroll
        for (int i = 0; i < 16; ++i) bb[i] = dppi<XOR2>(a[15 - i]);
#pragma unroll
        for (int i = 0; i < 16; ++i) a[i] = a[i] > bb[i] ? a[i] : bb[i];
        bitonic_merge_desc<16>(a);
        if (qq == 0) {
#pragma unroll
            for (int i = 0; i < 4; ++i) *(LAS u32x4*)(skeys + c * 16 + 4 * i) = (u32x4){(unsigned)a[4 * i], (unsigned)a[4 * i + 1], (unsigned)a[4 * i + 2], (unsigned)a[4 * i + 3]};
        }
    }
    asm volatile("s_waitcnt lgkmcnt(0)" ::: "memory");
    {
        const int hh = lane >> 3, q8 = lane & 7;
        int a[16];
#pragma unroll
        for (int s = 0; s < 8; ++s) {
            const int code = s < 7 ? (int)((ct >> (8 * s)) & 0xFF) : 0xFF;
            const int ci = code == 0xFF ? 0 : code;
            const int ka = skeys[(2 * hh) * 16 + (ci >> 4)], kb = skeys[(2 * hh + 1) * 16 + (ci & 15)];
            const float sum = kval(ka, 7) + kval(kb, 7);
            a[s] = code == 0xFF ? (int)0x80000000 : okey(sum, 8, 255 - code);
        }
        {
            int c8[8];
#pragma unroll
            for (int i = 0; i < 8; ++i) c8[i] = a[i];
            bitonic_sort_desc<8>(c8);
#pragma unroll
            for (int i = 0; i < 8; ++i) a[i] = c8[i];
        }
#pragma unroll
        for (int i = 0; i < 8; ++i) a[8 + i] = dppi<XOR1>(a[i]);
        { int tmp[8];
#pragma unroll
          for (int i = 0; i < 8; ++i) tmp[i] = a[8 + i];
#pragma unroll
          for (int i = 0; i < 8; ++i) a[8 + i] = tmp[7 - i]; }
        bitonic_merge_desc<16>(a);
        int bb[16];
#pragma unroll
        for (int i = 0; i < 16; ++i) bb[i] = dppi<XOR2>(a[15 - i]);
#pragma unroll
        for (int i = 0; i < 16; ++i) a[i] = a[i] > bb[i] ? a[i] : bb[i];
        bitonic_merge_desc<16>(a);
#pragma unroll
        for (int i = 0; i < 16; ++i) bb[i] = dppi<XOR7>(a[15 - i]);
#pragma unroll
        for (int i = 0; i < 16; ++i) a[i] = a[i] > bb[i] ? a[i] : bb[i];
        bitonic_merge_desc<16>(a);
        int k0 = a[0], k1 = a[1];
#pragma unroll
        for (int i = 1; i < 8; ++i) { k0 = q8 == i ? a[2 * i] : k0; k1 = q8 == i ? a[2 * i + 1] : k1; }
        const float mx = kval(a[0], 8);
        const int c0 = 255 - (k0 & 255), c1 = 255 - (k1 & 255);
        const int ka0 = skeys[(2 * hh) * 16 + (c0 >> 4)], kb0 = skeys[(2 * hh + 1) * 16 + (c0 & 15)];
        const int ka1 = skeys[(2 * hh) * 16 + (c1 >> 4)], kb1 = skeys[(2 * hh + 1) * 16 + (c1 & 15)];
        const float s0 = kval(ka0, 7) + kval(kb0, 7), s1 = kval(ka1, 7) + kval(kb1, 7);
        const float e0 = __expf(s0 - mx), e1 = __expf(s1 - mx);
        float z = e0 + e1; z += dppf<XOR1>(z); z += dppf<XOR2>(z); z += dppf<XOR7>(z);
        const float rz = 1.0f / z;
        const unsigned e0i = (unsigned)((127 - (ka0 & 127)) * NKEYS + (127 - (kb0 & 127))), e1i = (unsigned)((127 - (ka1 & 127)) * NKEYS + (127 - (kb1 & 127)));
        *(unsigned*)(E + (size_t)t * 128 + hh * 16 + 2 * q8) = e0i | (e1i << 16);
        *(f32x2_t*)(G + (size_t)t * 128 + hh * 16 + 2 * q8) = (f32x2_t){e0 * rz, e1 * rz};
    }
    if (lane == 0) { const f32x4* sp = (const f32x4*)(SSQ + (size_t)t * 16); const f32x4 s0 = sp[0], s1 = sp[1], s2 = sp[2], s3 = sp[3];
        const float tot = (((s0[0] + s0[1]) + (s0[2] + s0[3])) + ((s1[0] + s1[1]) + (s1[2] + s1[3]))) + (((s2[0] + s2[1]) + (s2[2] + s2[3])) + ((s3[0] + s3[1]) + (s3[2] + s3[3])));
        RSTD[t] = 1.0f / sqrtf(tot * (1.0f / DM) + EPS); }
    asm volatile("s_waitcnt lgkmcnt(0)" ::: "memory");
}

constexpr size_t SLICE_BYTES = (size_t)NEXP * 128;
__device__ __forceinline__ float wave_max(float x) {
    x = fmaxf(x, dppf<XOR1>(x)); x = fmaxf(x, dppf<XOR2>(x)); x = fmaxf(x, dppf<XOR7>(x)); x = fmaxf(x, dppf<XOR8>(x));
    auto s = __builtin_amdgcn_permlane16_swap(__float_as_uint(x), __float_as_uint(x), false, false); x = fmaxf(__uint_as_float(s[0]), __uint_as_float(s[1]));
    auto t = __builtin_amdgcn_permlane32_swap(__float_as_uint(x), __float_as_uint(x), false, false); return fmaxf(__uint_as_float(t[0]), __uint_as_float(t[1]));
}
template <int NR>
__device__ __forceinline__ void table_rows_fp8(const float* src, unsigned char* T8, float* INV, int e0, int es, int lane) {
    f32x4 v[NR][4];
#pragma unroll
    for (int i = 0; i < NR; ++i) { const f32x4* p = (const f32x4*)(src + (size_t)(e0 + i * es) * DM) + lane;
#pragma unroll
        for (int q = 0; q < 4; ++q) v[i][q] = __builtin_nontemporal_load(p + 64 * q); }
#pragma unroll
    for (int i = 0; i < NR; ++i) {
        float mx = 0.f;
#pragma unroll
        for (int q = 0; q < 4; ++q) mx = fmaxf(mx, fmaxf(fmaxf(fabsf(v[i][q][0]), fabsf(v[i][q][1])), fmaxf(fabsf(v[i][q][2]), fabsf(v[i][q][3]))));
        mx = wave_max(mx);
        const float sc = mx > 0.f ? 448.0f / mx : 1.0f;
        const int e = e0 + i * es;
#pragma unroll
        for (int q = 0; q < 4; ++q) { unsigned w = 0; w = __builtin_amdgcn_cvt_pk_fp8_f32(v[i][q][0] * sc, v[i][q][1] * sc, w, false); w = __builtin_amdgcn_cvt_pk_fp8_f32(v[i][q][2] * sc, v[i][q][3] * sc, w, true);
            *(unsigned*)(T8 + (size_t)(2 * q + (lane >> 5)) * SLICE_BYTES + (size_t)e * 128 + 4 * (lane & 31)) = w; }
        if (lane == 0) INV[e] = mx > 0.f ? mx * (1.0f / 448.0f) : 1.0f;
    }
}
__device__ __forceinline__ void tables_fp8(const float* peer_u, const float* peer_v, unsigned char* U8, unsigned char* V8, float* INVU, float* INVV, int r0, int r1, int w, int nw, int lane) {
    int e = r0 + w;
    for (; e + 3 * nw < r1; e += 4 * nw) { table_rows_fp8<4>(peer_u, U8, INVU, e, nw, lane); table_rows_fp8<4>(peer_v, V8, INVV, e, nw, lane); }
    for (; e + nw < r1; e += 2 * nw) { table_rows_fp8<2>(peer_u, U8, INVU, e, nw, lane); table_rows_fp8<2>(peer_v, V8, INVV, e, nw, lane); }
    for (; e < r1; e += nw) { table_rows_fp8<1>(peer_u, U8, INVU, e, nw, lane); table_rows_fp8<1>(peer_v, V8, INVV, e, nw, lane); }
}
struct ECtx { u32x4 ea, eb; };
struct XCtx { u32x4 xa, xb; float rs; };
__device__ __forceinline__ ECtx e_ctx(int lane, int t, const unsigned short* E) { ECtx c; c.ea = *(const u32x4*)(E + (size_t)t * 128 + (lane >> 3) * 16); c.eb = *(const u32x4*)(E + (size_t)t * 128 + (lane >> 3) * 16 + 8); return c; }
__device__ __forceinline__ XCtx x_ctx(int lane, int t, int s, const unsigned short* HB, const float* RSTD) { XCtx c; c.xa = *(const u32x4*)(HB + (size_t)t * DM + s * 128 + (lane & 7) * 16); c.xb = *(const u32x4*)(HB + (size_t)t * DM + s * 128 + (lane & 7) * 16 + 8); c.rs = RSTD[t]; return c; }
__device__ __forceinline__ void g_rows(u32x4 (&row)[16], const ECtx& c, const unsigned char* T8s, int c8) {
#pragma unroll
    for (int j = 0; j < 16; ++j) { const unsigned ew = getw(j < 8 ? c.ea : c.eb, (j & 7) >> 1); const unsigned e = (j & 1) ? (ew >> 16) : (ew & 0xffffu);
        row[j] = *(const u32x4*)(T8s + (size_t)e * 128 + c8 * 16); }
}
__device__ __forceinline__ void u_compute(int lane, int t, int s, const XCtx& c, const f32x2_t (&gch)[8], const u32x4 (&row)[16], unsigned short* PA) {
    const int rs = lane >> 3, c8 = lane & 7;
    f32x2_t xf[8];
#pragma unroll
    for (int i = 0; i < 4; ++i) { const unsigned wa = getw(c.xa, i), wb = getw(c.xb, i); xf[i] = (f32x2_t){bflo(wa), bfhi(wa)} * gch[i] * c.rs; xf[4 + i] = (f32x2_t){bflo(wb), bfhi(wb)} * gch[4 + i] * c.rs; }
    float part[16];
#pragma unroll
    for (int j = 0; j < 16; ++j) {
        f32x2_t acc = {0.f, 0.f};
#pragma unroll
        for (int w = 0; w < 4; ++w) { const unsigned q = getw(row[j], w);
            acc = __builtin_elementwise_fma(__builtin_amdgcn_cvt_pk_f32_fp8(q, false), xf[2 * w], acc); acc = __builtin_elementwise_fma(__builtin_amdgcn_cvt_pk_f32_fp8(q, true), xf[2 * w + 1], acc); }
        float p = acc.x + acc.y; p += dppf<XOR1>(p); p += dppf<XOR2>(p); p += dppf<XOR7>(p); part[j] = p;
    }
    float p0 = part[0], p1 = part[1];
#pragma unroll
    for (int i = 1; i < 8; ++i) { p0 = c8 == i ? part[2 * i] : p0; p1 = c8 == i ? part[2 * i + 1] : p1; }
    *(unsigned*)(PA + ((size_t)t * 8 + s) * 128 + rs * 16 + 2 * c8) = pkbf(p0, p1);
}
#define TCL(t_) ((t_) < NTOK ? (t_) : NTOK - 1)
__device__ __forceinline__ void upass_slice(int lane, int s, int wv, int nwv, const unsigned char* U8s, const unsigned short* E, const unsigned short* HB, const float* RSTD, const float* gffn, unsigned short* PA) {
    const int c8 = lane & 7;
    int t = wv; if (t >= NTOK) return;
    f32x2_t gch[8];
#pragma unroll
    for (int i = 0; i < 4; ++i) { const f32x4 g = *(const f32x4*)(gffn + s * 128 + c8 * 16 + 4 * i); gch[2 * i] = (f32x2_t){g[0], g[1]}; gch[2 * i + 1] = (f32x2_t){g[2], g[3]}; }
    ECtx eA = e_ctx(lane, t, E), eB = e_ctx(lane, TCL(t + nwv), E); XCtx xA = x_ctx(lane, t, s, HB, RSTD), xB;
    u32x4 rA[16], rB[16];
    g_rows(rA, eA, U8s, c8);
    for (; t < NTOK; t += 2 * nwv) {
        eA = e_ctx(lane, TCL(t + 2 * nwv), E); xB = x_ctx(lane, TCL(t + nwv), s, HB, RSTD); g_rows(rB, eB, U8s, c8);
        u_compute(lane, t, s, xA, gch, rA, PA);
        eB = e_ctx(lane, TCL(t + 3 * nwv), E); xA = x_ctx(lane, TCL(t + 2 * nwv), s, HB, RSTD); g_rows(rA, eA, U8s, c8);
        if (t + nwv < NTOK) u_compute(lane, t + nwv, s, xB, gch, rB, PA);
    }
}
template <int NT>
__device__ __forceinline__ void wpass_tokens(int lane, int t0, int ts, const unsigned short* E, const float* G, const unsigned short* PA, const float* INVU, const float* INVV, float* W) {
    unsigned pw[NT][8], ew[NT]; f32x2_t g[NT];
#pragma unroll
    for (int i = 0; i < NT; ++i) { const int t = t0 + i * ts;
#pragma unroll
        for (int s = 0; s < 8; ++s) pw[i][s] = *(const unsigned*)(PA + ((size_t)t * 8 + s) * 128 + 2 * lane);
        ew[i] = *(const unsigned*)(E + (size_t)t * 128 + 2 * lane); g[i] = *(const f32x2_t*)(G + (size_t)t * 128 + 2 * lane); }
    float iu0[NT], iu1[NT], iv0[NT], iv1[NT];
#pragma unroll
    for (int i = 0; i < NT; ++i) { const unsigned e0 = ew[i] & 0xffffu, e1 = ew[i] >> 16; iu0[i] = INVU[e0]; iu1[i] = INVU[e1]; iv0[i] = INVV[e0]; iv1[i] = INVV[e1]; }
#pragma unroll
    for (int i = 0; i < NT; ++i) { float a0 = 0.f, a1 = 0.f;
#pragma unroll
        for (int s = 0; s < 8; ++s) { a0 += bflo(pw[i][s]); a1 += bfhi(pw[i][s]); }
        a0 *= iu0[i]; a1 *= iu1[i];
        const float w0 = g[i].x * 0.5f * a0 * (1.0f + erff(a0 * 0.70710678118654752f)) * iv0[i], w1 = g[i].y * 0.5f * a1 * (1.0f + erff(a1 * 0.70710678118654752f)) * iv1[i];
        *(f32x2_t*)(W + (size_t)(t0 + i * ts) * 128 + 2 * lane) = (f32x2_t){w0, w1}; }
}
struct WCtx { f32x4 w0, w1, w2, w3; };
__device__ __forceinline__ WCtx w_ctx(int lane, int t, const float* W) { const f32x4* wp = (const f32x4*)(W + (size_t)t * 128 + (lane >> 3) * 16); WCtx c; c.w0 = wp[0]; c.w1 = wp[1]; c.w2 = wp[2]; c.w3 = wp[3]; return c; }
__device__ __forceinline__ void v_compute(int lane, int t, int s, const WCtx& wc, const u32x4 (&row)[16], unsigned short* PO) {
    const int rs = lane >> 3, c8 = lane & 7;
    f32x2_t o[8];
#pragma unroll
    for (int i = 0; i < 8; ++i) o[i] = (f32x2_t){0.f, 0.f};
#pragma unroll
    for (int j = 0; j < 16; ++j) {
        const f32x4 wq = j < 4 ? wc.w0 : j < 8 ? wc.w1 : j < 12 ? wc.w2 : wc.w3; const int jj = j & 3; const float wj = jj == 0 ? wq.x : jj == 1 ? wq.y : jj == 2 ? wq.z : wq.w; const f32x2_t w2v = {wj, wj};
#pragma unroll
        for (int w = 0; w < 4; ++w) { const unsigned q = getw(row[j], w);
            o[2 * w] = __builtin_elementwise_fma(__builtin_amdgcn_cvt_pk_f32_fp8(q, false), w2v, o[2 * w]); o[2 * w + 1] = __builtin_elementwise_fma(__builtin_amdgcn_cvt_pk_f32_fp8(q, true), w2v, o[2 * w + 1]); }
    }
    float of[16];
#pragma unroll
    for (int i = 0; i < 8; ++i) { of[2 * i] = o[i].x; of[2 * i + 1] = o[i].y; }
#pragma unroll
    for (int i = 0; i < 16; ++i) { float x = of[i]; x += dppf<XOR8>(x);
        auto s1 = __builtin_amdgcn_permlane16_swap(__float_as_uint(x), __float_as_uint(x), false, false); x = __uint_as_float(s1[0]) + __uint_as_float(s1[1]);
        auto s2 = __builtin_amdgcn_permlane32_swap(__float_as_uint(x), __float_as_uint(x), false, false); of[i] = __uint_as_float(s2[0]) + __uint_as_float(s2[1]); }
    if (rs == 0) {
        unsigned short* po = PO + (size_t)t * DM + s * 128 + c8 * 16;
        *(u32x4*)po = (u32x4){pkbf(of[0], of[1]), pkbf(of[2], of[3]), pkbf(of[4], of[5]), pkbf(of[6], of[7])};
        *(u32x4*)(po + 8) = (u32x4){pkbf(of[8], of[9]), pkbf(of[10], of[11]), pkbf(of[12], of[13]), pkbf(of[14], of[15])};
    }
}
__device__ __forceinline__ void vpass_slice(int lane, int s, int wv, int nwv, const unsigned char* V8s, const unsigned short* E, const float* W, unsigned short* PO) {
    const int c8 = lane & 7;
    int t = wv; if (t >= NTOK) return;
    ECtx eA = e_ctx(lane, t, E), eB = e_ctx(lane, TCL(t + nwv), E); WCtx wA = w_ctx(lane, t, W), wB;
    u32x4 rA[16], rB[16];
    g_rows(rA, eA, V8s, c8);
    for (; t < NTOK; t += 2 * nwv) {
        eA = e_ctx(lane, TCL(t + 2 * nwv), E); wB = w_ctx(lane, TCL(t + nwv), W); g_rows(rB, eB, V8s, c8);
        v_compute(lane, t, s, wA, rA, PO);
        eB = e_ctx(lane, TCL(t + 3 * nwv), E); wA = w_ctx(lane, TCL(t + 2 * nwv), W); g_rows(rA, eA, V8s, c8);
        if (t + nwv < NTOK) v_compute(lane, t + nwv, s, wB, rB, PO);
    }
}
#undef TCL
__device__ __forceinline__ void final_token(int lane, int t, float* Y, const unsigned short* HB, const unsigned short* PO, const float* gfin) {
    f32x4* yr = (f32x4*)(Y + (size_t)t * DM) + lane; const u32x2_t* pr = (const u32x2_t*)(PO + (size_t)t * DM) + lane; const u32x2_t* hr = (const u32x2_t*)(HB + (size_t)t * DM) + lane;
    f32x4 v[4]; float ss = 0.f;
#pragma unroll
    for (int j = 0; j < 4; ++j) { const u32x2_t hw = hr[64 * j]; v[j] = (f32x4){bflo(hw.x), bfhi(hw.x), bflo(hw.y), bfhi(hw.y)}; const u32x2_t p = pr[64 * j]; v[j][0] += bflo(p.x); v[j][1] += bfhi(p.x); v[j][2] += bflo(p.y); v[j][3] += bfhi(p.y);
        ss += (v[j][0] * v[j][0] + v[j][1] * v[j][1]) + (v[j][2] * v[j][2] + v[j][3] * v[j][3]); }
    const float rstd = 1.0f / sqrtf(wave_sum(ss) * (1.0f / DM) + EPS);
#pragma unroll
    for (int j = 0; j < 4; ++j) { const f32x4 g = *((const f32x4*)gfin + lane + 64 * j); yr[64 * j] = (f32x4){v[j][0] * rstd * g[0], v[j][1] * rstd * g[1], v[j][2] * rstd * g[2], v[j][3] * rstd * g[3]}; }
}
}

constexpr int NWAVES = 8;
#ifndef MK_N_LAUNCHES
#define MK_N_LAUNCHES 1
#endif
constexpr int N_LAUNCHES = MK_N_LAUNCHES;
constexpr int PER_PHASE = 7;
#ifndef PROBE
#define PROBE -1
#endif
#ifndef DIAG_SEL
#define DIAG_SEL -1
#endif
#ifndef TAIL_R0
#define TAIL_R0 6144
#endif
#ifndef XVAR
#define XVAR 0
#endif
#define NREP(k) ((PROBE == (k)) ? 2 : 1)

typedef unsigned short bf16;
typedef unsigned v4u __attribute__((ext_vector_type(4)));
typedef float f32x4 __attribute__((ext_vector_type(4)));
#define LDS_WAIT() asm volatile("s_waitcnt lgkmcnt(0)" ::: "memory")
#define VM_WAIT() asm volatile("s_waitcnt vmcnt(0)" ::: "memory")

constexpr size_t MiB = 1u << 20;
constexpr size_t WS_CTL = 0, CTL_ZERO_BYTES = 64 * 1024;
constexpr size_t WS_TAB = 1 * MiB;
constexpr size_t WS_SSQ = 1 * MiB + 64 * 1024;
constexpr size_t WS_WIN = 3 * MiB;
constexpr size_t WS_WA = 10 * MiB, WS_WB = 11 * MiB;
constexpr size_t WS_WO = 12 * MiB;
constexpr size_t WS_WE = 14 * MiB;
constexpr size_t WS_U8 = 18 * MiB, WS_V8 = 34 * MiB;
constexpr size_t WS_PA = 50 * MiB;
constexpr size_t WS_INVU = 2 * MiB + 128 * 1024, WS_INVV = WS_INVU + 64 * 1024;
constexpr size_t WS_RSTD = WS_INVV + 64 * 1024;
constexpr size_t WS_G = 3 * MiB, WS_E = 11 * MiB;
constexpr size_t WS_W = 114 * MiB, WS_PSS = 122 * MiB;
constexpr int CW_RANK = 8192;
constexpr size_t WS_XN = 82 * MiB;
constexpr size_t WS_ACT = 114 * MiB;
constexpr size_t WS_QA = WS_ACT, WS_QB = WS_ACT + 512 * 2;
constexpr size_t WS_KA = WS_ACT + 32 * MiB, WS_VA = WS_ACT + 36 * MiB, WS_KB = WS_ACT + 40 * MiB, WS_VB = WS_ACT + 44 * MiB;
constexpr size_t WS_GA = WS_ACT + 48 * MiB, WS_GB = WS_ACT + 80 * MiB;
constexpr size_t WS_SC = WS_ACT;
constexpr size_t WS_END = 242 * MiB;
static_assert(WS_GB + 32 * MiB <= WS_END && WS_SC + (size_t)NTOK * SCW * 4 <= WS_END, "d_ws map");

constexpr int RING_BYTES = 131072;
constexpr int MISC_OFF = RING_BYTES + 320;
constexpr int LDS_BYTES = 147456;

#define XB_TMO      128
#define XB_XCNT(j)  (256  + 64 * (j))
#define XB_XSUB(j)  (1280 + 64 * (j))
#define XB_XGEN(j)  (2304 + 64 * (j))
#define XB_TOP      3328
#define XB_TOPGEN   3392
#define XCD_BAR_WORDS 3456
#define XB_SPIN_CAP (1u << 18)

__device__ __forceinline__ unsigned xb_ld(unsigned* p)              { return __hip_atomic_load(p, __ATOMIC_RELAXED, __HIP_MEMORY_SCOPE_AGENT); }
__device__ __forceinline__ unsigned xb_add(unsigned* p, unsigned v) { return __hip_atomic_fetch_add(p, v, __ATOMIC_RELAXED, __HIP_MEMORY_SCOPE_AGENT); }
__device__ __forceinline__ unsigned xb_xcc_id() { return (unsigned)__builtin_amdgcn_s_getreg((3 << 11) | 20) & 0xFu; }
#define XB_SPIN(cond, bar) do { unsigned _sp = 0; while (cond) { __builtin_amdgcn_s_sleep(1); \
    if ((++_sp & 255u) == 0u) { if (xb_ld(&(bar)[XB_TMO])) break; if (_sp > XB_SPIN_CAP) { atomicAdd(&(bar)[XB_TMO], 1u); break; } } } } while (0)

struct XcdBarrier {
    unsigned* bar; unsigned x;
    volatile LAS unsigned* st;
};

__device__ __forceinline__ XcdBarrier xcd_barrier_post(unsigned* bar, volatile LAS unsigned* st) {
    XcdBarrier b; b.bar = bar; b.x = xb_xcc_id(); b.st = st;
    if (threadIdx.x == 0) (void)xb_add(&bar[XB_XCNT(b.x)], 1u);
    return b;
}
__device__ __forceinline__ void xcd_barrier_complete(unsigned* bar, unsigned x, unsigned& nloc, unsigned& nx) {
    const unsigned G = gridDim.x * gridDim.y * gridDim.z;
    unsigned sum, cnt, mine, sp = 0u;
    for (;;) {
        sum = 0u; cnt = 0u; mine = 0u;
#pragma unroll
        for (unsigned j = 0; j < 16; ++j) { const unsigned c = xb_ld(&bar[XB_XCNT(j)]); sum += c; cnt += (c > 0u) ? 1u : 0u; mine = (j == x) ? c : mine; }
        if (sum == G) break;
        __builtin_amdgcn_s_sleep(1);
        if ((++sp & 255u) == 0u) { if (xb_ld(&bar[XB_TMO])) break; if (sp > XB_SPIN_CAP) { atomicAdd(&bar[XB_TMO], 1u); break; } }
    }
    nloc = mine > 0u ? mine : 1u; nx = cnt > 0u ? cnt : 1u;
}

__device__ __forceinline__ void xcd_barrier(const XcdBarrier& b) {
    asm volatile("s_waitcnt vmcnt(0)" ::: "memory");
    __syncthreads();
    if (threadIdx.x == 0) {
        unsigned* bar = b.bar;
        __builtin_amdgcn_s_waitcnt(0);
        unsigned nloc = b.st[0], nx = b.st[1];
        if (nloc == 0u) { xcd_barrier_complete(bar, b.x, nloc, nx); b.st[0] = nloc; b.st[1] = nx; }
        const unsigned old = xb_add(&bar[XB_XSUB(b.x)], 1u);
        const unsigned gen = old / nloc;
        if (old + 1u == (gen + 1u) * nloc) {
            __builtin_amdgcn_fence(__ATOMIC_RELEASE, "agent");
            asm volatile("s_waitcnt vmcnt(0)" ::: "memory");
            const unsigned og = xb_add(&bar[XB_TOP], 1u);
            const unsigned tg = og / nx;
            if (og + 1u == (tg + 1u) * nx) xb_add(&bar[XB_TOPGEN], 1u);
            else XB_SPIN(xb_ld(&bar[XB_TOPGEN]) == tg, bar);
            __builtin_amdgcn_fence(__ATOMIC_ACQUIRE, "agent");
            xb_add(&bar[XB_XGEN(b.x)], 1u);
            asm volatile("s_waitcnt vmcnt(0)" ::: "memory");
        } else {
            XB_SPIN(xb_ld(&bar[XB_XGEN(b.x)]) == gen, bar);
            __builtin_amdgcn_fence(__ATOMIC_ACQUIRE, "agent");
            asm volatile("s_waitcnt vmcnt(0)" ::: "memory");
        }
    }
    __syncthreads();
}


struct Args { const float* in[17]; float* out; unsigned char* ws; int ph_lo, ph_hi, li, pad; };

__device__ __forceinline__ void p0_transpose_item(const float* W, int K, int N, bf16* WT, int k0, int src_n0, int dst_n0, LAS float* scr, int lane, int dpitch = 0, int dk0 = 0, bool split16 = false) {
    if (dpitch == 0) dpitch = K;
    const int sl = split16 ? ((lane & 15) + ((lane & 16) << 1)) : (lane & 31);
#pragma unroll 8
    for (int i = 0; i < 32; ++i) { const int kk = 2 * i + (lane >> 5); scr[kk * 33 + (lane & 31)] = W[(size_t)(k0 + kk) * N + src_n0 + sl]; }
    LDS_WAIT();
    const int c = lane & 7;
#pragma unroll
    for (int j = 0; j < 4; ++j) { const int n = (lane >> 3) + 8 * j; const LAS float* s = scr + (8 * c) * 33 + n;
        v4u o; o.x = pkbf(s[0 * 33], s[1 * 33]); o.y = pkbf(s[2 * 33], s[3 * 33]); o.z = pkbf(s[4 * 33], s[5 * 33]); o.w = pkbf(s[6 * 33], s[7 * 33]);
        *(v4u*)(WT + (size_t)(dst_n0 + n) * dpitch + dk0 + k0 + 8 * c) = o; }
    LDS_WAIT();
}
__device__ __forceinline__ int win_src_col(int dst_n0) {
    if (dst_n0 >= 1536) return dst_n0;
    const int tile = dst_n0 >> 8, c = dst_n0 & 255;
    return tile * 256 + 64 * ((c >> 5) & 3) + 16 * (c >> 7);
}
__device__ __forceinline__ int t5_bucket(int rel) {
    const int n = rel < 0 ? -rel : rel; int bkt;
    if (n < 8) bkt = n; else { int v = 8 + (31 - __builtin_clz(n * n)) - 6; bkt = v > 15 ? 15 : v; }
    return bkt + (rel > 0 ? 16 : 0);
}

__global__ void __launch_bounds__(NWAVES * 64, 2) mk_fwd(Args args) {
    extern __shared__ __attribute__((aligned(16))) unsigned char lds_raw[];
    LAS unsigned char* lds = (LAS unsigned char*)lds_raw;
    volatile LAS unsigned* MISC = (volatile LAS unsigned*)(lds + MISC_OFF);
    const int tid = threadIdx.x, lane = tid & 63, wave = __builtin_amdgcn_readfirstlane(tid >> 6);
    const int G = gridDim.x, bx = blockIdx.x; const int vcu = (G % 8 == 0) ? (bx % 8) * (G / 8) + bx / 8 : bx;
    const int gw = vcu * NWAVES + wave, NGW = G * NWAVES;
    unsigned char* ws = args.ws;
    const float* x = args.in[0]; const float* g_mix = args.in[1]; const float* w_in = args.in[2]; const float* b_gate = args.in[3];
    const float* q_norm_g = args.in[4]; const float* k_norm_g = args.in[5]; const float* rel_bias = args.in[6]; const float* sink = args.in[7];
    const float* w_a = args.in[8]; const float* w_b = args.in[9]; const float* w_out = args.in[10]; const float* g_ffn = args.in[11];
    const float* peer_wq = args.in[12]; const float* subkeys = args.in[13]; const float* peer_u = args.in[14]; const float* peer_v = args.in[15]; const float* g_final = args.in[16];
    float* out = args.out;
    float* ROPE = (float*)(ws + WS_TAB); float* BIAS = (float*)(ws + WS_TAB + 16384); float* SSQ = (float*)(ws + WS_SSQ);
    bf16 *WIN_T = (bf16*)(ws + WS_WIN), *WA_T = (bf16*)(ws + WS_WA), *WB_T = (bf16*)(ws + WS_WB), *WO_T = (bf16*)(ws + WS_WO), *WE_T = (bf16*)(ws + WS_WE);
    unsigned char *U8 = ws + WS_U8, *V8 = ws + WS_V8; bf16 *PA = (bf16*)(ws + WS_PA), *XN = (bf16*)(ws + WS_XN);
    float* RSTD = (float*)(ws + WS_RSTD); float *INVU = (float*)(ws + WS_INVU), *INVV = (float*)(ws + WS_INVV), *RG = (float*)(ws + WS_G), *RW = (float*)(ws + WS_W), *PSS = (float*)(ws + WS_PSS); bf16* RE = (bf16*)(ws + WS_E);
    bf16 *QA = (bf16*)(ws + WS_QA), *QB = (bf16*)(ws + WS_QB), *KA = (bf16*)(ws + WS_KA), *VA = (bf16*)(ws + WS_VA), *KB = (bf16*)(ws + WS_KB), *VB = (bf16*)(ws + WS_VB);
    bf16 *GA = (bf16*)(ws + WS_GA), *GB = (bf16*)(ws + WS_GB); bf16* SC = (bf16*)(ws + WS_SC);

    for (int u = tid; u < (LDS_BYTES - RING_BYTES) / 4; u += NWAVES * 64) ((LAS unsigned*)(lds + RING_BYTES))[u] = 0u;
    __syncthreads();
    XcdBarrier bar; bar.bar = (unsigned*)(ws + WS_CTL) + 1024; bar.x = 0; bar.st = nullptr;
    if (N_LAUNCHES != PER_PHASE) bar = xcd_barrier_post((unsigned*)(ws + WS_CTL) + 1024, MISC + 8);
    if (tid == 0) { const unsigned xc = xb_xcc_id(); MISC[13] = xc; MISC[12] = xb_add((unsigned*)(ws + WS_CTL) + CW_RANK + 64 * xc, 1u); }
    const bool tail_tables = (G == 256);
    const int lo = args.ph_lo, hi = args.ph_hi;
#define IN(k) (lo <= (k) && (k) < hi)
#define BOTH(k) (IN(k) && IN((k) + 1))
#define GRID_BAR() do { if (N_LAUNCHES != PER_PHASE) xcd_barrier(bar); STAMP(); } while (0)
#ifdef TSEL
    int n_stamp_ = 0;
#define STAMP() do { if (tid == 0) MISC[16 + n_stamp_] = (unsigned)__builtin_amdgcn_s_memrealtime(); ++n_stamp_; } while (0)
#else
#define STAMP() do { } while (0)
#endif
    STAMP();

    if (IN(0)) for (int rep_ = 0; rep_ < NREP(0); ++rep_) {
        if (rep_) { VM_WAIT(); __syncthreads(); }
        LAS float* scr = (LAS float*)(lds + wave * 16384);
        {
            constexpr int I_IN = (DM / 64) * (INW / 32), I_AB = (QW / 64) * (DM / 32), I_O = (DM / 64) * (DM / 32);
            constexpr int NITEMS = I_IN + 2 * I_AB + I_O;
            for (int it = gw; it < NITEMS; it += NGW) {
                int r = it;
                if (r < I_IN) { const int nblk = INW / 32, kb = r / nblk, nb = r % nblk; p0_transpose_item(w_in, DM, INW, WIN_T, 64 * kb, win_src_col(32 * nb), 32 * nb, scr, lane, 0, 0, 32 * nb < 1536); continue; } r -= I_IN;
                if (r < I_AB) { const int nblk = DM / 32, kb = r / nblk, nb = r % nblk; p0_transpose_item(w_a, QW, DM, WA_T, 64 * kb, 32 * nb, 32 * nb, scr, lane, DM, 0); continue; } r -= I_AB;
                if (r < I_AB) { const int nblk = DM / 32, kb = r / nblk, nb = r % nblk; p0_transpose_item(w_b, QW, DM, WA_T, 64 * kb, 32 * nb, 32 * nb, scr, lane, DM, QW); continue; }   r -= I_AB;
                { const int nblk = DM / 32, kb = r / nblk, nb = r % nblk; p0_transpose_item(w_out, DM, DM, WO_T, 64 * kb, 32 * nb, 32 * nb, scr, lane); }
            }
        }
        __syncthreads();
        {
            LAS float* sk_s = (LAS float*)lds;
            LAS float* wq_s = (LAS float*)(lds + 128 * 129 * 4);
            for (int it = vcu; it < 16 * 16; it += G) {
                const int c = it >> 4, k0 = (it & 15) * 64;
                for (int i = tid; i < 128 * 32; i += NWAVES * 64) { const int n = i >> 5, d4 = (i & 31) * 4; const f32x4 v = *(const f32x4*)(subkeys + ((size_t)c * NKEYS + n) * 128 + d4);
                    sk_s[n * 129 + d4] = v[0]; sk_s[n * 129 + d4 + 1] = v[1]; sk_s[n * 129 + d4 + 2] = v[2]; sk_s[n * 129 + d4 + 3] = v[3]; }
                for (int i = tid; i < 64 * 32; i += NWAVES * 64) { const int k = i >> 5, d4 = (i & 31) * 4; const f32x4 v = *(const f32x4*)(peer_wq + (size_t)(k0 + k) * SCW + c * 128 + d4);
                    wq_s[k * 129 + d4] = v[0]; wq_s[k * 129 + d4 + 1] = v[1]; wq_s[k * 129 + d4 + 2] = v[2]; wq_s[k * 129 + d4 + 3] = v[3]; }
                __syncthreads();
                {
                    typedef float f32x16_t __attribute__((ext_vector_type(16)));
                    const int tn = wave >> 1, tk = wave & 1; f32x16_t acc = {};
                    const LAS float* ap = sk_s + (32 * tn + (lane & 31)) * 129 + (lane >> 5); const LAS float* bp = wq_s + (32 * tk + (lane & 31)) * 129 + (lane >> 5);
#pragma unroll 8
                    for (int s = 0; s < 64; ++s) acc = __builtin_amdgcn_mfma_f32_32x32x2f32(ap[2 * s], bp[2 * s], acc, 0, 0, 0);
                    const float gk = g_ffn[k0 + 32 * tk + (lane & 31)];
#pragma unroll
                    for (int r = 0; r < 16; ++r) { const int n = 32 * tn + (r & 3) + 8 * (r >> 2) + 4 * (lane >> 5);
                        WE_T[(size_t)(c * 128 + n) * DM + k0 + 32 * tk + (lane & 31)] = (bf16)(pkbf(acc[r] * gk, 0.f) & 0xffffu); }
                }
                __syncthreads();
            }
        }
        peer::tables_fp8(peer_u, peer_v, U8, V8, INVU, INVV, 0, tail_tables ? TAIL_R0 : NEXP, gw, NGW, lane);
        for (int m = gw; m < NTOK; m += 2 * NGW) {
            const int m2 = (m + NGW < NTOK) ? m + NGW : m;
            const f32x4* xr = (const f32x4*)(x + (size_t)m * DM) + lane; const f32x4* xr2 = (const f32x4*)(x + (size_t)m2 * DM) + lane; f32x4 v[4], v2[4]; float s = 0.f, s2 = 0.f;
#pragma unroll
            for (int j = 0; j < 4; ++j) { v[j] = __builtin_nontemporal_load(xr + 64 * j); v2[j] = __builtin_nontemporal_load(xr2 + 64 * j); }
#pragma unroll
            for (int j = 0; j < 4; ++j) { s += (v[j][0] * v[j][0] + v[j][1] * v[j][1]) + (v[j][2] * v[j][2] + v[j][3] * v[j][3]); s2 += (v2[j][0] * v2[j][0] + v2[j][1] * v2[j][1]) + (v2[j][2] * v2[j][2] + v2[j][3] * v2[j][3]); }
            const float rstd = 1.0f / sqrtf(peer::wave_sum(s) * (1.0f / DM) + EPS), rstd2 = 1.0f / sqrtf(peer::wave_sum(s2) * (1.0f / DM) + EPS);
            unsigned long long* o8 = (unsigned long long*)(XN + (size_t)m * DM) + lane; unsigned long long* o82 = (unsigned long long*)(XN + (size_t)m2 * DM) + lane;
#pragma unroll
            for (int j = 0; j < 4; ++j) { const f32x4 g = *((const f32x4*)g_mix + lane + 64 * j);
                o8[64 * j] = (unsigned long long)pkbf(v[j][0] * rstd * g[0], v[j][1] * rstd * g[1]) | ((unsigned long long)pkbf(v[j][2] * rstd * g[2], v[j][3] * rstd * g[3]) << 32);
                o82[64 * j] = (unsigned long long)pkbf(v2[j][0] * rstd2 * g[0], v2[j][1] * rstd2 * g[1]) | ((unsigned long long)pkbf(v2[j][2] * rstd2 * g[2], v2[j][3] * rstd2 * g[3]) << 32); }
        }
        if (vcu == 0) {
            for (int i = tid; i < 64 * 16; i += NWAVES * 64) { const int pos = i >> 4, f = i & 15; const float fr = powf(10000.0f, -(float)f / 16.0f); const float ang = (float)pos * fr; ROPE[2 * i] = cosf(ang); ROPE[2 * i + 1] = sinf(ang); }
            for (int i = tid; i < 8 * 257; i += NWAVES * 64) { const int h = i / 257, rel = i % 257 - 128; BIAS[i] = rel_bias[t5_bucket(rel) * NH + h] * LOG2E; }
        }
        if (BOTH(0) && rep_ == NREP(0) - 1) GRID_BAR();
    }

    if (IN(1)) {
        pg8::Gemm g{XN, WIN_T, NTOK, INW, DM}; pg8::StaticOrder S; S.init(NTOK, INW, G, bx);
        pg8::EpiIn E{QA, KA, VA, QB, KB, VB, GA, GB, q_norm_g, k_norm_g, b_gate, ROPE};
        if (PROBE == 1) { pg8::gemm_phase<pg8::EpiIn, pg8::StaticOrder, true, true>(lds, g, S, E); VM_WAIT(); __syncthreads(); }
        if (PROBE == 11) { pg8::EpiNull EN{SSQ}; pg8::gemm_phase<pg8::EpiNull, pg8::StaticOrder, true, true>(lds, g, S, EN); VM_WAIT(); __syncthreads(); }
        pg8::gemm_phase<pg8::EpiIn, pg8::StaticOrder, true, true>(lds, g, S, E);
        if (tail_tables && bx >= 128) peer::tables_fp8(peer_u, peer_v, U8, V8, INVU, INVV, TAIL_R0, NEXP, (bx - 128) * NWAVES + wave, 128 * NWAVES, lane);
        if (BOTH(1)) GRID_BAR();
    }

    if (IN(2)) {
#ifdef DIAG_QK
        if (bx == 0) {
            LAS float* red = (LAS float*)lds; float worst = 0.f;
            for (int smp = 0; smp < 10; ++smp) {
                const int row = (smp * 2741 + 77) & (NTOK - 1), b = row >> 12, s = row & (SEQ - 1); const int kind = smp % 5;
                const int hh = (smp * 3 + 1) & 7, kh = smp & 1;
                float ref = 0.f, got = 0.f; const int d = tid & 63;
                if (tid < 64) {
                    int col;
                    if (kind == 0) col = hh * 64 + d; else if (kind == 1) col = 512 + kh * 64 + d; else if (kind == 2) col = (smp < 5 ? 640 : 1408) + kh * 64 + d; else if (kind == 3) col = (smp < 5 ? 768 + hh * 64 : 1280 + kh * 64) + d; else col = (smp < 5 ? 1536 : 2560) + hh * 64 + d;
                    float z = 0.f; for (int k = 0; k < DM; ++k) z += __builtin_bit_cast(float, (unsigned)XN[(size_t)row * DM + k] << 16) * w_in[(size_t)k * INW + col];
                    red[tid] = z;
                }
                __syncthreads();
                if (tid < 64) {
                    float z = red[tid];
                    if (kind == 0 || kind == 1) {
                        float ss = 0.f; for (int i = 0; i < 64; ++i) ss += red[i] * red[i];
                        const float rstd = 1.0f / sqrtf(ss / 64.0f + EPS); const float* g = kind == 0 ? q_norm_g : k_norm_g;
                        const int part = d >> 5, dd = d & 31, f = dd & 15; const int pos = part == 0 ? (s >> 6) : (s & 63);
                        const float ang = (float)pos * powf(10000.0f, -(float)f / 16.0f), cs = cosf(ang), sn = sinf(ang);
                        const float u1 = red[part * 32 + f] * rstd * g[part * 32 + f], u2 = red[part * 32 + 16 + f] * rstd * g[part * 32 + 16 + f];
                        z = dd < 16 ? u1 * cs - u2 * sn : u2 * cs + u1 * sn; if (kind == 0) z *= QSCALE;
                        got = kind == 0 ? __builtin_bit_cast(float, (unsigned)QA[(size_t)row * 1024 + hh * 64 + d] << 16) : __builtin_bit_cast(float, (unsigned)KA[kimg_off(b, kh, s, d)] << 16);
                    } else if (kind == 2) { got = __builtin_bit_cast(float, (unsigned)(smp < 5 ? VA : VB)[vimg_off(b, kh, s, d)] << 16);
                    } else if (kind == 3) { if (smp < 5) { z *= QSCALE; got = __builtin_bit_cast(float, (unsigned)QB[(size_t)row * 1024 + hh * 64 + d] << 16); } else got = __builtin_bit_cast(float, (unsigned)KB[kimg_off(b, kh, s, d)] << 16);
                    } else { z = 1.0f / (1.0f + expf(-(z + b_gate[(smp < 5 ? 0 : DM) + hh * 64 + d]))); got = __builtin_bit_cast(float, (unsigned)(smp < 5 ? GA : GB)[(size_t)row * DM + hh * 64 + d] << 16); }
                    ref = z;
                }
                __syncthreads();
                if (tid < 64) { red[128 + tid] = fabsf(ref - got); red[256 + tid] = fabsf(ref); }
                __syncthreads();
                if (tid == 0) { float e = 0.f, a = 0.f; for (int i = 0; i < 64; ++i) { e = fmaxf(e, red[128 + i]); a = fmaxf(a, red[256 + i]); } const float rel = e / fmaxf(a, 1e-20f); if (DIAG_SEL < 0 || DIAG_SEL == smp) worst = fmaxf(worst, rel); }
                __syncthreads();
            }
            if (tid == 0) MISC[41] = __float_as_uint(worst);
        }
        GRID_BAR();
#endif
        if (PROBE == 21) {
            bf16* DUM = XN;
            for (int u = vcu; u < 512; u += G) { const int xg = u >> 6, i = u & 63; const int b = xg >> 1, h = 4 * (xg & 1) + (i >> 4), qblk = i & 15;
                attn::attn_unit<false, XVAR>((LAS char*)lds, QA, KA, VA, DUM, b, h, qblk, nullptr, 0.f); }
        }
        if (PROBE == 22) {
            bf16* DUM = XN;
            for (int u = vcu; u < 512; u += G) { const int xg = u >> 6, i = u & 63; const int b = xg >> 1, h = 4 * (xg & 1) + (i >> 4), qblk = i & 15;
                attn::attn_unit<true>((LAS char*)lds, QB, KB, VB, DUM, b, h, qblk, BIAS + h * 257, sink[h] * LOG2E); }
        }
#ifdef DIAG_ATTN
        {
            bf16* DUM = XN;
            for (int u = vcu; u < 512; u += G) { const int xg = u >> 6, i = u & 63; const int b = xg >> 1, h = 4 * (xg & 1) + (i >> 4), qblk = i & 15;
                attn::attn_unit<false, 0, DIAG_ATTN == 1>((LAS char*)lds, QA, KA, VA, DUM, b, h, qblk, nullptr, 0.f); }
            for (int u = vcu; u < 512; u += G) { const int xg = u >> 6, i = u & 63; const int b = xg >> 1, h = 4 * (xg & 1) + (i >> 4), qblk = i & 15;
                attn::attn_unit<true>((LAS char*)lds, QB, KB, VB, DUM + 512, b, h, qblk, BIAS + h * 257, sink[h] * LOG2E); }
            GRID_BAR();
            if (bx == 0) {
                LAS float* sc = (LAS float*)lds; LAS float* red = (LAS float*)(lds + 32768); float worst = 0.f;
                for (int smp = 0; smp < 12; ++smp) {
                    const int win = smp & 1; const int b = (smp * 7 + 1) & 3, h = (smp * 5 + 3) & 7, q = smp == 1 ? 5 : smp == 3 ? 4090 : smp == 4 ? 4095 : (smp * 977 + 131 * win + (smp == 2 ? 0 : 17)) & 4095; const int kvh = h >> 2;
                    const bf16* Qp = (win ? QB : QA) + ((size_t)b * SEQ + q) * 1024 + h * HD; const bf16* Kp = win ? KB : KA; const bf16* Vp = win ? VB : VA;
                    float mx = -1e30f;
                    for (int j = tid; j < SEQ; j += 512) { float s = 0.f;
                        for (int d = 0; d < HD; ++d) s += __builtin_bit_cast(float, (unsigned)Qp[d] << 16) * __builtin_bit_cast(float, (unsigned)Kp[kimg_off(b, kvh, j, d)] << 16);
                        if (win) { const int rel = j - q; s = (rel >= -128 && rel <= 128) ? s + BIAS[h * 257 + rel + 128] : -1e30f; }
                        sc[j] = s; mx = fmaxf(mx, s); }
                    red[tid] = mx; __syncthreads();
                    if (tid == 0) { float m = -1e30f; for (int i = 0; i < 512; ++i) m = fmaxf(m, red[i]); if (win) m = fmaxf(m, sink[h] * LOG2E); red[512] = m; } __syncthreads();
                    const float m = red[512]; float ls = 0.f;
                    for (int j = tid; j < SEQ; j += 512) { const float p = exp2f(sc[j] - m); sc[j] = p; ls += p; }
                    __syncthreads(); red[tid] = ls; __syncthreads();
                    if (tid == 0) { float l = 0.f; for (int i = 0; i < 512; ++i) l += red[i]; if (win) l += exp2f(sink[h] * LOG2E - m); red[513] = l; } __syncthreads();
                    if (tid < HD) { float o = 0.f; for (int j = 0; j < SEQ; ++j) o += sc[j] * __builtin_bit_cast(float, (unsigned)Vp[vimg_off(b, kvh, j, tid)] << 16);
                        o /= red[513]; const float t = __builtin_bit_cast(float, (unsigned)DUM[((size_t)b * SEQ + q) * 1024 + win * 512 + h * HD + tid] << 16);
                        red[600 + tid] = fabsf(o - t); red[700 + tid] = fabsf(o); }
                    __syncthreads();
                    if (tid == 0) { float e = 0.f, a = 0.f; for (int i = 0; i < HD; ++i) { e = fmaxf(e, red[600 + i]); a = fmaxf(a, red[700 + i]); } const float rel = e / fmaxf(a, 1e-20f); if (DIAG_SEL < 0 || DIAG_SEL == smp) worst = fmaxf(worst, rel); }
                    __syncthreads();
                }
                if (tid == 0) MISC[40] = __float_as_uint(worst);
            }
            GRID_BAR();
        }
#endif
        float lbound;
        { const float gq = tid < HD ? fabsf(q_norm_g[tid]) : 0.f, gk = tid < HD ? fabsf(k_norm_g[tid]) : 0.f;
          const float mq = peer::wave_max(gq), mk = peer::wave_max(gk); LAS float* lb = (LAS float*)(lds + 70000);
          if (tid == 0) lb[0] = 64.0f * mq * mk * QSCALE * 1.02f; __syncthreads(); lbound = lb[0]; __syncthreads(); }
        const bool nomax = lbound <= 100.0f;
        for (int u = vcu; u < 512; u += G) { const int xg = u >> 6, i = u & 63; const int b = xg >> 1, h = 4 * (xg & 1) + (i >> 4), qblk = i & 15;
            if (nomax) attn::attn_unit<false, 0, true>((LAS char*)lds, QA, KA, VA, QA, b, h, qblk, nullptr, 0.f);
            else attn::attn_unit<false>((LAS char*)lds, QA, KA, VA, QA, b, h, qblk, nullptr, 0.f); }
        for (int u = vcu; u < 512; u += G) { const int xg = u >> 6, i = u & 63; const int b = xg >> 1, h = 4 * (xg & 1) + (i >> 4), qblk = i & 15;
            attn::attn_unit<true>((LAS char*)lds, QB, KB, VB, QB, b, h, qblk, BIAS + h * 257, sink[h] * LOG2E); }
        if (BOTH(2)) GRID_BAR();
    }

    if (IN(3)) {
        pg8::Gemm g{QA, WA_T, NTOK, DM, DM}; pg8::StaticOrder S; S.init(NTOK, DM, G, bx); pg8::EpiMix E{GA, GB, GB};
        if (PROBE == 3) { pg8::EpiMix E2{GA, GB, XN}; pg8::gemm_phase<pg8::EpiMix, pg8::StaticOrder, true, true>(lds, g, S, E2); VM_WAIT(); __syncthreads(); }
        pg8::gemm_phase<pg8::EpiMix, pg8::StaticOrder, true, true>(lds, g, S, E);
        if (BOTH(3)) GRID_BAR();
    }

    if (IN(4)) {
        pg8::Gemm g{GB, WO_T, NTOK, DM, DM}; pg8::StaticOrder S; S.init(NTOK, DM, G, bx); pg8::EpiOut E{x, XN, SSQ};
        for (int rep_ = 0; rep_ < NREP(4); ++rep_) pg8::gemm_phase<pg8::EpiOut, pg8::StaticOrder, true, true>(lds, g, S, E);
        if (BOTH(4)) GRID_BAR();
    }

    if (IN(5)) {
        pg8::Gemm g{XN, WE_T, NTOK, SCW, DM}; pg8::StaticOrder S; S.init(NTOK, SCW, G, bx); pg8::EpiScore E{SSQ, SC};
        for (int rep_ = 0; rep_ < NREP(5); ++rep_) pg8::gemm_phase<pg8::EpiScore, pg8::StaticOrder, true, true>(lds, g, S, E);
        if (BOTH(5)) GRID_BAR();
    }

    if (IN(6)) {
        LAS char* wl = (LAS char*)lds + wave * peer::WAVE_LDS;
        const unsigned long long ct = peer::cand_table(lane & 7);
        for (int rep_ = 0; rep_ < NREP(60); ++rep_) {
            peer::SCtx sA = peer::s_ctx(lane, gw < NTOK ? gw : 0, SC), sB;
            for (int t = gw; t < NTOK; t += 2 * NGW) {
                sB = peer::s_ctx(lane, t + NGW < NTOK ? t + NGW : t, SC);
                peer::route_token(wl, lane, t, ct, sA, SSQ, RE, RG, RSTD);
                sA = peer::s_ctx(lane, t + 2 * NGW < NTOK ? t + 2 * NGW : t, SC);
                if (t + NGW < NTOK) peer::route_token(wl, lane, t + NGW, ct, sB, SSQ, RE, RG, RSTD);
            }
        }
        GRID_BAR();
        int nloc = 0, nx = 0, ox = 0; const int myx = (int)MISC[13], rank = (int)MISC[12];
#pragma unroll
        for (int j = 0; j < 16; ++j) { const int c = (int)xb_ld((unsigned*)(ws + WS_CTL) + CW_RANK + 64 * j); nx += c > 0; ox += (c > 0 && j < myx); nloc = j == myx ? c : nloc; }
        const int wv = rank * NWAVES + wave, nwv = nloc * NWAVES;
        for (int rep_ = 0; rep_ < NREP(61); ++rep_) for (int s = ox; s < 8; s += nx) { const unsigned char* U8s = U8 + (size_t)s * peer::SLICE_BYTES;
            peer::upass_slice(lane, s, wv, nwv, U8s, RE, XN, RSTD, g_ffn, PA); }
        GRID_BAR();
        for (int rep_ = 0; rep_ < NREP(62); ++rep_) for (int t = gw; t < NTOK; t += NGW) peer::wpass_tokens<1>(lane, t, NGW, RE, RG, PA, INVU, INVV, RW);
        GRID_BAR();
        for (int s = ox; s < 8; s += nx) { const unsigned char* V8s = V8 + (size_t)s * peer::SLICE_BYTES;
            for (int rep_ = 0; rep_ < NREP(63); ++rep_) peer::vpass_slice(lane, s, wv, nwv, V8s, RE, RW, PA); }
        GRID_BAR();
        if (PROBE == 200) { for (int r_ = 0; r_ < 10; ++r_) GRID_BAR(); }
        for (int t = gw; t < NTOK; t += NGW) peer::final_token(lane, t, out, XN, PA, g_final);
#ifdef DIAG_ATTN
        if (bx == 0 && tid == 0) { VM_WAIT(); out[0] += 1000.0f * __uint_as_float(MISC[40]); }
#endif
#ifdef DIAG_QK
        if (bx == 0 && tid == 0) { VM_WAIT(); out[0] += 1000.0f * __uint_as_float(MISC[41]); }
#endif
#ifdef TSEL
        STAMP();
        if (bx == 0 && tid == 0) { VM_WAIT(); const unsigned d = MISC[16 + TSEL + 1] - MISC[16 + TSEL]; out[0] += (float)d * 0.001f; }
#endif
    }
#undef IN
#undef BOTH
#undef GRID_BAR
}

extern "C" void kernel_launch(void* const* d_in, const int* in_sizes, int n_in, void* d_out, int out_size, void* d_ws, size_t ws_size, hipStream_t stream) {
    static int grid = 0;
    if (grid == 0) {
        if (n_in != 17 || in_sizes[0] != NTOK * DM || out_size != NTOK * DM || ws_size < WS_END) { fprintf(stderr, "kernel_launch: unexpected shapes (n_in %d, in0 %d, out %d, ws %zu); nothing launched\n", n_in, n_in > 0 ? in_sizes[0] : -1, out_size, ws_size); grid = -1; return; }
        int dev = 0, cus = 0, per_cu = 0;
        if (hipGetDevice(&dev) != hipSuccess || hipDeviceGetAttribute(&cus, hipDeviceAttributeMultiprocessorCount, dev) != hipSuccess) { grid = -1; return; }
        if (hipFuncSetAttribute((const void*)mk_fwd, hipFuncAttributeMaxDynamicSharedMemorySize, LDS_BYTES) != hipSuccess) { fprintf(stderr, "kernel_launch: hipFuncSetAttribute failed\n"); grid = -1; return; }
        if (hipOccupancyMaxActiveBlocksPerMultiprocessor(&per_cu, (const void*)mk_fwd, NWAVES * 64, LDS_BYTES) != hipSuccess || per_cu < 1) { fprintf(stderr, "kernel_launch: occupancy query says %d blocks per CU; nothing launched\n", per_cu); (void)hipGetLastError(); grid = -1; return; }
        grid = cus;
    }
    if (grid < 0) return;
    if (hipMemsetAsync((char*)d_ws + WS_CTL, 0, CTL_ZERO_BYTES, stream) != hipSuccess) { fprintf(stderr, "kernel_launch: hipMemsetAsync failed\n"); return; }
    Args a{};
    for (int i = 0; i < 17; ++i) a.in[i] = (const float*)d_in[i];
    a.out = (float*)d_out; a.ws = (unsigned char*)d_ws;
    if (N_LAUNCHES == 1) {
        a.ph_lo = 0; a.ph_hi = PER_PHASE; a.li = 0;
#if defined(COOP_LAUNCH)
        void* kargs[] = {&a};
        hipError_t e = hipLaunchCooperativeKernel((const void*)mk_fwd, dim3(grid), dim3(NWAVES * 64), kargs, LDS_BYTES, stream);
        if (e != hipSuccess) fprintf(stderr, "kernel_launch: cooperative launch failed: %s (grid %d)\n", hipGetErrorString(e), grid);
#else
        if (PROBE == 100) { hipLaunchKernelGGL(mk_fwd, dim3(grid), dim3(NWAVES * 64), LDS_BYTES, stream, a); (void)hipMemsetAsync((char*)d_ws + WS_CTL, 0, CTL_ZERO_BYTES, stream); }
        hipLaunchKernelGGL(mk_fwd, dim3(grid), dim3(NWAVES * 64), LDS_BYTES, stream, a);
#endif
    } else {
        for (int li = 0; li < PER_PHASE; ++li) { a.ph_lo = li; a.ph_hi = li + 1; a.li = li;
            hipLaunchKernelGGL(mk_fwd, dim3(grid), dim3(NWAVES * 64), LDS_BYTES, stream, a); }
    }
}
```

```cpp
#include <hip/hip_runtime.h>
#include <cstdio>
#include <cstdint>
#include <cmath>
namespace pg8 {
#define PG8_LAS __attribute__((address_space(3)))
typedef unsigned short bf16_t;
typedef short bf16x8 __attribute__((ext_vector_type(8)));
typedef float f32x4 __attribute__((ext_vector_type(4)));
typedef unsigned u32x4 __attribute__((ext_vector_type(4)));
constexpr int BM = 256, BK = 64, HALF = 128, HTB = HALF * BK * 2  , STAGE_BYTES = 8 * HTB, NXCD = 8, WGM = 8;

__host__ __device__ __forceinline__ int lds_byte(int r, int c) { const int st = (r >> 4) * 2 + (c >> 5), rr = r & 15, cc = c & 31, ob = rr * 64 + cc * 2; return st * 1024 + (ob ^ (((ob >> 9) & 1) << 5)); }
__host__ __device__ __forceinline__ void stage_rc(int b, int& R, int& C) { const int st = b / 1024, sb = b % 1024, swz = sb ^ (((sb >> 9) & 1) << 5); R = (st >> 1) * 16 + swz / 64; C = (st & 1) * 32 + (swz % 64) / 2; }
__host__ __device__ __forceinline__ int perm32(int rho) { const int n = rho >> 4, i = rho & 15; return 8 * (i >> 2) + 4 * n + (i & 3); }

struct Unit { int pm, pn; };
struct Gemm { const bf16_t* A; const bf16_t* Bt; int M, N, K; };

struct StaticOrder {
    int nM, nN, nwg, G, c;
    __host__ __device__ void init(int M, int N, int G_, int c_) { nM = M / BM; nN = N / BM; nwg = nM * nN; G = G_; c = c_; }
    __host__ __device__ bool next(int i, Unit& u) const {
        const long L = (long)i * G + c; if (L >= nwg) return false;
        int wgid = (int)L; { const int q = nwg / NXCD, r = nwg % NXCD, xcd = wgid % NXCD, off = wgid / NXCD; wgid = (xcd < r ? xcd * (q + 1) : r * (q + 1) + (xcd - r) * q) + off; }
        const int nig = WGM * nN, gid = wgid / nig, fm = gid * WGM, gsz = (nM - fm) < WGM ? (nM - fm) : WGM;
        u.pm = fm + ((wgid % nig) % gsz); u.pn = (wgid % nig) / gsz; return true;
    }
    __device__ __forceinline__ void a_ready(const Unit&) const {}
    __device__ __forceinline__ void done(const Unit&) const {}
};

__device__ __forceinline__ unsigned cvt_pk_bf16(float lo, float hi) { unsigned r; asm volatile("v_cvt_pk_bf16_f32 %0, %1, %2" : "=v"(r) : "v"(lo), "v"(hi)); return r; }
typedef float f32x2 __attribute__((ext_vector_type(2)));
template <class Epi, class Sched, bool ALIGN_EPI = false, bool SP2 = false>
__device__ __forceinline__ void gemm_phase(PG8_LAS unsigned char* lds, const Gemm g, const Sched& S, const Epi& E) {
    const int tid = threadIdx.x, wid = __builtin_amdgcn_readfirstlane(tid >> 6), lane = tid & 63, wr = wid >> 2, wc = wid & 3, fr = lane & 15, fq = lane >> 4;
    const int K = g.K, nt = K / BK;
    unsigned voffA[2], voffB[2];
#pragma unroll
    for (int i = 0; i < 2; ++i) { int R, C; stage_rc(tid * 16 + i * 8192, R, C); const int Rb = Epi::PERM ? ((R & ~31) + perm32(R & 31)) : R;
        voffA[i] = (unsigned)(R * K + C) * 2u; voffB[i] = (unsigned)(Rb * K + C) * 2u; }
    const size_t kstep = (size_t)(BK * 2);
    const size_t hstep = (size_t)HALF * K * 2;
    const size_t tstep = 2 * hstep;
    const unsigned ldsw = (unsigned)wid * 1024u;
    const int aoff = lds_byte(wr * 64 + fr, fq * 8), boff = lds_byte(wc * 32 + fr, fq * 8);
#define PG8_SA(b, h) (((b) * 2 + (h)) * HTB)
#define PG8_SB(b, h) ((4 + (b) * 2 + (h)) * HTB)
#define PG8_STAGE(bufoff, gbase, voff) do { _Pragma("unroll") for (int _i = 0; _i < 2; ++_i) \
        __builtin_amdgcn_global_load_lds((const unsigned*)((const char*)(gbase) + (voff)[_i]), (PG8_LAS unsigned*)(lds + (bufoff) + ldsw + _i * 8192), 16, 0, 0); } while (0)
#define PG8_LDA(dst, b, h) do { _Pragma("unroll") for (int m = 0; m < 4; ++m) _Pragma("unroll") for (int k = 0; k < 2; ++k) dst[m][k] = *(const PG8_LAS bf16x8*)(lds + PG8_SA(b, h) + aoff + m * 2048 + k * 1024); } while (0)
#define PG8_LDB(dst, b, h) do { _Pragma("unroll") for (int n = 0; n < 2; ++n) _Pragma("unroll") for (int k = 0; k < 2; ++k) dst[n][k] = *(const PG8_LAS bf16x8*)(lds + PG8_SB(b, h) + boff + n * 2048 + k * 1024); } while (0)
#define PG8_MMA(ai, bj, At, Bt) do { __builtin_amdgcn_s_setprio(1); _Pragma("unroll") for (int m = 0; m < 4; ++m) _Pragma("unroll") for (int n = 0; n < 2; ++n) _Pragma("unroll") for (int k = 0; k < 2; ++k) \
        acc[ai][bj][m][n] = __builtin_amdgcn_mfma_f32_16x16x32_bf16(Bt[n][k], At[m][k], acc[ai][bj][m][n], 0, 0, 0); __builtin_amdgcn_s_setprio(0); } while (0)
#define PG8_WAIT_V(n) asm volatile("s_waitcnt vmcnt(" #n ")" ::: "memory")
#define PG8_WAIT_L(n) asm volatile("s_waitcnt lgkmcnt(" #n ")" ::: "memory")
#define PG8_BAR __builtin_amdgcn_s_barrier()
#define PG8_SCHED __builtin_amdgcn_sched_barrier(0)
    Unit cur, nxt; int ui = 0;
    if (!S.next(0, cur)) return;
    f32x4 acc[2][2][4][2];
#pragma unroll
    for (int a = 0; a < 2; ++a)
#pragma unroll
        for (int b = 0; b < 2; ++b)
#pragma unroll
            for (int m = 0; m < 4; ++m)
#pragma unroll
                for (int n = 0; n < 2; ++n) acc[a][b][m][n] = (f32x4){0.f, 0.f, 0.f, 0.f};
    bf16x8 At[4][2], B0[2][2], B1[2][2];
    const char* cA = (const char*)g.A + (size_t)cur.pm * tstep; const char* cB = (const char*)g.Bt + (size_t)cur.pn * tstep;
    S.a_ready(cur);
    if constexpr (SP2) {
        PG8_STAGE(PG8_SB(0, 0), cB, voffB); PG8_STAGE(PG8_SB(0, 1), cB + hstep, voffB); PG8_STAGE(PG8_SA(0, 0), cA, voffA); PG8_STAGE(PG8_SA(0, 1), cA + hstep, voffA);
        if (wr == 1) PG8_BAR;
        PG8_WAIT_V(2); PG8_BAR;
        PG8_STAGE(PG8_SB(1, 0), cB + kstep, voffB); PG8_STAGE(PG8_SA(1, 0), cA + kstep, voffA); PG8_STAGE(PG8_SB(1, 1), cB + hstep + kstep, voffB);
        PG8_WAIT_V(6); PG8_BAR;
    } else {
        PG8_STAGE(PG8_SB(0, 0), cB, voffB); PG8_STAGE(PG8_SA(0, 0), cA, voffA); PG8_STAGE(PG8_SB(0, 1), cB + hstep, voffB); PG8_STAGE(PG8_SA(0, 1), cA + hstep, voffA);
        if (wr == 1) PG8_BAR;
        PG8_WAIT_V(4); PG8_BAR;
        PG8_STAGE(PG8_SB(1, 0), cB + kstep, voffB); PG8_STAGE(PG8_SA(1, 0), cA + kstep, voffA); PG8_STAGE(PG8_SB(1, 1), cB + hstep + kstep, voffB);
        PG8_WAIT_V(6); PG8_BAR;
    }
    for (;;) {
        const bool has_next = S.next(ui + 1, nxt);
        const char* nA = has_next ? (const char*)g.A + (size_t)nxt.pm * tstep : cA; const char* nB = has_next ? (const char*)g.Bt + (size_t)nxt.pn * tstep : cB;
        for (int t = 0; t < nt; t += 2) {
            if constexpr (Epi::HAS_MID) { if (t == (nt >> 1)) E.mid(acc, cur, wr, wc, fr, fq); }
            const bool last = (t == nt - 2);
            const char* a1 = cA + (size_t)(t + 1) * kstep;
            const char* a2 = last ? nA : cA + (size_t)(t + 2) * kstep; const char* b2 = last ? nB : cB + (size_t)(t + 2) * kstep;
            const char* a3 = a2 + kstep; const char* b3 = b2 + kstep;
            if (last && has_next) S.a_ready(nxt);
            if constexpr (SP2) {
            PG8_LDB(B0, 0, 0); PG8_LDB(B1, 0, 1); PG8_SCHED; PG8_LDA(At, 0, 0); PG8_STAGE(PG8_SA(1, 1), a1 + hstep, voffA);
            PG8_WAIT_V(8); PG8_WAIT_L(0); PG8_BAR; PG8_MMA(0, 0, At, B0); PG8_MMA(0, 1, At, B1); PG8_BAR; PG8_SCHED;
            PG8_LDA(At, 0, 1); PG8_STAGE(PG8_SB(0, 0), b2, voffB); PG8_STAGE(PG8_SB(0, 1), b2 + hstep, voffB); PG8_STAGE(PG8_SA(0, 0), a2, voffA);
            PG8_WAIT_V(8); PG8_WAIT_L(0); PG8_BAR; PG8_MMA(1, 0, At, B0); PG8_MMA(1, 1, At, B1); PG8_BAR; PG8_SCHED;
            PG8_LDB(B0, 1, 0); PG8_LDB(B1, 1, 1); PG8_SCHED; PG8_LDA(At, 1, 0); PG8_STAGE(PG8_SA(0, 1), a2 + hstep, voffA);
            PG8_WAIT_V(8); PG8_WAIT_L(0); PG8_BAR; PG8_MMA(0, 0, At, B0); PG8_MMA(0, 1, At, B1); PG8_BAR; PG8_SCHED;
            PG8_LDA(At, 1, 1); PG8_STAGE(PG8_SB(1, 0), b3, voffB); PG8_STAGE(PG8_SB(1, 1), b3 + hstep, voffB); PG8_STAGE(PG8_SA(1, 0), a3, voffA);
            PG8_WAIT_V(8); PG8_WAIT_L(0); PG8_BAR; PG8_MMA(1, 0, At, B0); PG8_MMA(1, 1, At, B1); PG8_BAR; PG8_SCHED;
            } else {
            PG8_LDB(B0, 0, 0); PG8_SCHED; PG8_LDA(At, 0, 0); PG8_STAGE(PG8_SA(1, 1), a1 + hstep, voffA);
            PG8_WAIT_L(8); PG8_BAR; PG8_WAIT_L(0); PG8_MMA(0, 0, At, B0); PG8_BAR; PG8_SCHED;
            PG8_LDB(B1, 0, 1); PG8_STAGE(PG8_SB(0, 0), b2, voffB);
            PG8_BAR; PG8_WAIT_L(0); PG8_MMA(0, 1, At, B1); PG8_BAR;
            PG8_LDA(At, 0, 1); PG8_STAGE(PG8_SA(0, 0), a2, voffA);
            PG8_BAR; PG8_WAIT_L(0); PG8_MMA(1, 0, At, B0); PG8_BAR; PG8_SCHED;
            PG8_STAGE(PG8_SB(0, 1), b2 + hstep, voffB);
            PG8_WAIT_V(6); PG8_BAR; PG8_MMA(1, 1, At, B1); PG8_BAR;
            PG8_LDB(B0, 1, 0); PG8_SCHED; PG8_LDA(At, 1, 0); PG8_STAGE(PG8_SA(0, 1), a2 + hstep, voffA);
            PG8_WAIT_L(8); PG8_BAR; PG8_WAIT_L(0); PG8_MMA(0, 0, At, B0); PG8_BAR; PG8_SCHED;
            PG8_LDB(B1, 1, 1); PG8_STAGE(PG8_SB(1, 0), b3, voffB);
            PG8_BAR; PG8_WAIT_L(0); PG8_MMA(0, 1, At, B1); PG8_BAR;
            PG8_LDA(At, 1, 1); PG8_STAGE(PG8_SA(1, 0), a3, voffA);
            PG8_BAR; PG8_WAIT_L(0); PG8_MMA(1, 0, At, B0); PG8_BAR; PG8_SCHED;
            PG8_STAGE(PG8_SB(1, 1), b3 + hstep, voffB);
            PG8_WAIT_V(6); PG8_BAR; PG8_MMA(1, 1, At, B1); PG8_BAR;
            }
        }
        if constexpr (ALIGN_EPI) { if (wr == 0) PG8_BAR; }
        if constexpr (!Epi::AFTER_DRAIN) { E(acc, cur, wr, wc, fr, fq); S.done(cur); }
        if (!has_next) break;
#pragma unroll
        for (int a = 0; a < 2; ++a)
#pragma unroll
            for (int b = 0; b < 2; ++b)
#pragma unroll
                for (int m = 0; m < 4; ++m)
#pragma unroll
                    for (int n = 0; n < 2; ++n) acc[a][b][m][n] = (f32x4){0.f, 0.f, 0.f, 0.f};
        cur = nxt; cA = nA; cB = nB; ++ui;
        if constexpr (ALIGN_EPI) { if (wr == 1) PG8_BAR; }
    }
    PG8_WAIT_V(0);
    if constexpr (!ALIGN_EPI) { if (wr == 0) PG8_BAR; }
    PG8_BAR;
    if constexpr (Epi::AFTER_DRAIN) { E.fused(acc, cur, wr, wc, fr, fq, lds, wid, lane); S.done(cur); }
#undef PG8_SA
#undef PG8_SB
#undef PG8_STAGE
#undef PG8_LDA
#undef PG8_LDB
#undef PG8_MMA
#undef PG8_WAIT_V
#undef PG8_WAIT_L
#undef PG8_BAR
#undef PG8_SCHED
}
}

constexpr int DM = 1024, NB = 4, SEQ = 4096, NTOK = NB * SEQ;
constexpr int HD = 64, NH = 8, NKV = 2, QW = NH * HD  , GRIDW = 64;
constexpr int INW = 3584;
constexpr int PH = 8, NKEYS = 128, TOPK = 16, NEXP = NKEYS * NKEYS, SCW = PH * 2 * NKEYS  ;
constexpr float EPS = 1e-6f;
constexpr float LOG2E = 1.4426950408889634f;
constexpr float QSCALE = 0.125f * LOG2E;

typedef unsigned u32x2_t __attribute__((ext_vector_type(2)));
typedef float f32x2_t __attribute__((ext_vector_type(2)));
typedef __bf16 bf16x2_t __attribute__((ext_vector_type(2)));
__device__ __forceinline__ unsigned pkbf(float lo, float hi) { f32x2_t v = {lo, hi}; bf16x2_t b = __builtin_convertvector(v, bf16x2_t); return __builtin_bit_cast(unsigned, b); }
__device__ __forceinline__ float bflo(unsigned w) { return __builtin_bit_cast(float, w << 16); }
__device__ __forceinline__ float bfhi(unsigned w) { return __builtin_bit_cast(float, w & 0xffff0000u); }

__device__ __forceinline__ size_t kimg_off(int b, int kvh, int s, int dim) { return ((size_t)((b * NKV + kvh) * (SEQ / 64) + (s >> 6)) << 12) + (dim >> 3) * 512 + (s & 63) * 8 + (dim & 7); }
__device__ __forceinline__ size_t vimg_off(int b, int kvh, int s, int dim) { return ((size_t)((b * NKV + kvh) * (SEQ / 64) + (s >> 6)) << 12) + (dim >> 5) * 2048 + (s & 63) * 32 + (dim & 31); }

namespace pg8 {
#ifndef ST_WT
#define ST_WT 0
#endif
__device__ __forceinline__ void st16(void* p, const u32x4& v) {
#if ST_WT
    asm volatile("global_store_dwordx4 %0, %1, off sc1\n\ts_nop 1" :: "v"(p), "v"(v) : "memory");
#else
    *(u32x4*)p = v;
#endif
}
__device__ __forceinline__ u32x4 pk8(const f32x4& a, const f32x4& b) { return (u32x4){pkbf(a[0], a[1]), pkbf(a[2], a[3]), pkbf(b[0], b[1]), pkbf(b[2], b[3])}; }
struct EpiIn {
    static constexpr bool PERM = true, AFTER_DRAIN = false, HAS_MID = false;
    bf16_t *Qa, *Ka, *Va, *Qb, *Kb, *Vb, *Ga, *Gb;
    const float *qg, *kg, *bgate, *rope;
    __device__ __forceinline__ void operator()(const f32x4 (&acc)[2][2][4][2], const Unit& u, int wr, int wc, int fr, int fq) const {
        const int pn = u.pn;
        if (pn >= 6) {
            const bool isA = pn < 10; bf16_t* G = isA ? Ga : Gb; const int ct = (isA ? pn - 6 : pn - 10) * BM; const float* bb = bgate + (isA ? 0 : DM);
            f32x4 bv[2][2];
#pragma unroll
            for (int bj = 0; bj < 2; ++bj)
#pragma unroll
                for (int n = 0; n < 2; ++n) bv[bj][n] = *(const f32x4*)(bb + ct + bj * HALF + wc * 32 + 8 * fq + 4 * n);
#pragma unroll
            for (int ai = 0; ai < 2; ++ai)
#pragma unroll
                for (int m = 0; m < 4; ++m) { const int row = u.pm * BM + ai * HALF + wr * 64 + m * 16 + fr; bf16_t* rp = G + (size_t)row * DM + ct + wc * 32 + 8 * fq;
#pragma unroll
                    for (int bj = 0; bj < 2; ++bj) { f32x4 g[2];
#pragma unroll
                        for (int n = 0; n < 2; ++n) { const f32x4 z = acc[ai][bj][m][n] + bv[bj][n];
#pragma unroll
                            for (int j = 0; j < 4; ++j) g[n][j] = __builtin_amdgcn_rcpf(1.0f + __builtin_amdgcn_exp2f(-LOG2E * z[j])); }
                        st16(rp + bj * HALF, pk8(g[0], g[1])); } }
            return;
        }
        const bool brA = pn < 3; const int pl = brA ? pn : pn - 3;
        const bool isq = pl < 2, isk = (!isq) && wc < 2;
        const bool normrope = brA && (isq || isk);
        const int part = fq >> 1, base = 8 * (fq & 1);
        f32x4 gv[2][2];
        if (normrope) { const float* g = isq ? qg : kg;
#pragma unroll
            for (int bj = 0; bj < 2; ++bj)
#pragma unroll
                for (int n = 0; n < 2; ++n) gv[bj][n] = *(const f32x4*)(g + 32 * part + 16 * bj + base + 4 * n); }
        const float osc = isq ? QSCALE : 1.0f;
#pragma unroll
        for (int ai = 0; ai < 2; ++ai)
#pragma unroll
            for (int m = 0; m < 4; ++m) {
                const int row = u.pm * BM + ai * HALF + wr * 64 + m * 16 + fr; const int b = row >> 12, s = row & (SEQ - 1);
                f32x4 v[2][2];
#pragma unroll
                for (int bj = 0; bj < 2; ++bj)
#pragma unroll
                    for (int n = 0; n < 2; ++n) v[bj][n] = acc[ai][bj][m][n];
                if (normrope) {
                    float ss = 0.f;
#pragma unroll
                    for (int bj = 0; bj < 2; ++bj)
#pragma unroll
                        for (int n = 0; n < 2; ++n) ss += (v[bj][n][0] * v[bj][n][0] + v[bj][n][1] * v[bj][n][1]) + (v[bj][n][2] * v[bj][n][2] + v[bj][n][3] * v[bj][n][3]);
                    ss += __shfl_xor(ss, 16); ss += __shfl_xor(ss, 32);
                    const float rstd = 1.0f / sqrtf(ss * (1.0f / 64.0f) + EPS);
                    const int pos = part == 0 ? (s >> 6) : (s & (GRIDW - 1));
                    const float* rp = rope + (pos * 16 + base) * 2;
#pragma unroll
                    for (int n = 0; n < 2; ++n) { const f32x4 cs0 = *(const f32x4*)(rp + 8 * n), cs1 = *(const f32x4*)(rp + 8 * n + 4);
                        const float cc[4] = {cs0[0], cs0[2], cs1[0], cs1[2]}, sn[4] = {cs0[1], cs0[3], cs1[1], cs1[3]};
#pragma unroll
                        for (int j = 0; j < 4; ++j) { const float u1 = v[0][n][j] * rstd * gv[0][n][j], u2 = v[1][n][j] * rstd * gv[1][n][j];
                            v[0][n][j] = u1 * cc[j] - u2 * sn[j]; v[1][n][j] = u2 * cc[j] + u1 * sn[j]; } }
                }
#pragma unroll
                for (int bj = 0; bj < 2; ++bj) {
                    const u32x4 w = pk8(v[bj][0] * osc, v[bj][1] * osc);
                    const int dim = 32 * part + 16 * bj + base;
                    bf16_t* dst;
                    if (isq) dst = (brA ? Qa : Qb) + (size_t)row * (2 * QW) + (pl * 4 + wc) * HD + dim;
                    else if (wc < 2) dst = (brA ? Ka : Kb) + kimg_off(b, wc, s, dim);
                    else dst = (brA ? Va : Vb) + vimg_off(b, wc - 2, s, dim);
                    st16(dst, w);
                }
            }
    }
};

struct EpiMix {
    static constexpr bool PERM = true, AFTER_DRAIN = false, HAS_MID = true;
    const bf16_t* GA; const bf16_t* GB; bf16_t* OUT;
    __device__ __forceinline__ void mid(f32x4 (&acc)[2][2][4][2], const Unit& u, int wr, int wc, int fr, int fq) const {
        size_t off = (size_t)(u.pm * BM + wr * 64 + fr) * DM + u.pn * BM + wc * 32 + 8 * fq;
#pragma unroll
        for (int ai = 0; ai < 2; ++ai)
#pragma unroll
            for (int m = 0; m < 4; ++m) {
                asm volatile("" : "+v"(off));
#pragma unroll
                for (int bj = 0; bj < 2; ++bj) { const u32x4 a = *(const u32x4*)(GA + off + bj * HALF), b = *(const u32x4*)(GB + off + bj * HALF);
#pragma unroll
                    for (int n = 0; n < 2; ++n) { f32x4& c = acc[ai][bj][m][n]; const unsigned a0 = n ? a.z : a.x, a1 = n ? a.w : a.y, b0 = n ? b.z : b.x, b1 = n ? b.w : b.y;
                        c[0] *= bflo(a0) * __builtin_amdgcn_rcpf(fmaxf(bflo(b0), 1e-20f)); c[1] *= bfhi(a0) * __builtin_amdgcn_rcpf(fmaxf(bfhi(b0), 1e-20f));
                        c[2] *= bflo(a1) * __builtin_amdgcn_rcpf(fmaxf(bflo(b1), 1e-20f)); c[3] *= bfhi(a1) * __builtin_amdgcn_rcpf(fmaxf(bfhi(b1), 1e-20f)); } }
                off += (size_t)((m == 3) ? (HALF - 48) : 16) * DM;
            }
    }
    __device__ __forceinline__ void operator()(const f32x4 (&acc)[2][2][4][2], const Unit& u, int wr, int wc, int fr, int fq) const {
#pragma unroll
        for (int ai = 0; ai < 2; ++ai)
#pragma unroll
            for (int m = 0; m < 4; ++m) { const int row = u.pm * BM + ai * HALF + wr * 64 + m * 16 + fr; const size_t off = (size_t)row * DM + u.pn * BM + wc * 32 + 8 * fq;
#pragma unroll
                for (int bj = 0; bj < 2; ++bj) { const u32x4 g = *(const u32x4*)(GB + off + bj * HALF); const f32x4 a0 = acc[ai][bj][m][0], a1 = acc[ai][bj][m][1];
                    st16(OUT + off + bj * HALF, (u32x4){pkbf(a0[0] * bflo(g.x), a0[1] * bfhi(g.x)), pkbf(a0[2] * bflo(g.y), a0[3] * bfhi(g.y)), pkbf(a1[0] * bflo(g.z), a1[1] * bfhi(g.z)), pkbf(a1[2] * bflo(g.w), a1[3] * bfhi(g.w))}); } }
    }
};
struct EpiOut {
    static constexpr bool PERM = true, AFTER_DRAIN = false, HAS_MID = false;
    const float* X; bf16_t* HB; float* ssq;
    __device__ __forceinline__ void operator()(const f32x4 (&acc)[2][2][4][2], const Unit& u, int wr, int wc, int fr, int fq) const {
#pragma unroll
        for (int ai = 0; ai < 2; ++ai)
#pragma unroll
            for (int m = 0; m < 4; ++m) { const int row = u.pm * BM + ai * HALF + wr * 64 + m * 16 + fr; const size_t off = (size_t)row * DM + u.pn * BM + wc * 32 + 8 * fq; float ss = 0.f;
#pragma unroll
                for (int bj = 0; bj < 2; ++bj) { const size_t o2 = off + bj * HALF; const f32x4 h0 = *(const f32x4*)(X + o2) + acc[ai][bj][m][0], h1 = *(const f32x4*)(X + o2 + 4) + acc[ai][bj][m][1];
                    st16(HB + o2, pk8(h0, h1));
                    ss += ((h0[0] * h0[0] + h0[1] * h0[1]) + (h0[2] * h0[2] + h0[3] * h0[3])) + ((h1[0] * h1[0] + h1[1] * h1[1]) + (h1[2] * h1[2] + h1[3] * h1[3])); }
                ss += __shfl_xor(ss, 16); ss += __shfl_xor(ss, 32);
                if (fq == 0) ssq[(size_t)row * 16 + u.pn * 4 + wc] = ss; }
    }
};
typedef _Float16 f16x2_t __attribute__((ext_vector_type(2)));
__device__ __forceinline__ unsigned pkh(float lo, float hi) { f16x2_t h = {(_Float16)lo, (_Float16)hi}; return __builtin_bit_cast(unsigned, h); }
struct EpiScore {
    static constexpr bool PERM = true, AFTER_DRAIN = false, HAS_MID = false;
    const float* ssq; unsigned short* SC;
    __device__ __forceinline__ void operator()(const f32x4 (&acc)[2][2][4][2], const Unit& u, int wr, int wc, int fr, int fq) const {
#pragma unroll
        for (int ai = 0; ai < 2; ++ai)
#pragma unroll
            for (int m = 0; m < 4; ++m) { const int row = u.pm * BM + ai * HALF + wr * 64 + m * 16 + fr;
                const f32x4* sp = (const f32x4*)(ssq + (size_t)row * 16); const f32x4 s0 = sp[0], s1 = sp[1], s2 = sp[2], s3 = sp[3];
                const float tot = (((s0[0] + s0[1]) + (s0[2] + s0[3])) + ((s1[0] + s1[1]) + (s1[2] + s1[3]))) + (((s2[0] + s2[1]) + (s2[2] + s2[3])) + ((s3[0] + s3[1]) + (s3[2] + s3[3])));
                const float rstd = 1.0f / sqrtf(tot * (1.0f / DM) + EPS);
                unsigned short* rp = SC + (size_t)row * SCW + u.pn * BM + wc * 32 + 8 * fq;
#pragma unroll
                for (int bj = 0; bj < 2; ++bj) { const f32x4 v0 = acc[ai][bj][m][0] * rstd, v1 = acc[ai][bj][m][1] * rstd;
                    st16(rp + bj * HALF, (u32x4){pkh(v0[0], v0[1]), pkh(v0[2], v0[3]), pkh(v1[0], v1[1]), pkh(v1[2], v1[3])}); } }
    }
};
struct EpiNull {
    static constexpr bool PERM = true, AFTER_DRAIN = false, HAS_MID = false;
    float* sink;
    __device__ __forceinline__ void operator()(const f32x4 (&acc)[2][2][4][2], const Unit& u, int wr, int wc, int fr, int fq) const {
        f32x4 s = acc[0][0][0][0];
#pragma unroll
        for (int ai = 0; ai < 2; ++ai)
#pragma unroll
            for (int bj = 0; bj < 2; ++bj)
#pragma unroll
                for (int m = 0; m < 4; ++m)
#pragma unroll
                    for (int n = 0; n < 2; ++n) s += acc[ai][bj][m][n];
        if (s[0] + s[1] + s[2] + s[3] == 1.2345e30f) sink[0] = 1.f;
    }
};
}

#define LAS __attribute__((address_space(3)))
namespace attn {
typedef unsigned short bf16_t;
typedef short bf16x8 __attribute__((ext_vector_type(8)));
typedef short s16x4 __attribute__((ext_vector_type(4)));
typedef float f32x16 __attribute__((ext_vector_type(16)));
typedef unsigned u32x4 __attribute__((ext_vector_type(4)));
constexpr int LDS_K = 0, LDS_V = 32768;
constexpr int LDS_BIAS = 65536;
constexpr int LDS_BYTES = 65536 + 4 * 3072;
constexpr float THR = 8.0f;
__device__ __forceinline__ int crow(int r, int hi) { return (r & 3) + 8 * (r >> 2) + 4 * hi; }
__device__ __forceinline__ s16x4 vtr(const LAS char* p) { return __builtin_bit_cast(s16x4, __builtin_amdgcn_ds_read_tr16_b64_v4i16((LAS s16x4*)p)); }
__device__ __forceinline__ float xhalf_max(float v) { auto rr = __builtin_amdgcn_permlane32_swap(__float_as_uint(v), __float_as_uint(v), false, false); return fmaxf(__uint_as_float(rr[0]), __uint_as_float(rr[1])); }
__device__ __forceinline__ float xhalf_sum(float v) { auto rr = __builtin_amdgcn_permlane32_swap(__float_as_uint(v), __float_as_uint(v), false, false); return __uint_as_float(rr[0]) + __uint_as_float(rr[1]); }
#ifndef ATTN_KINS
#define ATTN_KINS 0
#endif
#ifndef ATTN_CLEANM
#define ATTN_CLEANM 0
#endif
#ifndef ATTN_PRIO
#define ATTN_PRIO 1
#endif
__device__ __forceinline__ float max3f(float a, float b, float c) { float r; asm("v_max3_f32 %0, %1, %2, %3" : "=v"(r) : "v"(a), "v"(b), "v"(c)); return r; }
__device__ __forceinline__ float max2f(float a, float b) { float r; asm("v_max_f32_e32 %0, %1, %2" : "=v"(r) : "v"(a), "v"(b)); return r; }
#define ATT_BAR() do { asm volatile("s_waitcnt lgkmcnt(0)" ::: "memory"); __builtin_amdgcn_s_barrier(); asm volatile("" ::: "memory"); } while (0)

template <bool WIN, int XV = 0, bool NOMAX = false>
__device__ __forceinline__ void attn_unit(LAS char* lds, const bf16_t* Q, const bf16_t* Kimg, const bf16_t* Vimg, bf16_t* O, int b, int hsel, int qblk, const float* bias_all  , const float* sink_all  ) {
    const int tid = threadIdx.x, lane = tid & 63, r32 = lane & 31, hi = lane >> 5; const int wid = __builtin_amdgcn_readfirstlane(tid >> 6); const int grp = wid >> 2;
    const int h = WIN ? 4 * hsel + (wid >> 1) : hsel, kvh = WIN ? hsel : (hsel >> 2);
    const int q0 = WIN ? qblk * 64 : qblk * 256, qw0 = q0 + (WIN ? 32 * (wid & 1) : 32 * wid), qrow = qw0 + r32; const size_t grow = (size_t)b * SEQ + qrow;
    int t_lo = 0, t_hi = SEQ / 64 - 1;
    if (WIN) { t_lo = q0 / 64 - 2; if (t_lo < 0) t_lo = 0; t_hi = q0 / 64 + 2; if (t_hi > SEQ / 64 - 1) t_hi = SEQ / 64 - 1; }
    const int n = t_hi - t_lo + 1;
    const float sink_l2 = WIN ? sink_all[h] * LOG2E : 0.f;
    const bf16_t* Kb = Kimg + ((size_t)((b * NKV + kvh) * (SEQ / 64) + t_lo) << 12) + tid * 8;
    const bf16_t* Vb = Vimg + ((size_t)((b * NKV + kvh) * (SEQ / 64) + t_lo) << 12) + tid * 8;
    bf16x8 qr[4];
#pragma unroll
    for (int d0 = 0; d0 < 4; ++d0) qr[d0] = *(const bf16x8*)(Q + grow * (2 * QW) + h * HD + d0 * 16 + hi * 8);
    LAS float* biasl = (LAS float*)(lds + LDS_BIAS) + (WIN ? (wid >> 1) * 768 : 0);
    if (WIN) { for (int j = tid; j < 4 * 768; j += 512) { const int hh = j / 768, jj = j % 768; ((LAS float*)(lds + LDS_BIAS))[j] = (jj >= 256 && jj <= 512) ? bias_all[(4 * hsel + hh) * 257 + jj - 256] : -1e30f; } }
    u32x4 kreg, vreg;
    { const u32x4 k0 = *(const u32x4*)Kb, v0 = *(const u32x4*)Vb, k1 = *(const u32x4*)(Kb + 4096), v1 = *(const u32x4*)(Vb + 4096);
      kreg = *(const u32x4*)(Kb + 2 * 4096); vreg = *(const u32x4*)(Vb + 2 * 4096);
      *(LAS u32x4*)(lds + LDS_K + tid * 16) = k0; *(LAS u32x4*)(lds + LDS_V + tid * 16) = v0;
      *(LAS u32x4*)(lds + LDS_K + 8192 + tid * 16) = k1; *(LAS u32x4*)(lds + LDS_V + 8192 + tid * 16) = v1; }
    ATT_BAR();
    if (grp) ATT_BAR();
    f32x16 o0 = {}, o1 = {}, o2, p0, p1, negm;
    float mref = WIN ? sink_l2 : 0.0f;
#pragma unroll
    for (int r = 0; r < 16; ++r) o2[r] = WIN ? 1.0f : 0.0f;
    const bf16x8 ones = {0x3F80, 0x3F80, 0x3F80, 0x3F80, 0x3F80, 0x3F80, 0x3F80, 0x3F80};
#pragma unroll
    for (int r = 0; r < 16; ++r) negm[r] = -mref;
    const int vlane = ((lane >> 4) & 1) * 32 + (lane & 3) * 8 + (4 * hi + ((lane & 15) >> 2)) * 64;
    const LAS char* kfr = lds + LDS_K + hi * 1024 + r32 * 16;
    u32x4 pk[4]; bf16x8 kf[8], vf[8];
#define ATT_LDK(sl) do { const LAS char* kp_ = kfr + (sl) * 8192; \
        _Pragma("unroll") for (int d0 = 0; d0 < 4; ++d0) { kf[2 * d0] = *(const LAS bf16x8*)(kp_ + d0 * 2048); kf[2 * d0 + 1] = *(const LAS bf16x8*)(kp_ + d0 * 2048 + 512); } } while (0)
#define ATT_LDV(sl) do { const LAS char* vp_ = lds + LDS_V + (sl) * 8192 + vlane; \
        _Pragma("unroll") for (int ks = 0; ks < 4; ++ks) { \
            const s16x4 l0 = vtr(vp_ + ks * 1024), h0 = vtr(vp_ + ks * 1024 + 512), l1 = vtr(vp_ + 4096 + ks * 1024), h1 = vtr(vp_ + 4096 + ks * 1024 + 512); \
            vf[2 * ks] = (bf16x8){l0[0], l0[1], l0[2], l0[3], h0[0], h0[1], h0[2], h0[3]}; vf[2 * ks + 1] = (bf16x8){l1[0], l1[1], l1[2], l1[3], h1[0], h1[1], h1[2], h1[3]}; } } while (0)
#define ATT_QK() do { \
        if (NOMAX) { const f32x16 z_ = {}; p0 = __builtin_amdgcn_mfma_f32_32x32x16_bf16(kf[0], qr[0], z_, 0, 0, 0); p1 = __builtin_amdgcn_mfma_f32_32x32x16_bf16(kf[1], qr[0], z_, 0, 0, 0); } \
        else { p0 = __builtin_amdgcn_mfma_f32_32x32x16_bf16(kf[0], qr[0], negm, 0, 0, 0); p1 = __builtin_amdgcn_mfma_f32_32x32x16_bf16(kf[1], qr[0], negm, 0, 0, 0); } \
        _Pragma("unroll") for (int d0 = 1; d0 < 4; ++d0) { p0 = __builtin_amdgcn_mfma_f32_32x32x16_bf16(kf[2 * d0], qr[d0], p0, 0, 0, 0); p1 = __builtin_amdgcn_mfma_f32_32x32x16_bf16(kf[2 * d0 + 1], qr[d0], p1, 0, 0, 0); } } while (0)
#define ATT_PV() do { \
        _Pragma("unroll") for (int ks = 0; ks < 4; ++ks) { const bf16x8 pf = __builtin_bit_cast(bf16x8, pk[ks]); \
            o0 = __builtin_amdgcn_mfma_f32_32x32x16_bf16(vf[2 * ks], pf, o0, 0, 0, 0); o1 = __builtin_amdgcn_mfma_f32_32x32x16_bf16(vf[2 * ks + 1], pf, o1, 0, 0, 0); \
            o2 = __builtin_amdgcn_mfma_f32_32x32x16_bf16(ones, pf, o2, 0, 0, 0); } } while (0)
    int ia = 0, ib = n - 1;
    if (WIN) { int lo_t = (qw0 - 128) >> 6; if (lo_t < t_lo) lo_t = t_lo; int hi_t = (qw0 + 31 + 128) >> 6; if (hi_t > t_hi) hi_t = t_hi; ia = lo_t - t_lo; ib = hi_t - t_lo; }
#define ATT_STAGE(i) do { if ((i) + 2 < n) { const int sl_ = ((i) + 2) & 3; *(LAS u32x4*)(lds + LDS_K + sl_ * 8192 + tid * 16) = kreg; *(LAS u32x4*)(lds + LDS_V + sl_ * 8192 + tid * 16) = vreg; \
            if ((i) + 3 < n) { kreg = *(const u32x4*)(Kb + (size_t)((i) + 3) * 4096); vreg = *(const u32x4*)(Vb + (size_t)((i) + 3) * 4096); } } } while (0)
    bool first = !WIN;
    int i = 0;
    if (ia == 0) { ATT_LDK(0); asm volatile("s_waitcnt lgkmcnt(0)" ::: "memory"); ATT_QK(); }
    ATT_BAR();
    for (; i < ia; ++i) {
        ATT_STAGE(i);
        ATT_BAR();
        if (i + 1 == ia) { ATT_LDK((i + 1) & 3); asm volatile("s_waitcnt lgkmcnt(0)" ::: "memory"); ATT_QK(); }
        ATT_BAR();
    }
    for (; i <= ib; ++i) {
#if ATTN_KINS
        if (i < ib) ATT_LDK((i + 1) & 3);
#else
        ATT_LDV(i & 3);
#endif
        __builtin_amdgcn_sched_barrier(0);
        asm volatile("s_nop 7" : "+v"(p0), "+v"(p1));
        if (WIN) {
            const LAS float* bp = biasl + (64 * (t_lo + i) - qrow + 4 * hi + 384);
#pragma unroll
            for (int r = 0; r < 16; ++r) { p0[r] += bp[(r & 3) + 8 * (r >> 2)]; p1[r] += bp[32 + (r & 3) + 8 * (r >> 2)]; }
        }
        if (!NOMAX) {
        float ra = max3f(p0[0], p0[1], p1[0]), rb = max3f(p0[2], p0[3], p1[1]); ra = max3f(ra, p1[2], p1[3]);
#pragma unroll
        for (int r = 4; r < 16; r += 4) { ra = max3f(ra, p0[r], p0[r + 1]); rb = max3f(rb, p0[r + 2], p0[r + 3]); ra = max3f(ra, p1[r], p1[r + 1]); rb = max3f(rb, p1[r + 2], p1[r + 3]); }
        float rm = xhalf_max(max2f(ra, rb));
        if (first || __builtin_amdgcn_ballot_w64(rm > THR) != 0ull) {
            const float delta = first ? rm : fmaxf(rm, 0.0f); const float f = first ? 1.0f : __builtin_amdgcn_exp2f(-delta);
            mref += delta;
#pragma unroll
            for (int r = 0; r < 16; ++r) { p0[r] -= delta; p1[r] -= delta; o0[r] *= f; o1[r] *= f; o2[r] *= f; negm[r] = -mref; }
            first = false;
        }
        }
#pragma unroll
        for (int r = 0; r < 16; ++r) { if (XV == 1 || XV == 4) { p0[r] *= 0.5f; p1[r] *= 0.5f; } else { p0[r] = __builtin_amdgcn_exp2f(p0[r]); p1[r] = __builtin_amdgcn_exp2f(p1[r]); } }
#pragma unroll
        for (int q = 0; q < 4; ++q) { pk[0][q] = pkbf(p0[2 * q], p0[2 * q + 1]); pk[1][q] = pkbf(p0[8 + 2 * q], p0[9 + 2 * q]); pk[2][q] = pkbf(p1[2 * q], p1[2 * q + 1]); pk[3][q] = pkbf(p1[8 + 2 * q], p1[9 + 2 * q]); }
        ATT_STAGE(i);
#if ATTN_KINS
        asm volatile("s_waitcnt lgkmcnt(0)" : "+v"(kf[0]), "+v"(kf[1]), "+v"(kf[2]), "+v"(kf[3]), "+v"(kf[4]), "+v"(kf[5]), "+v"(kf[6]), "+v"(kf[7]), "+v"(pk[0]), "+v"(pk[1]), "+v"(pk[2]), "+v"(pk[3]) : : "memory");
#else
        asm volatile("s_waitcnt lgkmcnt(0)" : "+v"(vf[0]), "+v"(vf[1]), "+v"(vf[2]), "+v"(vf[3]), "+v"(vf[4]), "+v"(vf[5]), "+v"(vf[6]), "+v"(vf[7]), "+v"(pk[0]), "+v"(pk[1]), "+v"(pk[2]), "+v"(pk[3]) : : "memory");
#endif
        if (XV != 3) ATT_BAR(); else asm volatile("s_waitcnt lgkmcnt(0)" ::: "memory");
        __builtin_amdgcn_s_setprio(ATTN_PRIO);
#if ATTN_KINS
        ATT_LDV(i & 3); __builtin_amdgcn_sched_barrier(0);
        f32x16 q0_, q1_;
        if (i < ib) { const f32x16 z_ = {}; q0_ = __builtin_amdgcn_mfma_f32_32x32x16_bf16(kf[0], qr[0], NOMAX ? z_ : negm, 0, 0, 0); q1_ = __builtin_amdgcn_mfma_f32_32x32x16_bf16(kf[1], qr[0], NOMAX ? z_ : negm, 0, 0, 0);
#pragma unroll
            for (int d0 = 1; d0 < 4; ++d0) { q0_ = __builtin_amdgcn_mfma_f32_32x32x16_bf16(kf[2 * d0], qr[d0], q0_, 0, 0, 0); q1_ = __builtin_amdgcn_mfma_f32_32x32x16_bf16(kf[2 * d0 + 1], qr[d0], q1_, 0, 0, 0); } }
        ATT_PV();
        if (i < ib) { p0 = q0_; p1 = q1_; }
#else
#if ATTN_CLEANM
        if (i < ib) { ATT_LDK((i + 1) & 3); __builtin_amdgcn_sched_barrier(0); }
#else
        if (i < ib) ATT_LDK((i + 1) & 3);
#endif
        if (XV != 2 && XV != 4) { ATT_PV(); if (i < ib) ATT_QK(); } else { asm volatile("" : "+v"(kf[0]), "+v"(kf[7]), "+v"(vf[0]), "+v"(vf[7])); }
#endif
        __builtin_amdgcn_s_setprio(0);
        ATT_BAR();
    }
    for (; i < n; ++i) { ATT_STAGE(i); ATT_BAR(); ATT_BAR(); }
#undef ATT_STAGE
#undef ATT_QK
#undef ATT_PV
#undef ATT_LDK
#undef ATT_LDV
    const float inv = 1.0f / o2[0];
    bf16_t* Orow = O + grow * (2 * QW) + h * HD + 4 * hi;
#pragma unroll
    for (int g = 0; g < 4; ++g) {
        u32x2_t w0, w1;
        w0.x = pkbf(o0[4 * g] * inv, o0[4 * g + 1] * inv); w0.y = pkbf(o0[4 * g + 2] * inv, o0[4 * g + 3] * inv);
        w1.x = pkbf(o1[4 * g] * inv, o1[4 * g + 1] * inv); w1.y = pkbf(o1[4 * g + 2] * inv, o1[4 * g + 3] * inv);
        *(u32x2_t*)(Orow + 8 * g) = w0; *(u32x2_t*)(Orow + 32 + 8 * g) = w1;
    }
    if (!grp) ATT_BAR();
}
}

namespace peer {
typedef unsigned u32x4 __attribute__((ext_vector_type(4)));
typedef float f32x4 __attribute__((ext_vector_type(4)));
constexpr int WAVE_LDS = 2048;

template <int CTRL> __device__ __forceinline__ int dppi(int x) { return __builtin_amdgcn_mov_dpp(x, CTRL, 0xf, 0xf, true); }
template <int CTRL> __device__ __forceinline__ float dppf(float x) { return __builtin_bit_cast(float, __builtin_amdgcn_mov_dpp(__builtin_bit_cast(int, x), CTRL, 0xf, 0xf, true)); }
constexpr int XOR1 = 0xB1, XOR2 = 0x4E, XOR7 = 0x141, XOR8 = 0x128;
__device__ __forceinline__ float wave_sum(float x) {
    x += dppf<XOR1>(x); x += dppf<XOR2>(x); x += dppf<XOR7>(x); x += dppf<XOR8>(x);
    auto s = __builtin_amdgcn_permlane16_swap(__float_as_uint(x), __float_as_uint(x), false, false); x = __uint_as_float(s[0]) + __uint_as_float(s[1]);
    auto t = __builtin_amdgcn_permlane32_swap(__float_as_uint(x), __float_as_uint(x), false, false); return __uint_as_float(t[0]) + __uint_as_float(t[1]);
}
__device__ __forceinline__ float dot2bf(unsigned a, unsigned b, float c) { return __builtin_amdgcn_fdot2_f32_bf16(__builtin_bit_cast(bf16x2_t, a), __builtin_bit_cast(bf16x2_t, b), c, false); }
__device__ __forceinline__ unsigned getw(const u32x4& v, int i) { return i == 0 ? v.x : i == 1 ? v.y : i == 2 ? v.z : v.w; }
__device__ __forceinline__ int okey(float f, int lowbits, int payload) { int b = __float_as_int(f); b ^= (b >> 31) & 0x7fffffff; return (b & ~((1 << lowbits) - 1)) | payload; }
__device__ __forceinline__ float kval(int k, int lowbits) { int b = (k & ~((1 << lowbits) - 1)) | (1 << (lowbits - 1)); b ^= (b >> 31) & 0x7fffffff; return __int_as_float(b); }
#define CE_DESC(a, b) do { const int _x = (a), _y = (b); (a) = _x > _y ? _x : _y; (b) = _x > _y ? _y : _x; } while (0)
template <int N> __device__ __forceinline__ void bitonic_sort_desc(int (&a)[N]) {
#pragma unroll
    for (int k = 2; k <= N; k <<= 1)
#pragma unroll
        for (int j = k >> 1; j > 0; j >>= 1)
#pragma unroll
            for (int i = 0; i < N; ++i) { const int l = i ^ j; if (l > i) { if ((i & k) == 0) CE_DESC(a[i], a[l]); else CE_DESC(a[l], a[i]); } }
}
template <int N> __device__ __forceinline__ void bitonic_merge_desc(int (&a)[N]) {
#pragma unroll
    for (int j = N >> 1; j > 0; j >>= 1)
#pragma unroll
        for (int i = 0; i < N; ++i) { const int l = i ^ j; if (l > i) CE_DESC(a[i], a[l]); }
}
__device__ __forceinline__ unsigned long long cand_table(int q8) {
    unsigned long long r = 0xFFFFFFFFFFFFFFFFull; int n = 0;
#pragma unroll
    for (int i = 0; i < 16; ++i)
#pragma unroll
        for (int j = 0; j < 16; ++j) if ((i + 1) * (j + 1) <= 16) { if (n / 7 == q8) { const int s = n % 7; r = (r & ~(0xFFull << (8 * s))) | ((unsigned long long)(i * 16 + j) << (8 * s)); } ++n; }
    return r;
}

struct SCtx { u32x4 v[4]; };
__device__ __forceinline__ SCtx s_ctx(int lane, int t, const unsigned short* SC) { SCtx c; const u32x4* p = (const u32x4*)(SC + (size_t)t * SCW + (lane >> 2) * NKEYS + (lane & 3) * 32);
#pragma unroll
    for (int i = 0; i < 4; ++i) c.v[i] = p[i];
    return c; }
__device__ __forceinline__ void route_token(LAS char* wl, int lane, int t, unsigned long long ct, const SCtx& scx  , const float* SSQ, unsigned short* E, float* G, float* RSTD) {
    LAS int* skeys = (LAS int*)wl;
    {
        const int c = lane >> 2, qq = lane & 3;
        int a[16], bb[16];
#pragma unroll
        for (int i = 0; i < 2; ++i) { const u32x4 v = scx.v[i];
#pragma unroll
            for (int j = 0; j < 4; ++j) { const unsigned w = getw(v, j); const pg8::f16x2_t h = __builtin_bit_cast(pg8::f16x2_t, w);
                a[8 * i + 2 * j] = okey((float)h.x, 7, 127 - (qq * 32 + 8 * i + 2 * j)); a[8 * i + 2 * j + 1] = okey((float)h.y, 7, 127 - (qq * 32 + 8 * i + 2 * j + 1)); } }
#pragma unroll
        for (int i = 0; i < 2; ++i) { const u32x4 v = scx.v[2 + i];
#pragma unroll
            for (int j = 0; j < 4; ++j) { const unsigned w = getw(v, j); const pg8::f16x2_t h = __builtin_bit_cast(pg8::f16x2_t, w);
                bb[8 * i + 2 * j] = okey((float)h.x, 7, 127 - (qq * 32 + 16 + 8 * i + 2 * j)); bb[8 * i + 2 * j + 1] = okey((float)h.y, 7, 127 - (qq * 32 + 16 + 8 * i + 2 * j + 1)); } }
        bitonic_sort_desc<16>(a); bitonic_sort_desc<16>(bb);
#pragma unroll
        for (int i = 0; i < 16; ++i) a[i] = a[i] > bb[15 - i] ? a[i] : bb[15 - i];
        bitonic_merge_desc<16>(a);
#pragma unroll
        for (int i = 0; i < 16; ++i) bb[i] = dppi<XOR1>(a[15 - i]);
#pragma unroll
        for (int i = 0; i < 16; ++i) a[i] = a[i] > bb[i] ? a[i] : bb[i];
        bitonic_merge_desc<16>(a);
#pragma unroll
        for (int i = 0; i < 16; ++i) bb[i] = dppi<XOR2>(a[15 - i]);
#pragma unroll
        for (int i = 0; i < 16; ++i) a[i] = a[i] > bb[i] ? a[i] : bb[i];
        bitonic_merge_desc<16>(a);
        if (qq == 0) {
#pragma unroll
            for (int i = 0; i < 4; ++i) *(LAS u32x4*)(skeys + c * 16 + 4 * i) = (u32x4){(unsigned)a[4 * i], (unsigned)a[4 * i + 1], (unsigned)a[4 * i + 2], (unsigned)a[4 * i + 3]};
        }
    }
    asm volatile("s_waitcnt lgkmcnt(0)" ::: "memory");
    {
        const int hh = lane >> 3, q8 = lane & 7;
        int a[16];
#pragma unroll
        for (int s = 0; s < 8; ++s) {
            const int code = s < 7 ? (int)((ct >> (8 * s)) & 0xFF) : 0xFF;
            const int ci = code == 0xFF ? 0 : code;
            const int ka = skeys[(2 * hh) * 16 + (ci >> 4)], kb = skeys[(2 * hh + 1) * 16 + (ci & 15)];
            const float sum = kval(ka, 7) + kval(kb, 7);
            a[s] = code == 0xFF ? (int)0x80000000 : okey(sum, 8, 255 - code);
        }
        {
            int c8[8];
#pragma unroll
            for (int i = 0; i < 8; ++i) c8[i] = a[i];
            bitonic_sort_desc<8>(c8);
#pragma unroll
            for (int i = 0; i < 8; ++i) a[i] = c8[i];
        }
#pragma unroll
        for (int i = 0; i < 8; ++i) a[8 + i] = dppi<XOR1>(a[i]);
        { int tmp[8];
#pragma unroll
          for (int i = 0; i < 8; ++i) tmp[i] = a[8 + i];
#pragma unroll
          for (int i = 0; i < 8; ++i) a[8 + i] = tmp[7 - i]; }
        bitonic_merge_desc<16>(a);
        int bb[16];
#pragma unroll
        for (int i = 0; i < 16; ++i) bb[i] = dppi<XOR2>(a[15 - i]);
#pragma unroll
        for (int i = 0; i < 16; ++i) a[i] = a[i] > bb[i] ? a[i] : bb[i];
        bitonic_merge_desc<16>(a);
#pragma unroll
        for (int i = 0; i < 16; ++i) bb[i] = dppi<XOR7>(a[15 - i]);
#pragma unroll
        for (int i = 0; i < 16; ++i) a[i] = a[i] > bb[i] ? a[i] : bb[i];
        bitonic_merge_desc<16>(a);
        int k0 = a[0], k1 = a[1];
#pragma unroll
        for (int i = 1; i < 8; ++i) { k0 = q8 == i ? a[2 * i] : k0; k1 = q8 == i ? a[2 * i + 1] : k1; }
        const float mx = kval(a[0], 8);
        const int c0 = 255 - (k0 & 255), c1 = 255 - (k1 & 255);
        const int ka0 = skeys[(2 * hh) * 16 + (c0 >> 4)], kb0 = skeys[(2 * hh + 1) * 16 + (c0 & 15)];
        const int ka1 = skeys[(2 * hh) * 16 + (c1 >> 4)], kb1 = skeys[(2 * hh + 1) * 16 + (c1 & 15)];
        const float s0 = kval(ka0, 7) + kval(kb0, 7), s1 = kval(ka1, 7) + kval(kb1, 7);
        const float e0 = __expf(s0 - mx), e1 = __expf(s1 - mx);
        float z = e0 + e1; z += dppf<XOR1>(z); z += dppf<XOR2>(z); z += dppf<XOR7>(z);
        const float rz = 1.0f / z;
        const unsigned e0i = (unsigned)((127 - (ka0 & 127)) * NKEYS + (127 - (kb0 & 127))), e1i = (unsigned)((127 - (ka1 & 127)) * NKEYS + (127 - (kb1 & 127)));
        *(unsigned*)(E + (size_t)t * 128 + hh * 16 + 2 * q8) = e0i | (e1i << 16);
        *(f32x2_t*)(G + (size_t)t * 128 + hh * 16 + 2 * q8) = (f32x2_t){e0 * rz, e1 * rz};
    }
    if (lane == 0) { const f32x4* sp = (const f32x4*)(SSQ + (size_t)t * 16); const f32x4 s0 = sp[0], s1 = sp[1], s2 = sp[2], s3 = sp[3];
        const float tot = (((s0[0] + s0[1]) + (s0[2] + s0[3])) + ((s1[0] + s1[1]) + (s1[2] + s1[3]))) + (((s2[0] + s2[1]) + (s2[2] + s2[3])) + ((s3[0] + s3[1]) + (s3[2] + s3[3])));
        RSTD[t] = 1.0f / sqrtf(tot * (1.0f / DM) + EPS); }
    asm volatile("s_waitcnt lgkmcnt(0)" ::: "memory");
}

constexpr size_t SLICE_BYTES = (size_t)NEXP * 128;
__device__ __forceinline__ float wave_max(float x) {
    x = fmaxf(x, dppf<XOR1>(x)); x = fmaxf(x, dppf<XOR2>(x)); x = fmaxf(x, dppf<XOR7>(x)); x = fmaxf(x, dppf<XOR8>(x));
    auto s = __builtin_amdgcn_permlane16_swap(__float_as_uint(x), __float_as_uint(x), false, false); x = fmaxf(__uint_as_float(s[0]), __uint_as_float(s[1]));
    auto t = __builtin_amdgcn_permlane32_swap(__float_as_uint(x), __float_as_uint(x), false, false); return fmaxf(__uint_as_float(t[0]), __uint_as_float(t[1]));
}
template <int NR>
__device__ __forceinline__ void table_rows_fp8(const float* src, unsigned char* T8, float* INV, int e0, int es, int lane, const float* gmul  ) {
    f32x4 v[NR][4];
#pragma unroll
    for (int i = 0; i < NR; ++i) { const f32x4* p = (const f32x4*)(src + (size_t)(e0 + i * es) * DM) + lane;
#pragma unroll
        for (int q = 0; q < 4; ++q) v[i][q] = __builtin_nontemporal_load(p + 64 * q); }
    if (gmul) {
#pragma unroll
        for (int q = 0; q < 4; ++q) { const f32x4 g = *((const f32x4*)gmul + lane + 64 * q);
#pragma unroll
            for (int i = 0; i < NR; ++i) v[i][q] = v[i][q] * g; } }
#pragma unroll
    for (int i = 0; i < NR; ++i) {
        float mx = 0.f;
#pragma unroll
        for (int q = 0; q < 4; ++q) mx = fmaxf(mx, fmaxf(fmaxf(fabsf(v[i][q][0]), fabsf(v[i][q][1])), fmaxf(fabsf(v[i][q][2]), fabsf(v[i][q][3]))));
        mx = wave_max(mx);
        const float sc = mx > 0.f ? 448.0f / mx : 1.0f;
        const int e = e0 + i * es;
#pragma unroll
        for (int q = 0; q < 4; ++q) { unsigned w = 0; w = __builtin_amdgcn_cvt_pk_fp8_f32(v[i][q][0] * sc, v[i][q][1] * sc, w, false); w = __builtin_amdgcn_cvt_pk_fp8_f32(v[i][q][2] * sc, v[i][q][3] * sc, w, true);
            *(unsigned*)(T8 + (size_t)(2 * q + (lane >> 5)) * SLICE_BYTES + (size_t)e * 128 + 4 * (lane & 31)) = w; }
        if (lane == 0) INV[e] = mx > 0.f ? mx * (1.0f / 448.0f) : 1.0f;
    }
}
__device__ __forceinline__ void tables_fp8(const float* peer_u, const float* peer_v, unsigned char* U8, unsigned char* V8, float* INVU, float* INVV, const float* gffn, int r0, int r1, int w, int nw, int lane) {
    int e = r0 + w;
    for (; e + 3 * nw < r1; e += 4 * nw) { table_rows_fp8<4>(peer_u, U8, INVU, e, nw, lane, gffn); table_rows_fp8<4>(peer_v, V8, INVV, e, nw, lane, nullptr); }
    for (; e + nw < r1; e += 2 * nw) { table_rows_fp8<2>(peer_u, U8, INVU, e, nw, lane, gffn); table_rows_fp8<2>(peer_v, V8, INVV, e, nw, lane, nullptr); }
    for (; e < r1; e += nw) { table_rows_fp8<1>(peer_u, U8, INVU, e, nw, lane, gffn); table_rows_fp8<1>(peer_v, V8, INVV, e, nw, lane, nullptr); }
}
struct ECtx { u32x4 ea, eb; };
struct XCtx { u32x4 xa, xb; };
__device__ __forceinline__ ECtx e_ctx(int lane, int t, const unsigned short* E) { ECtx c; c.ea = *(const u32x4*)(E + (size_t)t * 128 + (lane >> 3) * 16); c.eb = *(const u32x4*)(E + (size_t)t * 128 + (lane >> 3) * 16 + 8); return c; }
__device__ __forceinline__ XCtx x_ctx(int lane, int t, int s, const unsigned short* HB) { XCtx c; c.xa = *(const u32x4*)(HB + (size_t)t * DM + s * 128 + (lane & 7) * 16); c.xb = *(const u32x4*)(HB + (size_t)t * DM + s * 128 + (lane & 7) * 16 + 8); return c; }
__device__ __forceinline__ void g_rows(u32x4 (&row)[16], const ECtx& c, const unsigned char* T8s, int c8) {
#pragma unroll
    for (int j = 0; j < 16; ++j) { const unsigned ew = getw(j < 8 ? c.ea : c.eb, (j & 7) >> 1); const unsigned e = (j & 1) ? (ew >> 16) : (ew & 0xffffu);
        row[j] = *(const u32x4*)(T8s + (size_t)e * 128 + c8 * 16); }
}
__device__ __forceinline__ unsigned e_at(const ECtx& c, int j) { const unsigned ew = getw(j < 8 ? c.ea : c.eb, (j & 7) >> 1); return (j & 1) ? (ew >> 16) : (ew & 0xffffu); }
__device__ __forceinline__ void u_compute(int lane, int t, int s, const XCtx& c, u32x4 (&row)[16], const ECtx& en, const unsigned char* U8s, unsigned short* PA) {
    const int rs = lane >> 3, c8 = lane & 7;
    f32x2_t xf[8];
#pragma unroll
    for (int i = 0; i < 4; ++i) { const unsigned wa = getw(c.xa, i), wb = getw(c.xb, i); xf[i] = (f32x2_t){bflo(wa), bfhi(wa)}; xf[4 + i] = (f32x2_t){bflo(wb), bfhi(wb)}; }
    float p0 = 0.f, p1 = 0.f;
#pragma unroll
    for (int j = 0; j < 16; ++j) {
        f32x2_t acc = {0.f, 0.f};
#pragma unroll
        for (int w = 0; w < 4; ++w) { const unsigned q = getw(row[j], w);
            acc = __builtin_elementwise_fma(__builtin_amdgcn_cvt_pk_f32_fp8(q, false), xf[2 * w], acc); acc = __builtin_elementwise_fma(__builtin_amdgcn_cvt_pk_f32_fp8(q, true), xf[2 * w + 1], acc); }
        row[j] = *(const u32x4*)(U8s + (size_t)e_at(en, j) * 128 + c8 * 16);
        __builtin_amdgcn_sched_barrier(0);
        float p = acc.x + acc.y; p += dppf<XOR1>(p); p += dppf<XOR2>(p); p += dppf<XOR7>(p);
        if (j & 1) p1 = (c8 == (j >> 1)) ? p : p1; else p0 = (c8 == (j >> 1)) ? p : p0;
    }
    *(unsigned*)(PA + ((size_t)t * 8 + s) * 128 + rs * 16 + 2 * c8) = pkbf(p0, p1);
}
#define TCL(t_) ((t_) < NTOK ? (t_) : NTOK - 1)
__device__ __forceinline__ void upass_slice(int lane, int s, int wv, int nwv, const unsigned char* U8s, const unsigned short* E, const unsigned short* HB, unsigned short* PA) {
    const int c8 = lane & 7;
    int t = wv; if (t >= NTOK) return;
    ECtx eA = e_ctx(lane, t, E), eB = e_ctx(lane, TCL(t + nwv), E); XCtx xA = x_ctx(lane, t, s, HB), xB;
    u32x4 rA[16], rB[16];
    g_rows(rA, eA, U8s, c8); g_rows(rB, eB, U8s, c8);
    eA = e_ctx(lane, TCL(t + 2 * nwv), E);
    for (; t < NTOK; t += 2 * nwv) {
        eB = e_ctx(lane, TCL(t + 3 * nwv), E); xB = x_ctx(lane, TCL(t + nwv), s, HB);
        u_compute(lane, t, s, xA, rA, eA, U8s, PA);
        eA = e_ctx(lane, TCL(t + 4 * nwv), E); xA = x_ctx(lane, TCL(t + 2 * nwv), s, HB);
        if (t + nwv < NTOK) u_compute(lane, t + nwv, s, xB, rB, eB, U8s, PA);
    }
}
template <int NT>
__device__ __forceinline__ void wpass_tokens(int lane, int t0, int ts, const unsigned short* E, const float* G, const unsigned short* PA, const float* INVU, const float* INVV, const float* RSTD, float* W) {
    unsigned pw[NT][8], ew[NT]; f32x2_t g[NT];
#pragma unroll
    for (int i = 0; i < NT; ++i) { const int t = t0 + i * ts;
#pragma unroll
        for (int s = 0; s < 8; ++s) pw[i][s] = *(const unsigned*)(PA + ((size_t)t * 8 + s) * 128 + 2 * lane);
        ew[i] = *(const unsigned*)(E + (size_t)t * 128 + 2 * lane); g[i] = *(const f32x2_t*)(G + (size_t)t * 128 + 2 * lane); }
    float iu0[NT], iu1[NT], iv0[NT], iv1[NT];
#pragma unroll
    for (int i = 0; i < NT; ++i) { const unsigned e0 = ew[i] & 0xffffu, e1 = ew[i] >> 16; iu0[i] = INVU[e0]; iu1[i] = INVU[e1]; iv0[i] = INVV[e0]; iv1[i] = INVV[e1]; }
#pragma unroll
    for (int i = 0; i < NT; ++i) { float a0 = 0.f, a1 = 0.f;
#pragma unroll
        for (int s = 0; s < 8; ++s) { a0 += bflo(pw[i][s]); a1 += bfhi(pw[i][s]); }
        const float rs = RSTD[t0 + i * ts]; a0 *= iu0[i] * rs; a1 *= iu1[i] * rs;
        const float w0 = g[i].x * 0.5f * a0 * (1.0f + erff(a0 * 0.70710678118654752f)) * iv0[i], w1 = g[i].y * 0.5f * a1 * (1.0f + erff(a1 * 0.70710678118654752f)) * iv1[i];
        *(f32x2_t*)(W + (size_t)(t0 + i * ts) * 128 + 2 * lane) = (f32x2_t){w0, w1}; }
}
struct WCtx { f32x4 w0, w1, w2, w3; };
__device__ __forceinline__ WCtx w_ctx(int lane, int t, const float* W) { const f32x4* wp = (const f32x4*)(W + (size_t)t * 128 + (lane >> 3) * 16); WCtx c; c.w0 = wp[0]; c.w1 = wp[1]; c.w2 = wp[2]; c.w3 = wp[3]; return c; }
__device__ __forceinline__ void v_compute(int lane, int t, int s, const WCtx& wc, u32x4 (&row)[16], const ECtx& en, const unsigned char* V8s, unsigned short* PO) {
    const int rs = lane >> 3, c8 = lane & 7;
    f32x2_t o[8];
#pragma unroll
    for (int i = 0; i < 8; ++i) o[i] = (f32x2_t){0.f, 0.f};
#pragma unroll
    for (int j = 0; j < 16; ++j) {
        const f32x4 wq = j < 4 ? wc.w0 : j < 8 ? wc.w1 : j < 12 ? wc.w2 : wc.w3; const int jj = j & 3; const float wj = jj == 0 ? wq.x : jj == 1 ? wq.y : jj == 2 ? wq.z : wq.w; const f32x2_t w2v = {wj, wj};
#pragma unroll
        for (int w = 0; w < 4; ++w) { const unsigned q = getw(row[j], w);
            o[2 * w] = __builtin_elementwise_fma(__builtin_amdgcn_cvt_pk_f32_fp8(q, false), w2v, o[2 * w]); o[2 * w + 1] = __builtin_elementwise_fma(__builtin_amdgcn_cvt_pk_f32_fp8(q, true), w2v, o[2 * w + 1]); }
        row[j] = *(const u32x4*)(V8s + (size_t)e_at(en, j) * 128 + c8 * 16);
        __builtin_amdgcn_sched_barrier(0);
    }
    float of[16];
#pragma unroll
    for (int i = 0; i < 8; ++i) { of[2 * i] = o[i].x; of[2 * i + 1] = o[i].y; }
#pragma unroll
    for (int i = 0; i < 16; ++i) { float x = of[i]; x += dppf<XOR8>(x);
        auto s1 = __builtin_amdgcn_permlane16_swap(__float_as_uint(x), __float_as_uint(x), false, false); x = __uint_as_float(s1[0]) + __uint_as_float(s1[1]);
        auto s2 = __builtin_amdgcn_permlane32_swap(__float_as_uint(x), __float_as_uint(x), false, false); of[i] = __uint_as_float(s2[0]) + __uint_as_float(s2[1]); }
    if (rs == 0) {
        unsigned short* po = PO + (size_t)t * DM + s * 128 + c8 * 16;
        *(u32x4*)po = (u32x4){pkbf(of[0], of[1]), pkbf(of[2], of[3]), pkbf(of[4], of[5]), pkbf(of[6], of[7])};
        *(u32x4*)(po + 8) = (u32x4){pkbf(of[8], of[9]), pkbf(of[10], of[11]), pkbf(of[12], of[13]), pkbf(of[14], of[15])};
    }
}
__device__ __forceinline__ void vpass_slice(int lane, int s, int wv, int nwv, const unsigned char* V8s, const unsigned short* E, const float* W, unsigned short* PO) {
    const int c8 = lane & 7;
    int t = wv; if (t >= NTOK) return;
    ECtx eA = e_ctx(lane, t, E), eB = e_ctx(lane, TCL(t + nwv), E); WCtx wA = w_ctx(lane, t, W), wB;
    u32x4 rA[16], rB[16];
    g_rows(rA, eA, V8s, c8); g_rows(rB, eB, V8s, c8);
    eA = e_ctx(lane, TCL(t + 2 * nwv), E);
    for (; t < NTOK; t += 2 * nwv) {
        eB = e_ctx(lane, TCL(t + 3 * nwv), E); wB = w_ctx(lane, TCL(t + nwv), W);
        v_compute(lane, t, s, wA, rA, eA, V8s, PO);
        eA = e_ctx(lane, TCL(t + 4 * nwv), E); wA = w_ctx(lane, TCL(t + 2 * nwv), W);
        if (t + nwv < NTOK) v_compute(lane, t + nwv, s, wB, rB, eB, V8s, PO);
    }
}
#undef TCL
__device__ __forceinline__ void final_token(int lane, int t, float* Y, const unsigned short* HB, const unsigned short* PO, const float* gfin) {
    f32x4* yr = (f32x4*)(Y + (size_t)t * DM) + lane; const u32x2_t* pr = (const u32x2_t*)(PO + (size_t)t * DM) + lane; const u32x2_t* hr = (const u32x2_t*)(HB + (size_t)t * DM) + lane;
    f32x4 v[4]; float ss = 0.f;
#pragma unroll
    for (int j = 0; j < 4; ++j) { const u32x2_t hw = hr[64 * j]; v[j] = (f32x4){bflo(hw.x), bfhi(hw.x), bflo(hw.y), bfhi(hw.y)}; const u32x2_t p = pr[64 * j]; v[j][0] += bflo(p.x); v[j][1] += bfhi(p.x); v[j][2] += bflo(p.y); v[j][3] += bfhi(p.y);
        ss += (v[j][0] * v[j][0] + v[j][1] * v[j][1]) + (v[j][2] * v[j][2] + v[j][3] * v[j][3]); }
    const float rstd = 1.0f / sqrtf(wave_sum(ss) * (1.0f / DM) + EPS);
#pragma unroll
    for (int j = 0; j < 4; ++j) { const f32x4 g = *((const f32x4*)gfin + lane + 64 * j); yr[64 * j] = (f32x4){v[j][0] * rstd * g[0], v[j][1] * rstd * g[1], v[j][2] * rstd * g[2], v[j][3] * rstd * g[3]}; }
}
}

constexpr int NWAVES = 8;
#ifndef MK_N_LAUNCHES
#define MK_N_LAUNCHES 1
#endif
constexpr int N_LAUNCHES = MK_N_LAUNCHES;
constexpr int PER_PHASE = 7;
#ifndef PROBE
#define PROBE -1
#endif
#ifndef DIAG_SEL
#define DIAG_SEL -1
#endif
#ifndef TAIL_R0
#define TAIL_R0 6144
#endif
#ifndef XVAR
#define XVAR 0
#endif
#define NREP(k) ((PROBE == (k)) ? 2 : 1)

typedef unsigned short bf16;
typedef unsigned v4u __attribute__((ext_vector_type(4)));
typedef float f32x4 __attribute__((ext_vector_type(4)));
#define LDS_WAIT() asm volatile("s_waitcnt lgkmcnt(0)" ::: "memory")
#define VM_WAIT() asm volatile("s_waitcnt vmcnt(0)" ::: "memory")

constexpr size_t MiB = 1u << 20;
constexpr size_t WS_CTL = 0, CTL_ZERO_BYTES = 64 * 1024;
constexpr size_t WS_TAB = 1 * MiB;
constexpr size_t WS_SSQ = 1 * MiB + 64 * 1024;
constexpr size_t WS_WIN = 3 * MiB;
constexpr size_t WS_WA = 10 * MiB, WS_WB = 11 * MiB;
constexpr size_t WS_WO = 12 * MiB;
constexpr size_t WS_WE = 14 * MiB;
constexpr size_t WS_U8 = 18 * MiB, WS_V8 = 34 * MiB;
constexpr size_t WS_PA = 50 * MiB;
constexpr size_t WS_INVU = 2 * MiB + 128 * 1024, WS_INVV = WS_INVU + 64 * 1024;
constexpr size_t WS_RSTD = WS_INVV + 64 * 1024;
constexpr size_t WS_G = 3 * MiB, WS_E = 11 * MiB;
constexpr size_t WS_W = 114 * MiB, WS_PSS = 122 * MiB;
constexpr int CW_RANK = 8192;
constexpr size_t WS_XN = 82 * MiB;
constexpr size_t WS_ACT = 114 * MiB;
constexpr size_t WS_QA = WS_ACT, WS_QB = WS_ACT + 512 * 2;
constexpr size_t WS_KA = WS_ACT + 32 * MiB, WS_VA = WS_ACT + 36 * MiB, WS_KB = WS_ACT + 40 * MiB, WS_VB = WS_ACT + 44 * MiB;
constexpr size_t WS_GA = WS_ACT + 48 * MiB, WS_GB = WS_ACT + 80 * MiB;
constexpr size_t WS_SC = WS_ACT;
constexpr size_t WS_END = 242 * MiB;
static_assert(WS_GB + 32 * MiB <= WS_END && WS_SC + (size_t)NTOK * SCW * 4 <= WS_END, "d_ws map");

constexpr int RING_BYTES = 131072;
constexpr int MISC_OFF = RING_BYTES + 320;
constexpr int LDS_BYTES = 147456;

#define XB_TMO      128
#define XB_XCNT(j)  (256  + 64 * (j))
#define XB_XSUB(j)  (1280 + 64 * (j))
#define XB_XGEN(j)  (2304 + 64 * (j))
#define XB_TOP      3328
#define XB_TOPGEN   3392
#define XCD_BAR_WORDS 3456
#define XB_SPIN_CAP (1u << 18)

__device__ __forceinline__ unsigned xb_ld(unsigned* p)              { return __hip_atomic_load(p, __ATOMIC_RELAXED, __HIP_MEMORY_SCOPE_AGENT); }
__device__ __forceinline__ unsigned xb_add(unsigned* p, unsigned v) { return __hip_atomic_fetch_add(p, v, __ATOMIC_RELAXED, __HIP_MEMORY_SCOPE_AGENT); }
__device__ __forceinline__ unsigned xb_xcc_id() { return (unsigned)__builtin_amdgcn_s_getreg((3 << 11) | 20) & 0xFu; }
#define XB_SPIN(cond, bar) do { unsigned _sp = 0; while (cond) { __builtin_amdgcn_s_sleep(1); \
    if ((++_sp & 255u) == 0u) { if (xb_ld(&(bar)[XB_TMO])) break; if (_sp > XB_SPIN_CAP) { atomicAdd(&(bar)[XB_TMO], 1u); break; } } } } while (0)

struct XcdBarrier {
    unsigned* bar; unsigned x;
    volatile LAS unsigned* st;
};

__device__ __forceinline__ XcdBarrier xcd_barrier_post(unsigned* bar, volatile LAS unsigned* st) {
    XcdBarrier b; b.bar = bar; b.x = xb_xcc_id(); b.st = st;
    if (threadIdx.x == 0) (void)xb_add(&bar[XB_XCNT(b.x)], 1u);
    return b;
}
__device__ __forceinline__ void xcd_barrier_complete(unsigned* bar, unsigned x, unsigned& nloc, unsigned& nx) {
    const unsigned G = gridDim.x * gridDim.y * gridDim.z;
    unsigned sum, cnt, mine, sp = 0u;
    for (;;) {
        sum = 0u; cnt = 0u; mine = 0u;
#pragma unroll
        for (unsigned j = 0; j < 16; ++j) { const unsigned c = xb_ld(&bar[XB_XCNT(j)]); sum += c; cnt += (c > 0u) ? 1u : 0u; mine = (j == x) ? c : mine; }
        if (sum == G) break;
        __builtin_amdgcn_s_sleep(1);
        if ((++sp & 255u) == 0u) { if (xb_ld(&bar[XB_TMO])) break; if (sp > XB_SPIN_CAP) { atomicAdd(&bar[XB_TMO], 1u); break; } }
    }
    nloc = mine > 0u ? mine : 1u; nx = cnt > 0u ? cnt : 1u;
}

__device__ __forceinline__ void xcd_barrier(const XcdBarrier& b) {
    asm volatile("s_waitcnt vmcnt(0)" ::: "memory");
    __syncthreads();
    if (threadIdx.x == 0) {
        unsigned* bar = b.bar;
        __builtin_amdgcn_s_waitcnt(0);
        unsigned nloc = b.st[0], nx = b.st[1];
        if (nloc == 0u) { xcd_barrier_complete(bar, b.x, nloc, nx); b.st[0] = nloc; b.st[1] = nx; }
        const unsigned old = xb_add(&bar[XB_XSUB(b.x)], 1u);
        const unsigned gen = old / nloc;
        if (old + 1u == (gen + 1u) * nloc) {
            __builtin_amdgcn_fence(__ATOMIC_RELEASE, "agent");
            asm volatile("s_waitcnt vmcnt(0)" ::: "memory");
            const unsigned og = xb_add(&bar[XB_TOP], 1u);
            const unsigned tg = og / nx;
            if (og + 1u == (tg + 1u) * nx) xb_add(&bar[XB_TOPGEN], 1u);
            else XB_SPIN(xb_ld(&bar[XB_TOPGEN]) == tg, bar);
            __builtin_amdgcn_fence(__ATOMIC_ACQUIRE, "agent");
            xb_add(&bar[XB_XGEN(b.x)], 1u);
            asm volatile("s_waitcnt vmcnt(0)" ::: "memory");
        } else {
            XB_SPIN(xb_ld(&bar[XB_XGEN(b.x)]) == gen, bar);
            __builtin_amdgcn_fence(__ATOMIC_ACQUIRE, "agent");
            asm volatile("s_waitcnt vmcnt(0)" ::: "memory");
        }
    }
    __syncthreads();
}


struct Args { const float* in[17]; float* out; unsigned char* ws; int ph_lo, ph_hi, li, pad; };

__device__ __forceinline__ void p0_transpose_item(const float* W, int K, int N, bf16* WT, int k0, int src_n0, int dst_n0, LAS float* scr, int lane, int dpitch = 0, int dk0 = 0, bool split16 = false) {
    if (dpitch == 0) dpitch = K;
    const int sl = split16 ? ((lane & 15) + ((lane & 16) << 1)) : (lane & 31);
#pragma unroll 8
    for (int i = 0; i < 32; ++i) { const int kk = 2 * i + (lane >> 5); scr[kk * 33 + (lane & 31)] = W[(size_t)(k0 + kk) * N + src_n0 + sl]; }
    LDS_WAIT();
    const int c = lane & 7;
#pragma unroll
    for (int j = 0; j < 4; ++j) { const int n = (lane >> 3) + 8 * j; const LAS float* s = scr + (8 * c) * 33 + n;
        v4u o; o.x = pkbf(s[0 * 33], s[1 * 33]); o.y = pkbf(s[2 * 33], s[3 * 33]); o.z = pkbf(s[4 * 33], s[5 * 33]); o.w = pkbf(s[6 * 33], s[7 * 33]);
        *(v4u*)(WT + (size_t)(dst_n0 + n) * dpitch + dk0 + k0 + 8 * c) = o; }
    LDS_WAIT();
}
__device__ __forceinline__ int win_src_col(int dst_n0) {
    if (dst_n0 >= 1536) return dst_n0;
    const int tile = dst_n0 >> 8, c = dst_n0 & 255;
    return tile * 256 + 64 * ((c >> 5) & 3) + 16 * (c >> 7);
}
__device__ __forceinline__ int t5_bucket(int rel) {
    const int n = rel < 0 ? -rel : rel; int bkt;
    if (n < 8) bkt = n; else { int v = 8 + (31 - __builtin_clz(n * n)) - 6; bkt = v > 15 ? 15 : v; }
    return bkt + (rel > 0 ? 16 : 0);
}

__global__ void __launch_bounds__(NWAVES * 64, 2) mk_fwd(Args args) {
    extern __shared__ __attribute__((aligned(16))) unsigned char lds_raw[];
    LAS unsigned char* lds = (LAS unsigned char*)lds_raw;
    volatile LAS unsigned* MISC = (volatile LAS unsigned*)(lds + MISC_OFF);
    const int tid = threadIdx.x, lane = tid & 63, wave = __builtin_amdgcn_readfirstlane(tid >> 6);
    const int G = gridDim.x, bx = blockIdx.x; const int vcu = (G % 8 == 0) ? (bx % 8) * (G / 8) + bx / 8 : bx;
    const int gw = vcu * NWAVES + wave, NGW = G * NWAVES;
    unsigned char* ws = args.ws;
    const float* x = args.in[0]; const float* g_mix = args.in[1]; const float* w_in = args.in[2]; const float* b_gate = args.in[3];
    const float* q_norm_g = args.in[4]; const float* k_norm_g = args.in[5]; const float* rel_bias = args.in[6]; const float* sink = args.in[7];
    const float* w_a = args.in[8]; const float* w_b = args.in[9]; const float* w_out = args.in[10]; const float* g_ffn = args.in[11];
    const float* peer_wq = args.in[12]; const float* subkeys = args.in[13]; const float* peer_u = args.in[14]; const float* peer_v = args.in[15]; const float* g_final = args.in[16];
    float* out = args.out;
    float* ROPE = (float*)(ws + WS_TAB); float* BIAS = (float*)(ws + WS_TAB + 16384); float* SSQ = (float*)(ws + WS_SSQ);
    bf16 *WIN_T = (bf16*)(ws + WS_WIN), *WA_T = (bf16*)(ws + WS_WA), *WB_T = (bf16*)(ws + WS_WB), *WO_T = (bf16*)(ws + WS_WO), *WE_T = (bf16*)(ws + WS_WE);
    unsigned char *U8 = ws + WS_U8, *V8 = ws + WS_V8; bf16 *PA = (bf16*)(ws + WS_PA), *XN = (bf16*)(ws + WS_XN);
    float* RSTD = (float*)(ws + WS_RSTD); float *INVU = (float*)(ws + WS_INVU), *INVV = (float*)(ws + WS_INVV), *RG = (float*)(ws + WS_G), *RW = (float*)(ws + WS_W), *PSS = (float*)(ws + WS_PSS); bf16* RE = (bf16*)(ws + WS_E);
    bf16 *QA = (bf16*)(ws + WS_QA), *QB = (bf16*)(ws + WS_QB), *KA = (bf16*)(ws + WS_KA), *VA = (bf16*)(ws + WS_VA), *KB = (bf16*)(ws + WS_KB), *VB = (bf16*)(ws + WS_VB);
    bf16 *GA = (bf16*)(ws + WS_GA), *GB = (bf16*)(ws + WS_GB); bf16* SC = (bf16*)(ws + WS_SC);

    for (int u = tid; u < (LDS_BYTES - RING_BYTES) / 4; u += NWAVES * 64) ((LAS unsigned*)(lds + RING_BYTES))[u] = 0u;
    __syncthreads();
    XcdBarrier bar; bar.bar = (unsigned*)(ws + WS_CTL) + 1024; bar.x = 0; bar.st = nullptr;
    if (N_LAUNCHES != PER_PHASE) bar = xcd_barrier_post((unsigned*)(ws + WS_CTL) + 1024, MISC + 8);
    if (tid == 0) { const unsigned xc = xb_xcc_id(); MISC[13] = xc; MISC[12] = xb_add((unsigned*)(ws + WS_CTL) + CW_RANK + 64 * xc, 1u); }
    const bool tail_tables = (G == 256);
    const int lo = args.ph_lo, hi = args.ph_hi;
#define IN(k) (lo <= (k) && (k) < hi)
#define BOTH(k) (IN(k) && IN((k) + 1))
#define GRID_BAR() do { if (N_LAUNCHES != PER_PHASE) xcd_barrier(bar); STAMP(); } while (0)
#ifdef TSEL
    int n_stamp_ = 0;
#define STAMP() do { if (tid == 0) MISC[16 + n_stamp_] = (unsigned)__builtin_amdgcn_s_memrealtime(); ++n_stamp_; } while (0)
#else
#define STAMP() do { } while (0)
#endif
    STAMP();

    if (IN(0)) for (int rep_ = 0; rep_ < NREP(0); ++rep_) {
        if (rep_) { VM_WAIT(); __syncthreads(); }
        LAS float* scr = (LAS float*)(lds + wave * 16384);
        {
            constexpr int I_IN = (DM / 64) * (INW / 32), I_AB = (QW / 64) * (DM / 32), I_O = (DM / 64) * (DM / 32);
            constexpr int NITEMS = I_IN + 2 * I_AB + I_O;
            for (int it = gw; it < NITEMS; it += NGW) {
                int r = it;
                if (r < I_IN) { const int nblk = INW / 32, kb = r / nblk, nb = r % nblk; p0_transpose_item(w_in, DM, INW, WIN_T, 64 * kb, win_src_col(32 * nb), 32 * nb, scr, lane, 0, 0, 32 * nb < 1536); continue; } r -= I_IN;
                if (r < I_AB) { const int nblk = DM / 32, kb = r / nblk, nb = r % nblk; p0_transpose_item(w_a, QW, DM, WA_T, 64 * kb, 32 * nb, 32 * nb, scr, lane, DM, 0); continue; } r -= I_AB;
                if (r < I_AB) { const int nblk = DM / 32, kb = r / nblk, nb = r % nblk; p0_transpose_item(w_b, QW, DM, WA_T, 64 * kb, 32 * nb, 32 * nb, scr, lane, DM, QW); continue; }   r -= I_AB;
                { const int nblk = DM / 32, kb = r / nblk, nb = r % nblk; p0_transpose_item(w_out, DM, DM, WO_T, 64 * kb, 32 * nb, 32 * nb, scr, lane); }
            }
        }
        __syncthreads();
        {
            LAS float* sk_s = (LAS float*)lds;
            LAS float* wq_s = (LAS float*)(lds + 128 * 129 * 4);
            for (int it = vcu; it < 16 * 16; it += G) {
                const int c = it >> 4, k0 = (it & 15) * 64;
                for (int i = tid; i < 128 * 32; i += NWAVES * 64) { const int n = i >> 5, d4 = (i & 31) * 4; const f32x4 v = *(const f32x4*)(subkeys + ((size_t)c * NKEYS + n) * 128 + d4);
                    sk_s[n * 129 + d4] = v[0]; sk_s[n * 129 + d4 + 1] = v[1]; sk_s[n * 129 + d4 + 2] = v[2]; sk_s[n * 129 + d4 + 3] = v[3]; }
                for (int i = tid; i < 64 * 32; i += NWAVES * 64) { const int k = i >> 5, d4 = (i & 31) * 4; const f32x4 v = *(const f32x4*)(peer_wq + (size_t)(k0 + k) * SCW + c * 128 + d4);
                    wq_s[k * 129 + d4] = v[0]; wq_s[k * 129 + d4 + 1] = v[1]; wq_s[k * 129 + d4 + 2] = v[2]; wq_s[k * 129 + d4 + 3] = v[3]; }
                __syncthreads();
                {
                    typedef float f32x16_t __attribute__((ext_vector_type(16)));
                    const int tn = wave >> 1, tk = wave & 1; f32x16_t acc = {};
                    const LAS float* ap = sk_s + (32 * tn + (lane & 31)) * 129 + (lane >> 5); const LAS float* bp = wq_s + (32 * tk + (lane & 31)) * 129 + (lane >> 5);
#pragma unroll 8
                    for (int s = 0; s < 64; ++s) acc = __builtin_amdgcn_mfma_f32_32x32x2f32(ap[2 * s], bp[2 * s], acc, 0, 0, 0);
                    const float gk = g_ffn[k0 + 32 * tk + (lane & 31)];
#pragma unroll
                    for (int r = 0; r < 16; ++r) { const int n = 32 * tn + (r & 3) + 8 * (r >> 2) + 4 * (lane >> 5);
                        WE_T[(size_t)(c * 128 + n) * DM + k0 + 32 * tk + (lane & 31)] = (bf16)(pkbf(acc[r] * gk, 0.f) & 0xffffu); }
                }
                __syncthreads();
            }
        }
        peer::tables_fp8(peer_u, peer_v, U8, V8, INVU, INVV, g_ffn, 0, tail_tables ? TAIL_R0 : NEXP, gw, NGW, lane);
        for (int m = gw; m < NTOK; m += 2 * NGW) {
            const int m2 = (m + NGW < NTOK) ? m + NGW : m;
            const f32x4* xr = (const f32x4*)(x + (size_t)m * DM) + lane; const f32x4* xr2 = (const f32x4*)(x + (size_t)m2 * DM) + lane; f32x4 v[4], v2[4]; float s = 0.f, s2 = 0.f;
#pragma unroll
            for (int j = 0; j < 4; ++j) { v[j] = __builtin_nontemporal_load(xr + 64 * j); v2[j] = __builtin_nontemporal_load(xr2 + 64 * j); }
#pragma unroll
            for (int j = 0; j < 4; ++j) { s += (v[j][0] * v[j][0] + v[j][1] * v[j][1]) + (v[j][2] * v[j][2] + v[j][3] * v[j][3]); s2 += (v2[j][0] * v2[j][0] + v2[j][1] * v2[j][1]) + (v2[j][2] * v2[j][2] + v2[j][3] * v2[j][3]); }
            const float rstd = 1.0f / sqrtf(peer::wave_sum(s) * (1.0f / DM) + EPS), rstd2 = 1.0f / sqrtf(peer::wave_sum(s2) * (1.0f / DM) + EPS);
            unsigned long long* o8 = (unsigned long long*)(XN + (size_t)m * DM) + lane; unsigned long long* o82 = (unsigned long long*)(XN + (size_t)m2 * DM) + lane;
#pragma unroll
            for (int j = 0; j < 4; ++j) { const f32x4 g = *((const f32x4*)g_mix + lane + 64 * j);
                o8[64 * j] = (unsigned long long)pkbf(v[j][0] * rstd * g[0], v[j][1] * rstd * g[1]) | ((unsigned long long)pkbf(v[j][2] * rstd * g[2], v[j][3] * rstd * g[3]) << 32);
                o82[64 * j] = (unsigned long long)pkbf(v2[j][0] * rstd2 * g[0], v2[j][1] * rstd2 * g[1]) | ((unsigned long long)pkbf(v2[j][2] * rstd2 * g[2], v2[j][3] * rstd2 * g[3]) << 32); }
        }
        if (vcu == 0) {
            for (int i = tid; i < 64 * 16; i += NWAVES * 64) { const int pos = i >> 4, f = i & 15; const float fr = powf(10000.0f, -(float)f / 16.0f); const float ang = (float)pos * fr; ROPE[2 * i] = cosf(ang); ROPE[2 * i + 1] = sinf(ang); }
            for (int i = tid; i < 8 * 257; i += NWAVES * 64) { const int h = i / 257, rel = i % 257 - 128; BIAS[i] = rel_bias[t5_bucket(rel) * NH + h] * LOG2E; }
        }
        if (BOTH(0) && rep_ == NREP(0) - 1) GRID_BAR();
    }

    if (IN(1)) {
        pg8::Gemm g{XN, WIN_T, NTOK, INW, DM}; pg8::StaticOrder S; S.init(NTOK, INW, G, bx);
        pg8::EpiIn E{QA, KA, VA, QB, KB, VB, GA, GB, q_norm_g, k_norm_g, b_gate, ROPE};
        if (PROBE == 1) { pg8::gemm_phase<pg8::EpiIn, pg8::StaticOrder, true, true>(lds, g, S, E); VM_WAIT(); __syncthreads(); }
        if (PROBE == 11) { pg8::EpiNull EN{SSQ}; pg8::gemm_phase<pg8::EpiNull, pg8::StaticOrder, true, true>(lds, g, S, EN); VM_WAIT(); __syncthreads(); }
        pg8::gemm_phase<pg8::EpiIn, pg8::StaticOrder, true, true>(lds, g, S, E);
        if (tail_tables && bx >= 128) peer::tables_fp8(peer_u, peer_v, U8, V8, INVU, INVV, g_ffn, TAIL_R0, NEXP, (bx - 128) * NWAVES + wave, 128 * NWAVES, lane);
        if (BOTH(1)) GRID_BAR();
    }

    if (IN(2)) {
#ifdef DIAG_QK
        if (bx == 0) {
            LAS float* red = (LAS float*)lds; float worst = 0.f;
            for (int smp = 0; smp < 10; ++smp) {
                const int row = (smp * 2741 + 77) & (NTOK - 1), b = row >> 12, s = row & (SEQ - 1); const int kind = smp % 5;
                const int hh = (smp * 3 + 1) & 7, kh = smp & 1;
                float ref = 0.f, got = 0.f; const int d = tid & 63;
                if (tid < 64) {
                    int col;
                    if (kind == 0) col = hh * 64 + d; else if (kind == 1) col = 512 + kh * 64 + d; else if (kind == 2) col = (smp < 5 ? 640 : 1408) + kh * 64 + d; else if (kind == 3) col = (smp < 5 ? 768 + hh * 64 : 1280 + kh * 64) + d; else col = (smp < 5 ? 1536 : 2560) + hh * 64 + d;
                    float z = 0.f; for (int k = 0; k < DM; ++k) z += __builtin_bit_cast(float, (unsigned)XN[(size_t)row * DM + k] << 16) * w_in[(size_t)k * INW + col];
                    red[tid] = z;
                }
                __syncthreads();
                if (tid < 64) {
                    float z = red[tid];
                    if (kind == 0 || kind == 1) {
                        float ss = 0.f; for (int i = 0; i < 64; ++i) ss += red[i] * red[i];
                        const float rstd = 1.0f / sqrtf(ss / 64.0f + EPS); const float* g = kind == 0 ? q_norm_g : k_norm_g;
                        const int part = d >> 5, dd = d & 31, f = dd & 15; const int pos = part == 0 ? (s >> 6) : (s & 63);
                        const float ang = (float)pos * powf(10000.0f, -(float)f / 16.0f), cs = cosf(ang), sn = sinf(ang);
                        const float u1 = red[part * 32 + f] * rstd * g[part * 32 + f], u2 = red[part * 32 + 16 + f] * rstd * g[part * 32 + 16 + f];
                        z = dd < 16 ? u1 * cs - u2 * sn : u2 * cs + u1 * sn; if (kind == 0) z *= QSCALE;
                        got = kind == 0 ? __builtin_bit_cast(float, (unsigned)QA[(size_t)row * 1024 + hh * 64 + d] << 16) : __builtin_bit_cast(float, (unsigned)KA[kimg_off(b, kh, s, d)] << 16);
                    } else if (kind == 2) { got = __builtin_bit_cast(float, (unsigned)(smp < 5 ? VA : VB)[vimg_off(b, kh, s, d)] << 16);
                    } else if (kind == 3) { if (smp < 5) { z *= QSCALE; got = __builtin_bit_cast(float, (unsigned)QB[(size_t)row * 1024 + hh * 64 + d] << 16); } else got = __builtin_bit_cast(float, (unsigned)KB[kimg_off(b, kh, s, d)] << 16);
                    } else { z = 1.0f / (1.0f + expf(-(z + b_gate[(smp < 5 ? 0 : DM) + hh * 64 + d]))); got = __builtin_bit_cast(float, (unsigned)(smp < 5 ? GA : GB)[(size_t)row * DM + hh * 64 + d] << 16); }
                    ref = z;
                }
                __syncthreads();
                if (tid < 64) { red[128 + tid] = fabsf(ref - got); red[256 + tid] = fabsf(ref); }
                __syncthreads();
                if (tid == 0) { float e = 0.f, a = 0.f; for (int i = 0; i < 64; ++i) { e = fmaxf(e, red[128 + i]); a = fmaxf(a, red[256 + i]); } const float rel = e / fmaxf(a, 1e-20f); if (DIAG_SEL < 0 || DIAG_SEL == smp) worst = fmaxf(worst, rel); }
                __syncthreads();
            }
            if (tid == 0) MISC[41] = __float_as_uint(worst);
        }
        GRID_BAR();
#endif
        if (PROBE == 21) {
            bf16* DUM = XN;
            for (int u = vcu; u < 512; u += G) { const int xg = u >> 6, i = u & 63; const int b = xg >> 1, h = 4 * (xg & 1) + (i >> 4), qblk = i & 15;
                attn::attn_unit<false, XVAR>((LAS char*)lds, QA, KA, VA, DUM, b, h, qblk, nullptr, nullptr); }
        }
        if (PROBE == 22) {
            bf16* DUM = XN;
            for (int u = vcu; u < 512; u += G) { const int xg = u >> 6, i = u & 63;
                attn::attn_unit<true>((LAS char*)lds, QB, KB, VB, DUM, xg >> 1, xg & 1, i, BIAS, sink); }
        }
#ifdef DIAG_ATTN
        {
            bf16* DUM = XN;
            for (int u = vcu; u < 512; u += G) { const int xg = u >> 6, i = u & 63; const int b = xg >> 1, h = 4 * (xg & 1) + (i >> 4), qblk = i & 15;
                attn::attn_unit<false, 0, DIAG_ATTN == 1>((LAS char*)lds, QA, KA, VA, DUM, b, h, qblk, nullptr, nullptr); }
            for (int u = vcu; u < 512; u += G) { const int xg = u >> 6, i = u & 63;
                attn::attn_unit<true>((LAS char*)lds, QB, KB, VB, DUM + 512, xg >> 1, xg & 1, i, BIAS, sink); }
            GRID_BAR();
            if (bx == 0) {
                LAS float* sc = (LAS float*)lds; LAS float* red = (LAS float*)(lds + 32768); float worst = 0.f;
                for (int smp = 0; smp < 12; ++smp) {
                    const int win = smp & 1; const int b = (smp * 7 + 1) & 3, h = (smp * 5 + 3) & 7, q = smp == 1 ? 5 : smp == 3 ? 4090 : smp == 4 ? 4095 : (smp * 977 + 131 * win + (smp == 2 ? 0 : 17)) & 4095; const int kvh = h >> 2;
                    const bf16* Qp = (win ? QB : QA) + ((size_t)b * SEQ + q) * 1024 + h * HD; const bf16* Kp = win ? KB : KA; const bf16* Vp = win ? VB : VA;
                    float mx = -1e30f;
                    for (int j = tid; j < SEQ; j += 512) { float s = 0.f;
                        for (int d = 0; d < HD; ++d) s += __builtin_bit_cast(float, (unsigned)Qp[d] << 16) * __builtin_bit_cast(float, (unsigned)Kp[kimg_off(b, kvh, j, d)] << 16);
                        if (win) { const int rel = j - q; s = (rel >= -128 && rel <= 128) ? s + BIAS[h * 257 + rel + 128] : -1e30f; }
                        sc[j] = s; mx = fmaxf(mx, s); }
                    red[tid] = mx; __syncthreads();
                    if (tid == 0) { float m = -1e30f; for (int i = 0; i < 512; ++i) m = fmaxf(m, red[i]); if (win) m = fmaxf(m, sink[h] * LOG2E); red[512] = m; } __syncthreads();
                    const float m = red[512]; float ls = 0.f;
                    for (int j = tid; j < SEQ; j += 512) { const float p = exp2f(sc[j] - m); sc[j] = p; ls += p; }
                    __syncthreads(); red[tid] = ls; __syncthreads();
                    if (tid == 0) { float l = 0.f; for (int i = 0; i < 512; ++i) l += red[i]; if (win) l += exp2f(sink[h] * LOG2E - m); red[513] = l; } __syncthreads();
                    if (tid < HD) { float o = 0.f; for (int j = 0; j < SEQ; ++j) o += sc[j] * __builtin_bit_cast(float, (unsigned)Vp[vimg_off(b, kvh, j, tid)] << 16);
                        o /= red[513]; const float t = __builtin_bit_cast(float, (unsigned)DUM[((size_t)b * SEQ + q) * 1024 + win * 512 + h * HD + tid] << 16);
                        red[600 + tid] = fabsf(o - t); red[700 + tid] = fabsf(o); }
                    __syncthreads();
                    if (tid == 0) { float e = 0.f, a = 0.f; for (int i = 0; i < HD; ++i) { e = fmaxf(e, red[600 + i]); a = fmaxf(a, red[700 + i]); } const float rel = e / fmaxf(a, 1e-20f); if (DIAG_SEL < 0 || DIAG_SEL == smp) worst = fmaxf(worst, rel); }
                    __syncthreads();
                }
                if (tid == 0) MISC[40] = __float_as_uint(worst);
            }
            GRID_BAR();
        }
#endif
        float lbound;
        { const float gq = tid < HD ? fabsf(q_norm_g[tid]) : 0.f, gk = tid < HD ? fabsf(k_norm_g[tid]) : 0.f;
          const float mq = peer::wave_max(gq), mk = peer::wave_max(gk); LAS float* lb = (LAS float*)(lds + 70000);
          if (tid == 0) lb[0] = 64.0f * mq * mk * QSCALE * 1.02f; __syncthreads(); lbound = lb[0]; __syncthreads(); }
        const bool nomax = lbound <= 100.0f;
        for (int u = vcu; u < 512; u += G) { const int xg = u >> 6, i = u & 63; const int b = xg >> 1, h = 4 * (xg & 1) + (i >> 4), qblk = i & 15;
            if (nomax) attn::attn_unit<false, 0, true>((LAS char*)lds, QA, KA, VA, QA, b, h, qblk, nullptr, nullptr);
            else attn::attn_unit<false>((LAS char*)lds, QA, KA, VA, QA, b, h, qblk, nullptr, nullptr); }
        for (int u = vcu; u < 512; u += G) { const int xg = u >> 6, i = u & 63;
            attn::attn_unit<true>((LAS char*)lds, QB, KB, VB, QB, xg >> 1, xg & 1, i, BIAS, sink); }
        if (BOTH(2)) GRID_BAR();
    }

    if (IN(3)) {
        pg8::Gemm g{QA, WA_T, NTOK, DM, DM}; pg8::StaticOrder S; S.init(NTOK, DM, G, bx); pg8::EpiMix E{GA, GB, GB};
        if (PROBE == 3) { pg8::EpiMix E2{GA, GB, XN}; pg8::gemm_phase<pg8::EpiMix, pg8::StaticOrder, true, true>(lds, g, S, E2); VM_WAIT(); __syncthreads(); }
        pg8::gemm_phase<pg8::EpiMix, pg8::StaticOrder, true, true>(lds, g, S, E);
        if (BOTH(3)) GRID_BAR();
    }

    if (IN(4)) {
        pg8::Gemm g{GB, WO_T, NTOK, DM, DM}; pg8::StaticOrder S; S.init(NTOK, DM, G, bx); pg8::EpiOut E{x, XN, SSQ};
        for (int rep_ = 0; rep_ < NREP(4); ++rep_) pg8::gemm_phase<pg8::EpiOut, pg8::StaticOrder, true, true>(lds, g, S, E);
        if (BOTH(4)) GRID_BAR();
    }

    if (IN(5)) {
        pg8::Gemm g{XN, WE_T, NTOK, SCW, DM}; pg8::StaticOrder S; S.init(NTOK, SCW, G, bx); pg8::EpiScore E{SSQ, SC};
        for (int rep_ = 0; rep_ < NREP(5); ++rep_) pg8::gemm_phase<pg8::EpiScore, pg8::StaticOrder, true, true>(lds, g, S, E);
        if (BOTH(5)) GRID_BAR();
    }

    if (IN(6)) {
        LAS char* wl = (LAS char*)lds + wave * peer::WAVE_LDS;
        const unsigned long long ct = peer::cand_table(lane & 7);
        for (int rep_ = 0; rep_ < NREP(60); ++rep_) {
            peer::SCtx sA = peer::s_ctx(lane, gw < NTOK ? gw : 0, SC), sB;
            for (int t = gw; t < NTOK; t += 2 * NGW) {
                sB = peer::s_ctx(lane, t + NGW < NTOK ? t + NGW : t, SC);
                peer::route_token(wl, lane, t, ct, sA, SSQ, RE, RG, RSTD);
                sA = peer::s_ctx(lane, t + 2 * NGW < NTOK ? t + 2 * NGW : t, SC);
                if (t + NGW < NTOK) peer::route_token(wl, lane, t + NGW, ct, sB, SSQ, RE, RG, RSTD);
            }
        }
        GRID_BAR();
        int nloc = 0, nx = 0, ox = 0; const int myx = (int)MISC[13], rank = (int)MISC[12];
#pragma unroll
        for (int j = 0; j < 16; ++j) { const int c = (int)xb_ld((unsigned*)(ws + WS_CTL) + CW_RANK + 64 * j); nx += c > 0; ox += (c > 0 && j < myx); nloc = j == myx ? c : nloc; }
        const int wv = rank * NWAVES + wave, nwv = nloc * NWAVES;
        for (int rep_ = 0; rep_ < NREP(61); ++rep_) for (int s = ox; s < 8; s += nx) { const unsigned char* U8s = U8 + (size_t)s * peer::SLICE_BYTES;
            peer::upass_slice(lane, s, wv, nwv, U8s, RE, XN, PA); }
        GRID_BAR();
        for (int rep_ = 0; rep_ < NREP(62); ++rep_) for (int t = gw; t < NTOK; t += NGW) peer::wpass_tokens<1>(lane, t, NGW, RE, RG, PA, INVU, INVV, RSTD, RW);
        GRID_BAR();
        for (int s = ox; s < 8; s += nx) { const unsigned char* V8s = V8 + (size_t)s * peer::SLICE_BYTES;
            for (int rep_ = 0; rep_ < NREP(63); ++rep_) peer::vpass_slice(lane, s, wv, nwv, V8s, RE, RW, PA); }
        GRID_BAR();
        if (PROBE == 200) { for (int r_ = 0; r_ < 10; ++r_) GRID_BAR(); }
        for (int t = gw; t < NTOK; t += NGW) peer::final_token(lane, t, out, XN, PA, g_final);
#ifdef DIAG_ATTN
        if (bx == 0 && tid == 0) { VM_WAIT(); out[0] += 1000.0f * __uint_as_float(MISC[40]); }
#endif
#ifdef DIAG_QK
        if (bx == 0 && tid == 0) { VM_WAIT(); out[0] += 1000.0f * __uint_as_float(MISC[41]); }
#endif
#ifdef TSEL
        STAMP();
        if (bx == 0 && tid == 0) { VM_WAIT(); const unsigned d = MISC[16 + TSEL + 1] - MISC[16 + TSEL]; out[0] += (float)d * 0.001f; }
#endif
    }
#undef IN
#undef BOTH
#undef GRID_BAR
}

extern "C" void kernel_launch(void* const* d_in, const int* in_sizes, int n_in, void* d_out, int out_size, void* d_ws, size_t ws_size, hipStream_t stream) {
    static int grid = 0;
    if (grid == 0) {
        if (n_in != 17 || in_sizes[0] != NTOK * DM || out_size != NTOK * DM || ws_size < WS_END) { fprintf(stderr, "kernel_launch: unexpected shapes (n_in %d, in0 %d, out %d, ws %zu); nothing launched\n", n_in, n_in > 0 ? in_sizes[0] : -1, out_size, ws_size); grid = -1; return; }
        int dev = 0, cus = 0, per_cu = 0;
        if (hipGetDevice(&dev) != hipSuccess || hipDeviceGetAttribute(&cus, hipDeviceAttributeMultiprocessorCount, dev) != hipSuccess) { grid = -1; return; }
        if (hipFuncSetAttribute((const void*)mk_fwd, hipFuncAttributeMaxDynamicSharedMemorySize, LDS_BYTES) != hipSuccess) { fprintf(stderr, "kernel_launch: hipFuncSetAttribute failed\n"); grid = -1; return; }
        if (hipOccupancyMaxActiveBlocksPerMultiprocessor(&per_cu, (const void*)mk_fwd, NWAVES * 64, LDS_BYTES) != hipSuccess || per_cu < 1) { fprintf(stderr, "kernel_launch: occupancy query says %d blocks per CU; nothing launched\n", per_cu); (void)hipGetLastError(); grid = -1; return; }
        grid = cus;
    }
    if (grid < 0) return;
    if (hipMemsetAsync((char*)d_ws + WS_CTL, 0, CTL_ZERO_BYTES, stream) != hipSuccess) { fprintf(stderr, "kernel_launch: hipMemsetAsync failed\n"); return; }
    Args a{};
    for (int i = 0; i < 17; ++i) a.in[i] = (const float*)d_in[i];
    a.out = (float*)d_out; a.ws = (unsigned char*)d_ws;
    if (N_LAUNCHES == 1) {
        a.ph_lo = 0; a.ph_hi = PER_PHASE; a.li = 0;
#if defined(COOP_LAUNCH)
        void* kargs[] = {&a};
        hipError_t e = hipLaunchCooperativeKernel((const void*)mk_fwd, dim3(grid), dim3(NWAVES * 64), kargs, LDS_BYTES, stream);
        if (e != hipSuccess) fprintf(stderr, "kernel_launch: cooperative launch failed: %s (grid %d)\n", hipGetErrorString(e), grid);
#else
        if (PROBE == 100) { hipLaunchKernelGGL(mk_fwd, dim3(grid), dim3(NWAVES * 64), LDS_BYTES, stream, a); (void)hipMemsetAsync((char*)d_ws + WS_CTL, 0, CTL_ZERO_BYTES, stream); }
        hipLaunchKernelGGL(mk_fwd, dim3(grid), dim3(NWAVES * 64), LDS_BYTES, stream, a);
#endif
    } else {
        for (int li = 0; li < PER_PHASE; ++li) { a.ph_lo = li; a.ph_hi = li + 1; a.li = li;
            hipLaunchKernelGGL(mk_fwd, dim3(grid), dim3(NWAVES * 64), LDS_BYTES, stream, a); }
    }
}
```

```cpp
#include <hip/hip_runtime.h>
#include <cstdio>
#include <cstdint>
#include <cmath>
namespace pg8 {
#define PG8_LAS __attribute__((address_space(3)))
typedef unsigned short bf16_t;
typedef short bf16x8 __attribute__((ext_vector_type(8)));
typedef float f32x4 __attribute__((ext_vector_type(4)));
typedef unsigned u32x4 __attribute__((ext_vector_type(4)));
constexpr int BM = 256, BK = 64, HALF = 128, HTB = HALF * BK * 2  , STAGE_BYTES = 8 * HTB, NXCD = 8, WGM = 8;

__host__ __device__ __forceinline__ int lds_byte(int r, int c) { const int st = (r >> 4) * 2 + (c >> 5), rr = r & 15, cc = c & 31, ob = rr * 64 + cc * 2; return st * 1024 + (ob ^ (((ob >> 9) & 1) << 5)); }
__host__ __device__ __forceinline__ void stage_rc(int b, int& R, int& C) { const int st = b / 1024, sb = b % 1024, swz = sb ^ (((sb >> 9) & 1) << 5); R = (st >> 1) * 16 + swz / 64; C = (st & 1) * 32 + (swz % 64) / 2; }
__host__ __device__ __forceinline__ int perm32(int rho) { const int n = rho >> 4, i = rho & 15; return 8 * (i >> 2) + 4 * n + (i & 3); }

struct Unit { int pm, pn; };
struct Gemm { const bf16_t* A; const bf16_t* Bt; int M, N, K; };

struct StaticOrder {
    int nM, nN, nwg, G, c;
    __host__ __device__ void init(int M, int N, int G_, int c_) { nM = M / BM; nN = N / BM; nwg = nM * nN; G = G_; c = c_; }
    __host__ __device__ bool next(int i, Unit& u) const {
        const long L = (long)i * G + c; if (L >= nwg) return false;
        int wgid = (int)L; { const int q = nwg / NXCD, r = nwg % NXCD, xcd = wgid % NXCD, off = wgid / NXCD; wgid = (xcd < r ? xcd * (q + 1) : r * (q + 1) + (xcd - r) * q) + off; }
        const int nig = WGM * nN, gid = wgid / nig, fm = gid * WGM, gsz = (nM - fm) < WGM ? (nM - fm) : WGM;
        u.pm = fm + ((wgid % nig) % gsz); u.pn = (wgid % nig) / gsz; return true;
    }
    __device__ __forceinline__ void a_ready(const Unit&) const {}
    __device__ __forceinline__ void done(const Unit&) const {}
};

__device__ __forceinline__ unsigned cvt_pk_bf16(float lo, float hi) { unsigned r; asm volatile("v_cvt_pk_bf16_f32 %0, %1, %2" : "=v"(r) : "v"(lo), "v"(hi)); return r; }
typedef float f32x2 __attribute__((ext_vector_type(2)));
#ifndef PG8_PRIO
#define PG8_PRIO 1
#endif
template <class Epi, class Sched, bool ALIGN_EPI = false, bool SP2 = false>
__device__ __forceinline__ void gemm_phase(PG8_LAS unsigned char* lds, const Gemm g, const Sched& S, const Epi& E) {
    const int tid = threadIdx.x, wid = __builtin_amdgcn_readfirstlane(tid >> 6), lane = tid & 63, wr = wid >> 2, wc = wid & 3, fr = lane & 15, fq = lane >> 4;
    const int K = g.K, nt = K / BK;
    unsigned voffA[2], voffB[2];
#pragma unroll
    for (int i = 0; i < 2; ++i) { int R, C; stage_rc(tid * 16 + i * 8192, R, C); const int Rb = Epi::PERM ? ((R & ~31) + perm32(R & 31)) : R;
        voffA[i] = (unsigned)(R * K + C) * 2u; voffB[i] = (unsigned)(Rb * K + C) * 2u; }
    const size_t kstep = (size_t)(BK * 2);
    const size_t hstep = (size_t)HALF * K * 2;
    const size_t tstep = 2 * hstep;
    const unsigned ldsw = (unsigned)wid * 1024u;
    const int aoff = lds_byte(wr * 64 + fr, fq * 8), boff = lds_byte(wc * 32 + fr, fq * 8);
#define PG8_SA(b, h) (((b) * 2 + (h)) * HTB)
#define PG8_SB(b, h) ((4 + (b) * 2 + (h)) * HTB)
#define PG8_STAGE(bufoff, gbase, voff) do { _Pragma("unroll") for (int _i = 0; _i < 2; ++_i) \
        __builtin_amdgcn_global_load_lds((const unsigned*)((const char*)(gbase) + (voff)[_i]), (PG8_LAS unsigned*)(lds + (bufoff) + ldsw + _i * 8192), 16, 0, 0); } while (0)
#define PG8_LDA(dst, b, h) do { _Pragma("unroll") for (int m = 0; m < 4; ++m) _Pragma("unroll") for (int k = 0; k < 2; ++k) dst[m][k] = *(const PG8_LAS bf16x8*)(lds + PG8_SA(b, h) + aoff + m * 2048 + k * 1024); } while (0)
#define PG8_LDB(dst, b, h) do { _Pragma("unroll") for (int n = 0; n < 2; ++n) _Pragma("unroll") for (int k = 0; k < 2; ++k) dst[n][k] = *(const PG8_LAS bf16x8*)(lds + PG8_SB(b, h) + boff + n * 2048 + k * 1024); } while (0)
#define PG8_MMA(ai, bj, At, Bt) do { __builtin_amdgcn_s_setprio(PG8_PRIO); _Pragma("unroll") for (int m = 0; m < 4; ++m) _Pragma("unroll") for (int n = 0; n < 2; ++n) _Pragma("unroll") for (int k = 0; k < 2; ++k) \
        acc[ai][bj][m][n] = __builtin_amdgcn_mfma_f32_16x16x32_bf16(Bt[n][k], At[m][k], acc[ai][bj][m][n], 0, 0, 0); __builtin_amdgcn_s_setprio(0); } while (0)
#define PG8_WAIT_V(n) asm volatile("s_waitcnt vmcnt(" #n ")" ::: "memory")
#define PG8_WAIT_L(n) asm volatile("s_waitcnt lgkmcnt(" #n ")" ::: "memory")
#define PG8_BAR __builtin_amdgcn_s_barrier()
#define PG8_SCHED __builtin_amdgcn_sched_barrier(0)
    Unit cur, nxt; int ui = 0;
    if (!S.next(0, cur)) return;
    f32x4 acc[2][2][4][2];
#pragma unroll
    for (int a = 0; a < 2; ++a)
#pragma unroll
        for (int b = 0; b < 2; ++b)
#pragma unroll
            for (int m = 0; m < 4; ++m)
#pragma unroll
                for (int n = 0; n < 2; ++n) acc[a][b][m][n] = (f32x4){0.f, 0.f, 0.f, 0.f};
    bf16x8 At[4][2], B0[2][2], B1[2][2];
    const char* cA = (const char*)g.A + (size_t)cur.pm * tstep; const char* cB = (const char*)g.Bt + (size_t)cur.pn * tstep;
    S.a_ready(cur);
    if constexpr (SP2) {
        PG8_STAGE(PG8_SB(0, 0), cB, voffB); PG8_STAGE(PG8_SB(0, 1), cB + hstep, voffB); PG8_STAGE(PG8_SA(0, 0), cA, voffA); PG8_STAGE(PG8_SA(0, 1), cA + hstep, voffA);
        if (wr == 1) PG8_BAR;
        PG8_WAIT_V(2); PG8_BAR;
        PG8_STAGE(PG8_SB(1, 0), cB + kstep, voffB); PG8_STAGE(PG8_SA(1, 0), cA + kstep, voffA); PG8_STAGE(PG8_SB(1, 1), cB + hstep + kstep, voffB);
        PG8_WAIT_V(6); PG8_BAR;
    } else {
        PG8_STAGE(PG8_SB(0, 0), cB, voffB); PG8_STAGE(PG8_SA(0, 0), cA, voffA); PG8_STAGE(PG8_SB(0, 1), cB + hstep, voffB); PG8_STAGE(PG8_SA(0, 1), cA + hstep, voffA);
        if (wr == 1) PG8_BAR;
        PG8_WAIT_V(4); PG8_BAR;
        PG8_STAGE(PG8_SB(1, 0), cB + kstep, voffB); PG8_STAGE(PG8_SA(1, 0), cA + kstep, voffA); PG8_STAGE(PG8_SB(1, 1), cB + hstep + kstep, voffB);
        PG8_WAIT_V(6); PG8_BAR;
    }
    for (;;) {
        const bool has_next = S.next(ui + 1, nxt);
        const char* nA = has_next ? (const char*)g.A + (size_t)nxt.pm * tstep : cA; const char* nB = has_next ? (const char*)g.Bt + (size_t)nxt.pn * tstep : cB;
        for (int t = 0; t < nt; t += 2) {
            if constexpr (Epi::HAS_MID) { if (t == (nt >> 1)) E.mid(acc, cur, wr, wc, fr, fq); }
            if constexpr (Epi::HAS_KSTEP) E.kstep(t, nt, cur, lds + STAGE_BYTES + 2048 + wid * 1024, tid);
            const bool last = (t == nt - 2);
            const char* a1 = cA + (size_t)(t + 1) * kstep;
            const char* a2 = last ? nA : cA + (size_t)(t + 2) * kstep; const char* b2 = last ? nB : cB + (size_t)(t + 2) * kstep;
            const char* a3 = a2 + kstep; const char* b3 = b2 + kstep;
            if (last && has_next) S.a_ready(nxt);
            if constexpr (SP2) {
            PG8_LDB(B0, 0, 0); PG8_LDB(B1, 0, 1); PG8_SCHED; PG8_LDA(At, 0, 0); PG8_STAGE(PG8_SA(1, 1), a1 + hstep, voffA);
            PG8_WAIT_V(8); PG8_WAIT_L(0); PG8_BAR; PG8_MMA(0, 0, At, B0); PG8_MMA(0, 1, At, B1); PG8_BAR; PG8_SCHED;
            PG8_LDA(At, 0, 1); PG8_STAGE(PG8_SB(0, 0), b2, voffB); PG8_STAGE(PG8_SB(0, 1), b2 + hstep, voffB); PG8_STAGE(PG8_SA(0, 0), a2, voffA);
            PG8_WAIT_V(8); PG8_WAIT_L(0); PG8_BAR; PG8_MMA(1, 0, At, B0); PG8_MMA(1, 1, At, B1); PG8_BAR; PG8_SCHED;
            PG8_LDB(B0, 1, 0); PG8_LDB(B1, 1, 1); PG8_SCHED; PG8_LDA(At, 1, 0); PG8_STAGE(PG8_SA(0, 1), a2 + hstep, voffA);
            PG8_WAIT_V(8); PG8_WAIT_L(0); PG8_BAR; PG8_MMA(0, 0, At, B0); PG8_MMA(0, 1, At, B1); PG8_BAR; PG8_SCHED;
            PG8_LDA(At, 1, 1); PG8_STAGE(PG8_SB(1, 0), b3, voffB); PG8_STAGE(PG8_SB(1, 1), b3 + hstep, voffB); PG8_STAGE(PG8_SA(1, 0), a3, voffA);
            PG8_WAIT_V(8); PG8_WAIT_L(0); PG8_BAR; PG8_MMA(1, 0, At, B0); PG8_MMA(1, 1, At, B1); PG8_BAR; PG8_SCHED;
            } else {
            PG8_LDB(B0, 0, 0); PG8_SCHED; PG8_LDA(At, 0, 0); PG8_STAGE(PG8_SA(1, 1), a1 + hstep, voffA);
            PG8_WAIT_L(8); PG8_BAR; PG8_WAIT_L(0); PG8_MMA(0, 0, At, B0); PG8_BAR; PG8_SCHED;
            PG8_LDB(B1, 0, 1); PG8_STAGE(PG8_SB(0, 0), b2, voffB);
            PG8_BAR; PG8_WAIT_L(0); PG8_MMA(0, 1, At, B1); PG8_BAR;
            PG8_LDA(At, 0, 1); PG8_STAGE(PG8_SA(0, 0), a2, voffA);
            PG8_BAR; PG8_WAIT_L(0); PG8_MMA(1, 0, At, B0); PG8_BAR; PG8_SCHED;
            PG8_STAGE(PG8_SB(0, 1), b2 + hstep, voffB);
            PG8_WAIT_V(6); PG8_BAR; PG8_MMA(1, 1, At, B1); PG8_BAR;
            PG8_LDB(B0, 1, 0); PG8_SCHED; PG8_LDA(At, 1, 0); PG8_STAGE(PG8_SA(0, 1), a2 + hstep, voffA);
            PG8_WAIT_L(8); PG8_BAR; PG8_WAIT_L(0); PG8_MMA(0, 0, At, B0); PG8_BAR; PG8_SCHED;
            PG8_LDB(B1, 1, 1); PG8_STAGE(PG8_SB(1, 0), b3, voffB);
            PG8_BAR; PG8_WAIT_L(0); PG8_MMA(0, 1, At, B1); PG8_BAR;
            PG8_LDA(At, 1, 1); PG8_STAGE(PG8_SA(1, 0), a3, voffA);
            PG8_BAR; PG8_WAIT_L(0); PG8_MMA(1, 0, At, B0); PG8_BAR; PG8_SCHED;
            PG8_STAGE(PG8_SB(1, 1), b3 + hstep, voffB);
            PG8_WAIT_V(6); PG8_BAR; PG8_MMA(1, 1, At, B1); PG8_BAR;
            }
        }
        if constexpr (ALIGN_EPI) { if (wr == 0) PG8_BAR; }
        if constexpr (!Epi::AFTER_DRAIN) { E(acc, cur, wr, wc, fr, fq); S.done(cur); }
        if (!has_next) break;
#pragma unroll
        for (int a = 0; a < 2; ++a)
#pragma unroll
            for (int b = 0; b < 2; ++b)
#pragma unroll
                for (int m = 0; m < 4; ++m)
#pragma unroll
                    for (int n = 0; n < 2; ++n) acc[a][b][m][n] = (f32x4){0.f, 0.f, 0.f, 0.f};
        cur = nxt; cA = nA; cB = nB; ++ui;
        if constexpr (ALIGN_EPI) { if (wr == 1) PG8_BAR; }
    }
    PG8_WAIT_V(0);
    if constexpr (!ALIGN_EPI) { if (wr == 0) PG8_BAR; }
    PG8_BAR;
    if constexpr (Epi::AFTER_DRAIN) { E.fused(acc, cur, wr, wc, fr, fq, lds, wid, lane); S.done(cur); }
#undef PG8_SA
#undef PG8_SB
#undef PG8_STAGE
#undef PG8_LDA
#undef PG8_LDB
#undef PG8_MMA
#undef PG8_WAIT_V
#undef PG8_WAIT_L
#undef PG8_BAR
#undef PG8_SCHED
}
}

constexpr int DM = 1024, NB = 4, SEQ = 4096, NTOK = NB * SEQ;
constexpr int HD = 64, NH = 8, NKV = 2, QW = NH * HD  , GRIDW = 64;
constexpr int INW = 3584;
constexpr int PH = 8, NKEYS = 128, TOPK = 16, NEXP = NKEYS * NKEYS, SCW = PH * 2 * NKEYS  ;
constexpr float EPS = 1e-6f;
constexpr float LOG2E = 1.4426950408889634f;
constexpr float QSCALE = 0.125f * LOG2E;

typedef unsigned u32x2_t __attribute__((ext_vector_type(2)));
typedef float f32x2_t __attribute__((ext_vector_type(2)));
typedef __bf16 bf16x2_t __attribute__((ext_vector_type(2)));
__device__ __forceinline__ unsigned pkbf(float lo, float hi) { f32x2_t v = {lo, hi}; bf16x2_t b = __builtin_convertvector(v, bf16x2_t); return __builtin_bit_cast(unsigned, b); }
__device__ __forceinline__ float bflo(unsigned w) { return __builtin_bit_cast(float, w << 16); }
__device__ __forceinline__ float bfhi(unsigned w) { return __builtin_bit_cast(float, w & 0xffff0000u); }

__device__ __forceinline__ size_t kimg_off(int b, int kvh, int s, int dim) { return ((size_t)((b * NKV + kvh) * (SEQ / 64) + (s >> 6)) << 12) + (dim >> 3) * 512 + (s & 63) * 8 + (dim & 7); }
__device__ __forceinline__ size_t vimg_off(int b, int kvh, int s, int dim) { return ((size_t)((b * NKV + kvh) * (SEQ / 64) + (s >> 6)) << 12) + (dim >> 5) * 2048 + (s & 63) * 32 + (dim & 31); }

namespace pg8 {
#ifndef PF_X
#define PF_X 0
#endif
#ifndef ST_WT
#define ST_WT 0
#endif
__device__ __forceinline__ void st16(void* p, const u32x4& v) {
#if ST_WT
    asm volatile("global_store_dwordx4 %0, %1, off sc1\n\ts_nop 1" :: "v"(p), "v"(v) : "memory");
#else
    *(u32x4*)p = v;
#endif
}
__device__ __forceinline__ u32x4 pk8(const f32x4& a, const f32x4& b) { return (u32x4){pkbf(a[0], a[1]), pkbf(a[2], a[3]), pkbf(b[0], b[1]), pkbf(b[2], b[3])}; }
__device__ __forceinline__ float ub0(unsigned w) { return (float)(w & 0xffu); }
__device__ __forceinline__ float ub1(unsigned w) { return (float)((w >> 8) & 0xffu); }
__device__ __forceinline__ float ub2(unsigned w) { return (float)((w >> 16) & 0xffu); }
__device__ __forceinline__ float ub3(unsigned w) { return (float)(w >> 24); }
__device__ __forceinline__ float xsum16_32(float x) {
    auto a = __builtin_amdgcn_permlane16_swap(__float_as_uint(x), __float_as_uint(x), false, false); x = __uint_as_float(a[0]) + __uint_as_float(a[1]);
    auto b = __builtin_amdgcn_permlane32_swap(__float_as_uint(x), __float_as_uint(x), false, false); return __uint_as_float(b[0]) + __uint_as_float(b[1]);
}
struct EpiIn {
    static constexpr bool PERM = true, AFTER_DRAIN = false, HAS_MID = false, HAS_KSTEP = false;
    bf16_t *Qa, *Ka, *Va, *Qb, *Kb, *Vb; unsigned char *Ga, *Gb;
    const float *qg, *kg, *bgate, *rope;
    const float* rstdx;
    __device__ __forceinline__ void operator()(const f32x4 (&acc)[2][2][4][2], const Unit& u, int wr, int wc, int fr, int fq) const {
        const int pn = u.pn;
        float rsx[8];
#pragma unroll
        for (int ai = 0; ai < 2; ++ai)
#pragma unroll
            for (int m = 0; m < 4; ++m) rsx[ai * 4 + m] = rstdx[u.pm * BM + ai * HALF + wr * 64 + m * 16 + fr];
        if (pn >= 6) {
            const bool isA = pn < 10; unsigned char* G = isA ? Ga : Gb; const int ct = (isA ? pn - 6 : pn - 10) * BM; const float* bb = bgate + (isA ? 0 : DM); const float qmin = isA ? 0.0f : 1.0f;
            f32x4 bv[2][2];
#pragma unroll
            for (int bj = 0; bj < 2; ++bj)
#pragma unroll
                for (int n = 0; n < 2; ++n) bv[bj][n] = *(const f32x4*)(bb + ct + bj * HALF + wc * 32 + 8 * fq + 4 * n);
#pragma unroll
            for (int ai = 0; ai < 2; ++ai)
#pragma unroll
                for (int m = 0; m < 4; ++m) { const int row = u.pm * BM + ai * HALF + wr * 64 + m * 16 + fr; unsigned char* rp = G + (size_t)row * DM + ct + wc * 32 + 8 * fq;
#pragma unroll
                    for (int bj = 0; bj < 2; ++bj) { unsigned w[2];
#pragma unroll
                        for (int n = 0; n < 2; ++n) { const f32x4 z = acc[ai][bj][m][n] * rsx[ai * 4 + m] + bv[bj][n]; unsigned q[4];
#pragma unroll
                            for (int j = 0; j < 4; ++j) { const float g = __builtin_amdgcn_rcpf(1.0f + __builtin_amdgcn_exp2f(-LOG2E * z[j])); q[j] = __float_as_uint(fmaxf(__builtin_fmaf(g, 255.0f, 8388608.0f), 8388608.0f + qmin)); }
                            w[n] = __builtin_amdgcn_perm(q[1], q[0], 0x0c0c0400u) | __builtin_amdgcn_perm(q[3], q[2], 0x04000c0cu); }
                        *(u32x2_t*)(rp + bj * HALF) = (u32x2_t){w[0], w[1]}; } }
            return;
        }
        const bool brA = pn < 3; const int pl = brA ? pn : pn - 3;
        const bool isq = pl < 2, isk = (!isq) && wc < 2;
        const bool normrope = brA && (isq || isk);
        const int part = fq >> 1, base = 8 * (fq & 1);
        f32x4 gv[2][2];
        if (normrope) { const float* g = isq ? qg : kg;
#pragma unroll
            for (int bj = 0; bj < 2; ++bj)
#pragma unroll
                for (int n = 0; n < 2; ++n) gv[bj][n] = *(const f32x4*)(g + 32 * part + 16 * bj + base + 4 * n); }
        const float osc = isq ? QSCALE : 1.0f;
#pragma unroll
        for (int ai = 0; ai < 2; ++ai)
#pragma unroll
            for (int m = 0; m < 4; ++m) {
                const int row = u.pm * BM + ai * HALF + wr * 64 + m * 16 + fr; const int b = row >> 12, s = row & (SEQ - 1);
                f32x4 v[2][2];
#pragma unroll
                for (int bj = 0; bj < 2; ++bj)
#pragma unroll
                    for (int n = 0; n < 2; ++n) v[bj][n] = acc[ai][bj][m][n] * rsx[ai * 4 + m];
                if (normrope) {
                    float ss = 0.f;
#pragma unroll
                    for (int bj = 0; bj < 2; ++bj)
#pragma unroll
                        for (int n = 0; n < 2; ++n) ss += (v[bj][n][0] * v[bj][n][0] + v[bj][n][1] * v[bj][n][1]) + (v[bj][n][2] * v[bj][n][2] + v[bj][n][3] * v[bj][n][3]);
                    ss += __shfl_xor(ss, 16); ss += __shfl_xor(ss, 32);
                    const float rstd = 1.0f / sqrtf(ss * (1.0f / 64.0f) + EPS);
                    const int pos = part == 0 ? (s >> 6) : (s & (GRIDW - 1));
                    const float* rp = rope + (pos * 16 + base) * 2;
#pragma unroll
                    for (int n = 0; n < 2; ++n) { const f32x4 cs0 = *(const f32x4*)(rp + 8 * n), cs1 = *(const f32x4*)(rp + 8 * n + 4);
                        const float cc[4] = {cs0[0], cs0[2], cs1[0], cs1[2]}, sn[4] = {cs0[1], cs0[3], cs1[1], cs1[3]};
#pragma unroll
                        for (int j = 0; j < 4; ++j) { const float u1 = v[0][n][j] * rstd * gv[0][n][j], u2 = v[1][n][j] * rstd * gv[1][n][j];
                            v[0][n][j] = u1 * cc[j] - u2 * sn[j]; v[1][n][j] = u2 * cc[j] + u1 * sn[j]; } }
                }
#pragma unroll
                for (int bj = 0; bj < 2; ++bj) {
                    const u32x4 w = pk8(v[bj][0] * osc, v[bj][1] * osc);
                    const int dim = 32 * part + 16 * bj + base;
                    bf16_t* dst;
                    if (isq) dst = (brA ? Qa : Qb) + (size_t)row * (2 * QW) + (pl * 4 + wc) * HD + dim;
                    else if (wc < 2) dst = (brA ? Ka : Kb) + kimg_off(b, wc, s, dim);
                    else dst = (brA ? Va : Vb) + vimg_off(b, wc - 2, s, dim);
                    st16(dst, w);
                }
            }
    }
};

#ifndef PF_G
#define PF_G 0
#endif
struct EpiMix {
    static constexpr bool PERM = true, AFTER_DRAIN = false, HAS_MID = true, HAS_KSTEP = (PF_G != 0);
    const unsigned char* GA; const unsigned char* GB; bf16_t* OUT;
    __device__ __forceinline__ void kstep(int t, int nt, const Unit& u, PG8_LAS unsigned char* dummy, int tid) const {
        if (t < 4) {
#pragma unroll
            for (int i = 0; i < 4; ++i) { const int p = t * 4 + i; const unsigned char* Gp = (p & 8) ? GB : GA; const int r = (p & 7) * 32 + (tid >> 4);
                __builtin_amdgcn_global_load_lds((const unsigned*)(Gp + (size_t)(u.pm * BM + r) * DM + u.pn * BM + (tid & 15) * 16), (PG8_LAS unsigned*)dummy, 16, 0, 0); }
        }
    }
    __device__ __forceinline__ void mid(f32x4 (&acc)[2][2][4][2], const Unit& u, int wr, int wc, int fr, int fq) const {
        size_t off = (size_t)(u.pm * BM + wr * 64 + fr) * DM + u.pn * BM + wc * 32 + 8 * fq;
#pragma unroll
        for (int ai = 0; ai < 2; ++ai)
#pragma unroll
            for (int m = 0; m < 4; ++m) {
                asm volatile("" : "+v"(off));
#pragma unroll
                for (int bj = 0; bj < 2; ++bj) { const u32x2_t a = *(const u32x2_t*)(GA + off + bj * HALF), b = *(const u32x2_t*)(GB + off + bj * HALF);
#pragma unroll
                    for (int n = 0; n < 2; ++n) { f32x4& c = acc[ai][bj][m][n]; const unsigned aw = n ? a.y : a.x, bw = n ? b.y : b.x;
                        c[0] *= ub0(aw) * __builtin_amdgcn_rcpf(ub0(bw)); c[1] *= ub1(aw) * __builtin_amdgcn_rcpf(ub1(bw));
                        c[2] *= ub2(aw) * __builtin_amdgcn_rcpf(ub2(bw)); c[3] *= ub3(aw) * __builtin_amdgcn_rcpf(ub3(bw)); } }
                off += (size_t)((m == 3) ? (HALF - 48) : 16) * DM;
            }
    }
    __device__ __forceinline__ void operator()(const f32x4 (&acc)[2][2][4][2], const Unit& u, int wr, int wc, int fr, int fq) const {
#pragma unroll
        for (int ai = 0; ai < 2; ++ai)
#pragma unroll
            for (int m = 0; m < 4; ++m) { const int row = u.pm * BM + ai * HALF + wr * 64 + m * 16 + fr; const size_t off = (size_t)row * DM + u.pn * BM + wc * 32 + 8 * fq;
#pragma unroll
                for (int bj = 0; bj < 2; ++bj) { const u32x2_t g = *(const u32x2_t*)(GB + off + bj * HALF); const f32x4 a0 = acc[ai][bj][m][0] * (1.0f / 255.0f), a1 = acc[ai][bj][m][1] * (1.0f / 255.0f);
                    st16(OUT + off + bj * HALF, (u32x4){pkbf(a0[0] * ub0(g.x), a0[1] * ub1(g.x)), pkbf(a0[2] * ub2(g.x), a0[3] * ub3(g.x)), pkbf(a1[0] * ub0(g.y), a1[1] * ub1(g.y)), pkbf(a1[2] * ub2(g.y), a1[3] * ub3(g.y))}); } }
    }
};
struct EpiOut {
    static constexpr bool PERM = true, AFTER_DRAIN = false, HAS_MID = false, HAS_KSTEP = (PF_X != 0);
    const float* X; bf16_t* HB; float* ssq;
    __device__ __forceinline__ void kstep(int t, int nt, const Unit& u, PG8_LAS unsigned char* dummy, int tid) const {
        const int p0 = (t >> 1) * 4;
#pragma unroll
        for (int i = 0; i < 4; ++i) { const int r = (p0 + i) * 8 + (tid >> 6);
            __builtin_amdgcn_global_load_lds((const unsigned*)(X + (size_t)(u.pm * BM + r) * DM + u.pn * BM + (tid & 63) * 4), (PG8_LAS unsigned*)dummy, 16, 0, 0); }
    }
    __device__ __forceinline__ void operator()(const f32x4 (&acc)[2][2][4][2], const Unit& u, int wr, int wc, int fr, int fq) const {
#pragma unroll
        for (int ai = 0; ai < 2; ++ai)
#pragma unroll
            for (int m = 0; m < 4; ++m) { const int row = u.pm * BM + ai * HALF + wr * 64 + m * 16 + fr; const size_t off = (size_t)row * DM + u.pn * BM + wc * 32 + 8 * fq; float ss = 0.f;
#pragma unroll
                for (int bj = 0; bj < 2; ++bj) { const size_t o2 = off + bj * HALF; const u32x4 xb = *(const u32x4*)(HB + o2);
                    const f32x4 h0 = (f32x4){bflo(xb.x), bfhi(xb.x), bflo(xb.y), bfhi(xb.y)} + acc[ai][bj][m][0], h1 = (f32x4){bflo(xb.z), bfhi(xb.z), bflo(xb.w), bfhi(xb.w)} + acc[ai][bj][m][1];
                    st16(HB + o2, pk8(h0, h1));
                    ss += ((h0[0] * h0[0] + h0[1] * h0[1]) + (h0[2] * h0[2] + h0[3] * h0[3])) + ((h1[0] * h1[0] + h1[1] * h1[1]) + (h1[2] * h1[2] + h1[3] * h1[3])); }
                ss += __shfl_xor(ss, 16); ss += __shfl_xor(ss, 32);
                if (fq == 0) ssq[(size_t)row * 16 + u.pn * 4 + wc] = ss; }
    }
};
typedef _Float16 f16x2_t __attribute__((ext_vector_type(2)));
__device__ __forceinline__ unsigned pkh(float lo, float hi) { f16x2_t h = {(_Float16)lo, (_Float16)hi}; return __builtin_bit_cast(unsigned, h); }
struct EpiScore {
    static constexpr bool PERM = true, AFTER_DRAIN = false, HAS_MID = false, HAS_KSTEP = false;
    const float* ssq; unsigned short* SC;
    __device__ __forceinline__ void operator()(const f32x4 (&acc)[2][2][4][2], const Unit& u, int wr, int wc, int fr, int fq) const {
        float rs[8];
#pragma unroll
        for (int ai = 0; ai < 2; ++ai)
#pragma unroll
            for (int m = 0; m < 4; ++m) { const int row = u.pm * BM + ai * HALF + wr * 64 + m * 16 + fr; const f32x4 q = *(const f32x4*)(ssq + (size_t)row * 16 + 4 * fq); rs[ai * 4 + m] = (q[0] + q[1]) + (q[2] + q[3]); }
#pragma unroll
        for (int i = 0; i < 8; ++i) rs[i] = 1.0f / sqrtf(xsum16_32(rs[i]) * (1.0f / DM) + EPS);
#pragma unroll
        for (int ai = 0; ai < 2; ++ai)
#pragma unroll
            for (int m = 0; m < 4; ++m) { const int row = u.pm * BM + ai * HALF + wr * 64 + m * 16 + fr; const float rstd = rs[ai * 4 + m];
                unsigned short* rp = SC + (size_t)row * SCW + u.pn * BM + wc * 32 + 8 * fq;
#pragma unroll
                for (int bj = 0; bj < 2; ++bj) { const f32x4 v0 = acc[ai][bj][m][0] * rstd, v1 = acc[ai][bj][m][1] * rstd;
                    st16(rp + bj * HALF, (u32x4){pkh(v0[0], v0[1]), pkh(v0[2], v0[3]), pkh(v1[0], v1[1]), pkh(v1[2], v1[3])}); } }
    }
};
struct EpiNull {
    static constexpr bool PERM = true, AFTER_DRAIN = false, HAS_MID = false, HAS_KSTEP = false;
    float* sink;
    __device__ __forceinline__ void operator()(const f32x4 (&acc)[2][2][4][2], const Unit& u, int wr, int wc, int fr, int fq) const {
        f32x4 s = acc[0][0][0][0];
#pragma unroll
        for (int ai = 0; ai < 2; ++ai)
#pragma unroll
            for (int bj = 0; bj < 2; ++bj)
#pragma unroll
                for (int m = 0; m < 4; ++m)
#pragma unroll
                    for (int n = 0; n < 2; ++n) s += acc[ai][bj][m][n];
        if (s[0] + s[1] + s[2] + s[3] == 1.2345e30f) sink[0] = 1.f;
    }
};
}

#define LAS __attribute__((address_space(3)))
namespace attn {
typedef unsigned short bf16_t;
typedef short bf16x8 __attribute__((ext_vector_type(8)));
typedef short s16x4 __attribute__((ext_vector_type(4)));
typedef float f32x16 __attribute__((ext_vector_type(16)));
typedef unsigned u32x4 __attribute__((ext_vector_type(4)));
constexpr int LDS_K = 0, LDS_V = 32768;
constexpr int LDS_BIAS = 65536;
constexpr int LDS_BYTES = 65536 + 4 * 3072;
constexpr float THR = 8.0f;
__device__ __forceinline__ int crow(int r, int hi) { return (r & 3) + 8 * (r >> 2) + 4 * hi; }
__device__ __forceinline__ s16x4 vtr(const LAS char* p) { return __builtin_bit_cast(s16x4, __builtin_amdgcn_ds_read_tr16_b64_v4i16((LAS s16x4*)p)); }
template <int OFF> __device__ __forceinline__ s16x4 vtr_asm(const LAS char* p) { s16x4 r; asm volatile("ds_read_b64_tr_b16 %0, %1 offset:%2" : "=v"(r) : "v"(p), "n"(OFF)); return r; }
__device__ __forceinline__ float xhalf_max(float v) { auto rr = __builtin_amdgcn_permlane32_swap(__float_as_uint(v), __float_as_uint(v), false, false); return fmaxf(__uint_as_float(rr[0]), __uint_as_float(rr[1])); }
__device__ __forceinline__ float xhalf_sum(float v) { auto rr = __builtin_amdgcn_permlane32_swap(__float_as_uint(v), __float_as_uint(v), false, false); return __uint_as_float(rr[0]) + __uint_as_float(rr[1]); }
#ifndef ATTN_KINS
#define ATTN_KINS 0
#endif
#ifndef ATTN_CLEANM
#define ATTN_CLEANM 0
#endif
#ifndef ATTN_PRIO
#define ATTN_PRIO 3
#endif
#ifndef ATTN_1BAR
#define ATTN_1BAR 0
#endif
#ifndef ATTN_ILV
#define ATTN_ILV 1
#endif
#ifndef ATTN_ILV_S
#define ATTN_ILV_S 0
#endif
#ifndef ATTN_ILV_M
#define ATTN_ILV_M 0
#endif
#ifndef ATTN_FADD_ASM
#define ATTN_FADD_ASM 0
#endif
#ifndef ATTN_ILVM_ALL
#define ATTN_ILVM_ALL 0
#endif
#ifndef ATTN_VLATE
#define ATTN_VLATE 0
#endif
#ifndef ATTN_ILVW
#define ATTN_ILVW 0
#endif
#ifndef ATTN_SPRIO
#define ATTN_SPRIO 0
#endif
#ifndef ATTN_STAGE_FIRST
#define ATTN_STAGE_FIRST 0
#endif
#ifndef ATTN_STAGE_LAST
#define ATTN_STAGE_LAST 0
#endif
#ifndef ATTN_CVT_ILV
#define ATTN_CVT_ILV 0
#endif
#ifndef ATTN_WIDE_ST
#define ATTN_WIDE_ST 1
#endif
#ifndef ATTN_VSUM
#define ATTN_VSUM 0
#endif
#ifndef ATTN_DMA
#define ATTN_DMA 0
#endif
__device__ __forceinline__ float fadd_s(float a, float b) {
#if ATTN_FADD_ASM
    float r; asm("v_add_f32_e32 %0, %1, %2" : "=v"(r) : "v"(a), "v"(b)); return r;
#else
    return a + b;
#endif
}
__device__ __forceinline__ float max3f(float a, float b, float c) { float r; asm("v_max3_f32 %0, %1, %2, %3" : "=v"(r) : "v"(a), "v"(b), "v"(c)); return r; }
__device__ __forceinline__ float max2f(float a, float b) { float r; asm("v_max_f32_e32 %0, %1, %2" : "=v"(r) : "v"(a), "v"(b)); return r; }
#define ATT_BAR() do { asm volatile("s_waitcnt lgkmcnt(0)" ::: "memory"); __builtin_amdgcn_s_barrier(); asm volatile("" ::: "memory"); } while (0)

template <bool WIN, int XV = 0, bool NOMAX = false>
__device__ __forceinline__ void attn_unit(LAS char* lds, const bf16_t* Q, const bf16_t* Kimg, const bf16_t* Vimg, bf16_t* O, int b, int hsel, int qblk, const float* bias_all  , const float* sink_all  ) {
    const int tid = threadIdx.x, lane = tid & 63, r32 = lane & 31, hi = lane >> 5; const int wid = __builtin_amdgcn_readfirstlane(tid >> 6); const int grp = wid >> 2;
    const int h = WIN ? 4 * hsel + (wid >> 1) : hsel, kvh = WIN ? hsel : (hsel >> 2);
    constexpr bool ONEBAR = ATTN_1BAR && !WIN;
    const int q0 = WIN ? qblk * 64 : qblk * 256, qw0 = q0 + (WIN ? 32 * (wid & 1) : 32 * wid), qrow = qw0 + r32; const size_t grow = (size_t)b * SEQ + qrow;
    int t_lo = 0, t_hi = SEQ / 64 - 1;
    if (WIN) { t_lo = q0 / 64 - 2; if (t_lo < 0) t_lo = 0; t_hi = q0 / 64 + 2; if (t_hi > SEQ / 64 - 1) t_hi = SEQ / 64 - 1; }
    const int n = t_hi - t_lo + 1;
    const float sink_l2 = WIN ? sink_all[h] * LOG2E : 0.f;
    const bf16_t* Kb = Kimg + ((size_t)((b * NKV + kvh) * (SEQ / 64) + t_lo) << 12) + tid * 8;
    const bf16_t* Vb = Vimg + ((size_t)((b * NKV + kvh) * (SEQ / 64) + t_lo) << 12) + tid * 8;
    bf16x8 qr[4];
#pragma unroll
    for (int d0 = 0; d0 < 4; ++d0) qr[d0] = *(const bf16x8*)(Q + grow * (2 * QW) + h * HD + d0 * 16 + hi * 8);
    LAS float* biasl = (LAS float*)(lds + LDS_BIAS) + (WIN ? (wid >> 1) * 768 : 0);
    if (WIN) { for (int j = tid; j < 4 * 768; j += 512) { const int hh = j / 768, jj = j % 768; ((LAS float*)(lds + LDS_BIAS))[j] = (jj >= 256 && jj <= 512) ? bias_all[(4 * hsel + hh) * 257 + jj - 256] : -1e30f; } }
    constexpr bool DMA = ATTN_DMA && !WIN;
#define ATT_DMA_TILE(j, sl) do { __builtin_amdgcn_global_load_lds((const unsigned*)(Kb + (size_t)(j) * 4096), (LAS unsigned*)(lds + LDS_K + (sl) * 8192 + wid * 1024), 16, 0, 0); \
        __builtin_amdgcn_global_load_lds((const unsigned*)(Vb + (size_t)(j) * 4096), (LAS unsigned*)(lds + LDS_V + (sl) * 8192 + wid * 1024), 16, 0, 0); } while (0)
    u32x4 kreg, vreg;
    if (DMA) { ATT_DMA_TILE(0, 0); ATT_DMA_TILE(1, 1); ATT_DMA_TILE(2, 2); asm volatile("s_waitcnt vmcnt(0)" ::: "memory"); }
    else { const u32x4 k0 = *(const u32x4*)Kb, v0 = *(const u32x4*)Vb, k1 = *(const u32x4*)(Kb + 4096), v1 = *(const u32x4*)(Vb + 4096);
      kreg = *(const u32x4*)(Kb + 2 * 4096); vreg = *(const u32x4*)(Vb + 2 * 4096);
      *(LAS u32x4*)(lds + LDS_K + tid * 16) = k0; *(LAS u32x4*)(lds + LDS_V + tid * 16) = v0;
      *(LAS u32x4*)(lds + LDS_K + 8192 + tid * 16) = k1; *(LAS u32x4*)(lds + LDS_V + 8192 + tid * 16) = v1; }
    ATT_BAR();
    if (grp) ATT_BAR();
    f32x16 o0 = {}, o1 = {}, o2, p0, p1, negm;
    float mref = WIN ? sink_l2 : 0.0f;
    constexpr bool ILV = ATTN_ILV && NOMAX && !WIN && XV == 0 && !ATTN_KINS;
    constexpr bool ILVM = ATTN_ILV && XV == 0 && !ATTN_KINS && (ILV || ATTN_ILVM_ALL);
    constexpr bool ILVW = (ATTN_ILV != 0) && (ATTN_ILVW != 0) && !ILV && XV == 0 && !ATTN_KINS;
    constexpr bool VLATE = ILV && ATTN_VLATE && !ATTN_ILV_S && ATTN_ILV != 2;
    constexpr bool VSUM = ILV && ATTN_VSUM;
    float lsum = 0.f;
#pragma unroll
    for (int r = 0; r < 16; ++r) o2[r] = WIN ? 1.0f : 0.0f;
    const bf16x8 ones = {0x3F80, 0x3F80, 0x3F80, 0x3F80, 0x3F80, 0x3F80, 0x3F80, 0x3F80};
#pragma unroll
    for (int r = 0; r < 16; ++r) negm[r] = -mref;
    const int vlane = ((lane >> 4) & 1) * 32 + (lane & 3) * 8 + (4 * hi + ((lane & 15) >> 2)) * 64;
    const LAS char* kfr = lds + LDS_K + hi * 1024 + r32 * 16;
    u32x4 pk[4]; bf16x8 kf[8], vf[8];
#define ATT_LDK(sl) do { const LAS char* kp_ = kfr + (sl) * 8192; \
        _Pragma("unroll") for (int d0 = 0; d0 < 4; ++d0) { kf[2 * d0] = *(const LAS bf16x8*)(kp_ + d0 * 2048); kf[2 * d0 + 1] = *(const LAS bf16x8*)(kp_ + d0 * 2048 + 512); } } while (0)
#define ATT_LDV1(ks) do { s16x4 l0, h0, l1, h1; \
            if (DMA) { l0 = vtr_asm<(ks) * 1024>(vp_); h0 = vtr_asm<(ks) * 1024 + 512>(vp_); l1 = vtr_asm<4096 + (ks) * 1024>(vp_); h1 = vtr_asm<4096 + (ks) * 1024 + 512>(vp_); } \
            else { l0 = vtr(vp_ + (ks) * 1024); h0 = vtr(vp_ + (ks) * 1024 + 512); l1 = vtr(vp_ + 4096 + (ks) * 1024); h1 = vtr(vp_ + 4096 + (ks) * 1024 + 512); } \
            vf[2 * (ks)] = (bf16x8){l0[0], l0[1], l0[2], l0[3], h0[0], h0[1], h0[2], h0[3]}; vf[2 * (ks) + 1] = (bf16x8){l1[0], l1[1], l1[2], l1[3], h1[0], h1[1], h1[2], h1[3]}; } while (0)
#define ATT_LDV(sl) do { const LAS char* vp_ = lds + LDS_V + (sl) * 8192 + vlane; ATT_LDV1(0); ATT_LDV1(1); ATT_LDV1(2); ATT_LDV1(3); } while (0)
#define ATT_QK() do { \
        if (NOMAX) { const f32x16 z_ = {}; p0 = __builtin_amdgcn_mfma_f32_32x32x16_bf16(kf[0], qr[0], z_, 0, 0, 0); p1 = __builtin_amdgcn_mfma_f32_32x32x16_bf16(kf[1], qr[0], z_, 0, 0, 0); } \
        else { p0 = __builtin_amdgcn_mfma_f32_32x32x16_bf16(kf[0], qr[0], negm, 0, 0, 0); p1 = __builtin_amdgcn_mfma_f32_32x32x16_bf16(kf[1], qr[0], negm, 0, 0, 0); } \
        _Pragma("unroll") for (int d0 = 1; d0 < 4; ++d0) { p0 = __builtin_amdgcn_mfma_f32_32x32x16_bf16(kf[2 * d0], qr[d0], p0, 0, 0, 0); p1 = __builtin_amdgcn_mfma_f32_32x32x16_bf16(kf[2 * d0 + 1], qr[d0], p1, 0, 0, 0); } } while (0)
#define ATT_PV() do { \
        _Pragma("unroll") for (int ks = 0; ks < 4; ++ks) { const bf16x8 pf = __builtin_bit_cast(bf16x8, pk[ks]); \
            o0 = __builtin_amdgcn_mfma_f32_32x32x16_bf16(vf[2 * ks], pf, o0, 0, 0, 0); o1 = __builtin_amdgcn_mfma_f32_32x32x16_bf16(vf[2 * ks + 1], pf, o1, 0, 0, 0); \
            o2 = __builtin_amdgcn_mfma_f32_32x32x16_bf16(ones, pf, o2, 0, 0, 0); } } while (0)
    int ia = 0, ib = n - 1;
    if (WIN) { int lo_t = (qw0 - 128) >> 6; if (lo_t < t_lo) lo_t = t_lo; int hi_t = (qw0 + 31 + 128) >> 6; if (hi_t > t_hi) hi_t = t_hi; ia = lo_t - t_lo; ib = hi_t - t_lo; }
#define ATT_STAGE(i) do { if (DMA) { if ((i) + 3 < n) ATT_DMA_TILE((i) + 3, ((i) + 3) & 3); } \
        else if ((i) + 2 < n) { const int sl_ = ((i) + 2) & 3; *(LAS u32x4*)(lds + LDS_K + sl_ * 8192 + tid * 16) = kreg; *(LAS u32x4*)(lds + LDS_V + sl_ * 8192 + tid * 16) = vreg; \
            if ((i) + 3 < n) { kreg = *(const u32x4*)(Kb + (size_t)((i) + 3) * 4096); vreg = *(const u32x4*)(Vb + (size_t)((i) + 3) * 4096); } } } while (0)
    bool first = !WIN;
    int i = 0;
    if (ia == 0) { ATT_LDK(0); asm volatile("s_waitcnt lgkmcnt(0)" ::: "memory"); ATT_QK(); if (VLATE) ATT_LDV(0); }
    if (!ONEBAR || !grp) ATT_BAR();
    for (; i < ia; ++i) {
        ATT_STAGE(i);
        ATT_BAR();
        if (i + 1 == ia) { ATT_LDK((i + 1) & 3); asm volatile("s_waitcnt lgkmcnt(0)" ::: "memory"); ATT_QK(); }
        ATT_BAR();
    }
    for (; i <= ib; ++i) {
        if (ILV) {
            if (ATTN_STAGE_FIRST) { ATT_STAGE(i); __builtin_amdgcn_sched_barrier(0); }
            const LAS char* vp_ = lds + LDS_V + (i & 3) * 8192 + vlane;
#if ATTN_ILV_S == 2
            asm volatile("s_nop 7" : "+v"(p0), "+v"(p1));
            s16x4 l0_, h0_, l1_, h1_;
#define ATT_E4(P, a) do { _Pragma("unroll") for (int r = (a); r < (a) + 4; ++r) P[r] = __builtin_amdgcn_exp2f(P[r]); asm volatile("" : "+v"(P)); __builtin_amdgcn_sched_barrier(0); } while (0)
#define ATT_RA(ks) do { l0_ = vtr_asm<(ks) * 1024>(vp_); h0_ = vtr_asm<(ks) * 1024 + 512>(vp_); __builtin_amdgcn_sched_barrier(0); } while (0)
#define ATT_RB(ks) do { l1_ = vtr_asm<4096 + (ks) * 1024>(vp_); h1_ = vtr_asm<4096 + (ks) * 1024 + 512>(vp_); \
            vf[2 * (ks)] = (bf16x8){l0_[0], l0_[1], l0_[2], l0_[3], h0_[0], h0_[1], h0_[2], h0_[3]}; vf[2 * (ks) + 1] = (bf16x8){l1_[0], l1_[1], l1_[2], l1_[3], h1_[0], h1_[1], h1_[2], h1_[3]}; __builtin_amdgcn_sched_barrier(0); } while (0)
            ATT_E4(p0, 0); ATT_RA(0); ATT_E4(p0, 4); ATT_RB(0); ATT_E4(p0, 8); ATT_RA(1); ATT_E4(p0, 12); ATT_RB(1);
            ATT_E4(p1, 0); ATT_RA(2); ATT_E4(p1, 4); ATT_RB(2); ATT_E4(p1, 8); ATT_RA(3); ATT_E4(p1, 12); ATT_RB(3);
#undef ATT_E4
#undef ATT_RA
#undef ATT_RB
#elif ATTN_ILV_S == 1
            asm volatile("s_nop 7" : "+v"(p0), "+v"(p1));
#pragma unroll
            for (int r = 0; r < 4; ++r) p0[r] = __builtin_amdgcn_exp2f(p0[r]);
            asm volatile("" : "+v"(p0));
            __builtin_amdgcn_sched_barrier(0); ATT_LDV1(0); __builtin_amdgcn_sched_barrier(0);
#pragma unroll
            for (int r = 4; r < 12; ++r) p0[r] = __builtin_amdgcn_exp2f(p0[r]);
            asm volatile("" : "+v"(p0));
            __builtin_amdgcn_sched_barrier(0); ATT_LDV1(1); __builtin_amdgcn_sched_barrier(0);
#pragma unroll
            for (int r = 12; r < 16; ++r) p0[r] = __builtin_amdgcn_exp2f(p0[r]);
#pragma unroll
            for (int r = 0; r < 4; ++r) p1[r] = __builtin_amdgcn_exp2f(p1[r]);
            asm volatile("" : "+v"(p0), "+v"(p1));
            __builtin_amdgcn_sched_barrier(0); ATT_LDV1(2); __builtin_amdgcn_sched_barrier(0);
#pragma unroll
            for (int r = 4; r < 12; ++r) p1[r] = __builtin_amdgcn_exp2f(p1[r]);
            asm volatile("" : "+v"(p1));
            __builtin_amdgcn_sched_barrier(0); ATT_LDV1(3); __builtin_amdgcn_sched_barrier(0);
#pragma unroll
            for (int r = 12; r < 16; ++r) p1[r] = __builtin_amdgcn_exp2f(p1[r]);
            asm volatile("" : "+v"(p1));
#elif ATTN_ILV == 2
            asm volatile("s_nop 7" : "+v"(p0), "+v"(p1));
#pragma unroll
            for (int r = 0; r < 8; ++r) p0[r] = __builtin_amdgcn_exp2f(p0[r]);
            asm volatile("" : "+v"(p0));
            __builtin_amdgcn_sched_barrier(0); ATT_LDV1(0); __builtin_amdgcn_sched_barrier(0);
#pragma unroll
            for (int r = 8; r < 16; ++r) p0[r] = __builtin_amdgcn_exp2f(p0[r]);
            asm volatile("" : "+v"(p0));
            __builtin_amdgcn_sched_barrier(0); ATT_LDV1(1); __builtin_amdgcn_sched_barrier(0);
#pragma unroll
            for (int r = 0; r < 8; ++r) p1[r] = __builtin_amdgcn_exp2f(p1[r]);
            asm volatile("" : "+v"(p1));
            __builtin_amdgcn_sched_barrier(0); ATT_LDV1(2); __builtin_amdgcn_sched_barrier(0);
#pragma unroll
            for (int r = 8; r < 16; ++r) p1[r] = __builtin_amdgcn_exp2f(p1[r]);
            asm volatile("" : "+v"(p1));
            __builtin_amdgcn_sched_barrier(0); ATT_LDV1(3); __builtin_amdgcn_sched_barrier(0);
#else
#define ATT_SUM8(P, a) do { if (VSUM) { const float t_ = fadd_s(fadd_s(fadd_s(P[a], P[(a) + 1]), fadd_s(P[(a) + 2], P[(a) + 3])), fadd_s(fadd_s(P[(a) + 4], P[(a) + 5]), fadd_s(P[(a) + 6], P[(a) + 7]))); lsum = fadd_s(lsum, t_); asm volatile("" : "+v"(lsum)); } } while (0)
            if (!VLATE) ATT_LDV1(0); __builtin_amdgcn_sched_barrier(0);
            asm volatile("s_nop 7" : "+v"(p0), "+v"(p1));
#pragma unroll
            for (int r = 0; r < 8; ++r) p0[r] = __builtin_amdgcn_exp2f(p0[r]);
            asm volatile("" : "+v"(p0));
            __builtin_amdgcn_sched_barrier(0); if (!VLATE) ATT_LDV1(1); __builtin_amdgcn_sched_barrier(0);
#pragma unroll
            for (int r = 8; r < 16; ++r) p0[r] = __builtin_amdgcn_exp2f(p0[r]);
            asm volatile("" : "+v"(p0));
            if (ATTN_CVT_ILV) {
#pragma unroll
                for (int q = 0; q < 4; ++q) { pk[0][q] = pkbf(p0[2 * q], p0[2 * q + 1]); pk[1][q] = pkbf(p0[8 + 2 * q], p0[9 + 2 * q]); }
                asm volatile("" : "+v"(pk[0]), "+v"(pk[1])); }
            __builtin_amdgcn_sched_barrier(0); if (!VLATE) ATT_LDV1(2); __builtin_amdgcn_sched_barrier(0);
            ATT_SUM8(p0, 0); __builtin_amdgcn_sched_barrier(0);
#pragma unroll
            for (int r = 0; r < 8; ++r) p1[r] = __builtin_amdgcn_exp2f(p1[r]);
            asm volatile("" : "+v"(p1));
            __builtin_amdgcn_sched_barrier(0); if (!VLATE) ATT_LDV1(3); __builtin_amdgcn_sched_barrier(0);
            ATT_SUM8(p0, 8); __builtin_amdgcn_sched_barrier(0);
#pragma unroll
            for (int r = 8; r < 16; ++r) p1[r] = __builtin_amdgcn_exp2f(p1[r]);
            asm volatile("" : "+v"(p1));
            __builtin_amdgcn_sched_barrier(0);
            ATT_SUM8(p1, 0); ATT_SUM8(p1, 8);
#undef ATT_SUM8
#endif
        } else {
#if ATTN_KINS
        if (i < ib) ATT_LDK((i + 1) & 3);
#else
        if (XV != 6 && !ILVW) ATT_LDV(i & 3);
#endif
        __builtin_amdgcn_sched_barrier(0);
        asm volatile("s_nop 7" : "+v"(p0), "+v"(p1));
        }
        if (WIN) {
            const LAS float* bp = biasl + (64 * (t_lo + i) - qrow + 4 * hi + 384);
#pragma unroll
            for (int r = 0; r < 16; ++r) { p0[r] += bp[(r & 3) + 8 * (r >> 2)]; p1[r] += bp[32 + (r & 3) + 8 * (r >> 2)]; }
        }
        if (!NOMAX) {
        float ra = max3f(p0[0], p0[1], p1[0]), rb = max3f(p0[2], p0[3], p1[1]); ra = max3f(ra, p1[2], p1[3]);
#pragma unroll
        for (int r = 4; r < 16; r += 4) { ra = max3f(ra, p0[r], p0[r + 1]); rb = max3f(rb, p0[r + 2], p0[r + 3]); ra = max3f(ra, p1[r], p1[r + 1]); rb = max3f(rb, p1[r + 2], p1[r + 3]); }
        float rm = xhalf_max(max2f(ra, rb));
        if (first || __builtin_amdgcn_ballot_w64(rm > THR) != 0ull) {
            const float delta = first ? rm : fmaxf(rm, 0.0f); const float f = first ? 1.0f : __builtin_amdgcn_exp2f(-delta);
            mref += delta;
#pragma unroll
            for (int r = 0; r < 16; ++r) { p0[r] -= delta; p1[r] -= delta; o0[r] *= f; o1[r] *= f; o2[r] *= f; negm[r] = -mref; }
            first = false;
        }
        }
        if (ILVW) {
            const LAS char* vp_ = lds + LDS_V + (i & 3) * 8192 + vlane;
            __builtin_amdgcn_sched_barrier(0); ATT_LDV1(0); __builtin_amdgcn_sched_barrier(0);
#pragma unroll
            for (int r = 0; r < 8; ++r) p0[r] = __builtin_amdgcn_exp2f(p0[r]);
            asm volatile("" : "+v"(p0));
            __builtin_amdgcn_sched_barrier(0); ATT_LDV1(1); __builtin_amdgcn_sched_barrier(0);
#pragma unroll
            for (int r = 8; r < 16; ++r) p0[r] = __builtin_amdgcn_exp2f(p0[r]);
            asm volatile("" : "+v"(p0));
            __builtin_amdgcn_sched_barrier(0); ATT_LDV1(2); __builtin_amdgcn_sched_barrier(0);
#pragma unroll
            for (int r = 0; r < 8; ++r) p1[r] = __builtin_amdgcn_exp2f(p1[r]);
            asm volatile("" : "+v"(p1));
            __builtin_amdgcn_sched_barrier(0); ATT_LDV1(3); __builtin_amdgcn_sched_barrier(0);
#pragma unroll
            for (int r = 8; r < 16; ++r) p1[r] = __builtin_amdgcn_exp2f(p1[r]);
            asm volatile("" : "+v"(p1));
        }
        if (!ILV && !ILVW)
#pragma unroll
        for (int r = 0; r < 16; ++r) { if (XV == 1 || XV == 4) { p0[r] *= 0.5f; p1[r] *= 0.5f; } else if (XV < 5) { p0[r] = __builtin_amdgcn_exp2f(p0[r]); p1[r] = __builtin_amdgcn_exp2f(p1[r]); } }
        if (XV >= 5) { asm volatile("" : "+v"(p0), "+v"(p1)); }
        if (ILV && ATTN_CVT_ILV && !ATTN_ILV_S && ATTN_ILV != 2) {
#pragma unroll
            for (int q = 0; q < 4; ++q) { pk[2][q] = pkbf(p1[2 * q], p1[2 * q + 1]); pk[3][q] = pkbf(p1[8 + 2 * q], p1[9 + 2 * q]); }
        } else
        if (XV < 5)
#pragma unroll
        for (int q = 0; q < 4; ++q) { pk[0][q] = pkbf(p0[2 * q], p0[2 * q + 1]); pk[1][q] = pkbf(p0[8 + 2 * q], p0[9 + 2 * q]); pk[2][q] = pkbf(p1[2 * q], p1[2 * q + 1]); pk[3][q] = pkbf(p1[8 + 2 * q], p1[9 + 2 * q]); }
        if (ILV && ATTN_STAGE_LAST) { asm volatile("" : "+v"(pk[0]), "+v"(pk[1]), "+v"(pk[2]), "+v"(pk[3])); __builtin_amdgcn_sched_barrier(0); }
        if (!(ILV && ATTN_STAGE_FIRST)) ATT_STAGE(i);
#if ATTN_KINS
        asm volatile("s_waitcnt lgkmcnt(0)" : "+v"(kf[0]), "+v"(kf[1]), "+v"(kf[2]), "+v"(kf[3]), "+v"(kf[4]), "+v"(kf[5]), "+v"(kf[6]), "+v"(kf[7]), "+v"(pk[0]), "+v"(pk[1]), "+v"(pk[2]), "+v"(pk[3]) : : "memory");
#else
        asm volatile("s_waitcnt lgkmcnt(0)" : "+v"(vf[0]), "+v"(vf[1]), "+v"(vf[2]), "+v"(vf[3]), "+v"(vf[4]), "+v"(vf[5]), "+v"(vf[6]), "+v"(vf[7]), "+v"(pk[0]), "+v"(pk[1]), "+v"(pk[2]), "+v"(pk[3]) : : "memory");
#endif
        if (DMA) {
            if (grp == 0) { if (i + 3 < n) asm volatile("s_waitcnt vmcnt(4)" ::: "memory"); else if (i + 2 < n) asm volatile("s_waitcnt vmcnt(2)" ::: "memory"); else asm volatile("s_waitcnt vmcnt(0)" ::: "memory"); }
            else { if (i + 3 < n) asm volatile("s_waitcnt vmcnt(2)" ::: "memory"); else asm volatile("s_waitcnt vmcnt(0)" ::: "memory"); } }
        if (XV != 3 && (!ONEBAR || grp)) ATT_BAR(); else asm volatile("s_waitcnt lgkmcnt(0)" ::: "memory");
        __builtin_amdgcn_s_setprio(ATTN_PRIO);
#if ATTN_KINS
        ATT_LDV(i & 3); __builtin_amdgcn_sched_barrier(0);
        f32x16 q0_, q1_;
        if (i < ib) { const f32x16 z_ = {}; q0_ = __builtin_amdgcn_mfma_f32_32x32x16_bf16(kf[0], qr[0], NOMAX ? z_ : negm, 0, 0, 0); q1_ = __builtin_amdgcn_mfma_f32_32x32x16_bf16(kf[1], qr[0], NOMAX ? z_ : negm, 0, 0, 0);
#pragma unroll
            for (int d0 = 1; d0 < 4; ++d0) { q0_ = __builtin_amdgcn_mfma_f32_32x32x16_bf16(kf[2 * d0], qr[d0], q0_, 0, 0, 0); q1_ = __builtin_amdgcn_mfma_f32_32x32x16_bf16(kf[2 * d0 + 1], qr[d0], q1_, 0, 0, 0); } }
        ATT_PV();
        if (i < ib) { p0 = q0_; p1 = q1_; }
#else
        if (ILVM) {
            const LAS char* kp_ = kfr + ((i + 1) & 3) * 8192;
#pragma unroll
            for (int ks = 0; ks < 4; ++ks) { const bf16x8 pf = __builtin_bit_cast(bf16x8, pk[ks]);
#if ATTN_ILV == 3
                if (i < ib) { kf[2 * ks] = *(const LAS bf16x8*)(kp_ + ks * 2048); kf[2 * ks + 1] = *(const LAS bf16x8*)(kp_ + ks * 2048 + 512); }
                __builtin_amdgcn_sched_barrier(0);
#endif
                o0 = __builtin_amdgcn_mfma_f32_32x32x16_bf16(vf[2 * ks], pf, o0, 0, 0, 0); o1 = __builtin_amdgcn_mfma_f32_32x32x16_bf16(vf[2 * ks + 1], pf, o1, 0, 0, 0);
                if (!VSUM) o2 = __builtin_amdgcn_mfma_f32_32x32x16_bf16(ones, pf, o2, 0, 0, 0);
                __builtin_amdgcn_sched_barrier(0);
#if ATTN_ILV_M == 5
                if (i < ib && ks == 0) { kf[0] = *(const LAS bf16x8*)(kp_); kf[1] = *(const LAS bf16x8*)(kp_ + 512); }
                if (i < ib && ks == 1) { kf[2] = *(const LAS bf16x8*)(kp_ + 2048); kf[3] = *(const LAS bf16x8*)(kp_ + 2048 + 512); kf[4] = *(const LAS bf16x8*)(kp_ + 2 * 2048); }
                if (i < ib && ks == 2) { kf[5] = *(const LAS bf16x8*)(kp_ + 2 * 2048 + 512); kf[6] = *(const LAS bf16x8*)(kp_ + 3 * 2048); kf[7] = *(const LAS bf16x8*)(kp_ + 3 * 2048 + 512); }
                __builtin_amdgcn_sched_barrier(0);
#elif ATTN_ILV_M == 6
                if (i < ib && ks == 0) { kf[0] = *(const LAS bf16x8*)(kp_); kf[1] = *(const LAS bf16x8*)(kp_ + 512); kf[2] = *(const LAS bf16x8*)(kp_ + 2048); }
                if (i < ib && ks == 1) { kf[3] = *(const LAS bf16x8*)(kp_ + 2048 + 512); kf[4] = *(const LAS bf16x8*)(kp_ + 2 * 2048); }
                if (i < ib && ks == 2) { kf[5] = *(const LAS bf16x8*)(kp_ + 2 * 2048 + 512); kf[6] = *(const LAS bf16x8*)(kp_ + 3 * 2048); kf[7] = *(const LAS bf16x8*)(kp_ + 3 * 2048 + 512); }
                __builtin_amdgcn_sched_barrier(0);
#elif ATTN_ILV_M == 4
                if (i < ib && ks == 0) { kf[0] = *(const LAS bf16x8*)(kp_); kf[1] = *(const LAS bf16x8*)(kp_ + 512); kf[2] = *(const LAS bf16x8*)(kp_ + 2048); }
                if (i < ib && ks == 1) { kf[3] = *(const LAS bf16x8*)(kp_ + 2048 + 512); kf[4] = *(const LAS bf16x8*)(kp_ + 2 * 2048); kf[5] = *(const LAS bf16x8*)(kp_ + 2 * 2048 + 512); }
                if (i < ib && ks == 2) { kf[6] = *(const LAS bf16x8*)(kp_ + 3 * 2048); kf[7] = *(const LAS bf16x8*)(kp_ + 3 * 2048 + 512); }
                __builtin_amdgcn_sched_barrier(0);
#elif ATTN_ILV_M == 2
                if (i < ib && ks < 2) { kf[4 * ks] = *(const LAS bf16x8*)(kp_ + (2 * ks) * 2048); kf[4 * ks + 1] = *(const LAS bf16x8*)(kp_ + (2 * ks) * 2048 + 512); kf[4 * ks + 2] = *(const LAS bf16x8*)(kp_ + (2 * ks + 1) * 2048); kf[4 * ks + 3] = *(const LAS bf16x8*)(kp_ + (2 * ks + 1) * 2048 + 512); }
                __builtin_amdgcn_sched_barrier(0);
#elif ATTN_ILV_M == 3
                if (i < ib && (ks == 1 || ks == 2)) { kf[2 * ks - 2] = *(const LAS bf16x8*)(kp_ + (ks - 1) * 2048); kf[2 * ks - 1] = *(const LAS bf16x8*)(kp_ + (ks - 1) * 2048 + 512); }
                if (i < ib && ks == 3) { kf[4] = *(const LAS bf16x8*)(kp_ + 2 * 2048); kf[5] = *(const LAS bf16x8*)(kp_ + 2 * 2048 + 512); kf[6] = *(const LAS bf16x8*)(kp_ + 3 * 2048); kf[7] = *(const LAS bf16x8*)(kp_ + 3 * 2048 + 512); }
                __builtin_amdgcn_sched_barrier(0);
#elif ATTN_ILV_M == 1
                if (i < ib && ks < 2) { kf[2 * ks] = *(const LAS bf16x8*)(kp_ + ks * 2048); kf[2 * ks + 1] = *(const LAS bf16x8*)(kp_ + ks * 2048 + 512); }
                if (i < ib && ks == 2) { kf[4] = *(const LAS bf16x8*)(kp_ + 2 * 2048); kf[5] = *(const LAS bf16x8*)(kp_ + 2 * 2048 + 512); kf[6] = *(const LAS bf16x8*)(kp_ + 3 * 2048); kf[7] = *(const LAS bf16x8*)(kp_ + 3 * 2048 + 512); }
                __builtin_amdgcn_sched_barrier(0);
#elif ATTN_ILV != 3
                if (i < ib) { kf[2 * ks] = *(const LAS bf16x8*)(kp_ + ks * 2048); kf[2 * ks + 1] = *(const LAS bf16x8*)(kp_ + ks * 2048 + 512); }
                __builtin_amdgcn_sched_barrier(0);
#endif
            }
            if (i < ib) ATT_QK();
            if (VLATE && i < ib) { __builtin_amdgcn_sched_barrier(0); ATT_LDV((i + 1) & 3); __builtin_amdgcn_sched_barrier(0); }
        } else {
#if ATTN_CLEANM
        if (i < ib) { ATT_LDK((i + 1) & 3); __builtin_amdgcn_sched_barrier(0); }
#else
        if (i < ib) ATT_LDK((i + 1) & 3);
#endif
        if (XV != 2 && XV != 4) { ATT_PV(); if (i < ib) ATT_QK(); } else { asm volatile("" : "+v"(kf[0]), "+v"(kf[7]), "+v"(vf[0]), "+v"(vf[7])); }
        }
#endif
        __builtin_amdgcn_s_setprio(ATTN_SPRIO);
        if (VLATE) { __builtin_amdgcn_s_barrier(); asm volatile("" ::: "memory"); }
        else if (!ONEBAR || !grp) ATT_BAR();
    }
    for (; i < n; ++i) { ATT_STAGE(i); ATT_BAR(); ATT_BAR(); }
#undef ATT_STAGE
#undef ATT_DMA_TILE
#undef ATT_QK
#undef ATT_PV
#undef ATT_LDK
#undef ATT_LDV
#undef ATT_LDV1
    const float inv = VSUM ? 1.0f / xhalf_sum(lsum) : 1.0f / o2[0];
#if ATTN_WIDE_ST
    bf16_t* Ob = O + grow * (2 * QW) + h * HD + 8 * hi;
#pragma unroll
    for (int hb = 0; hb < 2; ++hb)
#pragma unroll
        for (int pr = 0; pr < 2; ++pr) { const int g = 2 * pr; const f32x16& oo = hb ? o1 : o0;
            const unsigned ax = pkbf(oo[4 * g] * inv, oo[4 * g + 1] * inv), ay = pkbf(oo[4 * g + 2] * inv, oo[4 * g + 3] * inv);
            const unsigned bx_ = pkbf(oo[4 * g + 4] * inv, oo[4 * g + 5] * inv), by_ = pkbf(oo[4 * g + 6] * inv, oo[4 * g + 7] * inv);
            auto sx = __builtin_amdgcn_permlane32_swap(ax, bx_, false, false); auto sy = __builtin_amdgcn_permlane32_swap(ay, by_, false, false);
            *(u32x4*)(Ob + 32 * hb + 8 * g) = (u32x4){sx[0], sy[0], sx[1], sy[1]}; }
#else
    bf16_t* Orow = O + grow * (2 * QW) + h * HD + 4 * hi;
#pragma unroll
    for (int g = 0; g < 4; ++g) {
        u32x2_t w0, w1;
        w0.x = pkbf(o0[4 * g] * inv, o0[4 * g + 1] * inv); w0.y = pkbf(o0[4 * g + 2] * inv, o0[4 * g + 3] * inv);
        w1.x = pkbf(o1[4 * g] * inv, o1[4 * g + 1] * inv); w1.y = pkbf(o1[4 * g + 2] * inv, o1[4 * g + 3] * inv);
        *(u32x2_t*)(Orow + 8 * g) = w0; *(u32x2_t*)(Orow + 32 + 8 * g) = w1;
    }
#endif
    if (!ONEBAR && !grp) ATT_BAR();
}
}

#ifndef PEER_FP6
#define PEER_FP6 1
#endif
#ifndef FUSE_W
#define FUSE_W 0
#endif
#ifndef ROUTE_RSTD
#define ROUTE_RSTD (!PEER_FP6 || FUSE_W)
#endif
namespace peer {
typedef unsigned u32x4 __attribute__((ext_vector_type(4)));
typedef float f32x4 __attribute__((ext_vector_type(4)));
constexpr int WAVE_LDS = 2048;

template <int CTRL> __device__ __forceinline__ int dppi(int x) { return __builtin_amdgcn_mov_dpp(x, CTRL, 0xf, 0xf, true); }
template <int CTRL> __device__ __forceinline__ float dppf(float x) { return __builtin_bit_cast(float, __builtin_amdgcn_mov_dpp(__builtin_bit_cast(int, x), CTRL, 0xf, 0xf, true)); }
constexpr int XOR1 = 0xB1, XOR2 = 0x4E, XOR7 = 0x141, XOR8 = 0x128;
__device__ __forceinline__ float wave_sum(float x) {
    x += dppf<XOR1>(x); x += dppf<XOR2>(x); x += dppf<XOR7>(x); x += dppf<XOR8>(x);
    auto s = __builtin_amdgcn_permlane16_swap(__float_as_uint(x), __float_as_uint(x), false, false); x = __uint_as_float(s[0]) + __uint_as_float(s[1]);
    auto t = __builtin_amdgcn_permlane32_swap(__float_as_uint(x), __float_as_uint(x), false, false); return __uint_as_float(t[0]) + __uint_as_float(t[1]);
}
__device__ __forceinline__ float dot2bf(unsigned a, unsigned b, float c) { return __builtin_amdgcn_fdot2_f32_bf16(__builtin_bit_cast(bf16x2_t, a), __builtin_bit_cast(bf16x2_t, b), c, false); }
__device__ __forceinline__ unsigned getw(const u32x4& v, int i) { return i == 0 ? v.x : i == 1 ? v.y : i == 2 ? v.z : v.w; }
__device__ __forceinline__ int okey(float f, int lowbits, int payload) { int b = __float_as_int(f); b ^= (b >> 31) & 0x7fffffff; return (b & ~((1 << lowbits) - 1)) | payload; }
__device__ __forceinline__ float kval(int k, int lowbits) { int b = (k & ~((1 << lowbits) - 1)) | (1 << (lowbits - 1)); b ^= (b >> 31) & 0x7fffffff; return __int_as_float(b); }
#define CE_DESC(a, b) do { const int _x = (a), _y = (b); (a) = _x > _y ? _x : _y; (b) = _x > _y ? _y : _x; } while (0)
template <int N> __device__ __forceinline__ void bitonic_sort_desc(int (&a)[N]) {
#pragma unroll
    for (int k = 2; k <= N; k <<= 1)
#pragma unroll
        for (int j = k >> 1; j > 0; j >>= 1)
#pragma unroll
            for (int i = 0; i < N; ++i) { const int l = i ^ j; if (l > i) { if ((i & k) == 0) CE_DESC(a[i], a[l]); else CE_DESC(a[l], a[i]); } }
}
template <int N> __device__ __forceinline__ void bitonic_merge_desc(int (&a)[N]) {
#pragma unroll
    for (int j = N >> 1; j > 0; j >>= 1)
#pragma unroll
        for (int i = 0; i < N; ++i) { const int l = i ^ j; if (l > i) CE_DESC(a[i], a[l]); }
}
__device__ __forceinline__ void sort16_desc(int (&a)[16]) {
    CE_DESC(a[0], a[13]); CE_DESC(a[1], a[12]); CE_DESC(a[2], a[15]); CE_DESC(a[3], a[14]); CE_DESC(a[4], a[8]); CE_DESC(a[5], a[6]); CE_DESC(a[7], a[11]); CE_DESC(a[9], a[10]);
    CE_DESC(a[0], a[5]); CE_DESC(a[1], a[7]); CE_DESC(a[2], a[9]); CE_DESC(a[3], a[4]); CE_DESC(a[6], a[13]); CE_DESC(a[8], a[14]); CE_DESC(a[10], a[15]); CE_DESC(a[11], a[12]);
    CE_DESC(a[0], a[1]); CE_DESC(a[2], a[3]); CE_DESC(a[4], a[5]); CE_DESC(a[6], a[8]); CE_DESC(a[7], a[9]); CE_DESC(a[10], a[11]); CE_DESC(a[12], a[13]); CE_DESC(a[14], a[15]);
    CE_DESC(a[0], a[2]); CE_DESC(a[1], a[3]); CE_DESC(a[4], a[10]); CE_DESC(a[5], a[11]); CE_DESC(a[6], a[7]); CE_DESC(a[8], a[9]); CE_DESC(a[12], a[14]); CE_DESC(a[13], a[15]);
    CE_DESC(a[1], a[2]); CE_DESC(a[3], a[12]); CE_DESC(a[4], a[6]); CE_DESC(a[5], a[7]); CE_DESC(a[8], a[10]); CE_DESC(a[9], a[11]); CE_DESC(a[13], a[14]);
    CE_DESC(a[1], a[4]); CE_DESC(a[2], a[6]); CE_DESC(a[5], a[8]); CE_DESC(a[7], a[10]); CE_DESC(a[9], a[13]); CE_DESC(a[11], a[14]);
    CE_DESC(a[2], a[4]); CE_DESC(a[3], a[6]); CE_DESC(a[9], a[12]); CE_DESC(a[11], a[13]);
    CE_DESC(a[3], a[5]); CE_DESC(a[6], a[8]); CE_DESC(a[7], a[9]); CE_DESC(a[10], a[12]);
    CE_DESC(a[3], a[4]); CE_DESC(a[5], a[6]); CE_DESC(a[7], a[8]); CE_DESC(a[9], a[10]); CE_DESC(a[11], a[12]);
    CE_DESC(a[6], a[7]); CE_DESC(a[8], a[9]);
}
__device__ __forceinline__ void sort8_desc(int (&a)[8]) {
    CE_DESC(a[0], a[2]); CE_DESC(a[1], a[3]); CE_DESC(a[4], a[6]); CE_DESC(a[5], a[7]);
    CE_DESC(a[0], a[4]); CE_DESC(a[1], a[5]); CE_DESC(a[2], a[6]); CE_DESC(a[3], a[7]);
    CE_DESC(a[0], a[1]); CE_DESC(a[2], a[3]); CE_DESC(a[4], a[5]); CE_DESC(a[6], a[7]);
    CE_DESC(a[2], a[4]); CE_DESC(a[3], a[5]);
    CE_DESC(a[1], a[4]); CE_DESC(a[3], a[6]);
    CE_DESC(a[1], a[2]); CE_DESC(a[3], a[4]); CE_DESC(a[5], a[6]);
}
__device__ __forceinline__ unsigned sort16x2(unsigned w) { const unsigned m = (w >> 15) & 0x00010001u; return w ^ (unsigned)__mul24((int)m, 0x7FFF); }
__device__ __forceinline__ float kval16(int k) { int s = k >> 16; s ^= (s >> 15) & 0x7FFF; return (float)__builtin_bit_cast(_Float16, (unsigned short)s); }
__device__ __forceinline__ unsigned long long cand_table(int q8) {
    unsigned long long r = 0xFFFFFFFFFFFFFFFFull; int n = 0;
#pragma unroll
    for (int i = 0; i < 16; ++i)
#pragma unroll
        for (int j = 0; j < 16; ++j) if ((i + 1) * (j + 1) <= 16) { if (n / 7 == q8) { const int s = n % 7; r = (r & ~(0xFFull << (8 * s))) | ((unsigned long long)(i * 16 + j) << (8 * s)); } ++n; }
    return r;
}

struct SCtx { u32x4 v[4]; };
__device__ __forceinline__ SCtx s_ctx(int lane, int t, const unsigned short* SC) { SCtx c; const u32x4* p = (const u32x4*)(SC + (size_t)t * SCW + (lane >> 2) * NKEYS + (lane & 3) * 32);
#pragma unroll
    for (int i = 0; i < 4; ++i) c.v[i] = p[i];
    return c; }
__device__ __forceinline__ void route_token(LAS char* wl, int lane, int t, unsigned long long ct, const SCtx& scx  , const float* SSQ, unsigned short* E, float* G, float* RSTD) {
    LAS int* skeys = (LAS int*)wl;
    {
        const int c = lane >> 2, qq = lane & 3;
        int a[16], bb[16];
#pragma unroll
        for (int i = 0; i < 2; ++i) { const u32x4 v = scx.v[i];
#pragma unroll
            for (int j = 0; j < 4; ++j) { const unsigned w = sort16x2(getw(v, j)); const int e = 8 * i + 2 * j;
                a[e] = (int)((w << 16) | (unsigned)(31 - e)); a[e + 1] = (int)((w & 0xFFFF0000u) | (unsigned)(30 - e)); } }
#pragma unroll
        for (int i = 0; i < 2; ++i) { const u32x4 v = scx.v[2 + i];
#pragma unroll
            for (int j = 0; j < 4; ++j) { const unsigned w = sort16x2(getw(v, j)); const int e = 8 * i + 2 * j;
                bb[e] = (int)((w << 16) | (unsigned)(15 - e)); bb[e + 1] = (int)((w & 0xFFFF0000u) | (unsigned)(14 - e)); } }
        sort16_desc(a); sort16_desc(bb);
#pragma unroll
        for (int i = 0; i < 16; ++i) a[i] = a[i] > bb[15 - i] ? a[i] : bb[15 - i];
        bitonic_merge_desc<16>(a);
        { const int lanebase = (3 - qq) << 5;
#pragma unroll
          for (int i = 0; i < 16; ++i) a[i] |= lanebase; }
#pragma unroll
        for (int i = 0; i < 16; ++i) bb[i] = dppi<XOR1>(a[15 - i]);
#pragma unroll
        for (int i = 0; i < 16; ++i) a[i] = a[i] > bb[i] ? a[i] : bb[i];
        bitonic_merge_desc<16>(a);
#pragma unroll
        for (int i = 0; i < 16; ++i) bb[i] = dppi<XOR2>(a[15 - i]);
#pragma unroll
        for (int i = 0; i < 16; ++i) a[i] = a[i] > bb[i] ? a[i] : bb[i];
        bitonic_merge_desc<16>(a);
        if (qq == 0) {
#pragma unroll
            for (int i = 0; i < 4; ++i) *(LAS u32x4*)(skeys + c * 16 + 4 * i) = (u32x4){(unsigned)a[4 * i], (unsigned)a[4 * i + 1], (unsigned)a[4 * i + 2], (unsigned)a[4 * i + 3]};
        }
    }
    asm volatile("s_waitcnt lgkmcnt(0)" ::: "memory");
    {
        const int hh = lane >> 3, q8 = lane & 7;
        int a[16];
#pragma unroll
        for (int s = 0; s < 8; ++s) {
            const int code = s < 7 ? (int)((ct >> (8 * s)) & 0xFF) : 0xFF;
            const int ci = code == 0xFF ? 0 : code;
            const int ka = skeys[(2 * hh) * 16 + (ci >> 4)], kb = skeys[(2 * hh + 1) * 16 + (ci & 15)];
            const float sum = kval16(ka) + kval16(kb);
            a[s] = code == 0xFF ? (int)0x80000000 : okey(sum, 8, 255 - code);
        }
        {
            int c8[8];
#pragma unroll
            for (int i = 0; i < 8; ++i) c8[i] = a[i];
            sort8_desc(c8);
#pragma unroll
            for (int i = 0; i < 8; ++i) a[i] = c8[i];
        }
#pragma unroll
        for (int i = 0; i < 8; ++i) a[8 + i] = dppi<XOR1>(a[i]);
        { int tmp[8];
#pragma unroll
          for (int i = 0; i < 8; ++i) tmp[i] = a[8 + i];
#pragma unroll
          for (int i = 0; i < 8; ++i) a[8 + i] = tmp[7 - i]; }
        bitonic_merge_desc<16>(a);
        int bb[16];
#pragma unroll
        for (int i = 0; i < 16; ++i) bb[i] = dppi<XOR2>(a[15 - i]);
#pragma unroll
        for (int i = 0; i < 16; ++i) a[i] = a[i] > bb[i] ? a[i] : bb[i];
        bitonic_merge_desc<16>(a);
#pragma unroll
        for (int i = 0; i < 16; ++i) bb[i] = dppi<XOR7>(a[15 - i]);
#pragma unroll
        for (int i = 0; i < 16; ++i) a[i] = a[i] > bb[i] ? a[i] : bb[i];
        int k0 = a[0], k1 = a[1];
#pragma unroll
        for (int i = 1; i < 4; ++i) { k0 = q8 == i ? a[2 * i] : k0; k1 = q8 == i ? a[2 * i + 1] : k1; }
#pragma unroll
        for (int i = 4; i < 8; ++i) { k0 = q8 == i ? a[15 - 2 * i] : k0; k1 = q8 == i ? a[14 - 2 * i] : k1; }
        int kmax = a[0];
#pragma unroll
        for (int i = 1; i < 16; ++i) kmax = a[i] > kmax ? a[i] : kmax;
        const float mx = kval(kmax, 8);
        const int c0 = 255 - (k0 & 255), c1 = 255 - (k1 & 255);
        const int ka0 = skeys[(2 * hh) * 16 + (c0 >> 4)], kb0 = skeys[(2 * hh + 1) * 16 + (c0 & 15)];
        const int ka1 = skeys[(2 * hh) * 16 + (c1 >> 4)], kb1 = skeys[(2 * hh + 1) * 16 + (c1 & 15)];
        const float s0 = kval16(ka0) + kval16(kb0), s1 = kval16(ka1) + kval16(kb1);
        const float e0 = __expf(s0 - mx), e1 = __expf(s1 - mx);
        float z = e0 + e1; z += dppf<XOR1>(z); z += dppf<XOR2>(z); z += dppf<XOR7>(z);
        const float rz = 1.0f / z;
        const unsigned e0i = (unsigned)((127 - (ka0 & 127)) * NKEYS + (127 - (kb0 & 127))), e1i = (unsigned)((127 - (ka1 & 127)) * NKEYS + (127 - (kb1 & 127)));
        *(unsigned*)(E + (size_t)t * 128 + hh * 16 + 2 * q8) = e0i | (e1i << 16);
        *(f32x2_t*)(G + (size_t)t * 128 + hh * 16 + 2 * q8) = (f32x2_t){e0 * rz, e1 * rz};
    }
#if ROUTE_RSTD
    if (lane == 0) { const f32x4* sp = (const f32x4*)(SSQ + (size_t)t * 16); const f32x4 s0 = sp[0], s1 = sp[1], s2 = sp[2], s3 = sp[3];
        const float tot = (((s0[0] + s0[1]) + (s0[2] + s0[3])) + ((s1[0] + s1[1]) + (s1[2] + s1[3]))) + (((s2[0] + s2[1]) + (s2[2] + s2[3])) + ((s3[0] + s3[1]) + (s3[2] + s3[3])));
        RSTD[t] = 1.0f / sqrtf(tot * (1.0f / DM) + EPS); }
#endif
    asm volatile("s_waitcnt lgkmcnt(0)" ::: "memory");
}

constexpr size_t SLICE_BYTES = (size_t)NEXP * 128;
__device__ __forceinline__ float wave_max(float x) {
    x = fmaxf(x, dppf<XOR1>(x)); x = fmaxf(x, dppf<XOR2>(x)); x = fmaxf(x, dppf<XOR7>(x)); x = fmaxf(x, dppf<XOR8>(x));
    auto s = __builtin_amdgcn_permlane16_swap(__float_as_uint(x), __float_as_uint(x), false, false); x = fmaxf(__uint_as_float(s[0]), __uint_as_float(s[1]));
    auto t = __builtin_amdgcn_permlane32_swap(__float_as_uint(x), __float_as_uint(x), false, false); return fmaxf(__uint_as_float(t[0]), __uint_as_float(t[1]));
}
template <int NR>
__device__ __forceinline__ void table_rows_fp8(const float* src, unsigned char* T8, float* INV, int e0, int es, int lane, const float* gmul  ) {
    f32x4 v[NR][4];
#pragma unroll
    for (int i = 0; i < NR; ++i) { const f32x4* p = (const f32x4*)(src + (size_t)(e0 + i * es) * DM) + lane;
#pragma unroll
        for (int q = 0; q < 4; ++q) v[i][q] = __builtin_nontemporal_load(p + 64 * q); }
    if (gmul) {
#pragma unroll
        for (int q = 0; q < 4; ++q) { const f32x4 g = *((const f32x4*)gmul + lane + 64 * q);
#pragma unroll
            for (int i = 0; i < NR; ++i) v[i][q] = v[i][q] * g; } }
#pragma unroll
    for (int i = 0; i < NR; ++i) {
        float mx = 0.f;
#pragma unroll
        for (int q = 0; q < 4; ++q) mx = fmaxf(mx, fmaxf(fmaxf(fabsf(v[i][q][0]), fabsf(v[i][q][1])), fmaxf(fabsf(v[i][q][2]), fabsf(v[i][q][3]))));
        mx = wave_max(mx);
        const float sc = mx > 0.f ? 448.0f / mx : 1.0f;
        const int e = e0 + i * es;
#pragma unroll
        for (int q = 0; q < 4; ++q) { unsigned w = 0; w = __builtin_amdgcn_cvt_pk_fp8_f32(v[i][q][0] * sc, v[i][q][1] * sc, w, false); w = __builtin_amdgcn_cvt_pk_fp8_f32(v[i][q][2] * sc, v[i][q][3] * sc, w, true);
            *(unsigned*)(T8 + (size_t)(2 * q + (lane >> 5)) * SLICE_BYTES + (size_t)e * 128 + 4 * (lane & 31)) = w; }
        if (lane == 0) INV[e] = mx > 0.f ? mx * (1.0f / 448.0f) : 1.0f;
    }
}
__device__ __forceinline__ void tables_fp8(const float* peer_u, const float* peer_v, unsigned char* U8, unsigned char* V8, float* INVU, float* INVV, const float* gffn, int r0, int r1, int w, int nw, int lane) {
    int e = r0 + w;
    for (; e + 3 * nw < r1; e += 4 * nw) { table_rows_fp8<4>(peer_u, U8, INVU, e, nw, lane, gffn); table_rows_fp8<4>(peer_v, V8, INVV, e, nw, lane, nullptr); }
    for (; e + nw < r1; e += 2 * nw) { table_rows_fp8<2>(peer_u, U8, INVU, e, nw, lane, gffn); table_rows_fp8<2>(peer_v, V8, INVV, e, nw, lane, nullptr); }
    for (; e < r1; e += nw) { table_rows_fp8<1>(peer_u, U8, INVU, e, nw, lane, gffn); table_rows_fp8<1>(peer_v, V8, INVV, e, nw, lane, nullptr); }
}
struct ECtx { u32x4 ea, eb; };
struct XCtx { u32x4 xa, xb; };
__device__ __forceinline__ ECtx e_ctx(int lane, int t, const unsigned short* E) { ECtx c; c.ea = *(const u32x4*)(E + (size_t)t * 128 + (lane >> 3) * 16); c.eb = *(const u32x4*)(E + (size_t)t * 128 + (lane >> 3) * 16 + 8); return c; }
__device__ __forceinline__ XCtx x_ctx(int lane, int t, int s, const unsigned short* HB) { XCtx c; c.xa = *(const u32x4*)(HB + (size_t)t * DM + s * 128 + (lane & 7) * 16); c.xb = *(const u32x4*)(HB + (size_t)t * DM + s * 128 + (lane & 7) * 16 + 8); return c; }
__device__ __forceinline__ void g_rows(u32x4 (&row)[16], const ECtx& c, const unsigned char* T8s, int c8) {
#pragma unroll
    for (int j = 0; j < 16; ++j) { const unsigned ew = getw(j < 8 ? c.ea : c.eb, (j & 7) >> 1); const unsigned e = (j & 1) ? (ew >> 16) : (ew & 0xffffu);
        row[j] = *(const u32x4*)(T8s + (size_t)e * 128 + c8 * 16); }
}
__device__ __forceinline__ unsigned e_at(const ECtx& c, int j) { const unsigned ew = getw(j < 8 ? c.ea : c.eb, (j & 7) >> 1); return (j & 1) ? (ew >> 16) : (ew & 0xffffu); }
__device__ __forceinline__ void u_compute(int lane, int t, int s, const XCtx& c, u32x4 (&row)[16], const ECtx& en, const unsigned char* U8s, unsigned short* PA) {
    const int rs = lane >> 3, c8 = lane & 7;
    f32x2_t xf[8];
#pragma unroll
    for (int i = 0; i < 4; ++i) { const unsigned wa = getw(c.xa, i), wb = getw(c.xb, i); xf[i] = (f32x2_t){bflo(wa), bfhi(wa)}; xf[4 + i] = (f32x2_t){bflo(wb), bfhi(wb)}; }
    float p0 = 0.f, p1 = 0.f;
#pragma unroll
    for (int j = 0; j < 16; ++j) {
        f32x2_t acc = {0.f, 0.f};
#pragma unroll
        for (int w = 0; w < 4; ++w) { const unsigned q = getw(row[j], w);
            acc = __builtin_elementwise_fma(__builtin_amdgcn_cvt_pk_f32_fp8(q, false), xf[2 * w], acc); acc = __builtin_elementwise_fma(__builtin_amdgcn_cvt_pk_f32_fp8(q, true), xf[2 * w + 1], acc); }
        row[j] = *(const u32x4*)(U8s + (size_t)e_at(en, j) * 128 + c8 * 16);
        __builtin_amdgcn_sched_barrier(0);
        float p = acc.x + acc.y; p += dppf<XOR1>(p); p += dppf<XOR2>(p); p += dppf<XOR7>(p);
        if (j & 1) p1 = (c8 == (j >> 1)) ? p : p1; else p0 = (c8 == (j >> 1)) ? p : p0;
    }
    *(unsigned*)(PA + ((size_t)t * 8 + s) * 128 + rs * 16 + 2 * c8) = pkbf(p0, p1);
}
#define TCL(t_) ((t_) < NTOK ? (t_) : NTOK - 1)
__device__ __forceinline__ void upass_slice(int lane, int s, int wv, int nwv, const unsigned char* U8s, const unsigned short* E, const unsigned short* HB, unsigned short* PA) {
    const int c8 = lane & 7;
    int t = wv; if (t >= NTOK) return;
    ECtx eA = e_ctx(lane, t, E), eB = e_ctx(lane, TCL(t + nwv), E); XCtx xA = x_ctx(lane, t, s, HB), xB;
    u32x4 rA[16], rB[16];
    g_rows(rA, eA, U8s, c8); g_rows(rB, eB, U8s, c8);
    eA = e_ctx(lane, TCL(t + 2 * nwv), E);
    for (; t < NTOK; t += 2 * nwv) {
        eB = e_ctx(lane, TCL(t + 3 * nwv), E); xB = x_ctx(lane, TCL(t + nwv), s, HB);
        u_compute(lane, t, s, xA, rA, eA, U8s, PA);
        eA = e_ctx(lane, TCL(t + 4 * nwv), E); xA = x_ctx(lane, TCL(t + 2 * nwv), s, HB);
        if (t + nwv < NTOK) u_compute(lane, t + nwv, s, xB, rB, eB, U8s, PA);
    }
}
template <int NT>
__device__ __forceinline__ void wpass_tokens(int lane, int t0, int ts, const unsigned short* E, const float* G, const unsigned short* PA, const float* INVU, const float* INVV, const float* RSTD, float* W) {
    unsigned pw[NT][8], ew[NT]; f32x2_t g[NT];
#pragma unroll
    for (int i = 0; i < NT; ++i) { const int t = t0 + i * ts;
#pragma unroll
        for (int s = 0; s < 8; ++s) pw[i][s] = *(const unsigned*)(PA + ((size_t)t * 8 + s) * 128 + 2 * lane);
        ew[i] = *(const unsigned*)(E + (size_t)t * 128 + 2 * lane); g[i] = *(const f32x2_t*)(G + (size_t)t * 128 + 2 * lane); }
    float iu0[NT], iu1[NT], iv0[NT], iv1[NT];
#pragma unroll
    for (int i = 0; i < NT; ++i) { const unsigned e0 = ew[i] & 0xffffu, e1 = ew[i] >> 16; iu0[i] = INVU[e0]; iu1[i] = INVU[e1]; iv0[i] = INVV[e0]; iv1[i] = INVV[e1]; }
#pragma unroll
    for (int i = 0; i < NT; ++i) { float a0 = 0.f, a1 = 0.f;
#pragma unroll
        for (int s = 0; s < 8; ++s) { a0 += bflo(pw[i][s]); a1 += bfhi(pw[i][s]); }
        const float rs = RSTD[t0 + i * ts]; a0 *= iu0[i] * rs; a1 *= iu1[i] * rs;
        const float w0 = g[i].x * 0.5f * a0 * (1.0f + erff(a0 * 0.70710678118654752f)) * iv0[i], w1 = g[i].y * 0.5f * a1 * (1.0f + erff(a1 * 0.70710678118654752f)) * iv1[i];
        *(f32x2_t*)(W + (size_t)(t0 + i * ts) * 128 + 2 * lane) = (f32x2_t){w0, w1}; }
}
struct WCtx { f32x4 w0, w1, w2, w3; };
__device__ __forceinline__ WCtx w_ctx(int lane, int t, const float* W) { const f32x4* wp = (const f32x4*)(W + (size_t)t * 128 + (lane >> 3) * 16); WCtx c; c.w0 = wp[0]; c.w1 = wp[1]; c.w2 = wp[2]; c.w3 = wp[3]; return c; }
__device__ __forceinline__ void v_compute(int lane, int t, int s, const WCtx& wc, u32x4 (&row)[16], const ECtx& en, const unsigned char* V8s, unsigned short* PO) {
    const int rs = lane >> 3, c8 = lane & 7;
    f32x2_t o[8];
#pragma unroll
    for (int i = 0; i < 8; ++i) o[i] = (f32x2_t){0.f, 0.f};
#pragma unroll
    for (int j = 0; j < 16; ++j) {
        const f32x4 wq = j < 4 ? wc.w0 : j < 8 ? wc.w1 : j < 12 ? wc.w2 : wc.w3; const int jj = j & 3; const float wj = jj == 0 ? wq.x : jj == 1 ? wq.y : jj == 2 ? wq.z : wq.w; const f32x2_t w2v = {wj, wj};
#pragma unroll
        for (int w = 0; w < 4; ++w) { const unsigned q = getw(row[j], w);
            o[2 * w] = __builtin_elementwise_fma(__builtin_amdgcn_cvt_pk_f32_fp8(q, false), w2v, o[2 * w]); o[2 * w + 1] = __builtin_elementwise_fma(__builtin_amdgcn_cvt_pk_f32_fp8(q, true), w2v, o[2 * w + 1]); }
        row[j] = *(const u32x4*)(V8s + (size_t)e_at(en, j) * 128 + c8 * 16);
        __builtin_amdgcn_sched_barrier(0);
    }
    float of[16];
#pragma unroll
    for (int i = 0; i < 8; ++i) { of[2 * i] = o[i].x; of[2 * i + 1] = o[i].y; }
#pragma unroll
    for (int i = 0; i < 16; ++i) { float x = of[i]; x += dppf<XOR8>(x);
        auto s1 = __builtin_amdgcn_permlane16_swap(__float_as_uint(x), __float_as_uint(x), false, false); x = __uint_as_float(s1[0]) + __uint_as_float(s1[1]);
        auto s2 = __builtin_amdgcn_permlane32_swap(__float_as_uint(x), __float_as_uint(x), false, false); of[i] = __uint_as_float(s2[0]) + __uint_as_float(s2[1]); }
    if (rs == 0) {
        unsigned short* po = PO + (size_t)t * DM + s * 128 + c8 * 16;
        *(u32x4*)po = (u32x4){pkbf(of[0], of[1]), pkbf(of[2], of[3]), pkbf(of[4], of[5]), pkbf(of[6], of[7])};
        *(u32x4*)(po + 8) = (u32x4){pkbf(of[8], of[9]), pkbf(of[10], of[11]), pkbf(of[12], of[13]), pkbf(of[14], of[15])};
    }
}
__device__ __forceinline__ void vpass_slice(int lane, int s, int wv, int nwv, const unsigned char* V8s, const unsigned short* E, const float* W, unsigned short* PO) {
    const int c8 = lane & 7;
    int t = wv; if (t >= NTOK) return;
    ECtx eA = e_ctx(lane, t, E), eB = e_ctx(lane, TCL(t + nwv), E); WCtx wA = w_ctx(lane, t, W), wB;
    u32x4 rA[16], rB[16];
    g_rows(rA, eA, V8s, c8); g_rows(rB, eB, V8s, c8);
    eA = e_ctx(lane, TCL(t + 2 * nwv), E);
    for (; t < NTOK; t += 2 * nwv) {
        eB = e_ctx(lane, TCL(t + 3 * nwv), E); wB = w_ctx(lane, TCL(t + nwv), W);
        v_compute(lane, t, s, wA, rA, eA, V8s, PO);
        eA = e_ctx(lane, TCL(t + 4 * nwv), E); wA = w_ctx(lane, TCL(t + 2 * nwv), W);
        if (t + nwv < NTOK) v_compute(lane, t + nwv, s, wB, rB, eB, V8s, PO);
    }
}
#undef TCL
__device__ __forceinline__ void final_token(int lane, int t, float* Y, const unsigned short* HB, const unsigned short* PO, const float* gfin) {
    f32x4* yr = (f32x4*)(Y + (size_t)t * DM) + lane; const u32x2_t* pr = (const u32x2_t*)(PO + (size_t)t * DM) + lane; const u32x2_t* hr = (const u32x2_t*)(HB + (size_t)t * DM) + lane;
    f32x4 v[4]; float ss = 0.f;
#pragma unroll
    for (int j = 0; j < 4; ++j) { const u32x2_t hw = hr[64 * j]; v[j] = (f32x4){bflo(hw.x), bfhi(hw.x), bflo(hw.y), bfhi(hw.y)}; const u32x2_t p = pr[64 * j]; v[j][0] += bflo(p.x); v[j][1] += bfhi(p.x); v[j][2] += bflo(p.y); v[j][3] += bfhi(p.y);
        ss += (v[j][0] * v[j][0] + v[j][1] * v[j][1]) + (v[j][2] * v[j][2] + v[j][3] * v[j][3]); }
    const float rstd = 1.0f / sqrtf(wave_sum(ss) * (1.0f / DM) + EPS);
#pragma unroll
    for (int j = 0; j < 4; ++j) { const f32x4 g = *((const f32x4*)gfin + lane + 64 * j); yr[64 * j] = (f32x4){v[j][0] * rstd * g[0], v[j][1] * rstd * g[1], v[j][2] * rstd * g[2], v[j][3] * rstd * g[3]}; }
}
__device__ __forceinline__ void final_token2(int lane, int ta, int tb, float* Y, const unsigned short* HB, const unsigned short* PO, const float* gfin) {
    const u32x2_t* pa = (const u32x2_t*)(PO + (size_t)ta * DM) + lane; const u32x2_t* ha = (const u32x2_t*)(HB + (size_t)ta * DM) + lane;
    const u32x2_t* pb = (const u32x2_t*)(PO + (size_t)tb * DM) + lane; const u32x2_t* hb = (const u32x2_t*)(HB + (size_t)tb * DM) + lane;
    u32x2_t hwa[4], pwa[4], hwb[4], pwb[4];
#pragma unroll
    for (int j = 0; j < 4; ++j) { hwa[j] = ha[64 * j]; pwa[j] = pa[64 * j]; hwb[j] = hb[64 * j]; pwb[j] = pb[64 * j]; }
    f32x4 va[4], vb[4]; float sa = 0.f, sb = 0.f;
#pragma unroll
    for (int j = 0; j < 4; ++j) {
        va[j] = (f32x4){bflo(hwa[j].x) + bflo(pwa[j].x), bfhi(hwa[j].x) + bfhi(pwa[j].x), bflo(hwa[j].y) + bflo(pwa[j].y), bfhi(hwa[j].y) + bfhi(pwa[j].y)};
        vb[j] = (f32x4){bflo(hwb[j].x) + bflo(pwb[j].x), bfhi(hwb[j].x) + bfhi(pwb[j].x), bflo(hwb[j].y) + bflo(pwb[j].y), bfhi(hwb[j].y) + bfhi(pwb[j].y)};
        sa += (va[j][0] * va[j][0] + va[j][1] * va[j][1]) + (va[j][2] * va[j][2] + va[j][3] * va[j][3]); sb += (vb[j][0] * vb[j][0] + vb[j][1] * vb[j][1]) + (vb[j][2] * vb[j][2] + vb[j][3] * vb[j][3]); }
    const float ra = 1.0f / sqrtf(wave_sum(sa) * (1.0f / DM) + EPS), rb = 1.0f / sqrtf(wave_sum(sb) * (1.0f / DM) + EPS);
    f32x4* ya = (f32x4*)(Y + (size_t)ta * DM) + lane; f32x4* yb = (f32x4*)(Y + (size_t)tb * DM) + lane;
#pragma unroll
    for (int j = 0; j < 4; ++j) { const f32x4 g = *((const f32x4*)gfin + lane + 64 * j);
        __builtin_nontemporal_store((f32x4){va[j][0] * ra * g[0], va[j][1] * ra * g[1], va[j][2] * ra * g[2], va[j][3] * ra * g[3]}, ya + 64 * j);
        if (tb != ta) __builtin_nontemporal_store((f32x4){vb[j][0] * rb * g[0], vb[j][1] * rb * g[1], vb[j][2] * rb * g[2], vb[j][3] * rb * g[3]}, yb + 64 * j); }
}
#ifndef U6_XV
#define U6_XV 0
#endif
typedef float v16f_t __attribute__((ext_vector_type(16)));
typedef float v32f_t __attribute__((ext_vector_type(32)));
typedef unsigned v6u_t __attribute__((ext_vector_type(6)));
constexpr size_t SLICE6_BYTES = (size_t)NEXP * 192;
__device__ __forceinline__ void table_rows2_fp6(const float* src, unsigned char* T6, float* INV, int ea, int eb, int lane, const float* gmul, LAS float* scr  ) {
    f32x4 va[4], vb[4];
#pragma unroll
    for (int q = 0; q < 4; ++q) { va[q] = __builtin_nontemporal_load((const f32x4*)(src + (size_t)ea * DM) + lane + 64 * q); vb[q] = __builtin_nontemporal_load((const f32x4*)(src + (size_t)eb * DM) + lane + 64 * q); }
    if (gmul) {
#pragma unroll
        for (int q = 0; q < 4; ++q) { const f32x4 g = *((const f32x4*)gmul + lane + 64 * q); va[q] = va[q] * g; vb[q] = vb[q] * g; } }
    float ma = 0.f, mb = 0.f;
#pragma unroll
    for (int q = 0; q < 4; ++q) { ma = fmaxf(ma, fmaxf(fmaxf(fabsf(va[q][0]), fabsf(va[q][1])), fmaxf(fabsf(va[q][2]), fabsf(va[q][3])))); mb = fmaxf(mb, fmaxf(fmaxf(fabsf(vb[q][0]), fabsf(vb[q][1])), fmaxf(fabsf(vb[q][2]), fabsf(vb[q][3])))); }
    ma = wave_max(ma); mb = wave_max(mb);
    const float sa = ma > 0.f ? 7.5f / ma : 1.0f, sb = mb > 0.f ? 7.5f / mb : 1.0f;
#pragma unroll
    for (int q = 0; q < 4; ++q) { const int i = 4 * (lane + 64 * q), o = i + 4 * (i >> 5);
        *(LAS f32x4*)(scr + o) = va[q] * sa; *(LAS f32x4*)(scr + 1152 + o) = vb[q] * sb; }
    asm volatile("s_waitcnt lgkmcnt(0)" ::: "memory");
    const LAS float* cp = scr + (lane >> 5) * 1152 + (lane & 31) * 36;
    v16f_t x, y;
#pragma unroll
    for (int q = 0; q < 8; ++q) { const f32x4 c = *(const LAS f32x4*)(cp + 4 * q); x[2 * q] = c[0]; y[2 * q] = c[1]; x[2 * q + 1] = c[2]; y[2 * q + 1] = c[3]; }
    const v6u_t pk = __builtin_amdgcn_cvt_scalef32_2xpk16_fp6_f32(x, y, 1.0f);
    const int e = (lane >> 5) ? eb : ea;
    unsigned char* dst = T6 + (size_t)((lane & 31) >> 3) * SLICE6_BYTES + (size_t)e * 192 + (lane & 7) * 24;
    *(u32x2_t*)dst = (u32x2_t){pk[0], pk[1]}; *(u32x2_t*)(dst + 8) = (u32x2_t){pk[2], pk[3]}; *(u32x2_t*)(dst + 16) = (u32x2_t){pk[4], pk[5]};
    if (lane == 0) INV[2 * ea] = ma > 0.f ? ma * (1.0f / 7.5f) : 1.0f;
    if (lane == 32) INV[2 * eb] = mb > 0.f ? mb * (1.0f / 7.5f) : 1.0f;
    asm volatile("s_waitcnt lgkmcnt(0)" ::: "memory");
}
struct T6Ctx { f32x4 va[4], vb[4], g[4]; };
__device__ __forceinline__ T6Ctx t6_load(const float* src, int ea, int eb, int lane, const float* gvec) { T6Ctx c;
#pragma unroll
    for (int q = 0; q < 4; ++q) { c.va[q] = __builtin_nontemporal_load((const f32x4*)(src + (size_t)ea * DM) + lane + 64 * q); c.vb[q] = __builtin_nontemporal_load((const f32x4*)(src + (size_t)eb * DM) + lane + 64 * q); c.g[q] = *((const f32x4*)gvec + lane + 64 * q); }
    return c; }
__device__ __forceinline__ void t6_finish(const T6Ctx& c, unsigned char* T6, float* INV, int ea, int eb, int lane, bool use_g, LAS float* scr  ) {
    f32x4 va[4], vb[4];
#pragma unroll
    for (int q = 0; q < 4; ++q) { va[q] = use_g ? c.va[q] * c.g[q] : c.va[q]; vb[q] = use_g ? c.vb[q] * c.g[q] : c.vb[q]; }
    float ma = 0.f, mb = 0.f;
#pragma unroll
    for (int q = 0; q < 4; ++q) { ma = fmaxf(ma, fmaxf(fmaxf(fabsf(va[q][0]), fabsf(va[q][1])), fmaxf(fabsf(va[q][2]), fabsf(va[q][3])))); mb = fmaxf(mb, fmaxf(fmaxf(fabsf(vb[q][0]), fabsf(vb[q][1])), fmaxf(fabsf(vb[q][2]), fabsf(vb[q][3])))); }
    ma = wave_max(ma); mb = wave_max(mb);
    const float sa = ma > 0.f ? 7.5f / ma : 1.0f, sb = mb > 0.f ? 7.5f / mb : 1.0f;
#pragma unroll
    for (int q = 0; q < 4; ++q) { const int i = 4 * (lane + 64 * q), o = i + 4 * (i >> 5);
        *(LAS f32x4*)(scr + o) = va[q] * sa; *(LAS f32x4*)(scr + 1152 + o) = vb[q] * sb; }
    asm volatile("s_waitcnt lgkmcnt(0)" ::: "memory");
    const LAS float* cp = scr + (lane >> 5) * 1152 + (lane & 31) * 36;
    v16f_t x, y;
#pragma unroll
    for (int q = 0; q < 8; ++q) { const f32x4 cc = *(const LAS f32x4*)(cp + 4 * q); x[2 * q] = cc[0]; y[2 * q] = cc[1]; x[2 * q + 1] = cc[2]; y[2 * q + 1] = cc[3]; }
    const v6u_t pk = __builtin_amdgcn_cvt_scalef32_2xpk16_fp6_f32(x, y, 1.0f);
    const int e = (lane >> 5) ? eb : ea;
    unsigned char* dst = T6 + (size_t)((lane & 31) >> 3) * SLICE6_BYTES + (size_t)e * 192 + (lane & 7) * 24;
    *(u32x2_t*)dst = (u32x2_t){pk[0], pk[1]}; *(u32x2_t*)(dst + 8) = (u32x2_t){pk[2], pk[3]}; *(u32x2_t*)(dst + 16) = (u32x2_t){pk[4], pk[5]};
    if (lane == 0) INV[2 * ea] = ma > 0.f ? ma * (1.0f / 7.5f) : 1.0f;
    if (lane == 32) INV[2 * eb] = mb > 0.f ? mb * (1.0f / 7.5f) : 1.0f;
    asm volatile("s_waitcnt lgkmcnt(0)" ::: "memory");
}
__device__ __forceinline__ void tables_fp6(const float* peer_u, const float* peer_v, unsigned char* U6, unsigned char* V6, float* INVU, float* INVV, const float* gffn, int r0, int r1, int w, int nw, int lane, LAS float* scr) {
    for (int e = r0 + w; e < r1; e += 2 * nw) { const int e2 = (e + nw < r1) ? e + nw : e;
        table_rows2_fp6(peer_u, U6, INVU, e, e2, lane, gffn, scr); table_rows2_fp6(peer_v, V6, INVV, e, e2, lane, nullptr, scr); }
}
__device__ __forceinline__ v6u_t ld24(const unsigned char* p) { const u32x2_t a = *(const u32x2_t*)p, b = *(const u32x2_t*)(p + 8), c = *(const u32x2_t*)(p + 16); return (v6u_t){a.x, a.y, b.x, b.y, c.x, c.y}; }
struct X6Ctx { u32x4 x0, x1, x2, x3; };
__device__ __forceinline__ X6Ctx x6_ctx(int lane, int t, int s, const unsigned short* HB) { const u32x4* p = (const u32x4*)(HB + (size_t)t * DM + s * 256 + (lane & 7) * 32); X6Ctx c; c.x0 = p[0]; c.x1 = p[1]; c.x2 = p[2]; c.x3 = p[3]; return c; }
typedef __bf16 v32bf_t __attribute__((ext_vector_type(32)));
typedef unsigned v16u_t __attribute__((ext_vector_type(16)));
template <int G, int GR> __device__ __forceinline__ void u6_group(int lane, const unsigned (&xb)[16]  , v6u_t (&row)[4], const ECtx& er, const unsigned char* U6s, float& p0, float& p1) {
    const int c8 = lane & 7;
#pragma unroll
    for (int j = 0; j < 4; ++j) {
        const v16u_t r = __builtin_bit_cast(v16u_t, __builtin_amdgcn_cvt_scalef32_pk32_bf16_fp6(row[j], 1.0f));
        { unsigned off = e_at(er, 4 * GR + j) * 192u + c8 * 24u; unsigned mk = r[15]; asm volatile("" : "+v"(off), "+v"(mk));
          row[j] = ld24(U6s + off); }
        __builtin_amdgcn_sched_barrier(0);
        float a0 = 0.f, a1 = 0.f, a2 = 0.f, a3 = 0.f;
#pragma unroll
        for (int i = 0; i < 4; ++i) { a0 = dot2bf(r[4 * i], xb[4 * i], a0); a1 = dot2bf(r[4 * i + 1], xb[4 * i + 1], a1); a2 = dot2bf(r[4 * i + 2], xb[4 * i + 2], a2); a3 = dot2bf(r[4 * i + 3], xb[4 * i + 3], a3); }
        float p = (a0 + a1) + (a2 + a3); p += dppf<XOR1>(p); p += dppf<XOR2>(p); p += dppf<XOR7>(p);
        const int jj = 4 * G + j;
        if (jj & 1) p1 = (c8 == (jj >> 1)) ? p : p1; else p0 = (c8 == (jj >> 1)) ? p : p0;
    }
}
__device__ __forceinline__ void g6_rows(v6u_t (&row)[4], const ECtx& c, int g, const unsigned char* T6s, int c8) {
#pragma unroll
    for (int j = 0; j < 4; ++j) row[j] = ld24(T6s + (size_t)e_at(c, 4 * g + j) * 192 + c8 * 24);
}
__device__ __forceinline__ void upass6_slice(int lane, int s, int hf, int wv, int nwv, const unsigned char* U6s, const unsigned short* E, const unsigned short* HB, unsigned short* PA  ) {
    asm volatile("" : "+v"(lane));
    const int rs = lane >> 3, c8 = lane & 7;
    if (2 * wv + hf >= NTOK) return;
    const int st = 2 * nwv; int t = 2 * wv + hf;
    ECtx eC = e_ctx(lane, t, E); X6Ctx xc = x6_ctx(lane, t, s, HB), xn;
    v6u_t rA[4], rB[4];
    g6_rows(rA, eC, 0, U6s, c8); g6_rows(rB, eC, 1, U6s, c8);
    for (; t < NTOK; t += st) {
        const int tn = t + st < NTOK ? t + st : t;
        const ECtx eN = e_ctx(lane, tn, E); xn = x6_ctx(lane, tn, s, HB);
        unsigned xb[16];
#pragma unroll
        for (int i = 0; i < 4; ++i) { xb[i] = getw(xc.x0, i); xb[4 + i] = getw(xc.x1, i); xb[8 + i] = getw(xc.x2, i); xb[12 + i] = getw(xc.x3, i); }
        float p0 = 0.f, p1 = 0.f;
        u6_group<0, 2>(lane, xb, rA, eC, U6s, p0, p1);
        u6_group<1, 3>(lane, xb, rB, eC, U6s, p0, p1);
        u6_group<2, 0>(lane, xb, rA, eN, U6s, p0, p1);
        u6_group<3, 1>(lane, xb, rB, eN, U6s, p0, p1);
        *(unsigned*)(PA + ((size_t)t * 4 + s) * 128 + rs * 16 + 2 * c8) = pkbf(p0, p1);
        eC = eN; xc = xn;
    }
}
__device__ __forceinline__ void wpass6_token(int lane, int t, const unsigned short* E, const float* G, const unsigned short* PA, const float* INVU, const float* INVV, const float* SSQ, float* W) {
    float tot = SSQ[(size_t)t * 16 + (lane & 15)];
    tot += dppf<XOR1>(tot); tot += dppf<XOR2>(tot); tot += dppf<XOR7>(tot); tot += dppf<XOR8>(tot);
    float a0 = 0.f, a1 = 0.f;
#pragma unroll
    for (int s = 0; s < 4; ++s) { const unsigned w = *(const unsigned*)(PA + ((size_t)t * 4 + s) * 128 + 2 * lane); a0 += bflo(w); a1 += bfhi(w); }
    const unsigned ew = *(const unsigned*)(E + (size_t)t * 128 + 2 * lane); const unsigned e0 = ew & 0xffffu, e1 = ew >> 16;
    const f32x2_t g = *(const f32x2_t*)(G + (size_t)t * 128 + 2 * lane); const float rs = 1.0f / sqrtf(tot * (1.0f / DM) + EPS);
    const f32x2_t i0 = *(const f32x2_t*)(INVU + 2 * e0), i1 = *(const f32x2_t*)(INVU + 2 * e1);
    a0 *= i0.x * rs; a1 *= i1.x * rs;
    const float w0 = g.x * 0.5f * a0 * (1.0f + erff(a0 * 0.70710678118654752f)) * i0.y, w1 = g.y * 0.5f * a1 * (1.0f + erff(a1 * 0.70710678118654752f)) * i1.y;
    *(f32x2_t*)(W + (size_t)t * 128 + 2 * lane) = (f32x2_t){w0, w1};
}
struct WpIn { float tot; unsigned p[4]; unsigned ew; f32x2_t g; };
__device__ __forceinline__ WpIn wp_load(int lane, int t, const unsigned short* E, const float* G, const unsigned short* PA, const float* SSQ) { WpIn r; r.tot = SSQ[(size_t)t * 16 + (lane & 15)];
#pragma unroll
    for (int s = 0; s < 4; ++s) r.p[s] = *(const unsigned*)(PA + ((size_t)t * 4 + s) * 128 + 2 * lane);
    r.ew = *(const unsigned*)(E + (size_t)t * 128 + 2 * lane); r.g = *(const f32x2_t*)(G + (size_t)t * 128 + 2 * lane); return r; }
__device__ __forceinline__ void wp_finish(int lane, int t, const WpIn& in, const f32x2_t i0, const f32x2_t i1, float* W) {
    float tot = in.tot; tot += dppf<XOR1>(tot); tot += dppf<XOR2>(tot); tot += dppf<XOR7>(tot); tot += dppf<XOR8>(tot);
    float a0 = 0.f, a1 = 0.f;
#pragma unroll
    for (int s = 0; s < 4; ++s) { a0 += bflo(in.p[s]); a1 += bfhi(in.p[s]); }
    const float rs = 1.0f / sqrtf(tot * (1.0f / DM) + EPS);
    a0 *= i0.x * rs; a1 *= i1.x * rs;
    const float w0 = in.g.x * 0.5f * a0 * (1.0f + erff(a0 * 0.70710678118654752f)) * i0.y, w1 = in.g.y * 0.5f * a1 * (1.0f + erff(a1 * 0.70710678118654752f)) * i1.y;
    *(f32x2_t*)(W + (size_t)t * 128 + 2 * lane) = (f32x2_t){w0, w1};
}
__device__ __forceinline__ void wpass6_token2(int lane, int ta, int tb, const unsigned short* E, const float* G, const unsigned short* PA, const float* INV2, const float* SSQ, float* W) {
    const WpIn A = wp_load(lane, ta, E, G, PA, SSQ), B = wp_load(lane, tb, E, G, PA, SSQ);
    const f32x2_t a0 = *(const f32x2_t*)(INV2 + 2 * (A.ew & 0xffffu)), a1 = *(const f32x2_t*)(INV2 + 2 * (A.ew >> 16)), b0 = *(const f32x2_t*)(INV2 + 2 * (B.ew & 0xffffu)), b1 = *(const f32x2_t*)(INV2 + 2 * (B.ew >> 16));
    wp_finish(lane, ta, A, a0, a1, W);
    if (tb != ta) wp_finish(lane, tb, B, b0, b1, W);
}
template <int G, int GR> __device__ __forceinline__ void v6_group(int lane, const f32x4& wq, v6u_t (&row)[4], const ECtx& er, const unsigned char* V6s, f32x2_t (&o)[16]) {
    const int c8 = lane & 7;
#pragma unroll
    for (int j = 0; j < 4; ++j) {
        asm volatile("" : "+v"(row[j]), "+v"(o[0]), "+v"(o[1]), "+v"(o[2]), "+v"(o[3]), "+v"(o[4]), "+v"(o[5]), "+v"(o[6]), "+v"(o[7]), "+v"(o[8]), "+v"(o[9]), "+v"(o[10]), "+v"(o[11]), "+v"(o[12]), "+v"(o[13]), "+v"(o[14]), "+v"(o[15]));
        const v32f_t r = __builtin_amdgcn_cvt_scalef32_pk32_f32_fp6(row[j], 1.0f);
        { unsigned off = e_at(er, 4 * GR + j) * 192u + c8 * 24u; float mk = r[31]; asm volatile("" : "+v"(off), "+v"(mk));
          row[j] = ld24(V6s + off); }
        __builtin_amdgcn_sched_barrier(0);
        const float wj = j == 0 ? wq.x : j == 1 ? wq.y : j == 2 ? wq.z : wq.w; const f32x2_t w2v = {wj, wj};
#pragma unroll
        for (int i = 0; i < 16; ++i) o[i] = __builtin_elementwise_fma((f32x2_t){r[2 * i], r[2 * i + 1]}, w2v, o[i]);
    }
}
__device__ __forceinline__ void vpass6_slice(int lane, int s, int hf, int wv, int nwv, const unsigned char* V6s, const unsigned short* E, const float* W, unsigned short* PO) {
    asm volatile("" : "+v"(lane));
    const int rs = lane >> 3, c8 = lane & 7;
    if (2 * wv + hf >= NTOK) return;
    const int st = 2 * nwv; int t = 2 * wv + hf;
    ECtx eC = e_ctx(lane, t, E); WCtx wc = w_ctx(lane, t, W), wn;
    v6u_t rA[4], rB[4];
    g6_rows(rA, eC, 0, V6s, c8); g6_rows(rB, eC, 1, V6s, c8);
    for (; t < NTOK; t += st) {
        const int tn = t + st < NTOK ? t + st : t;
        const ECtx eN = e_ctx(lane, tn, E); wn = w_ctx(lane, tn, W);
        f32x2_t o[16];
#pragma unroll
        for (int i = 0; i < 16; ++i) o[i] = (f32x2_t){0.f, 0.f};
        v6_group<0, 2>(lane, wc.w0, rA, eC, V6s, o);
        v6_group<1, 3>(lane, wc.w1, rB, eC, V6s, o);
        v6_group<2, 0>(lane, wc.w2, rA, eN, V6s, o);
        v6_group<3, 1>(lane, wc.w3, rB, eN, V6s, o);
        float v[32];
#pragma unroll
        for (int i = 0; i < 16; ++i) { v[2 * i] = o[i].x; v[2 * i + 1] = o[i].y; }
        float w16[16];
#pragma unroll
        for (int i = 0; i < 16; ++i) { auto sw = __builtin_amdgcn_permlane32_swap(__float_as_uint(v[i]), __float_as_uint(v[i + 16]), false, false); w16[i] = __uint_as_float(sw[0]) + __uint_as_float(sw[1]); }
        float x8[8];
#pragma unroll
        for (int i = 0; i < 8; ++i) { auto sw = __builtin_amdgcn_permlane16_swap(__float_as_uint(w16[i]), __float_as_uint(w16[i + 8]), false, false); x8[i] = __uint_as_float(sw[0]) + __uint_as_float(sw[1]); }
        const bool b3 = (lane & 8) != 0; float y4[4];
#pragma unroll
        for (int i = 0; i < 4; ++i) { const float keep = b3 ? x8[i + 4] : x8[i], send = b3 ? x8[i] : x8[i + 4]; y4[i] = keep + dppf<XOR8>(send); }
        *(u32x2_t*)(PO + (size_t)t * DM + s * 256 + c8 * 32 + 4 * rs) = (u32x2_t){pkbf(y4[0], y4[1]), pkbf(y4[2], y4[3])};
        eC = eN; wc = wn;
    }
}
__device__ __forceinline__ void tables_fp6_pipe(const float* peer_u, const float* peer_v, unsigned char* U6, unsigned char* V6, float* INVU, float* INVV, const float* gffn, int r0, int r1, int w, int nw, int lane, LAS float* scr) {
    int e = r0 + w; if (e >= r1) return;
    int e2 = (e + nw < r1) ? e + nw : e;
    T6Ctx A = t6_load(peer_u, e, e2, lane, gffn);
    for (;;) {
        const T6Ctx B = t6_load(peer_v, e, e2, lane, gffn);
        t6_finish(A, U6, INVU, e, e2, lane, true, scr);
        const int en = e + 2 * nw; const bool more = en < r1; const int ea = more ? en : e, eb = (more && en + nw < r1) ? en + nw : ea;
        A = t6_load(peer_u, ea, eb, lane, gffn);
        t6_finish(B, V6, INVV, e, e2, lane, false, scr);
        if (!more) break;
        e = ea; e2 = eb;
    }
}
struct W6Ctx { unsigned ew, p0, p1, p2, p3; f32x2_t g; float rs; };
__device__ __forceinline__ W6Ctx w6_load(int lane, int t, const unsigned short* E, const float* G, const unsigned short* PA, const float* RSTD) {
    W6Ctx c; const unsigned* pp = (const unsigned*)(PA + (size_t)t * 512) + lane;
    c.p0 = pp[0]; c.p1 = pp[64]; c.p2 = pp[128]; c.p3 = pp[192];
    c.ew = *(const unsigned*)(E + (size_t)t * 128 + 2 * lane); c.g = *(const f32x2_t*)(G + (size_t)t * 128 + 2 * lane); c.rs = RSTD[t]; return c; }
struct W6Inv { float u0, u1, v0, v1; };
__device__ __forceinline__ W6Inv w6_inv(const W6Ctx& c, const float* INVU, const float* INVV) { const unsigned e0 = c.ew & 0xffffu, e1 = c.ew >> 16; W6Inv r; r.u0 = INVU[2 * e0]; r.u1 = INVU[2 * e1]; r.v0 = INVV[2 * e0]; r.v1 = INVV[2 * e1]; return r; }
__device__ __forceinline__ WCtx w6_finish(int lane, const W6Ctx& c, const W6Inv& iv, LAS float* wl) {
    float a0 = 0.f, a1 = 0.f;
    a0 += bflo(c.p0); a1 += bfhi(c.p0); a0 += bflo(c.p1); a1 += bfhi(c.p1); a0 += bflo(c.p2); a1 += bfhi(c.p2); a0 += bflo(c.p3); a1 += bfhi(c.p3);
    a0 *= iv.u0 * c.rs; a1 *= iv.u1 * c.rs;
    const float w0 = c.g.x * 0.5f * a0 * (1.0f + erff(a0 * 0.70710678118654752f)) * iv.v0, w1 = c.g.y * 0.5f * a1 * (1.0f + erff(a1 * 0.70710678118654752f)) * iv.v1;
    *(LAS f32x2_t*)(wl + 2 * lane) = (f32x2_t){w0, w1};
    const LAS f32x4* rp = (const LAS f32x4*)(wl + (lane >> 3) * 16); WCtx r; r.w0 = rp[0]; r.w1 = rp[1]; r.w2 = rp[2]; r.w3 = rp[3];
    return r; }
__device__ __forceinline__ void vpass6w_slice(int lane, int s, int hf, int wv, int nwv, const unsigned char* V6s, const unsigned short* E, const float* G, const unsigned short* PA, const float* INVU, const float* INVV, const float* RSTD, LAS float* wl, unsigned short* PO) {
    asm volatile("" : "+v"(lane));
    const int rs = lane >> 3, c8 = lane & 7;
    if (2 * wv + hf >= NTOK) return;
    const int st = 2 * nwv; int t = 2 * wv + hf;
    ECtx eC = e_ctx(lane, t, E);
    v6u_t rA[4], rB[4];
    g6_rows(rA, eC, 0, V6s, c8); g6_rows(rB, eC, 1, V6s, c8);
    WCtx wc;
    { const W6Ctx c0 = w6_load(lane, t, E, G, PA, RSTD); const W6Inv i0 = w6_inv(c0, INVU, INVV); wc = w6_finish(lane, c0, i0, wl); }
    for (; t < NTOK; t += st) {
        const int tn = t + st < NTOK ? t + st : t;
        const ECtx eN = e_ctx(lane, tn, E); const W6Ctx cN = w6_load(lane, tn, E, G, PA, RSTD);
        f32x2_t o[16];
#pragma unroll
        for (int i = 0; i < 16; ++i) o[i] = (f32x2_t){0.f, 0.f};
        v6_group<0, 2>(lane, wc.w0, rA, eC, V6s, o);
        v6_group<1, 3>(lane, wc.w1, rB, eC, V6s, o);
        const W6Inv iN = w6_inv(cN, INVU, INVV);
        v6_group<2, 0>(lane, wc.w2, rA, eN, V6s, o);
        v6_group<3, 1>(lane, wc.w3, rB, eN, V6s, o);
        float v[32];
#pragma unroll
        for (int i = 0; i < 16; ++i) { v[2 * i] = o[i].x; v[2 * i + 1] = o[i].y; }
        float w16[16];
#pragma unroll
        for (int i = 0; i < 16; ++i) { auto sw = __builtin_amdgcn_permlane32_swap(__float_as_uint(v[i]), __float_as_uint(v[i + 16]), false, false); w16[i] = __uint_as_float(sw[0]) + __uint_as_float(sw[1]); }
        float x8[8];
#pragma unroll
        for (int i = 0; i < 8; ++i) { auto sw = __builtin_amdgcn_permlane16_swap(__float_as_uint(w16[i]), __float_as_uint(w16[i + 8]), false, false); x8[i] = __uint_as_float(sw[0]) + __uint_as_float(sw[1]); }
        const bool b3 = (lane & 8) != 0; float y4[4];
#pragma unroll
        for (int i = 0; i < 4; ++i) { const float keep = b3 ? x8[i + 4] : x8[i], send = b3 ? x8[i] : x8[i + 4]; y4[i] = keep + dppf<XOR8>(send); }
        *(u32x2_t*)(PO + (size_t)t * DM + s * 256 + c8 * 32 + 4 * rs) = (u32x2_t){pkbf(y4[0], y4[1]), pkbf(y4[2], y4[3])};
        wc = w6_finish(lane, cN, iN, wl);
        eC = eN;
    }
}
#undef TCL6
}

constexpr int NWAVES = 8;
#ifndef MK_N_LAUNCHES
#define MK_N_LAUNCHES 1
#endif
constexpr int N_LAUNCHES = MK_N_LAUNCHES;
constexpr int PER_PHASE = 7;
#ifndef PROBE
#define PROBE -1
#endif
#ifndef DIAG_SEL
#define DIAG_SEL -1
#endif
#ifndef TAIL_R0
#define TAIL_R0 8192
#endif
#ifndef P5_TABLES
#define P5_TABLES 0
#endif
#ifndef TABLES_SPLIT
#define TABLES_SPLIT 0
#endif
#ifndef P5_ALIGN_EPI
#define P5_ALIGN_EPI 1
#endif
#ifndef TABLES_FIRST
#define TABLES_FIRST 1
#endif
#ifndef ROUTE_TABLES
#define ROUTE_TABLES 1
#endif
#ifndef FUSE_W
#define FUSE_W 0
#endif
#ifndef PEER_FP6
#define PEER_FP6 1
#endif
#ifndef TSEL_SPAN
#define TSEL_SPAN 1
#endif
#ifndef TSEL_BASE
#define TSEL_BASE 0
#endif
#ifndef TSEL_SCALE
#define TSEL_SCALE 0.001f
#endif
#ifndef TSEL2_SCALE
#define TSEL2_SCALE 0.001f
#endif
#ifndef TSEL2_BLK
#define TSEL2_BLK 0
#endif
#ifndef XVAR
#define XVAR 0
#endif
#define NREP(k) ((PROBE == (k)) ? 2 : 1)

typedef unsigned short bf16;
typedef unsigned v4u __attribute__((ext_vector_type(4)));
typedef float f32x4 __attribute__((ext_vector_type(4)));
#define LDS_WAIT() asm volatile("s_waitcnt lgkmcnt(0)" ::: "memory")
#define VM_WAIT() asm volatile("s_waitcnt vmcnt(0)" ::: "memory")

constexpr size_t MiB = 1u << 20;
constexpr size_t WS_CTL = 0, CTL_ZERO_BYTES = 64 * 1024;
constexpr size_t WS_TAB = 1 * MiB;
constexpr size_t WS_SSQ = 1 * MiB + 64 * 1024;
constexpr size_t WS_WIN = 3 * MiB;
constexpr size_t WS_WA = 10 * MiB, WS_WB = 11 * MiB;
constexpr size_t WS_WO = 12 * MiB;
constexpr size_t WS_WE = 14 * MiB;
constexpr size_t WS_U8 = 18 * MiB, WS_V8 = 34 * MiB;
constexpr size_t WS_PA = 50 * MiB;
constexpr size_t WS_INVU = 2 * MiB + 128 * 1024, WS_INVV = WS_INVU + 64 * 1024;
constexpr size_t WS_RSTD = WS_INVV + 64 * 1024; constexpr size_t WS_RSTDX = WS_RSTD + 64 * 1024;
constexpr size_t WS_G = 3 * MiB, WS_E = 11 * MiB;
constexpr size_t WS_W = 114 * MiB, WS_PSS = 122 * MiB;
constexpr int CW_RANK = 8192;
constexpr size_t WS_XN = 82 * MiB;
constexpr size_t WS_ACT = 114 * MiB;
constexpr size_t WS_QA = WS_ACT, WS_QB = WS_ACT + 512 * 2;
constexpr size_t WS_KA = WS_ACT + 32 * MiB, WS_VA = WS_ACT + 36 * MiB, WS_KB = WS_ACT + 40 * MiB, WS_VB = WS_ACT + 44 * MiB;
constexpr size_t WS_GA = WS_ACT + 48 * MiB, WS_GB = WS_ACT + 80 * MiB;
constexpr size_t WS_SC = WS_ACT;
constexpr size_t WS_END = 242 * MiB;
static_assert(WS_GB + 32 * MiB <= WS_END && WS_SC + (size_t)NTOK * SCW * 4 <= WS_END, "d_ws map");

constexpr int RING_BYTES = 131072;
constexpr int MISC_OFF = RING_BYTES + 320;
constexpr int LDS_BYTES = 147456;

#define XB_TMO      128
#define XB_XCNT(j)  (256  + 64 * (j))
#define XB_XSUB(j)  (1280 + 64 * (j))
#define XB_XGEN(j)  (2304 + 64 * (j))
#define XB_TOP      3328
#define XB_TOPGEN   3392
#define XCD_BAR_WORDS 3456
#define XB_SPIN_CAP (1u << 18)

__device__ __forceinline__ unsigned xb_ld(unsigned* p)              { return __hip_atomic_load(p, __ATOMIC_RELAXED, __HIP_MEMORY_SCOPE_AGENT); }
__device__ __forceinline__ unsigned xb_add(unsigned* p, unsigned v) { return __hip_atomic_fetch_add(p, v, __ATOMIC_RELAXED, __HIP_MEMORY_SCOPE_AGENT); }
__device__ __forceinline__ unsigned xb_xcc_id() { return (unsigned)__builtin_amdgcn_s_getreg((3 << 11) | 20) & 0xFu; }
#define XB_SPIN(cond, bar) do { unsigned _sp = 0; while (cond) { __builtin_amdgcn_s_sleep(1); \
    if ((++_sp & 255u) == 0u) { if (xb_ld(&(bar)[XB_TMO])) break; if (_sp > XB_SPIN_CAP) { atomicAdd(&(bar)[XB_TMO], 1u); break; } } } } while (0)

struct XcdBarrier {
    unsigned* bar; unsigned x;
    volatile LAS unsigned* st;
};

__device__ __forceinline__ XcdBarrier xcd_barrier_post(unsigned* bar, volatile LAS unsigned* st) {
    XcdBarrier b; b.bar = bar; b.x = xb_xcc_id(); b.st = st;
    if (threadIdx.x == 0) (void)xb_add(&bar[XB_XCNT(b.x)], 1u);
    return b;
}
__device__ __forceinline__ void xcd_barrier_complete(unsigned* bar, unsigned x, unsigned& nloc, unsigned& nx) {
    const unsigned G = gridDim.x * gridDim.y * gridDim.z;
    unsigned sum, cnt, mine, sp = 0u;
    for (;;) {
        sum = 0u; cnt = 0u; mine = 0u;
#pragma unroll
        for (unsigned j = 0; j < 16; ++j) { const unsigned c = xb_ld(&bar[XB_XCNT(j)]); sum += c; cnt += (c > 0u) ? 1u : 0u; mine = (j == x) ? c : mine; }
        if (sum == G) break;
        __builtin_amdgcn_s_sleep(1);
        if ((++sp & 255u) == 0u) { if (xb_ld(&bar[XB_TMO])) break; if (sp > XB_SPIN_CAP) { atomicAdd(&bar[XB_TMO], 1u); break; } }
    }
    nloc = mine > 0u ? mine : 1u; nx = cnt > 0u ? cnt : 1u;
}

__device__ __forceinline__ void xcd_barrier(const XcdBarrier& b) {
    asm volatile("s_waitcnt vmcnt(0)" ::: "memory");
    __syncthreads();
    if (threadIdx.x == 0) {
        unsigned* bar = b.bar;
        __builtin_amdgcn_s_waitcnt(0);
        unsigned nloc = b.st[0], nx = b.st[1];
        if (nloc == 0u) { xcd_barrier_complete(bar, b.x, nloc, nx); b.st[0] = nloc; b.st[1] = nx; }
        const unsigned old = xb_add(&bar[XB_XSUB(b.x)], 1u);
        const unsigned gen = old / nloc;
        if (old + 1u == (gen + 1u) * nloc) {
            __builtin_amdgcn_fence(__ATOMIC_RELEASE, "agent");
            asm volatile("s_waitcnt vmcnt(0)" ::: "memory");
            const unsigned og = xb_add(&bar[XB_TOP], 1u);
            const unsigned tg = og / nx;
            if (og + 1u == (tg + 1u) * nx) xb_add(&bar[XB_TOPGEN], 1u);
            else XB_SPIN(xb_ld(&bar[XB_TOPGEN]) == tg, bar);
            __builtin_amdgcn_fence(__ATOMIC_ACQUIRE, "agent");
            xb_add(&bar[XB_XGEN(b.x)], 1u);
            asm volatile("s_waitcnt vmcnt(0)" ::: "memory");
        } else {
            XB_SPIN(xb_ld(&bar[XB_XGEN(b.x)]) == gen, bar);
            __builtin_amdgcn_fence(__ATOMIC_ACQUIRE, "agent");
            asm volatile("s_waitcnt vmcnt(0)" ::: "memory");
        }
    }
    __syncthreads();
}


struct Args { const float* in[17]; float* out; unsigned char* ws; int ph_lo, ph_hi, li, pad; };

__device__ __forceinline__ void p0_transpose_item(const float* W, int K, int N, bf16* WT, int k0, int src_n0, int dst_n0, LAS float* scr, int lane, int dpitch = 0, int dk0 = 0, bool split16 = false, const float* kscale = nullptr  ) {
    if (dpitch == 0) dpitch = K;
    const int sl = split16 ? ((lane & 15) + ((lane & 16) << 1)) : (lane & 31);
#pragma unroll 8
    for (int i = 0; i < 32; ++i) { const int kk = 2 * i + (lane >> 5); scr[kk * 33 + (lane & 31)] = W[(size_t)(k0 + kk) * N + src_n0 + sl]; }
    LDS_WAIT();
    const int c = lane & 7;
    f32x4 g0 = {1.f, 1.f, 1.f, 1.f}, g1 = g0;
    if (kscale) { g0 = *(const f32x4*)(kscale + k0 + 8 * c); g1 = *(const f32x4*)(kscale + k0 + 8 * c + 4); }
#pragma unroll
    for (int j = 0; j < 4; ++j) { const int n = (lane >> 3) + 8 * j; const LAS float* s = scr + (8 * c) * 33 + n;
        v4u o; o.x = pkbf(s[0 * 33] * g0[0], s[1 * 33] * g0[1]); o.y = pkbf(s[2 * 33] * g0[2], s[3 * 33] * g0[3]); o.z = pkbf(s[4 * 33] * g1[0], s[5 * 33] * g1[1]); o.w = pkbf(s[6 * 33] * g1[2], s[7 * 33] * g1[3]);
        *(v4u*)(WT + (size_t)(dst_n0 + n) * dpitch + dk0 + k0 + 8 * c) = o; }
    LDS_WAIT();
}
__device__ __forceinline__ int win_src_col(int dst_n0) {
    if (dst_n0 >= 1536) return dst_n0;
    const int tile = dst_n0 >> 8, c = dst_n0 & 255;
    return tile * 256 + 64 * ((c >> 5) & 3) + 16 * (c >> 7);
}
__device__ __forceinline__ int t5_bucket(int rel) {
    const int n = rel < 0 ? -rel : rel; int bkt;
    if (n < 8) bkt = n; else { int v = 8 + (31 - __builtin_clz(n * n)) - 6; bkt = v > 15 ? 15 : v; }
    return bkt + (rel > 0 ? 16 : 0);
}

__global__ void __launch_bounds__(NWAVES * 64, 2) mk_fwd(Args args) {
    extern __shared__ __attribute__((aligned(16))) unsigned char lds_raw[];
    LAS unsigned char* lds = (LAS unsigned char*)lds_raw;
    volatile LAS unsigned* MISC = (volatile LAS unsigned*)(lds + MISC_OFF);
    const int tid = threadIdx.x, lane = tid & 63, wave = __builtin_amdgcn_readfirstlane(tid >> 6);
    const int G = gridDim.x, bx = blockIdx.x; const int vcu = (G % 8 == 0) ? (bx % 8) * (G / 8) + bx / 8 : bx;
    const int gw = vcu * NWAVES + wave, NGW = G * NWAVES;
    unsigned char* ws = args.ws;
    const float* x = args.in[0]; const float* g_mix = args.in[1]; const float* w_in = args.in[2]; const float* b_gate = args.in[3];
    const float* q_norm_g = args.in[4]; const float* k_norm_g = args.in[5]; const float* rel_bias = args.in[6]; const float* sink = args.in[7];
    const float* w_a = args.in[8]; const float* w_b = args.in[9]; const float* w_out = args.in[10]; const float* g_ffn = args.in[11];
    const float* peer_wq = args.in[12]; const float* subkeys = args.in[13]; const float* peer_u = args.in[14]; const float* peer_v = args.in[15]; const float* g_final = args.in[16];
    float* out = args.out;
    float* ROPE = (float*)(ws + WS_TAB); float* BIAS = (float*)(ws + WS_TAB + 16384); float* SSQ = (float*)(ws + WS_SSQ);
    bf16 *WIN_T = (bf16*)(ws + WS_WIN), *WA_T = (bf16*)(ws + WS_WA), *WB_T = (bf16*)(ws + WS_WB), *WO_T = (bf16*)(ws + WS_WO), *WE_T = (bf16*)(ws + WS_WE);
    unsigned char *U8 = ws + WS_U8, *V8 = ws + WS_V8; bf16 *PA = (bf16*)(ws + WS_PA), *XN = (bf16*)(ws + WS_XN), *PO2 = (bf16*)(ws + WS_ACT);
    float* RSTDX = (float*)(ws + WS_RSTDX); float* RSTD = (float*)(ws + WS_RSTD); float *INVU = (float*)(ws + WS_INVU), *INVV = PEER_FP6 ? (float*)(ws + WS_INVU) + 1 : (float*)(ws + WS_INVV),     *RG = (float*)(ws + WS_G), *RW = (float*)(ws + WS_W), *PSS = (float*)(ws + WS_PSS); bf16* RE = (bf16*)(ws + WS_E);
    bf16 *QA = (bf16*)(ws + WS_QA), *QB = (bf16*)(ws + WS_QB), *KA = (bf16*)(ws + WS_KA), *VA = (bf16*)(ws + WS_VA), *KB = (bf16*)(ws + WS_KB), *VB = (bf16*)(ws + WS_VB);
    unsigned char *GA = ws + WS_GA, *GB = ws + WS_GA + 16 * MiB; bf16* MIX = (bf16*)(ws + WS_GB); bf16* SC = (bf16*)(ws + WS_SC);

    for (int u = tid; u < (LDS_BYTES - RING_BYTES) / 4; u += NWAVES * 64) ((LAS unsigned*)(lds + RING_BYTES))[u] = 0u;
    __syncthreads();
    XcdBarrier bar; bar.bar = (unsigned*)(ws + WS_CTL) + 1024; bar.x = 0; bar.st = nullptr;
    if (N_LAUNCHES != PER_PHASE) bar = xcd_barrier_post((unsigned*)(ws + WS_CTL) + 1024, MISC + 8);
    if (tid == 0) { const unsigned xc = xb_xcc_id(); MISC[13] = xc; MISC[12] = xb_add((unsigned*)(ws + WS_CTL) + CW_RANK + 64 * xc, 1u); }
    const bool tail_tables = (G == 256);
    const int lo = args.ph_lo, hi = args.ph_hi;
#define IN(k) (lo <= (k) && (k) < hi)
#define BOTH(k) (IN(k) && IN((k) + 1))
#define GRID_BAR() do { if (N_LAUNCHES != PER_PHASE) xcd_barrier(bar); STAMP(); } while (0)
#ifdef TSEL
    int n_stamp_ = 0;
#define STAMP() do { if (tid == 0) MISC[16 + n_stamp_] = (unsigned)__builtin_amdgcn_s_memrealtime(); ++n_stamp_; } while (0)
#else
#define STAMP() do { } while (0)
#endif
    STAMP();

    if (IN(0)) for (int rep_ = 0; rep_ < NREP(0); ++rep_) {
        if (rep_) { VM_WAIT(); __syncthreads(); }
        LAS float* scr = (LAS float*)(lds + wave * 16384);
        for (int ord_ = 0; ord_ < 2; ++ord_) {
        if ((ord_ == 0) == (((bx >> 3) & 1) != 0)) {
        for (int m = gw; m < NTOK; m += 2 * NGW) {
            const int m2 = (m + NGW < NTOK) ? m + NGW : m;
            const f32x4* xr = (const f32x4*)(x + (size_t)m * DM) + lane; const f32x4* xr2 = (const f32x4*)(x + (size_t)m2 * DM) + lane; f32x4 v[4], v2[4]; float s = 0.f, s2 = 0.f;
#pragma unroll
            for (int j = 0; j < 4; ++j) { v[j] = __builtin_nontemporal_load(xr + 64 * j); v2[j] = __builtin_nontemporal_load(xr2 + 64 * j); }
#pragma unroll
            for (int j = 0; j < 4; ++j) { s += (v[j][0] * v[j][0] + v[j][1] * v[j][1]) + (v[j][2] * v[j][2] + v[j][3] * v[j][3]); s2 += (v2[j][0] * v2[j][0] + v2[j][1] * v2[j][1]) + (v2[j][2] * v2[j][2] + v2[j][3] * v2[j][3]); }
            const float rstd = 1.0f / sqrtf(peer::wave_sum(s) * (1.0f / DM) + EPS), rstd2 = 1.0f / sqrtf(peer::wave_sum(s2) * (1.0f / DM) + EPS);
            unsigned long long* o8 = (unsigned long long*)(XN + (size_t)m * DM) + lane; unsigned long long* o82 = (unsigned long long*)(XN + (size_t)m2 * DM) + lane;
#pragma unroll
            for (int j = 0; j < 4; ++j) {
                o8[64 * j] = (unsigned long long)pkbf(v[j][0], v[j][1]) | ((unsigned long long)pkbf(v[j][2], v[j][3]) << 32);
                o82[64 * j] = (unsigned long long)pkbf(v2[j][0], v2[j][1]) | ((unsigned long long)pkbf(v2[j][2], v2[j][3]) << 32); }
            if (lane == 0) { RSTDX[m] = rstd; RSTDX[m2] = rstd2; }
        }
        } else {
        {
            constexpr int I_IN = (DM / 64) * (INW / 32), I_AB = (QW / 64) * (DM / 32), I_O = (DM / 64) * (DM / 32);
            constexpr int NITEMS = I_IN + 2 * I_AB + I_O;
            for (int it = gw; it < NITEMS; it += NGW) {
                int r = it;
                if (r < I_IN) { const int nblk = INW / 32, kb = r / nblk, nb = r % nblk; p0_transpose_item(w_in, DM, INW, WIN_T, 64 * kb, win_src_col(32 * nb), 32 * nb, scr, lane, 0, 0, 32 * nb < 1536, g_mix); continue; } r -= I_IN;
                if (r < I_AB) { const int nblk = DM / 32, kb = r / nblk, nb = r % nblk; p0_transpose_item(w_a, QW, DM, WA_T, 64 * kb, 32 * nb, 32 * nb, scr, lane, DM, 0); continue; } r -= I_AB;
                if (r < I_AB) { const int nblk = DM / 32, kb = r / nblk, nb = r % nblk; p0_transpose_item(w_b, QW, DM, WA_T, 64 * kb, 32 * nb, 32 * nb, scr, lane, DM, QW); continue; }   r -= I_AB;
                { const int nblk = DM / 32, kb = r / nblk, nb = r % nblk; p0_transpose_item(w_out, DM, DM, WO_T, 64 * kb, 32 * nb, 32 * nb, scr, lane); }
            }
        }
        __syncthreads();
        {
            LAS float* sk_s = (LAS float*)lds;
            LAS float* wq_s = (LAS float*)(lds + 128 * 129 * 4);
            for (int it = vcu; it < 16 * 16; it += G) {
                const int c = it >> 4, k0 = (it & 15) * 64;
                for (int i = tid; i < 128 * 32; i += NWAVES * 64) { const int n = i >> 5, d4 = (i & 31) * 4; const f32x4 v = *(const f32x4*)(subkeys + ((size_t)c * NKEYS + n) * 128 + d4);
                    sk_s[n * 129 + d4] = v[0]; sk_s[n * 129 + d4 + 1] = v[1]; sk_s[n * 129 + d4 + 2] = v[2]; sk_s[n * 129 + d4 + 3] = v[3]; }
                for (int i = tid; i < 64 * 32; i += NWAVES * 64) { const int k = i >> 5, d4 = (i & 31) * 4; const f32x4 v = *(const f32x4*)(peer_wq + (size_t)(k0 + k) * SCW + c * 128 + d4);
                    wq_s[k * 129 + d4] = v[0]; wq_s[k * 129 + d4 + 1] = v[1]; wq_s[k * 129 + d4 + 2] = v[2]; wq_s[k * 129 + d4 + 3] = v[3]; }
                __syncthreads();
                {
                    typedef float f32x16_t __attribute__((ext_vector_type(16)));
                    const int tn = wave >> 1, tk = wave & 1; f32x16_t acc = {};
                    const LAS float* ap = sk_s + (32 * tn + (lane & 31)) * 129 + (lane >> 5); const LAS float* bp = wq_s + (32 * tk + (lane & 31)) * 129 + (lane >> 5);
#pragma unroll 8
                    for (int s = 0; s < 64; ++s) acc = __builtin_amdgcn_mfma_f32_32x32x2f32(ap[2 * s], bp[2 * s], acc, 0, 0, 0);
                    const float gk = g_ffn[k0 + 32 * tk + (lane & 31)];
#pragma unroll
                    for (int r = 0; r < 16; ++r) { const int n = 32 * tn + (r & 3) + 8 * (r >> 2) + 4 * (lane >> 5);
                        WE_T[(size_t)(c * 128 + n) * DM + k0 + 32 * tk + (lane & 31)] = (bf16)(pkbf(acc[r] * gk, 0.f) & 0xffffu); }
                }
                __syncthreads();
            }
        }
#if PEER_FP6
        if (!(ROUTE_TABLES && tail_tables)) peer::tables_fp6(peer_u, peer_v, U8, V8, INVU, INVV, g_ffn, 0, tail_tables ? TAIL_R0 : NEXP, gw, NGW, lane, (LAS float*)(lds + wave * 16384));
#else
        peer::tables_fp8(peer_u, peer_v, U8, V8, INVU, INVV, g_ffn, 0, tail_tables ? TAIL_R0 : NEXP, gw, NGW, lane);
#endif
        }
        }
#ifdef P0_STAMPS
        STAMP();
#endif
        if (vcu == 0) {
            for (int i = tid; i < 64 * 16; i += NWAVES * 64) { const int pos = i >> 4, f = i & 15; const float fr = exp2f(-(float)f * (13.287712379549449f / 16.0f))  ; const float ang = (float)pos * fr; float sn_, cs_; sincosf(ang, &sn_, &cs_); ROPE[2 * i] = cs_; ROPE[2 * i + 1] = sn_; }
            for (int i = tid; i < 8 * 257; i += NWAVES * 64) { const int h = i / 257, rel = i % 257 - 128; BIAS[i] = rel_bias[t5_bucket(rel) * NH + h] * LOG2E; }
        }
#ifdef DIAG_FP6
        if (bx == 0 && tid < 64) {
            typedef float v16f_ __attribute__((ext_vector_type(16))); typedef float v32f_ __attribute__((ext_vector_type(32))); typedef unsigned v6u_ __attribute__((ext_vector_type(6)));
            v16f_ xx, yy;
#pragma unroll
            for (int j = 0; j < 16; ++j) { xx[j] = 0.125f * j * ((lane & 1) ? -1.f : 1.f); yy[j] = (j < 8 ? 2.0f + 0.25f * j : 4.0f + 0.5f * (j - 8)) * ((lane & 2) ? -1.f : 1.f); }
            const v6u_ pk_ = __builtin_amdgcn_cvt_scalef32_2xpk16_fp6_f32(xx, yy, 1.0f);
            const v32f_ rr = __builtin_amdgcn_cvt_scalef32_pk32_f32_fp6(pk_, 1.0f);
            int b0 = 0, b1 = 0, b2 = 0, b3 = 0, b4 = 0;
#pragma unroll
            for (int j = 0; j < 16; ++j) { b0 += (rr[j] != xx[j]) + (rr[16 + j] != yy[j]); b1 += (rr[2 * j] != xx[j]) + (rr[2 * j + 1] != yy[j]); b2 += (rr[j] != yy[j]) + (rr[16 + j] != xx[j]); b3 += (rr[2 * j] != yy[j]) + (rr[2 * j + 1] != xx[j]); }
            const float ratio = rr[17] / yy[1];
#pragma unroll
            for (int j = 0; j < 16; ++j) { b4 += (rr[j] != xx[j] * ratio) + (rr[16 + j] != yy[j] * ratio); }
            int code = b0 == 0 ? 1 : b1 == 0 ? 2 : b2 == 0 ? 3 : b3 == 0 ? 4 : b4 == 0 ? 5 : 0;
            if (DIAG_FP6 == 2) code = (int)(ratio * 8.0f);
            if (DIAG_FP6 == 3) code = b0;
            if (tid == 0) MISC[42] = (unsigned)code;
        }
#endif
        if (BOTH(0) && rep_ == NREP(0) - 1) GRID_BAR();
    }

    if (IN(1)) {
        pg8::Gemm g{XN, WIN_T, NTOK, INW, DM}; pg8::StaticOrder S; S.init(NTOK, INW, G, bx);
        pg8::EpiIn E{QA, KA, VA, QB, KB, VB, GA, GB, q_norm_g, k_norm_g, b_gate, ROPE, RSTDX};
        if (PROBE == 1) { pg8::gemm_phase<pg8::EpiIn, pg8::StaticOrder, true, true>(lds, g, S, E); VM_WAIT(); __syncthreads(); }
        if (PROBE == 11) { pg8::EpiNull EN{SSQ}; pg8::gemm_phase<pg8::EpiNull, pg8::StaticOrder, true, true>(lds, g, S, EN); VM_WAIT(); __syncthreads(); }
#if PEER_FP6
        constexpr int TAIL_MID = TABLES_SPLIT ? (TAIL_R0 + NEXP) / 2 : NEXP;
        if (TABLES_FIRST && tail_tables && bx >= 128) { peer::tables_fp6_pipe(peer_u, peer_v, U8, V8, INVU, INVV, g_ffn, TAIL_R0, TAIL_MID, (bx - 128) * NWAVES + wave, 128 * NWAVES, lane, (LAS float*)(lds + wave * 16384)); LDS_WAIT(); __syncthreads(); }
#endif
        pg8::gemm_phase<pg8::EpiIn, pg8::StaticOrder, true, true>(lds, g, S, E);
#if PEER_FP6
        if (!TABLES_FIRST && tail_tables && bx >= 128) peer::tables_fp6(peer_u, peer_v, U8, V8, INVU, INVV, g_ffn, TAIL_R0, NEXP, (bx - 128) * NWAVES + wave, 128 * NWAVES, lane, (LAS float*)(lds + wave * 16384));
        if ((TABLES_FIRST != 0) && (TABLES_SPLIT != 0) && tail_tables && bx >= 128) { __syncthreads(); peer::tables_fp6_pipe(peer_u, peer_v, U8, V8, INVU, INVV, g_ffn, TAIL_MID, NEXP, (bx - 128) * NWAVES + wave, 128 * NWAVES, lane, (LAS float*)(lds + wave * 16384)); }
#else
        if (tail_tables && bx >= 128) peer::tables_fp8(peer_u, peer_v, U8, V8, INVU, INVV, g_ffn, TAIL_R0, NEXP, (bx - 128) * NWAVES + wave, 128 * NWAVES, lane);
#endif
        if (BOTH(1)) GRID_BAR();
    }

    if (IN(2)) {
#ifdef DIAG_QK
        if (bx == 0) {
            LAS float* red = (LAS float*)lds; float worst = 0.f;
            for (int smp = 0; smp < 10; ++smp) {
                const int row = (smp * 2741 + 77) & (NTOK - 1), b = row >> 12, s = row & (SEQ - 1); const int kind = smp % 5;
                const int hh = (smp * 3 + 1) & 7, kh = smp & 1;
                float ref = 0.f, got = 0.f; const int d = tid & 63;
                if (tid < 64) {
                    int col;
                    if (kind == 0) col = hh * 64 + d; else if (kind == 1) col = 512 + kh * 64 + d; else if (kind == 2) col = (smp < 5 ? 640 : 1408) + kh * 64 + d; else if (kind == 3) col = (smp < 5 ? 768 + hh * 64 : 1280 + kh * 64) + d; else col = (smp < 5 ? 1536 : 2560) + hh * 64 + d;
                    float z = 0.f; for (int k = 0; k < DM; ++k) z += __builtin_bit_cast(float, (unsigned)XN[(size_t)row * DM + k] << 16) * w_in[(size_t)k * INW + col];
                    red[tid] = z;
                }
                __syncthreads();
                if (tid < 64) {
                    float z = red[tid];
                    if (kind == 0 || kind == 1) {
                        float ss = 0.f; for (int i = 0; i < 64; ++i) ss += red[i] * red[i];
                        const float rstd = 1.0f / sqrtf(ss / 64.0f + EPS); const float* g = kind == 0 ? q_norm_g : k_norm_g;
                        const int part = d >> 5, dd = d & 31, f = dd & 15; const int pos = part == 0 ? (s >> 6) : (s & 63);
                        const float ang = (float)pos * powf(10000.0f, -(float)f / 16.0f), cs = cosf(ang), sn = sinf(ang);
                        const float u1 = red[part * 32 + f] * rstd * g[part * 32 + f], u2 = red[part * 32 + 16 + f] * rstd * g[part * 32 + 16 + f];
                        z = dd < 16 ? u1 * cs - u2 * sn : u2 * cs + u1 * sn; if (kind == 0) z *= QSCALE;
                        got = kind == 0 ? __builtin_bit_cast(float, (unsigned)QA[(size_t)row * 1024 + hh * 64 + d] << 16) : __builtin_bit_cast(float, (unsigned)KA[kimg_off(b, kh, s, d)] << 16);
                    } else if (kind == 2) { got = __builtin_bit_cast(float, (unsigned)(smp < 5 ? VA : VB)[vimg_off(b, kh, s, d)] << 16);
                    } else if (kind == 3) { if (smp < 5) { z *= QSCALE; got = __builtin_bit_cast(float, (unsigned)QB[(size_t)row * 1024 + hh * 64 + d] << 16); } else got = __builtin_bit_cast(float, (unsigned)KB[kimg_off(b, kh, s, d)] << 16);
                    } else { z = 1.0f / (1.0f + expf(-(z + b_gate[(smp < 5 ? 0 : DM) + hh * 64 + d]))); got = __builtin_bit_cast(float, (unsigned)(smp < 5 ? GA : GB)[(size_t)row * DM + hh * 64 + d] << 16); }
                    ref = z;
                }
                __syncthreads();
                if (tid < 64) { red[128 + tid] = fabsf(ref - got); red[256 + tid] = fabsf(ref); }
                __syncthreads();
                if (tid == 0) { float e = 0.f, a = 0.f; for (int i = 0; i < 64; ++i) { e = fmaxf(e, red[128 + i]); a = fmaxf(a, red[256 + i]); } const float rel = e / fmaxf(a, 1e-20f); if (DIAG_SEL < 0 || DIAG_SEL == smp) worst = fmaxf(worst, rel); }
                __syncthreads();
            }
            if (tid == 0) MISC[41] = __float_as_uint(worst);
        }
        GRID_BAR();
#endif
        if (PROBE == 21) {
            bf16* DUM = XN;
            for (int u = vcu; u < 512; u += G) { const int xg = u >> 6, i = u & 63; const int b = xg >> 1, h = 4 * (xg & 1) + (i >> 4), qblk = i & 15;
                attn::attn_unit<false, XVAR, true>((LAS char*)lds, QA, KA, VA, DUM, b, h, qblk, nullptr, nullptr); }
        }
        if (PROBE == 22) {
            bf16* DUM = XN;
            for (int u = vcu; u < 512; u += G) { const int xg = u >> 6, i = u & 63;
                attn::attn_unit<true>((LAS char*)lds, QB, KB, VB, DUM, xg >> 1, xg & 1, i, BIAS, sink); }
        }
#ifdef DIAG_ATTN
        {
            bf16* DUM = XN;
            for (int u = vcu; u < 512; u += G) { const int xg = u >> 6, i = u & 63; const int b = xg >> 1, h = 4 * (xg & 1) + (i >> 4), qblk = i & 15;
                attn::attn_unit<false, 0, DIAG_ATTN == 1>((LAS char*)lds, QA, KA, VA, DUM, b, h, qblk, nullptr, nullptr); }
            for (int u = vcu; u < 512; u += G) { const int xg = u >> 6, i = u & 63;
                attn::attn_unit<true>((LAS char*)lds, QB, KB, VB, DUM + 512, xg >> 1, xg & 1, i, BIAS, sink); }
            GRID_BAR();
            if (bx == 0) {
                LAS float* sc = (LAS float*)lds; LAS float* red = (LAS float*)(lds + 32768); float worst = 0.f;
                for (int smp = 0; smp < 12; ++smp) {
                    const int win = smp & 1; const int b = (smp * 7 + 1) & 3, h = (smp * 5 + 3) & 7, q = smp == 1 ? 5 : smp == 3 ? 4090 : smp == 4 ? 4095 : (smp * 977 + 131 * win + (smp == 2 ? 0 : 17)) & 4095; const int kvh = h >> 2;
                    const bf16* Qp = (win ? QB : QA) + ((size_t)b * SEQ + q) * 1024 + h * HD; const bf16* Kp = win ? KB : KA; const bf16* Vp = win ? VB : VA;
                    float mx = -1e30f;
                    for (int j = tid; j < SEQ; j += 512) { float s = 0.f;
                        for (int d = 0; d < HD; ++d) s += __builtin_bit_cast(float, (unsigned)Qp[d] << 16) * __builtin_bit_cast(float, (unsigned)Kp[kimg_off(b, kvh, j, d)] << 16);
                        if (win) { const int rel = j - q; s = (rel >= -128 && rel <= 128) ? s + BIAS[h * 257 + rel + 128] : -1e30f; }
                        sc[j] = s; mx = fmaxf(mx, s); }
                    red[tid] = mx; __syncthreads();
                    if (tid == 0) { float m = -1e30f; for (int i = 0; i < 512; ++i) m = fmaxf(m, red[i]); if (win) m = fmaxf(m, sink[h] * LOG2E); red[512] = m; } __syncthreads();
                    const float m = red[512]; float ls = 0.f;
                    for (int j = tid; j < SEQ; j += 512) { const float p = exp2f(sc[j] - m); sc[j] = p; ls += p; }
                    __syncthreads(); red[tid] = ls; __syncthreads();
                    if (tid == 0) { float l = 0.f; for (int i = 0; i < 512; ++i) l += red[i]; if (win) l += exp2f(sink[h] * LOG2E - m); red[513] = l; } __syncthreads();
                    if (tid < HD) { float o = 0.f; for (int j = 0; j < SEQ; ++j) o += sc[j] * __builtin_bit_cast(float, (unsigned)Vp[vimg_off(b, kvh, j, tid)] << 16);
                        o /= red[513]; const float t = __builtin_bit_cast(float, (unsigned)DUM[((size_t)b * SEQ + q) * 1024 + win * 512 + h * HD + tid] << 16);
                        red[600 + tid] = fabsf(o - t); red[700 + tid] = fabsf(o); }
                    __syncthreads();
                    if (tid == 0) { float e = 0.f, a = 0.f; for (int i = 0; i < HD; ++i) { e = fmaxf(e, red[600 + i]); a = fmaxf(a, red[700 + i]); } const float rel = e / fmaxf(a, 1e-20f); if (DIAG_SEL < 0 || DIAG_SEL == smp) worst = fmaxf(worst, rel); }
                    __syncthreads();
                }
                if (tid == 0) MISC[40] = __float_as_uint(worst);
            }
            GRID_BAR();
        }
#endif
        float lbound;
        { const float gq = tid < HD ? fabsf(q_norm_g[tid]) : 0.f, gk = tid < HD ? fabsf(k_norm_g[tid]) : 0.f;
          const float mq = peer::wave_max(gq), mk = peer::wave_max(gk); LAS float* lb = (LAS float*)(lds + 70000);
          if (tid == 0) lb[0] = 64.0f * mq * mk * QSCALE * 1.02f; __syncthreads(); lbound = lb[0]; __syncthreads(); }
        const bool nomax = lbound <= 100.0f;
        for (int u = vcu; u < 512; u += G) { const int xg = u >> 6, i = u & 63; const int b = xg >> 1, h = 4 * (xg & 1) + (i >> 4), qblk = i & 15;
            if (nomax) attn::attn_unit<false, 0, true>((LAS char*)lds, QA, KA, VA, QA, b, h, qblk, nullptr, nullptr);
            else attn::attn_unit<false>((LAS char*)lds, QA, KA, VA, QA, b, h, qblk, nullptr, nullptr); }
        for (int u = vcu; u < 512; u += G) { const int xg = u >> 6, i = u & 63;
            attn::attn_unit<true>((LAS char*)lds, QB, KB, VB, QB, xg >> 1, xg & 1, i, BIAS, sink); }
        if (BOTH(2)) GRID_BAR();
    }

    if (IN(3)) {
        pg8::Gemm g{QA, WA_T, NTOK, DM, DM}; pg8::StaticOrder S; S.init(NTOK, DM, G, bx); pg8::EpiMix E{GA, GB, MIX};
        if (PROBE == 3) { pg8::EpiMix E2{GA, GB, XN}; pg8::gemm_phase<pg8::EpiMix, pg8::StaticOrder, true, true>(lds, g, S, E2); VM_WAIT(); __syncthreads(); }
        pg8::gemm_phase<pg8::EpiMix, pg8::StaticOrder, true, true>(lds, g, S, E);
        if (BOTH(3)) GRID_BAR();
    }

    if (IN(4)) {
        pg8::Gemm g{MIX, WO_T, NTOK, DM, DM}; pg8::StaticOrder S; S.init(NTOK, DM, G, bx); pg8::EpiOut E{x, XN, SSQ};
#ifdef TSEL2
        if (tid == 0) MISC[48] = (unsigned)__builtin_amdgcn_s_memrealtime();
#endif
#if defined(P4_NULL)
        { pg8::EpiNull EN{SSQ}; pg8::gemm_phase<pg8::EpiNull, pg8::StaticOrder, true, true>(lds, g, S, EN); }
#else
        for (int rep_ = 0; rep_ < NREP(4); ++rep_) pg8::gemm_phase<pg8::EpiOut, pg8::StaticOrder, true, true>(lds, g, S, E);
#endif
#ifdef TSEL2
        if (tid == 0) MISC[49] = (unsigned)__builtin_amdgcn_s_memrealtime();
#endif
        if (BOTH(4)) GRID_BAR();
#ifdef TSEL2
        if (tid == 0) MISC[50] = (unsigned)__builtin_amdgcn_s_memrealtime();
#endif
    }

    if (IN(5)) {
        pg8::Gemm g{XN, WE_T, NTOK, SCW, DM}; pg8::StaticOrder S; S.init(NTOK, SCW, G, bx); pg8::EpiScore E{SSQ, SC};
#if PEER_FP6 && ROUTE_TABLES && P5_TABLES
        const bool p5_first = ((bx >> 3) & 1) != 0; const int p5_w = ((bx >> 4) * 8 + (bx & 7)) * NWAVES + wave, p5_nw = (G / 2) * NWAVES;
        if (tail_tables && p5_first) { peer::tables_fp6_pipe(peer_u, peer_v, U8, V8, INVU, INVV, g_ffn, 0, TAIL_R0 / 2, p5_w, p5_nw, lane, (LAS float*)(lds + wave * 16384)); LDS_WAIT(); __syncthreads(); }
#endif
        for (int rep_ = 0; rep_ < NREP(5); ++rep_) pg8::gemm_phase<pg8::EpiScore, pg8::StaticOrder, (P5_ALIGN_EPI != 0), true>(lds, g, S, E);
#if PEER_FP6 && ROUTE_TABLES && P5_TABLES
        if (tail_tables && !p5_first) { __syncthreads(); peer::tables_fp6_pipe(peer_u, peer_v, U8, V8, INVU, INVV, g_ffn, TAIL_R0 / 2, TAIL_R0, p5_w, p5_nw, lane, (LAS float*)(lds + wave * 16384)); }
#endif
        if (BOTH(5)) GRID_BAR();
    }

    if (IN(6)) {
        LAS char* wl = (LAS char*)lds + wave * peer::WAVE_LDS;
        const unsigned long long ct = peer::cand_table(lane & 7);
        for (int rep_ = 0; rep_ < NREP(60); ++rep_) {
            peer::SCtx sA = peer::s_ctx(lane, gw < NTOK ? gw : 0, SC), sB;
#if PEER_FP6 && ROUTE_TABLES && !P5_TABLES
            LAS float* tscr = (LAS float*)(lds + 16384 + wave * 9216); int tj = 0;
#endif
            for (int t = gw; t < NTOK; t += 2 * NGW) {
                sB = peer::s_ctx(lane, t + NGW < NTOK ? t + NGW : t, SC);
#if PEER_FP6 && ROUTE_TABLES && !P5_TABLES
                const int te = gw + (tj >> 1) * 2 * NGW; const bool tv = tail_tables && te < TAIL_R0; const int tea = tv ? te : 0, teb = (tv && te + NGW < TAIL_R0) ? te + NGW : tea; const bool tu = (tj & 1) == 0;
                const peer::T6Ctx tc = peer::t6_load(tu ? peer_u : peer_v, tea, teb, lane, g_ffn);
#endif
                peer::route_token(wl, lane, t, ct, sA, SSQ, RE, RG, RSTD);
                sA = peer::s_ctx(lane, t + 2 * NGW < NTOK ? t + 2 * NGW : t, SC);
                if (t + NGW < NTOK) peer::route_token(wl, lane, t + NGW, ct, sB, SSQ, RE, RG, RSTD);
#if PEER_FP6 && ROUTE_TABLES && !P5_TABLES
                if (tv) { peer::t6_finish(tc, tu ? U8 : V8, tu ? INVU : INVV, tea, teb, lane, tu, tscr); ++tj; }
#endif
            }
#if PEER_FP6 && ROUTE_TABLES && !P5_TABLES
            if (tail_tables) for (;; ++tj) { const int te = gw + (tj >> 1) * 2 * NGW; if (te >= TAIL_R0) break; const int teb = te + NGW < TAIL_R0 ? te + NGW : te; const bool tu = (tj & 1) == 0;
                peer::table_rows2_fp6(tu ? peer_u : peer_v, tu ? U8 : V8, tu ? INVU : INVV, te, teb, lane, tu ? g_ffn : nullptr, tscr); }
#endif
        }
        GRID_BAR();
        int nloc = 0, nx = 0, ox = 0; const int myx = (int)MISC[13], rank = (int)MISC[12];
#pragma unroll
        for (int j = 0; j < 16; ++j) { const int c = (int)xb_ld((unsigned*)(ws + WS_CTL) + CW_RANK + 64 * j); nx += c > 0; ox += (c > 0 && j < myx); nloc = j == myx ? c : nloc; }
        nloc = __builtin_amdgcn_readfirstlane(nloc); nx = __builtin_amdgcn_readfirstlane(nx); ox = __builtin_amdgcn_readfirstlane(ox);
        const int wv = rank * NWAVES + wave, nwv = nloc * NWAVES;
#if PEER_FP6
        for (int rep_ = 0; rep_ < NREP(61); ++rep_) for (int un = ox; un < 8; un += nx) { const int s = un & 3, hf = un >> 2;
            peer::upass6_slice(lane, s, hf, wv, nwv, U8 + (size_t)s * peer::SLICE6_BYTES, RE, XN, PA); }
#else
        for (int rep_ = 0; rep_ < NREP(61); ++rep_) for (int s = ox; s < 8; s += nx) { const unsigned char* U8s = U8 + (size_t)s * peer::SLICE_BYTES;
            peer::upass_slice(lane, s, wv, nwv, U8s, RE, XN, PA); }
#endif
        GRID_BAR();
#if PEER_FP6 && FUSE_W
        for (int un = ox; un < 8; un += nx) { const int s = un & 3, hf = un >> 2;
            peer::vpass6w_slice(lane, s, hf, wv, nwv, V8 + (size_t)s * peer::SLICE6_BYTES, RE, RG, PA, INVU, INVV, RSTD, (LAS float*)wl, PO2); }
#else
#if PEER_FP6
        for (int t = gw; t < NTOK; t += NGW) peer::wpass6_token(lane, t, RE, RG, PA, INVU, INVV, SSQ, RW);
#else
        for (int rep_ = 0; rep_ < NREP(62); ++rep_) for (int t = gw; t < NTOK; t += NGW) peer::wpass_tokens<1>(lane, t, NGW, RE, RG, PA, INVU, INVV, RSTD, RW);
#endif
        GRID_BAR();
#if PEER_FP6
        for (int un = ox; un < 8; un += nx) { const int s = un & 3, hf = un >> 2;
            for (int rep_ = 0; rep_ < NREP(63); ++rep_) peer::vpass6_slice(lane, s, hf, wv, nwv, V8 + (size_t)s * peer::SLICE6_BYTES, RE, RW, PA); }
#else
        for (int s = ox; s < 8; s += nx) { const unsigned char* V8s = V8 + (size_t)s * peer::SLICE_BYTES;
            for (int rep_ = 0; rep_ < NREP(63); ++rep_) peer::vpass_slice(lane, s, wv, nwv, V8s, RE, RW, PA); }
#endif
#endif
        GRID_BAR();
        if (PROBE == 200) { for (int r_ = 0; r_ < 10; ++r_) GRID_BAR(); }
        #if PEER_FP6 && FUSE_W
        for (int t = gw; t < NTOK; t += NGW) peer::final_token(lane, t, out, XN, PO2, g_final);
#else
        for (int t = gw; t < NTOK; t += 2 * NGW) peer::final_token2(lane, t, t + NGW < NTOK ? t + NGW : t, out, XN, PA, g_final);
#endif
#ifdef DIAG_ATTN
        if (bx == 0 && tid == 0) { VM_WAIT(); out[0] += 1000.0f * __uint_as_float(MISC[40]); }
#endif
#ifdef DIAG_FP6
        if (bx == 0 && tid == 0) { VM_WAIT(); out[0] += 100.0f + 10.0f * (float)MISC[42]; }
#endif
#ifdef TSEL2
        if (bx == TSEL2_BLK && tid == 0) { VM_WAIT(); const unsigned d = MISC[48 + TSEL2 + 1] - MISC[48 + TSEL2]; out[0] += (float)d * TSEL2_SCALE; }
#endif
#ifdef DIAG_QK
        if (bx == 0 && tid == 0) { VM_WAIT(); out[0] += 1000.0f * __uint_as_float(MISC[41]); }
#endif
#ifdef TSEL
        STAMP();
        if (bx == 0 && tid == 0) { VM_WAIT(); const unsigned d = MISC[16 + TSEL + TSEL_SPAN] - MISC[16 + TSEL]; out[0] += (float)((int)d - TSEL_BASE) * TSEL_SCALE; }
#endif
    }
#undef IN
#undef BOTH
#undef GRID_BAR
}

extern "C" void kernel_launch(void* const* d_in, const int* in_sizes, int n_in, void* d_out, int out_size, void* d_ws, size_t ws_size, hipStream_t stream) {
    static int grid = 0;
    if (grid == 0) {
        if (n_in != 17 || in_sizes[0] != NTOK * DM || out_size != NTOK * DM || ws_size < WS_END) { fprintf(stderr, "kernel_launch: unexpected shapes (n_in %d, in0 %d, out %d, ws %zu); nothing launched\n", n_in, n_in > 0 ? in_sizes[0] : -1, out_size, ws_size); grid = -1; return; }
        int dev = 0, cus = 0, per_cu = 0;
        if (hipGetDevice(&dev) != hipSuccess || hipDeviceGetAttribute(&cus, hipDeviceAttributeMultiprocessorCount, dev) != hipSuccess) { grid = -1; return; }
        if (hipFuncSetAttribute((const void*)mk_fwd, hipFuncAttributeMaxDynamicSharedMemorySize, LDS_BYTES) != hipSuccess) { fprintf(stderr, "kernel_launch: hipFuncSetAttribute failed\n"); grid = -1; return; }
        if (hipOccupancyMaxActiveBlocksPerMultiprocessor(&per_cu, (const void*)mk_fwd, NWAVES * 64, LDS_BYTES) != hipSuccess || per_cu < 1) { fprintf(stderr, "kernel_launch: occupancy query says %d blocks per CU; nothing launched\n", per_cu); (void)hipGetLastError(); grid = -1; return; }
        grid = cus;
    }
    if (grid < 0) return;
    if (hipMemsetAsync((char*)d_ws + WS_CTL, 0, CTL_ZERO_BYTES, stream) != hipSuccess) { fprintf(stderr, "kernel_launch: hipMemsetAsync failed\n"); return; }
    Args a{};
    for (int i = 0; i < 17; ++i) a.in[i] = (const float*)d_in[i];
    a.out = (float*)d_out; a.ws = (unsigned char*)d_ws;
    if (N_LAUNCHES == 1) {
        a.ph_lo = 0; a.ph_hi = PER_PHASE; a.li = 0;
#if defined(COOP_LAUNCH)
        void* kargs[] = {&a};
        hipError_t e = hipLaunchCooperativeKernel((const void*)mk_fwd, dim3(grid), dim3(NWAVES * 64), kargs, LDS_BYTES, stream);
        if (e != hipSuccess) fprintf(stderr, "kernel_launch: cooperative launch failed: %s (grid %d)\n", hipGetErrorString(e), grid);
#else
        if (PROBE == 100) { hipLaunchKernelGGL(mk_fwd, dim3(grid), dim3(NWAVES * 64), LDS_BYTES, stream, a); (void)hipMemsetAsync((char*)d_ws + WS_CTL, 0, CTL_ZERO_BYTES, stream); }
        hipLaunchKernelGGL(mk_fwd, dim3(grid), dim3(NWAVES * 64), LDS_BYTES, stream, a);
#endif
    } else {
        for (int li = 0; li < PER_PHASE; ++li) { a.ph_lo = li; a.ph_hi = li + 1; a.li = li;
            hipLaunchKernelGGL(mk_fwd, dim3(grid), dim3(NWAVES * 64), LDS_BYTES, stream, a); }
    }
}
```
